# Optimizing an MI355X kernel written in HIP

```python
import math
import jax
import jax.numpy as jnp
from jax import lax
import numpy as np

D_MODEL = 1024
BATCH = 4
SEQ = 4096
DEPTH = 2

CTX_LEN = 256
GRID_W = 64
N_MIXERS = 4
MIX_W = D_MODEL
GROUP_W = MIX_W // N_MIXERS
HEAD_DIM = 64
ROPE_FREQS = HEAD_DIM // 4
ROPE_BASE = 10000.0
Q_BLOCK = 128
EPS = 1e-6
S5_CH = 16
S5_GROUPS = GROUP_W // S5_CH
S5_STATE = 64
GA_HEADS = GROUP_W // HEAD_DIM
GA_KV = GA_HEADS // 2
SSD_HEADDIM = 64
SSD_HEADS = GROUP_W // SSD_HEADDIM
SSD_NGROUPS = 2
SSD_STATE = 128
SSD_CHUNK = 128
SSD_CONV = 3
SSD_XBC = GROUP_W + 2 * SSD_NGROUPS * SSD_STATE
WA_HEADS = GROUP_W // HEAD_DIM
WA_KV = WA_HEADS // 2
WINDOW = 128
MOE_GROUPS = 4
MOE_PER_GROUP = 8
N_EXPERTS = MOE_GROUPS * MOE_PER_GROUP
MOE_TOPK = 2
D_EXPERT = D_MODEL // 2
MOE_BLOCK = 128
SPLITS = (GROUP_W, GA_HEADS * HEAD_DIM, GA_KV * HEAD_DIM, GA_KV * HEAD_DIM, GROUP_W, SSD_XBC, 2 * SSD_HEADS, WA_HEADS * HEAD_DIM, WA_KV * HEAD_DIM, WA_KV * HEAD_DIM)
D_IN = sum(SPLITS)

kernel_name = 'hybrid_parallel_heads_dit_block'


def rmsnorm(x, g):
    xf = x.astype(jnp.float32)
    y = xf * lax.rsqrt(jnp.mean(xf * xf, axis=-1, keepdims=True) + EPS)
    return (y * g.astype(jnp.float32)).astype(x.dtype)


def _modulate(h, shift, scale):
    return h * (1.0 + scale) + shift


def _heads(t):
    return t.reshape(t.shape[0], t.shape[1], -1, HEAD_DIM)


def _flip(t, rev):
    return jnp.flip(t, axis=1) if rev else t


def rope_tables(n_tok, dtype):
    n_rows = n_tok // GRID_W
    rows = jnp.repeat(jnp.arange(n_rows), GRID_W)
    cols = jnp.tile(jnp.arange(GRID_W), n_rows)
    inv = jnp.power(ROPE_BASE, -jnp.arange(ROPE_FREQS, dtype=jnp.float32) / ROPE_FREQS)
    ang = jnp.stack([rows, cols], axis=-1).astype(jnp.float32)[..., None] * inv
    return jnp.cos(ang).astype(dtype), jnp.sin(ang).astype(dtype)


def apply_rope(x, cos, sin):
    shp = x.shape
    xv = x.reshape(*shp[:-1], 2, 2, ROPE_FREQS)
    rot = jnp.stack([-xv[..., 1, :], xv[..., 0, :]], axis=-2)
    c = cos[:, None, :, None, :]
    s = sin[:, None, :, None, :]
    return (xv * c + rot * s).reshape(shp)


def s5_discretize(lam_re, lam_im, log_dt, b_re, b_im):
    lr = lam_re.astype(jnp.float32)
    li = lam_im.astype(jnp.float32)
    dt = jnp.exp(log_dt.astype(jnp.float32))[:, None]
    mag = jnp.exp(lr * dt)
    a_re = mag * jnp.cos(li * dt)
    a_im = mag * jnp.sin(li * dt)
    den = lr * lr + li * li
    f_re = ((a_re - 1.0) * lr + a_im * li) / den
    f_im = (a_im * lr - (a_re - 1.0) * li) / den
    br = b_re.astype(jnp.float32)
    bi = b_im.astype(jnp.float32)
    bb_re = f_re[..., None] * br - f_im[..., None] * bi
    bb_im = f_re[..., None] * bi + f_im[..., None] * br
    return a_re, a_im, bb_re, bb_im


def _complex_affine_op(e1, e2):
    ar1, ai1, br1, bi1 = e1
    ar2, ai2, br2, bi2 = e2
    return (ar2 * ar1 - ai2 * ai1, ar2 * ai1 + ai2 * ar1,
            ar2 * br1 - ai2 * bi1 + br2, ar2 * bi1 + ai2 * br1 + bi2)


def s5_scan(bu_re, bu_im, a_re, a_im, h0, rev):
    if h0 is not None:
        first = -1 if rev else 0
        bu_re = bu_re.at[:, first].add(a_re * h0[0] - a_im * h0[1])
        bu_im = bu_im.at[:, first].add(a_re * h0[1] + a_im * h0[0])
    ar = jnp.broadcast_to(a_re, bu_re.shape)
    ai = jnp.broadcast_to(a_im, bu_re.shape)
    _, _, hr, hi = lax.associative_scan(_complex_affine_op, (ar, ai, bu_re, bu_im), reverse=rev, axis=1)
    return hr, hi


def _s5_readout(h, c_re, c_im):
    return jnp.einsum('blgp,gcp->blgc', h[0], c_re) - jnp.einsum('blgp,gcp->blgc', h[1], c_im)


def s5_mixer(u_l, u_c, lam_re, lam_im, log_dt, b_re, b_im, c_re, c_im, d_skip, glu_w, glu_b, ctx_out):
    def grp(u):
        return u.astype(jnp.float32).reshape(u.shape[0], u.shape[1], S5_GROUPS, S5_CH)
    ul, uc = grp(u_l), grp(u_c)
    dsk = d_skip.astype(jnp.float32).reshape(S5_GROUPS, S5_CH)
    y_l = ul * dsk
    y_c = uc * dsk
    for d in range(2):
        rev = d == 1
        a_re, a_im, bb_re, bb_im = s5_discretize(lam_re[d], lam_im[d], log_dt[d], b_re[d], b_im[d])
        cr = c_re[d].astype(jnp.float32)
        ci = c_im[d].astype(jnp.float32)
        hc = s5_scan(jnp.einsum('blgc,gpc->blgp', uc, bb_re), jnp.einsum('blgc,gpc->blgp', uc, bb_im), a_re, a_im, None, rev)
        last = 0 if rev else -1
        h_fin = (hc[0][:, last], hc[1][:, last])
        hl = s5_scan(jnp.einsum('blgc,gpc->blgp', ul, bb_re), jnp.einsum('blgc,gpc->blgp', ul, bb_im), a_re, a_im, h_fin, rev)
        y_l = y_l + _s5_readout(hl, cr, ci)
        if ctx_out:
            y_c = y_c + _s5_readout(hc, cr, ci)

    def glu(y, like):
        g = jax.nn.gelu(y.reshape(y.shape[0], y.shape[1], GROUP_W)).astype(like.dtype)
        return g * jax.nn.sigmoid(g @ glu_w + glu_b)
    return glu(y_l, u_l), (glu(y_c, u_c) if ctx_out else None)


def _attend(qb, k, v):
    s = jnp.einsum('bqkgd,bskd->bkgqs', qb, k).astype(jnp.float32) * (HEAD_DIM ** -0.5)
    p = jax.nn.softmax(s, axis=-1).astype(v.dtype)
    return jnp.einsum('bkgqs,bskd->bqkgd', p, v)


def gqa_global(q_l, k_l, v_l, q_c, k_c, v_c, qn_g, kn_g, cos, sin, ctx_out):
    bsz, L = q_l.shape[:2]
    grp = GA_HEADS // GA_KV
    q_l = apply_rope(rmsnorm(q_l, qn_g), cos, sin)
    k_l = apply_rope(rmsnorm(k_l, kn_g), cos, sin)
    q_c = rmsnorm(q_c, qn_g)
    k_c = rmsnorm(k_c, kn_g)
    k_all = jnp.concatenate([k_c, k_l], axis=1)
    v_all = jnp.concatenate([v_c, v_l], axis=1)
    nb = L // Q_BLOCK
    qb = q_l.reshape(bsz, nb, Q_BLOCK, GA_KV, grp, HEAD_DIM).swapaxes(0, 1)
    o = lax.map(lambda qi: _attend(qi, k_all, v_all), qb)
    y_l = o.swapaxes(0, 1).reshape(bsz, L, GROUP_W)
    y_c = None
    if ctx_out:
        lc = q_c.shape[1]
        y_c = _attend(q_c.reshape(bsz, lc, GA_KV, grp, HEAD_DIM), k_c, v_c).reshape(bsz, lc, GROUP_W)
    return y_l, y_c


def depthwise_conv(x, w, b):
    pad = (SSD_CONV - 1) // 2
    y = lax.conv_general_dilated(x, w[:, None, :].astype(x.dtype), window_strides=(1,),
                                 padding=[(pad, SSD_CONV - 1 - pad)],
                                 dimension_numbers=('NWC', 'WIO', 'NWC'),
                                 feature_group_count=x.shape[-1])
    return y + b


def _segsum(a):
    cs = jnp.cumsum(a, axis=-1)
    diff = cs[..., :, None] - cs[..., None, :]
    n = a.shape[-1]
    return jnp.where(jnp.tril(jnp.ones((n, n), dtype=bool)), diff, -jnp.inf)


def ssd_chunked(X, A, Bh, Ch, h0):
    b, l, h, p = X.shape
    n = Bh.shape[-1]
    nc = l // SSD_CHUNK
    X = X.astype(jnp.float32).reshape(b, nc, SSD_CHUNK, h, p)
    Bc = Bh.astype(jnp.float32).reshape(b, nc, SSD_CHUNK, h, n)
    Cc = Ch.astype(jnp.float32).reshape(b, nc, SSD_CHUNK, h, n)
    A = A.astype(jnp.float32).reshape(b, nc, SSD_CHUNK, h).transpose(0, 3, 1, 2)
    A_cum = jnp.cumsum(A, axis=-1)
    scores = jnp.einsum('bclhn,bcshn->bhcls', Cc, Bc) * jnp.exp(_segsum(A))
    y_diag = jnp.einsum('bhcls,bcshp->bclhp', scores, X)
    decay_states = jnp.exp(A_cum[..., -1:] - A_cum)
    states = jnp.einsum('bclhn,bhcl,bclhp->bchpn', Bc, decay_states, X)
    states = jnp.concatenate([h0[:, None], states], axis=1)
    decay_chunk = jnp.exp(_segsum(jnp.pad(A_cum[..., -1], ((0, 0), (0, 0), (1, 0)))))
    states = jnp.einsum('bhzc,bchpn->bzhpn', decay_chunk, states)
    y_off = jnp.einsum('bclhn,bchpn,bhcl->bclhp', Cc, states[:, :-1], jnp.exp(A_cum))
    return (y_diag + y_off).reshape(b, l, h, p), states[:, -1]


def _ssd_dir(x, bm, cm, dt, a, h0, rev):
    y, h_fin = ssd_chunked(_flip(x * dt[..., None], rev), _flip(dt * a, rev), _flip(bm, rev), _flip(cm, rev), h0)
    return _flip(y, rev), h_fin


def ssd_mixer(z_l, xbc_l, dt_l, z_c, xbc_c, dt_c, conv_w, conv_b, dt_bias, a_log, d_skip, norm_g, ctx_out):
    rep = SSD_HEADS // SSD_NGROUPS

    def prep(xbc, dtr):
        xbc = jax.nn.silu(depthwise_conv(xbc, conv_w, conv_b))
        bsz, L = xbc.shape[:2]
        x, bm, cm = jnp.split(xbc, [GROUP_W, GROUP_W + SSD_NGROUPS * SSD_STATE], axis=-1)
        x = x.reshape(bsz, L, SSD_HEADS, SSD_HEADDIM).astype(jnp.float32)
        bm = jnp.repeat(bm.reshape(bsz, L, SSD_NGROUPS, SSD_STATE), rep, axis=2)
        cm = jnp.repeat(cm.reshape(bsz, L, SSD_NGROUPS, SSD_STATE), rep, axis=2)
        dt = jax.nn.softplus(dtr.astype(jnp.float32).reshape(bsz, L, 2, SSD_HEADS) + dt_bias.astype(jnp.float32))
        return x, bm, cm, dt

    xl, bl, cl, dtl = prep(xbc_l, dt_l)
    xc, bc, cc, dtc = prep(xbc_c, dt_c)
    a = -jnp.exp(a_log.astype(jnp.float32))
    dsk = d_skip.astype(jnp.float32)[:, None]
    y_l = xl * dsk
    y_c = xc * dsk
    bsz = xl.shape[0]
    for d in range(2):
        rev = d == 1
        h0 = jnp.zeros((bsz, SSD_HEADS, SSD_HEADDIM, SSD_STATE), jnp.float32)
        yc_d, h_ctx = _ssd_dir(xc, bc, cc, dtc[:, :, d], a[d], h0, rev)
        yl_d, _ = _ssd_dir(xl, bl, cl, dtl[:, :, d], a[d], h_ctx, rev)
        y_l = y_l + yl_d
        if ctx_out:
            y_c = y_c + yc_d

    def gate(y, z):
        y = y.reshape(z.shape).astype(z.dtype)
        return rmsnorm(y * jax.nn.silu(z), norm_g)
    return gate(y_l, z_l), (gate(y_c, z_c) if ctx_out else None)


def _band(t, nb):
    bsz = t.shape[0]
    tp = jnp.pad(t.reshape(bsz, nb, Q_BLOCK, WA_KV, HEAD_DIM), ((0, 0), (1, 1), (0, 0), (0, 0), (0, 0)))
    return jnp.concatenate([tp[:, :-2], tp[:, 1:-1], tp[:, 2:]], axis=2)


def gqa_window(q_l, k_l, v_l, q_c, k_c, v_c, sink, cos, sin, ctx_out):
    bsz, L = q_l.shape[:2]
    lc = k_c.shape[1]
    grp = WA_HEADS // WA_KV
    scale = HEAD_DIM ** -0.5
    nb = L // Q_BLOCK
    q_l = apply_rope(q_l, cos, sin)
    k_l = apply_rope(k_l, cos, sin)
    qb = q_l.reshape(bsz, nb, Q_BLOCK, WA_KV, grp, HEAD_DIM)
    kb, vb = _band(k_l, nb), _band(v_l, nb)
    qpos = jnp.arange(L).reshape(nb, Q_BLOCK)
    kpos = (jnp.arange(nb)[:, None] - 1) * Q_BLOCK + jnp.arange(3 * Q_BLOCK)[None, :]
    valid = ((jnp.abs(qpos[:, :, None] - kpos[:, None, :]) <= WINDOW)
             & (kpos >= 0)[:, None, :] & (kpos < L)[:, None, :])
    s_band = jnp.einsum('bnqkgd,bnskd->bnkgqs', qb, kb).astype(jnp.float32) * scale
    s_band = jnp.where(valid[None, :, None, None], s_band, -jnp.inf)
    s_ctx = jnp.einsum('bnqkgd,bskd->bnkgqs', qb, k_c).astype(jnp.float32) * scale
    sink_f = sink.astype(jnp.float32).reshape(WA_KV, grp, 1, 1)
    sink_l = jnp.broadcast_to(sink_f, s_ctx.shape[:-1] + (1,))
    p = jax.nn.softmax(jnp.concatenate([sink_l, s_ctx, s_band], axis=-1), axis=-1).astype(v_l.dtype)
    o = (jnp.einsum('bnkgqs,bskd->bnqkgd', p[..., 1:1 + lc], v_c)
         + jnp.einsum('bnkgqs,bnskd->bnqkgd', p[..., 1 + lc:], vb))
    y_l = o.reshape(bsz, L, GROUP_W)
    y_c = None
    if ctx_out:
        qc = q_c.reshape(bsz, lc, WA_KV, grp, HEAD_DIM)
        s_cc = jnp.einsum('bqkgd,bskd->bkgqs', qc, k_c).astype(jnp.float32) * scale
        sink_c = jnp.broadcast_to(sink_f, s_cc.shape[:-1] + (1,))
        pc = jax.nn.softmax(jnp.concatenate([sink_c, s_cc], axis=-1), axis=-1).astype(v_c.dtype)
        y_c = jnp.einsum('bkgqs,bskd->bqkgd', pc[..., 1:], v_c).reshape(bsz, lc, GROUP_W)
    return y_l, y_c


def _swiglu(xb, wg, wu, wd):
    return (jax.nn.silu(xb @ wg) * (xb @ wu)) @ wd


def hier_moe(xf, coarse_w, coarse_b, fine_w, fine_b, w_gate, w_up, w_down):
    T, dm = xf.shape
    pc = jax.nn.softmax((xf @ coarse_w + coarse_b).astype(jnp.float32), axis=-1)
    pg, g = lax.top_k(pc, 1)
    fl = (xf @ fine_w + fine_b).astype(jnp.float32).reshape(T, MOE_GROUPS, MOE_PER_GROUP)
    fl = jnp.take_along_axis(fl, g[:, :, None], axis=1)[:, 0]
    tv, ti = lax.top_k(fl, MOE_TOPK)
    w = pg * jax.nn.softmax(tv, axis=-1)
    flat_e = (g * MOE_PER_GROUP + ti).reshape(-1)
    flat_w = w.reshape(-1)
    flat_tok = jnp.repeat(jnp.arange(T), MOE_TOPK)
    n_slots = T * MOE_TOPK
    order = jnp.argsort(flat_e)
    se, stok, sw = flat_e[order], flat_tok[order], flat_w[order]
    counts = jnp.zeros((N_EXPERTS,), jnp.int32).at[flat_e].add(1)
    starts = jnp.cumsum(counts) - counts
    pcounts = (counts + MOE_BLOCK - 1) // MOE_BLOCK * MOE_BLOCK
    pends = jnp.cumsum(pcounts)
    pstarts = pends - pcounts
    dest = pstarts[se] + jnp.arange(n_slots) - starts[se]
    n_blocks = -(-n_slots // MOE_BLOCK) + N_EXPERTS
    buf = jnp.zeros((n_blocks * MOE_BLOCK, dm), xf.dtype).at[dest].set(xf[stok])
    blk_e = jnp.minimum(jnp.searchsorted(pends, jnp.arange(n_blocks) * MOE_BLOCK, side='right'), N_EXPERTS - 1)
    out = lax.map(lambda a: _swiglu(a[0], w_gate[a[1]], w_up[a[1]], w_down[a[1]]),
                  (buf.reshape(n_blocks, MOE_BLOCK, dm), blk_e))
    out = out.reshape(-1, dm)[dest] * sw[:, None].astype(xf.dtype)
    return jax.ops.segment_sum(out, stok, num_segments=T)


def hybrid_layer(xl, xc, c, c_ctx, cos, sin, ada_w, ada_b, norm1_g, norm2_g, w_in, w_out,
                 s5_lam_re, s5_lam_im, s5_log_dt, s5_b_re, s5_b_im, s5_c_re, s5_c_im, s5_d, s5_glu_w, s5_glu_b,
                 ga_qn_g, ga_kn_g, ssd_conv_w, ssd_conv_b, ssd_dt_bias, ssd_a_log, ssd_d, ssd_norm_g, wa_sink,
                 moe_coarse_w, moe_coarse_b, moe_fine_w, moe_fine_b, moe_w_gate, moe_w_up, moe_w_down, ctx_out):
    dm = xl.shape[-1]
    mod_l = (jax.nn.silu(c) @ ada_w + ada_b)[:, None, :]
    mod_c = jax.nn.silu(c_ctx) @ ada_w + ada_b
    sh1, sc1, g1, sh2, sc2, g2 = jnp.split(mod_l, 6, axis=-1)
    csh1, csc1, cg1, csh2, csc2, cg2 = jnp.split(mod_c, 6, axis=-1)
    cuts = [int(v) for v in np.cumsum(SPLITS)[:-1]]
    pl = jnp.split(_modulate(rmsnorm(xl, norm1_g), sh1, sc1) @ w_in, cuts, axis=-1)
    pc = jnp.split(_modulate(rmsnorm(xc, norm1_g), csh1, csc1) @ w_in, cuts, axis=-1)

    a_l, a_c = s5_mixer(pl[0], pc[0], s5_lam_re, s5_lam_im, s5_log_dt, s5_b_re, s5_b_im, s5_c_re, s5_c_im,
                        s5_d, s5_glu_w, s5_glu_b, ctx_out)
    b_l, b_c = gqa_global(_heads(pl[1]), _heads(pl[2]), _heads(pl[3]), _heads(pc[1]), _heads(pc[2]), _heads(pc[3]),
                          ga_qn_g, ga_kn_g, cos, sin, ctx_out)
    m_l, m_c = ssd_mixer(pl[4], pl[5], pl[6], pc[4], pc[5], pc[6], ssd_conv_w, ssd_conv_b, ssd_dt_bias,
                         ssd_a_log, ssd_d, ssd_norm_g, ctx_out)
    w_l, w_c = gqa_window(_heads(pl[7]), _heads(pl[8]), _heads(pl[9]), _heads(pc[7]), _heads(pc[8]), _heads(pc[9]),
                          wa_sink, cos, sin, ctx_out)

    xl = xl + g1 * (jnp.concatenate([a_l, b_l, m_l, w_l], axis=-1) @ w_out)
    hl = _modulate(rmsnorm(xl, norm2_g), sh2, sc2)
    n_lat = hl.shape[0] * hl.shape[1]
    if ctx_out:
        xc = xc + cg1 * (jnp.concatenate([a_c, b_c, m_c, w_c], axis=-1) @ w_out)
        hc = _modulate(rmsnorm(xc, norm2_g), csh2, csc2)
        tokens = jnp.concatenate([hl.reshape(-1, dm), hc.reshape(-1, dm)], axis=0)
    else:
        tokens = hl.reshape(-1, dm)
    f = hier_moe(tokens, moe_coarse_w, moe_coarse_b, moe_fine_w, moe_fine_b, moe_w_gate, moe_w_up, moe_w_down)
    xl = xl + g2 * f[:n_lat].reshape(xl.shape)
    if ctx_out:
        xc = xc + cg2 * f[n_lat:].reshape(xc.shape)
        return xl, xc
    return xl, None


def setup_inputs(seed: int = 0) -> dict:
    key = jax.random.key(seed)
    ks = iter(jax.random.split(key, 64))
    f32 = jnp.float32
    Dm = D_MODEL

    def nrm(shape, s=1.0):
        return jax.random.normal(next(ks), shape, f32) * s

    def unif(shape, lo, hi):
        return jax.random.uniform(next(ks), shape, f32, lo, hi)

    inp = {}
    inp['x'] = nrm((BATCH, SEQ, Dm))
    inp['c'] = nrm((BATCH, Dm))
    inp['ctx'] = nrm((BATCH, CTX_LEN, Dm))
    inp['c_ctx'] = nrm((Dm,))
    inp['ada_w'] = nrm((DEPTH, Dm, 6 * Dm), 0.5 * Dm ** -0.5)
    inp['ada_b'] = nrm((DEPTH, 6 * Dm), 0.02)
    inp['norm1_g'] = 1.0 + nrm((DEPTH, Dm), 0.05)
    inp['norm2_g'] = 1.0 + nrm((DEPTH, Dm), 0.05)
    inp['w_in'] = nrm((DEPTH, Dm, D_IN), Dm ** -0.5)
    inp['w_out'] = nrm((DEPTH, MIX_W, Dm), MIX_W ** -0.5)
    sshape = (DEPTH, 2, S5_GROUPS, S5_STATE)
    inp['s5_lam_re'] = -0.5 + nrm(sshape, 0.01)
    inp['s5_lam_im'] = jnp.pi * jnp.arange(S5_STATE, dtype=f32) + nrm(sshape, 0.01)
    inp['s5_log_dt'] = unif((DEPTH, 2, S5_GROUPS), math.log(1e-3), math.log(1e-1))
    inp['s5_b_re'] = nrm((DEPTH, 2, S5_GROUPS, S5_STATE, S5_CH), (2 * S5_CH) ** -0.5)
    inp['s5_b_im'] = nrm((DEPTH, 2, S5_GROUPS, S5_STATE, S5_CH), (2 * S5_CH) ** -0.5)
    inp['s5_c_re'] = nrm((DEPTH, 2, S5_GROUPS, S5_CH, S5_STATE), S5_STATE ** -0.5)
    inp['s5_c_im'] = nrm((DEPTH, 2, S5_GROUPS, S5_CH, S5_STATE), S5_STATE ** -0.5)
    inp['s5_d'] = nrm((DEPTH, GROUP_W))
    inp['s5_glu_w'] = nrm((DEPTH, GROUP_W, GROUP_W), GROUP_W ** -0.5)
    inp['s5_glu_b'] = nrm((DEPTH, GROUP_W), 0.02)
    inp['ga_qn_g'] = 1.0 + nrm((DEPTH, HEAD_DIM), 0.05)
    inp['ga_kn_g'] = 1.0 + nrm((DEPTH, HEAD_DIM), 0.05)
    inp['ssd_conv_w'] = nrm((DEPTH, SSD_CONV, SSD_XBC), SSD_CONV ** -0.5)
    inp['ssd_conv_b'] = nrm((DEPTH, SSD_XBC), 0.02)
    dt0 = jnp.exp(unif((DEPTH, 2, SSD_HEADS), math.log(1e-3), math.log(1e-1)))
    inp['ssd_dt_bias'] = dt0 + jnp.log(-jnp.expm1(-dt0))
    inp['ssd_a_log'] = jnp.log(unif((DEPTH, 2, SSD_HEADS), 1.0, 16.0))
    inp['ssd_d'] = 1.0 + nrm((DEPTH, SSD_HEADS), 0.1)
    inp['ssd_norm_g'] = 1.0 + nrm((DEPTH, GROUP_W), 0.05)
    inp['wa_sink'] = nrm((DEPTH, WA_HEADS))
    inp['moe_coarse_w'] = nrm((DEPTH, Dm, MOE_GROUPS), Dm ** -0.5)
    inp['moe_coarse_b'] = nrm((DEPTH, MOE_GROUPS), 0.01)
    inp['moe_fine_w'] = nrm((DEPTH, Dm, N_EXPERTS), Dm ** -0.5)
    inp['moe_fine_b'] = nrm((DEPTH, N_EXPERTS), 0.01)
    inp['moe_w_gate'] = nrm((DEPTH, N_EXPERTS, Dm, D_EXPERT), Dm ** -0.5)
    inp['moe_w_up'] = nrm((DEPTH, N_EXPERTS, Dm, D_EXPERT), Dm ** -0.5)
    inp['moe_w_down'] = nrm((DEPTH, N_EXPERTS, D_EXPERT, Dm), D_EXPERT ** -0.5)
    inp['final_g'] = 1.0 + nrm((Dm,), 0.05)
    return inp


def reference(x, c, ctx, c_ctx, ada_w, ada_b, norm1_g, norm2_g, w_in, w_out,
              s5_lam_re, s5_lam_im, s5_log_dt, s5_b_re, s5_b_im, s5_c_re, s5_c_im, s5_d, s5_glu_w, s5_glu_b,
              ga_qn_g, ga_kn_g, ssd_conv_w, ssd_conv_b, ssd_dt_bias, ssd_a_log, ssd_d, ssd_norm_g, wa_sink,
              moe_coarse_w, moe_coarse_b, moe_fine_w, moe_fine_b, moe_w_gate, moe_w_up, moe_w_down, final_g):
    cos, sin = rope_tables(x.shape[1], x.dtype)
    xl, xc = x, ctx
    for i in range(DEPTH):
        xl, xc = hybrid_layer(
            xl, xc, c, c_ctx, cos, sin, ada_w[i], ada_b[i], norm1_g[i], norm2_g[i], w_in[i], w_out[i],
            s5_lam_re[i], s5_lam_im[i], s5_log_dt[i], s5_b_re[i], s5_b_im[i], s5_c_re[i], s5_c_im[i],
            s5_d[i], s5_glu_w[i], s5_glu_b[i], ga_qn_g[i], ga_kn_g[i], ssd_conv_w[i], ssd_conv_b[i],
            ssd_dt_bias[i], ssd_a_log[i], ssd_d[i], ssd_norm_g[i], wa_sink[i],
            moe_coarse_w[i], moe_coarse_b[i], moe_fine_w[i], moe_fine_b[i], moe_w_gate[i], moe_w_up[i],
            moe_w_down[i], i < DEPTH - 1)
    return rmsnorm(xl, final_g)
```

```cpp
#include <hip/hip_runtime.h>
#include <cstdio>
#include <cstdint>

#ifndef MK_SINGLE
#define MK_SINGLE 1
#endif

namespace {
typedef unsigned short bf16;
#define LAS __attribute__((address_space(3)))

constexpr int D = 1024, NB = 4, SEQ = 4096, CTX = 256, LT = SEQ + CTX, NT = NB * LT;
constexpr int DIN = 2312;
constexpr int C_U = 0, C_GQ = 256, C_GK = 512, C_GV = 640, C_Z = 768, C_XBC = 1024, C_DT = 1792, C_WQ = 1800, C_WK = 2056, C_WV = 2184;
constexpr int NEXP = 32, DE = 512;
constexpr int NSLOT = 2 * NT + NEXP * 128;
constexpr float EPS = 1e-6f;
constexpr int NTHR = 256;

constexpr size_t al(size_t x) { return (x + 255) & ~(size_t)255; }
constexpr size_t WS_CTL = 0, CTL_BYTES = 1u << 20;
constexpr size_t WS_MOD = WS_CTL + CTL_BYTES;
constexpr size_t WS_S5A = al(WS_MOD + 2 * 5 * 6144 * 4);
constexpr size_t WS_S5BB = al(WS_S5A + 2 * 2 * 16 * 64 * 2 * 4);
constexpr size_t WS_ROPE = al(WS_S5BB + 2 * 2 * 16 * 64 * 16 * 2 * 4);
constexpr size_t WS_X = al(WS_ROPE + 64 * 16 * 2 * 4);
constexpr size_t WS_HA = al(WS_X + (size_t)NT * D * 4);
constexpr size_t WS_P = al(WS_HA + (size_t)NT * D * 2);
constexpr size_t WS_OUT = WS_P;
constexpr size_t P_BYTES = (size_t)NT * DIN * 4 > (size_t)NSLOT * D * 4 ? (size_t)NT * DIN * 4 : (size_t)NSLOT * D * 4;
constexpr size_t WS_GQ = al(WS_P + P_BYTES);
constexpr size_t WS_GK = al(WS_GQ + (size_t)NT * 256 * 2);
constexpr size_t WS_GV = al(WS_GK + (size_t)NT * 128 * 2);
constexpr size_t WS_WQ = al(WS_GV + (size_t)NT * 128 * 2);
constexpr size_t WS_WK = al(WS_WQ + (size_t)NT * 256 * 2);
constexpr size_t WS_WV = al(WS_WK + (size_t)NT * 128 * 2);
constexpr size_t WS_XBCS = al(WS_WV + (size_t)NT * 128 * 2);
constexpr size_t WS_YS5 = al(WS_XBCS + (size_t)NT * 768 * 2);
constexpr size_t WS_YSSD = al(WS_YS5 + (size_t)2 * NT * 256 * 4);
constexpr size_t WS_G5 = al(WS_YSSD + (size_t)2 * NT * 256 * 4);
constexpr size_t WS_MIX = al(WS_G5 + (size_t)NT * 256 * 2);
constexpr size_t WS_TOKE = al(WS_MIX + (size_t)NT * D * 2);
constexpr size_t WS_TOKP = al(WS_TOKE + (size_t)NT * 2 * 4);
constexpr size_t WS_TOKW = al(WS_TOKP + (size_t)NT * 2 * 4);
constexpr size_t WS_LIST = al(WS_TOKW + (size_t)NT * 2 * 4);
constexpr size_t WS_ACT = al(WS_LIST + (size_t)NEXP * NT * 4);
constexpr size_t WS_END = al(WS_ACT + (size_t)NSLOT * DE * 2);
constexpr int CW_CNT = 64;
constexpr int CW_BAR = 4096;

struct Params {
    const float* in[37];
    float* out;
    unsigned char* ws;
    int ph_lo, ph_hi;
};

__device__ __forceinline__ float bf2f(bf16 v) { return __uint_as_float(((unsigned)v) << 16); }
__device__ __forceinline__ bf16 f2bf(float f) { unsigned u = __float_as_uint(f); return (bf16)((u + 0x7fffu + ((u >> 16) & 1u)) >> 16); }
__device__ __forceinline__ float silu_f(float x) { return x / (1.f + __expf(-x)); }
__device__ __forceinline__ float sigmoid_f(float x) { return 1.f / (1.f + __expf(-x)); }
__device__ __forceinline__ float gelu_tanh(float x) { const float u = 0.7978845608028654f * (x + 0.044715f * x * x * x); return 0.5f * x * (1.f + tanhf(u)); }
__device__ __forceinline__ float softplus_f(float x) { return fmaxf(x, 0.f) + log1pf(__expf(-fabsf(x))); }
__device__ __forceinline__ float wave_sum(float v) {
#pragma unroll
    for (int o = 1; o < 64; o <<= 1) v += __shfl_xor(v, o);
    return v;
}
__device__ __forceinline__ float block_sum(float v, float* red) {
    v = wave_sum(v);
    __syncthreads();
    if ((threadIdx.x & 63) == 0) red[threadIdx.x >> 6] = v;
    __syncthreads();
    return red[0] + red[1] + red[2] + red[3];
}
__device__ __forceinline__ void unpack8(const uint4 v, float (&f)[8]) {
    f[0] = __uint_as_float(v.x << 16); f[1] = __uint_as_float(v.x & 0xffff0000u);
    f[2] = __uint_as_float(v.y << 16); f[3] = __uint_as_float(v.y & 0xffff0000u);
    f[4] = __uint_as_float(v.z << 16); f[5] = __uint_as_float(v.z & 0xffff0000u);
    f[6] = __uint_as_float(v.w << 16); f[7] = __uint_as_float(v.w & 0xffff0000u);
}

#define XB_TMO      128
#define XB_XCNT(j)  (256  + 64 * (j))
#define XB_XSUB(j)  (1280 + 64 * (j))
#define XB_XGEN(j)  (2304 + 64 * (j))
#define XB_TOP      3328
#define XB_TOPGEN   3392
#define XCD_BAR_WORDS 3456
#define XB_SPIN_CAP (1u << 22)
__device__ __forceinline__ unsigned xb_ld(unsigned* p)              { return __hip_atomic_load(p, __ATOMIC_RELAXED, __HIP_MEMORY_SCOPE_AGENT); }
__device__ __forceinline__ unsigned xb_add(unsigned* p, unsigned v) { return __hip_atomic_fetch_add(p, v, __ATOMIC_RELAXED, __HIP_MEMORY_SCOPE_AGENT); }
__device__ __forceinline__ unsigned xb_xcc_id() { return (unsigned)__builtin_amdgcn_s_getreg((3 << 11) | 20) & 0xFu; }
#define XB_SPIN(cond, bar) do { unsigned _sp = 0; while (cond) { __builtin_amdgcn_s_sleep(1); \
    if ((++_sp & 255u) == 0u) { if (xb_ld(&(bar)[XB_TMO])) break; if (_sp > XB_SPIN_CAP) { atomicAdd(&(bar)[XB_TMO], 1u); break; } } } } while (0)
struct XcdBarrier { unsigned* bar; unsigned x; volatile unsigned* st; };
__device__ __forceinline__ XcdBarrier xcd_barrier_post(unsigned* bar, volatile unsigned* st) {
    XcdBarrier b; b.bar = bar; b.x = xb_xcc_id(); b.st = st;
    if (threadIdx.x == 0) (void)xb_add(&bar[XB_XCNT(b.x)], 1u);
    return b;
}
__device__ __forceinline__ void xcd_barrier_complete(unsigned* bar, unsigned x, unsigned& nloc, unsigned& nx) {
    const unsigned G = gridDim.x * gridDim.y * gridDim.z;
    unsigned sum, cnt, mine, sp = 0u;
    for (;;) {
        sum = 0u; cnt = 0u; mine = 0u;
#pragma unroll
        for (unsigned j = 0; j < 16; ++j) { const unsigned c = xb_ld(&bar[XB_XCNT(j)]); sum += c; cnt += (c > 0u) ? 1u : 0u; mine = (j == x) ? c : mine; }
        if (sum == G) break;
        __builtin_amdgcn_s_sleep(1);
        if ((++sp & 255u) == 0u) { if (xb_ld(&bar[XB_TMO])) break; if (sp > XB_SPIN_CAP) { atomicAdd(&bar[XB_TMO], 1u); break; } }
    }
    nloc = mine > 0u ? mine : 1u; nx = cnt > 0u ? cnt : 1u;
}
__device__ __forceinline__ void xcd_barrier(const XcdBarrier& b) {
    asm volatile("s_waitcnt vmcnt(0)" ::: "memory");
    __syncthreads();
    if (threadIdx.x == 0) {
        unsigned* bar = b.bar;
        __builtin_amdgcn_s_waitcnt(0);
        unsigned nloc = b.st[0], nx = b.st[1];
        if (nloc == 0u) { xcd_barrier_complete(bar, b.x, nloc, nx); b.st[0] = nloc; b.st[1] = nx; }
        const unsigned old = xb_add(&bar[XB_XSUB(b.x)], 1u);
        const unsigned gen = old / nloc;
        if (old + 1u == (gen + 1u) * nloc) {
            __builtin_amdgcn_fence(__ATOMIC_RELEASE, "agent");
            asm volatile("s_waitcnt vmcnt(0)" ::: "memory");
            const unsigned og = xb_add(&bar[XB_TOP], 1u);
            const unsigned tg = og / nx;
            if (og + 1u == (tg + 1u) * nx) xb_add(&bar[XB_TOPGEN], 1u);
            else XB_SPIN(xb_ld(&bar[XB_TOPGEN]) == tg, bar);
            __builtin_amdgcn_fence(__ATOMIC_ACQUIRE, "agent");
            xb_add(&bar[XB_XGEN(b.x)], 1u);
            asm volatile("s_waitcnt vmcnt(0)" ::: "memory");
        } else {
            XB_SPIN(xb_ld(&bar[XB_XGEN(b.x)]) == gen, bar);
            __builtin_amdgcn_fence(__ATOMIC_ACQUIRE, "agent");
            asm volatile("s_waitcnt vmcnt(0)" ::: "memory");
        }
    }
    __syncthreads();
}

struct Ctx {
    const Params* p;
    unsigned char* ws;
    float* smf;
    int tid;
    __device__ __forceinline__ const float* in(int i) const { return p->in[i]; }
    template <class T> __device__ __forceinline__ T* w(size_t off) const { return (T*)(ws + off); }
};

__device__ __forceinline__ void ngemm8(const bf16* const (&ar)[8], const float* bcol, int ldb, int K, float (&acc)[8]) {
    for (int k0 = 0; k0 < K; k0 += 8) {
        float w[8];
#pragma unroll
        for (int kk = 0; kk < 8; ++kk) w[kk] = bcol[(size_t)(k0 + kk) * ldb];
#pragma unroll
        for (int r = 0; r < 8; ++r) {
            float a[8]; unpack8(*(const uint4*)(ar[r] + k0), a);
#pragma unroll
            for (int kk = 0; kk < 8; ++kk) acc[r] = fmaf(a[kk], w[kk], acc[r]);
        }
    }
}

__device__ __forceinline__ void ph_prep(const Ctx& c, int gtid, int gthreads) {
    float* MOD = c.w<float>(WS_MOD);
    for (int it = gtid; it < 2 * 6144; it += gthreads) {
        const int l = it / 6144, j = it % 6144;
        const float* aw = c.in(4) + (size_t)l * D * 6144 + j;
        float acc[5] = {0.f, 0.f, 0.f, 0.f, 0.f};
        for (int k = 0; k < D; ++k) {
            const float w = aw[(size_t)k * 6144];
#pragma unroll
            for (int r = 0; r < 4; ++r) acc[r] = fmaf(silu_f(c.in(1)[r * D + k]), w, acc[r]);
            acc[4] = fmaf(silu_f(c.in(3)[k]), w, acc[4]);
        }
        const float bb = c.in(5)[l * 6144 + j];
#pragma unroll
        for (int r = 0; r < 5; ++r) MOD[(l * 5 + r) * 6144 + j] = acc[r] + bb;
    }
    float* S5A = c.w<float>(WS_S5A); float* S5BB = c.w<float>(WS_S5BB);
    for (int it = gtid; it < 2 * 2 * 16 * 64; it += gthreads) {
        const int ldg = it / 64;
        const float lr = c.in(10)[it], li = c.in(11)[it], dt = expf(c.in(12)[ldg]);
        const float mag = expf(lr * dt), are = mag * cosf(li * dt), aim = mag * sinf(li * dt);
        const float den = lr * lr + li * li;
        const float fre = ((are - 1.f) * lr + aim * li) / den, fim = (aim * lr - (are - 1.f) * li) / den;
        S5A[it * 2] = are; S5A[it * 2 + 1] = aim;
        for (int ch = 0; ch < 16; ++ch) {
            const float br = c.in(13)[(size_t)it * 16 + ch], bi = c.in(14)[(size_t)it * 16 + ch];
            S5BB[((size_t)it * 16 + ch) * 2] = fre * br - fim * bi;
            S5BB[((size_t)it * 16 + ch) * 2 + 1] = fre * bi + fim * br;
        }
    }
    float* ROPE = c.w<float>(WS_ROPE);
    for (int it = gtid; it < 64 * 16; it += gthreads) {
        const int pos = it / 16, f = it % 16;
        const float inv = powf(10000.0f, -(float)f / 16.0f);
        const float ang = (float)pos * inv;
        ROPE[it * 2] = cosf(ang); ROPE[it * 2 + 1] = sinf(ang);
    }
    float4* X4 = c.w<float4>(WS_X);
    for (size_t it = gtid; it < (size_t)NT * (D / 4); it += gthreads) {
        const int n = (int)(it / (D / 4)), q = (int)(it % (D / 4));
        const int b = n / LT, pos = n % LT;
        const float4* src = pos < CTX ? (const float4*)(c.in(2) + ((size_t)b * CTX + pos) * D) : (const float4*)(c.in(0) + ((size_t)b * SEQ + (pos - CTX)) * D);
        X4[it] = src[q];
    }
}

__device__ __forceinline__ void ph_norm1(const Ctx& c, int layer, int gw, int nwaves) {
    const int lane = c.tid & 63;
    const float* X = c.w<float>(WS_X); bf16* HA = c.w<bf16>(WS_HA);
    const float* MOD = c.w<float>(WS_MOD) + (size_t)layer * 5 * 6144;
    const float* g = c.in(6) + layer * D;
    for (int n = gw; n < NT; n += nwaves) {
        const int b = n / LT, pos = n % LT, mr = pos < CTX ? 4 : b;
        const float* x = X + (size_t)n * D;
        float v[16]; float ss = 0.f;
#pragma unroll
        for (int i = 0; i < 16; ++i) { v[i] = x[lane + 64 * i]; ss += v[i] * v[i]; }
        const float rstd = rsqrtf(wave_sum(ss) * (1.f / D) + EPS);
#pragma unroll
        for (int i = 0; i < 16; ++i) {
            const int k = lane + 64 * i;
            const float h = v[i] * rstd * g[k] * (1.f + MOD[mr * 6144 + 1024 + k]) + MOD[mr * 6144 + k];
            HA[(size_t)n * D + k] = f2bf(h);
        }
    }
}

__device__ __forceinline__ void ph_inproj(const Ctx& c, int layer, int tile) {
    constexpr int NCB = (DIN + 255) / 256;
    const int rt = tile / NCB, cb = tile % NCB;
    const int j = cb * 256 + c.tid;
    if (j >= DIN) return;
    const bf16* HA = c.w<bf16>(WS_HA);
    const bf16* ar[8];
#pragma unroll
    for (int r = 0; r < 8; ++r) ar[r] = HA + (size_t)(rt * 8 + r) * D;
    float acc[8] = {0.f, 0.f, 0.f, 0.f, 0.f, 0.f, 0.f, 0.f};
    ngemm8(ar, c.in(8) + (size_t)layer * D * DIN + j, DIN, D, acc);
    float* P = c.w<float>(WS_P);
#pragma unroll
    for (int r = 0; r < 8; ++r) P[(size_t)(rt * 8 + r) * DIN + j] = acc[r];
}

__device__ __forceinline__ void ph_post(const Ctx& c, int layer, int n) {
    const int t = c.tid, lane = t & 63, wv = t >> 6;
    const int b = n / LT, pos = n % LT;
    const float* P = c.w<float>(WS_P) + (size_t)n * DIN;
    const float* ROPE = c.w<float>(WS_ROPE);
    const bool lat = pos >= CTX; const int l = pos - CTX;
    float cs = 1.f, sn = 0.f;
    if (lat) { const int a = lane >> 5, f = lane & 15; const int rp = a == 0 ? (l >> 6) : (l & 63); cs = ROPE[(rp * 16 + f) * 2]; sn = ROPE[(rp * 16 + f) * 2 + 1]; }
    const bool h2 = (lane >> 4) & 1;
    {
        float v = P[C_GQ + t];
        const float rstd = rsqrtf(wave_sum(v * v) * (1.f / 64.f) + EPS);
        v = v * rstd * c.in(20)[layer * 64 + lane];
        const float pr = __shfl_xor(v, 16);
        const float o = v * cs + (h2 ? pr : -pr) * sn;
        c.w<bf16>(WS_GQ)[(((size_t)b * 4 + wv) * LT + pos) * 64 + lane] = f2bf(o);
    }
    if (wv < 2) {
        float v = P[C_GK + t];
        const float rstd = rsqrtf(wave_sum(v * v) * (1.f / 64.f) + EPS);
        v = v * rstd * c.in(21)[layer * 64 + lane];
        const float pr = __shfl_xor(v, 16);
        const float o = v * cs + (h2 ? pr : -pr) * sn;
        c.w<bf16>(WS_GK)[(((size_t)b * 2 + wv) * LT + pos) * 64 + lane] = f2bf(o);
    } else {
        const float v = P[C_GV + (t - 128)];
        c.w<bf16>(WS_GV)[(((size_t)b * 2 + (wv - 2)) * LT + pos) * 64 + lane] = f2bf(v);
    }
    {
        const float v = P[C_WQ + t];
        const float pr = __shfl_xor(v, 16);
        const float o = v * cs + (h2 ? pr : -pr) * sn;
        c.w<bf16>(WS_WQ)[(((size_t)b * 4 + wv) * LT + pos) * 64 + lane] = f2bf(o);
    }
    if (wv < 2) {
        const float v = P[C_WK + t];
        const float pr = __shfl_xor(v, 16);
        const float o = v * cs + (h2 ? pr : -pr) * sn;
        c.w<bf16>(WS_WK)[(((size_t)b * 2 + wv) * LT + pos) * 64 + lane] = f2bf(o);
    } else {
        const float v = P[C_WV + (t - 128)];
        c.w<bf16>(WS_WV)[(((size_t)b * 2 + (wv - 2)) * LT + pos) * 64 + lane] = f2bf(v);
    }
    const bool hasL = (pos != 0) && (pos != CTX), hasR = (pos != CTX - 1) && (pos != LT - 1);
    const float* cw = c.in(22) + (size_t)layer * 3 * 768; const float* cb = c.in(23) + layer * 768;
    bf16* XS = c.w<bf16>(WS_XBCS) + (size_t)n * 768;
#pragma unroll
    for (int r = 0; r < 3; ++r) {
        const int ch = r * 256 + t;
        float y = cw[768 + ch] * P[C_XBC + ch] + cb[ch];
        if (hasL) y += cw[ch] * P[C_XBC + ch - DIN];
        if (hasR) y += cw[2 * 768 + ch] * P[C_XBC + ch + DIN];
        XS[ch] = f2bf(silu_f(y));
    }
}

__device__ __forceinline__ void s5_scan_wave(const Ctx& c, int layer, int widx) {
    const int lane = c.tid & 63;
    const int dir = widx & 1, g = (widx >> 1) & 15, b = widx >> 5;
    const int ldg = (layer * 2 + dir) * 16 + g;
    const float* S5A = c.w<float>(WS_S5A) + ((size_t)ldg * 64 + lane) * 2;
    const float are = S5A[0], aim = S5A[1];
    const float* BB = c.w<float>(WS_S5BB) + ((size_t)ldg * 64 + lane) * 32;
    float bre[16], bim[16];
#pragma unroll
    for (int ch = 0; ch < 16; ++ch) { bre[ch] = BB[ch * 2]; bim[ch] = BB[ch * 2 + 1]; }
    const float* cre = c.in(15) + (size_t)ldg * 16 * 64 + lane; const float* cim = c.in(16) + (size_t)ldg * 16 * 64 + lane;
    float cr[16], ci[16];
#pragma unroll
    for (int ch = 0; ch < 16; ++ch) { cr[ch] = cre[ch * 64]; ci[ch] = cim[ch * 64]; }
    const float* P = c.w<float>(WS_P);
    float* Y = c.w<float>(WS_YS5) + (size_t)dir * NT * 256;
    float hr = 0.f, hi = 0.f;
    for (int s = 0; s < LT; ++s) {
        int pos;
        if (dir == 0) pos = s; else pos = s < CTX ? (CTX - 1 - s) : (LT - 1 - (s - CTX));
        const size_t n = (size_t)b * LT + pos;
        const float* u = P + n * DIN + C_U + g * 16;
        float br_ = 0.f, bi_ = 0.f;
#pragma unroll
        for (int ch = 0; ch < 16; ++ch) { const float uv = u[ch]; br_ = fmaf(bre[ch], uv, br_); bi_ = fmaf(bim[ch], uv, bi_); }
        const float nr = are * hr - aim * hi + br_, ni = are * hi + aim * hr + bi_;
        hr = nr; hi = ni;
        float yv = 0.f;
#pragma unroll
        for (int ch = 0; ch < 16; ++ch) {
            const float s_ = wave_sum(hr * cr[ch] - hi * ci[ch]);
            if (lane == ch) yv = s_;
        }
        if (lane < 16) Y[n * 256 + g * 16 + lane] = yv;
    }
}

__device__ __forceinline__ void ssd_scan_block(const Ctx& c, int layer, int bidx) {
    const int t = c.tid;
    const int dir = bidx & 1, h = (bidx >> 1) & 3, b = bidx >> 3;
    const int p = t >> 2, nq = t & 3, grp = h >> 1;
    const float dtb = c.in(24)[(layer * 2 + dir) * 4 + h];
    const float a = -expf(c.in(25)[(layer * 2 + dir) * 4 + h]);
    const float* P = c.w<float>(WS_P);
    const bf16* XS = c.w<bf16>(WS_XBCS);
    float* Y = c.w<float>(WS_YSSD) + (size_t)dir * NT * 256;
    float hs[32];
#pragma unroll
    for (int i = 0; i < 32; ++i) hs[i] = 0.f;
    for (int s = 0; s < LT; ++s) {
        int pos;
        if (dir == 0) pos = s; else pos = s < CTX ? (CTX - 1 - s) : (LT - 1 - (s - CTX));
        const size_t n = (size_t)b * LT + pos;
        const float dtv = softplus_f(P[n * DIN + C_DT + dir * 4 + h] + dtb);
        const float dec = __expf(dtv * a);
        const bf16* xs = XS + n * 768;
        const float xp = bf2f(xs[h * 64 + p]) * dtv;
        float y = 0.f;
#pragma unroll
        for (int q = 0; q < 4; ++q) {
            float Bv[8], Cv[8];
            unpack8(*(const uint4*)(xs + 256 + grp * 128 + nq * 32 + q * 8), Bv);
            unpack8(*(const uint4*)(xs + 512 + grp * 128 + nq * 32 + q * 8), Cv);
#pragma unroll
            for (int i = 0; i < 8; ++i) { const float hv = fmaf(dec, hs[q * 8 + i], xp * Bv[i]); hs[q * 8 + i] = hv; y = fmaf(Cv[i], hv, y); }
        }
        y += __shfl_xor(y, 1); y += __shfl_xor(y, 2);
        if (nq == 0) Y[n * 256 + h * 64 + p] = y;
    }
}

__device__ __forceinline__ void attn_block(const Ctx& c, int layer, int idx) {
    const int t = c.tid;
    const int qt = idx % 17, h = (idx / 17) & 3, b = (idx / 68) & 3, kind = idx / 272;
    const int kvh = h >> 1;
    const bf16* Q = c.w<bf16>(kind ? WS_WQ : WS_GQ) + ((size_t)b * 4 + h) * LT * 64;
    const bf16* K = c.w<bf16>(kind ? WS_WK : WS_GK) + ((size_t)b * 2 + kvh) * LT * 64;
    const bf16* V = c.w<bf16>(kind ? WS_WV : WS_GV) + ((size_t)b * 2 + kvh) * LT * 64;
    const int qpos = qt * 256 + t;
    float q[64], o[64];
#pragma unroll
    for (int i = 0; i < 8; ++i) { float f[8]; unpack8(*(const uint4*)(Q + (size_t)qpos * 64 + i * 8), f);
#pragma unroll
        for (int j = 0; j < 8; ++j) q[i * 8 + j] = f[j] * 0.125f; }
#pragma unroll
    for (int i = 0; i < 64; ++i) o[i] = 0.f;
    float m = -1e30f, l = 0.f;
    if (kind == 1) { m = c.in(28)[layer * 4 + h]; l = 1.f; }
    int k0 = CTX, k1 = CTX;
    if (qt >= 1) {
        if (kind == 0) { k0 = CTX; k1 = LT; }
        else { const int q0 = qt * 256 - 128; k0 = q0 < CTX ? CTX : q0; const int q1 = qt * 256 + 255 + 128 + 1; k1 = q1 > LT ? LT : q1; }
    }
    for (int seg = 0; seg < 2; ++seg) {
        const int ka = seg == 0 ? 0 : k0, kb = seg == 0 ? CTX : k1;
        for (int kk = ka; kk < kb; ++kk) {
            const bool valid = (seg == 0) || (kind == 0) || (abs(kk - qpos) <= 128);
            const bf16* kr = K + (size_t)kk * 64;
            float s = 0.f;
#pragma unroll
            for (int i = 0; i < 8; ++i) { float f[8]; unpack8(*(const uint4*)(kr + i * 8), f);
#pragma unroll
                for (int j = 0; j < 8; ++j) s = fmaf(q[i * 8 + j], f[j], s); }
            if (valid) {
                const float mn = fmaxf(m, s), al_ = __expf(m - mn), pv = __expf(s - mn);
                l = l * al_ + pv; m = mn;
                const bf16* vr = V + (size_t)kk * 64;
#pragma unroll
                for (int i = 0; i < 8; ++i) { float f[8]; unpack8(*(const uint4*)(vr + i * 8), f);
#pragma unroll
                    for (int j = 0; j < 8; ++j) o[i * 8 + j] = fmaf(o[i * 8 + j], al_, pv * f[j]); }
            }
        }
    }
    const float rl = 1.f / l;
    bf16* MIX = c.w<bf16>(WS_MIX) + ((size_t)b * LT + qpos) * D + (kind ? 768 : 256) + h * 64;
#pragma unroll
    for (int i = 0; i < 64; ++i) MIX[i] = f2bf(o[i] * rl);
}

constexpr int MIXER_TILES = 32 + 32 + 544;
__device__ __forceinline__ void ph_mixers(const Ctx& c, int layer, int tile) {
    if (tile < 32) ssd_scan_block(c, layer, tile);
    else if (tile < 64) s5_scan_wave(c, layer, (tile - 32) * 4 + (c.tid >> 6));
    else attn_block(c, layer, tile - 64);
}

__device__ __forceinline__ void ph_gates(const Ctx& c, int layer, int n) {
    const int t = c.tid;
    const float* P = c.w<float>(WS_P) + (size_t)n * DIN;
    const float* Y5 = c.w<float>(WS_YS5); const float* YS = c.w<float>(WS_YSSD);
    {
        const float y = Y5[(size_t)n * 256 + t] + Y5[((size_t)NT + n) * 256 + t] + P[C_U + t] * c.in(17)[layer * 256 + t];
        c.w<bf16>(WS_G5)[(size_t)n * 256 + t] = f2bf(gelu_tanh(y));
    }
    {
        const float x = bf2f(c.w<bf16>(WS_XBCS)[(size_t)n * 768 + t]);
        float y = YS[(size_t)n * 256 + t] + YS[((size_t)NT + n) * 256 + t] + x * c.in(26)[layer * 4 + (t >> 6)];
        y *= silu_f(P[C_Z + t]);
        const float ss = block_sum(y * y, c.smf);
        const float o = y * rsqrtf(ss * (1.f / 256.f) + EPS) * c.in(27)[layer * 256 + t];
        c.w<bf16>(WS_MIX)[(size_t)n * D + 512 + t] = f2bf(o);
    }
}

__device__ __forceinline__ void ph_glu(const Ctx& c, int layer, int rt) {
    const bf16* G5 = c.w<bf16>(WS_G5);
    const bf16* ar[8];
#pragma unroll
    for (int r = 0; r < 8; ++r) ar[r] = G5 + (size_t)(rt * 8 + r) * 256;
    float acc[8] = {0.f, 0.f, 0.f, 0.f, 0.f, 0.f, 0.f, 0.f};
    ngemm8(ar, c.in(18) + (size_t)layer * 256 * 256 + c.tid, 256, 256, acc);
    const float bb = c.in(19)[layer * 256 + c.tid];
#pragma unroll
    for (int r = 0; r < 8; ++r) {
        const size_t n = (size_t)rt * 8 + r;
        const float gv = bf2f(G5[n * 256 + c.tid]);
        c.w<bf16>(WS_MIX)[n * D + c.tid] = f2bf(gv * sigmoid_f(acc[r] + bb));
    }
}

__device__ __forceinline__ void ph_outproj(const Ctx& c, int layer, int tile) {
    const int rt = tile >> 2, j = (tile & 3) * 256 + c.tid;
    const bf16* MIX = c.w<bf16>(WS_MIX);
    const bf16* ar[8];
#pragma unroll
    for (int r = 0; r < 8; ++r) ar[r] = MIX + (size_t)(rt * 8 + r) * D;
    float acc[8] = {0.f, 0.f, 0.f, 0.f, 0.f, 0.f, 0.f, 0.f};
    ngemm8(ar, c.in(9) + (size_t)layer * D * D + j, D, D, acc);
    const float* MOD = c.w<float>(WS_MOD) + (size_t)layer * 5 * 6144;
    float* X = c.w<float>(WS_X);
#pragma unroll
    for (int r = 0; r < 8; ++r) {
        const int n = rt * 8 + r, b = n / LT, pos = n % LT, mr = pos < CTX ? 4 : b;
        X[(size_t)n * D + j] += MOD[mr * 6144 + 2048 + j] * acc[r];
    }
}

__device__ __forceinline__ void ph_norm2(const Ctx& c, int layer, int gw, int nwaves) {
    const int lane = c.tid & 63;
    const float* X = c.w<float>(WS_X); bf16* HA = c.w<bf16>(WS_HA);
    const float* MOD = c.w<float>(WS_MOD) + (size_t)layer * 5 * 6144;
    const float* g = c.in(7) + layer * D;
    const float* cw = c.in(29) + (size_t)layer * D * 4; const float* fw = c.in(31) + (size_t)layer * D * 32;
    unsigned* cnt = c.w<unsigned>(WS_CTL) + CW_CNT + layer * 32;
    for (int n = gw; n < NT; n += nwaves) {
        const int b = n / LT, pos = n % LT, mr = pos < CTX ? 4 : b;
        const float* x = X + (size_t)n * D;
        float v[16]; float ss = 0.f;
#pragma unroll
        for (int i = 0; i < 16; ++i) { v[i] = x[lane + 64 * i]; ss += v[i] * v[i]; }
        const float rstd = rsqrtf(wave_sum(ss) * (1.f / D) + EPS);
        float lg[36];
#pragma unroll
        for (int e = 0; e < 36; ++e) lg[e] = 0.f;
#pragma unroll
        for (int i = 0; i < 16; ++i) {
            const int k = lane + 64 * i;
            const float h = v[i] * rstd * g[k] * (1.f + MOD[mr * 6144 + 4096 + k]) + MOD[mr * 6144 + 3072 + k];
            HA[(size_t)n * D + k] = f2bf(h);
            const float4 c4 = *(const float4*)(cw + (size_t)k * 4);
            lg[0] = fmaf(h, c4.x, lg[0]); lg[1] = fmaf(h, c4.y, lg[1]); lg[2] = fmaf(h, c4.z, lg[2]); lg[3] = fmaf(h, c4.w, lg[3]);
#pragma unroll
            for (int q = 0; q < 8; ++q) { const float4 f4 = *(const float4*)(fw + (size_t)k * 32 + q * 4);
                lg[4 + q * 4] = fmaf(h, f4.x, lg[4 + q * 4]); lg[5 + q * 4] = fmaf(h, f4.y, lg[5 + q * 4]); lg[6 + q * 4] = fmaf(h, f4.z, lg[6 + q * 4]); lg[7 + q * 4] = fmaf(h, f4.w, lg[7 + q * 4]); }
        }
#pragma unroll
        for (int e = 0; e < 36; ++e) lg[e] = wave_sum(lg[e]);
        if (lane == 0) {
            float cl[4]; float mx = -1e30f; int gi = 0;
#pragma unroll
            for (int e = 0; e < 4; ++e) { cl[e] = lg[e] + c.in(30)[layer * 4 + e]; if (cl[e] > mx) { mx = cl[e]; gi = e; } }
            float den = 0.f;
#pragma unroll
            for (int e = 0; e < 4; ++e) den += expf(cl[e] - mx);
            const float pg = 1.f / den;
            float f1 = -1e30f, f2 = -1e30f; int i1 = 0, i2 = 0;
#pragma unroll
            for (int gsel = 0; gsel < 4; ++gsel) if (gsel == gi) {
#pragma unroll
                for (int e = 0; e < 8; ++e) {
                    const float fv = lg[4 + gsel * 8 + e] + c.in(32)[layer * 32 + gsel * 8 + e];
                    if (fv > f1) { f2 = f1; i2 = i1; f1 = fv; i1 = e; } else if (fv > f2) { f2 = fv; i2 = e; }
                }
            }
            const float e2 = expf(f2 - f1), w1 = pg / (1.f + e2), w2 = pg * e2 / (1.f + e2);
            const int ex1 = gi * 8 + i1, ex2 = gi * 8 + i2;
            const unsigned p1 = atomicAdd(&cnt[ex1], 1u), p2 = atomicAdd(&cnt[ex2], 1u);
            int* TE = c.w<int>(WS_TOKE); int* TP = c.w<int>(WS_TOKP); float* TW = c.w<float>(WS_TOKW); int* LI = c.w<int>(WS_LIST);
            TE[n * 2] = ex1; TE[n * 2 + 1] = ex2; TP[n * 2] = (int)p1; TP[n * 2 + 1] = (int)p2; TW[n * 2] = w1; TW[n * 2 + 1] = w2;
            LI[(size_t)ex1 * NT + p1] = n; LI[(size_t)ex2 * NT + p2] = n;
        }
    }
}

__device__ __forceinline__ void moe_offsets(const Ctx& c, int layer, int* sm) {
    __syncthreads();
    if (c.tid == 0) {
        const unsigned* cnt = c.w<unsigned>(WS_CTL) + CW_CNT + layer * 32;
        int acc = 0;
        for (int e = 0; e < 32; ++e) { const int ce = (int)__hip_atomic_load(cnt + e, __ATOMIC_RELAXED, __HIP_MEMORY_SCOPE_AGENT); sm[e] = acc; sm[33 + e] = ce; acc += (ce + 127) & ~127; }
        sm[32] = acc;
    }
    __syncthreads();
}
__device__ __forceinline__ int slot_expert(const int* sm, int slot) { int e = 0;
#pragma unroll 1
    for (int i = 1; i < 32; ++i) if (slot >= sm[i]) e = i;
    return e; }

__device__ __forceinline__ void ph_moe1(const Ctx& c, int layer, int tile, const int* sm) {
    const int st = tile >> 1, j = (tile & 1) * 256 + c.tid;
    const int s0 = st * 8;
    if (s0 >= sm[32]) return;
    const int e = slot_expert(sm, s0), base = s0 - sm[e], ce = sm[33 + e];
    if (base >= ce) return;
    const bf16* HA = c.w<bf16>(WS_HA); const int* LI = c.w<int>(WS_LIST) + (size_t)e * NT;
    const bf16* ar[8];
#pragma unroll
    for (int r = 0; r < 8; ++r) { const int tok = (base + r < ce) ? LI[base + r] : LI[base]; ar[r] = HA + (size_t)tok * D; }
    float ag[8] = {0.f, 0.f, 0.f, 0.f, 0.f, 0.f, 0.f, 0.f}, au[8] = {0.f, 0.f, 0.f, 0.f, 0.f, 0.f, 0.f, 0.f};
    ngemm8(ar, c.in(33) + ((size_t)layer * NEXP + e) * D * DE + j, DE, D, ag);
    ngemm8(ar, c.in(34) + ((size_t)layer * NEXP + e) * D * DE + j, DE, D, au);
    bf16* ACT = c.w<bf16>(WS_ACT);
#pragma unroll
    for (int r = 0; r < 8; ++r) if (base + r < ce) ACT[(size_t)(s0 + r) * DE + j] = f2bf(silu_f(ag[r]) * au[r]);
}
__device__ __forceinline__ void ph_moe2(const Ctx& c, int layer, int tile, const int* sm) {
    const int st = tile >> 2, j = (tile & 3) * 256 + c.tid;
    const int s0 = st * 8;
    if (s0 >= sm[32]) return;
    const int e = slot_expert(sm, s0), base = s0 - sm[e], ce = sm[33 + e];
    if (base >= ce) return;
    const bf16* ACT = c.w<bf16>(WS_ACT);
    const bf16* ar[8];
#pragma unroll
    for (int r = 0; r < 8; ++r) ar[r] = ACT + (size_t)((base + r < ce) ? (s0 + r) : s0) * DE;
    float acc[8] = {0.f, 0.f, 0.f, 0.f, 0.f, 0.f, 0.f, 0.f};
    ngemm8(ar, c.in(35) + ((size_t)layer * NEXP + e) * DE * D + j, D, DE, acc);
    float* OUT = c.w<float>(WS_OUT);
#pragma unroll
    for (int r = 0; r < 8; ++r) if (base + r < ce) OUT[(size_t)(s0 + r) * D + j] = acc[r];
}

__device__ __forceinline__ void ph_combine(const Ctx& c, int layer, int n, const int* sm) {
    const int t = c.tid;
    const int b = n / LT, pos = n % LT, mr = pos < CTX ? 4 : b;
    const int* TE = c.w<int>(WS_TOKE); const int* TP = c.w<int>(WS_TOKP); const float* TW = c.w<float>(WS_TOKW);
    const int s0 = sm[TE[n * 2]] + TP[n * 2], s1 = sm[TE[n * 2 + 1]] + TP[n * 2 + 1];
    const float w0 = TW[n * 2], w1 = TW[n * 2 + 1];
    const float* OUT = c.w<float>(WS_OUT);
    const float* MOD = c.w<float>(WS_MOD) + (size_t)layer * 5 * 6144 + mr * 6144 + 5120;
    float* X = c.w<float>(WS_X) + (size_t)n * D;
    float v[4]; float ss = 0.f;
#pragma unroll
    for (int i = 0; i < 4; ++i) {
        const int k = t + 256 * i;
        v[i] = X[k] + MOD[k] * (w0 * OUT[(size_t)s0 * D + k] + w1 * OUT[(size_t)s1 * D + k]);
        X[k] = v[i]; ss += v[i] * v[i];
    }
    if (layer == 1 && pos >= CTX) {
        ss = block_sum(ss, c.smf);
        const float rstd = rsqrtf(ss * (1.f / D) + EPS);
        float* o = c.p->out + ((size_t)b * SEQ + (pos - CTX)) * D;
#pragma unroll
        for (int i = 0; i < 4; ++i) { const int k = t + 256 * i; o[k] = v[i] * rstd * c.in(36)[k]; }
    }
}

constexpr int PH_PER_LAYER = 11, N_PHASES = 1 + 2 * PH_PER_LAYER;

__global__ void __launch_bounds__(NTHR) mk_fwd(Params prm) {
    __shared__ __attribute__((aligned(16))) float smem[128];
    Ctx c; c.p = &prm; c.ws = prm.ws; c.smf = smem; c.tid = threadIdx.x;
    const int G = gridDim.x, bid = blockIdx.x;
    const int gtid = bid * NTHR + c.tid, gthreads = G * NTHR;
    const int gw = gtid >> 6, nwaves = gthreads >> 6;
    int* smi = (int*)(smem + 16);
#if MK_SINGLE
    volatile unsigned* bst = (volatile unsigned*)(smem + 120);
    if (c.tid == 0) { bst[0] = 0u; bst[1] = 0u; }
    __syncthreads();
    XcdBarrier bar = xcd_barrier_post(c.w<unsigned>(WS_CTL) + CW_BAR, bst);
#endif
    for (int ph = prm.ph_lo; ph < prm.ph_hi; ++ph) {
        if (ph == 0) ph_prep(c, gtid, gthreads);
        else {
            const int layer = (ph - 1) / PH_PER_LAYER, sp = (ph - 1) % PH_PER_LAYER;
            switch (sp) {
            case 0: ph_norm1(c, layer, gw, nwaves); break;
            case 1: for (int t = bid; t < (NT / 8) * 10; t += G) ph_inproj(c, layer, t); break;
            case 2: for (int t = bid; t < NT; t += G) ph_post(c, layer, t); break;
            case 3: for (int t = bid; t < MIXER_TILES; t += G) ph_mixers(c, layer, t); break;
            case 4: for (int t = bid; t < NT; t += G) ph_gates(c, layer, t); break;
            case 5: for (int t = bid; t < NT / 8; t += G) ph_glu(c, layer, t); break;
            case 6: for (int t = bid; t < (NT / 8) * 4; t += G) ph_outproj(c, layer, t); break;
            case 7: ph_norm2(c, layer, gw, nwaves); break;
            case 8: moe_offsets(c, layer, smi); for (int t = bid; t < (NSLOT / 8) * 2; t += G) ph_moe1(c, layer, t, smi); break;
            case 9: moe_offsets(c, layer, smi); for (int t = bid; t < (NSLOT / 8) * 4; t += G) ph_moe2(c, layer, t, smi); break;
            case 10: moe_offsets(c, layer, smi); for (int t = bid; t < NT; t += G) ph_combine(c, layer, t, smi); break;
            }
        }
#if MK_SINGLE
        if (ph + 1 < prm.ph_hi) xcd_barrier(bar);
#endif
    }
}
}

extern "C" void kernel_launch(void* const* d_in, const int* in_sizes, int n_in, void* d_out, int out_size, void* d_ws, size_t ws_size, hipStream_t stream) {
    static int grid = 0;
    if (grid == 0) {
        if (n_in != 37 || ws_size < WS_END) { fprintf(stderr, "kernel_launch: need 37 inputs and %zu bytes of workspace; got %d, %zu\n", (size_t)WS_END, n_in, ws_size); grid = -1; return; }
        int dev = 0, cus = 0, per_cu = 0;
        hipGetDevice(&dev); hipDeviceGetAttribute(&cus, hipDeviceAttributeMultiprocessorCount, dev);
        if (hipOccupancyMaxActiveBlocksPerMultiprocessor(&per_cu, (const void*)mk_fwd, NTHR, 0) != hipSuccess || per_cu < 1) per_cu = 1;
        if (per_cu > 4) per_cu = 4;
        grid = cus * per_cu;
    }
    if (grid < 0) return;
    hipMemsetAsync((char*)d_ws + WS_CTL, 0, CTL_BYTES, stream);
    Params p{};
    for (int i = 0; i < 37; ++i) p.in[i] = (const float*)d_in[i];
    p.out = (float*)d_out; p.ws = (unsigned char*)d_ws;
#if MK_SINGLE
    p.ph_lo = 0; p.ph_hi = N_PHASES;
    void* args[] = {&p};
    hipError_t e = hipLaunchCooperativeKernel((const void*)mk_fwd, dim3(grid), dim3(NTHR), args, 0, stream);
    if (e != hipSuccess) fprintf(stderr, "cooperative launch failed: %s (grid %d)\n", hipGetErrorString(e), grid);
#else
    for (int ph = 0; ph < N_PHASES; ++ph) {
        p.ph_lo = ph; p.ph_hi = ph + 1;
        hipLaunchKernelGGL(mk_fwd, dim3(grid), dim3(NTHR), 0, stream, p);
    }
#endif
}
```

```cpp
#include <hip/hip_runtime.h>
#include <cstdio>
#include <cstdint>

#ifndef MK_SINGLE
#define MK_SINGLE 1
#endif

namespace {
typedef unsigned short bf16;
#define LAS __attribute__((address_space(3)))

constexpr int D = 1024, NB = 4, SEQ = 4096, CTX = 256, LT = SEQ + CTX, NT = NB * LT;
constexpr int DIN = 2312;
constexpr int C_U = 0, C_GQ = 256, C_GK = 512, C_GV = 640, C_Z = 768, C_XBC = 1024, C_DT = 1792, C_WQ = 1800, C_WK = 2056, C_WV = 2184;
constexpr int NEXP = 32, DE = 512;
constexpr int NSLOT = 2 * NT + NEXP * 128;
constexpr float EPS = 1e-6f;
constexpr int NTHR = 256;

constexpr size_t al(size_t x) { return (x + 255) & ~(size_t)255; }
constexpr size_t WS_CTL = 0, CTL_BYTES = 1u << 20;
constexpr size_t WS_MOD = WS_CTL + CTL_BYTES;
constexpr size_t WS_S5A = al(WS_MOD + 2 * 5 * 6144 * 4);
constexpr size_t WS_S5BB = al(WS_S5A + 2 * 2 * 16 * 64 * 2 * 4);
constexpr size_t WS_ROPE = al(WS_S5BB + 2 * 2 * 16 * 64 * 16 * 2 * 4);
constexpr size_t WS_X = al(WS_ROPE + 64 * 16 * 2 * 4);
constexpr size_t WS_HA = al(WS_X + (size_t)NT * D * 4);
constexpr size_t WS_P = al(WS_HA + (size_t)NT * D * 2);
constexpr size_t WS_OUT = WS_P;
constexpr size_t P_BYTES = (size_t)NT * DIN * 2 > (size_t)NSLOT * D * 2 ? (size_t)NT * DIN * 2 : (size_t)NSLOT * D * 2;
constexpr size_t WS_GQ = al(WS_P + P_BYTES);
constexpr size_t WS_GK = al(WS_GQ + (size_t)NT * 256 * 2);
constexpr size_t WS_GV = al(WS_GK + (size_t)NT * 128 * 2);
constexpr size_t WS_WQ = al(WS_GV + (size_t)NT * 128 * 2);
constexpr size_t WS_WK = al(WS_WQ + (size_t)NT * 256 * 2);
constexpr size_t WS_WV = al(WS_WK + (size_t)NT * 128 * 2);
constexpr size_t WS_XBCS = al(WS_WV + (size_t)NT * 128 * 2);
constexpr size_t WS_YSSD = al(WS_XBCS + (size_t)NT * 768 * 2);
constexpr size_t WS_G5 = al(WS_YSSD + (size_t)NT * 256 * 4);
constexpr size_t WS_MIX = al(WS_G5 + (size_t)NT * 256 * 2);
constexpr size_t WS_TOKE = al(WS_MIX + (size_t)NT * D * 2);
constexpr size_t WS_TOKP = al(WS_TOKE + (size_t)NT * 2 * 4);
constexpr size_t WS_TOKW = al(WS_TOKP + (size_t)NT * 2 * 4);
constexpr size_t WS_LIST = al(WS_TOKW + (size_t)NT * 2 * 4);
constexpr size_t WS_ACT = al(WS_LIST + (size_t)NEXP * NT * 4);
constexpr size_t WS_DTR = al(WS_ACT + (size_t)NSLOT * DE * 2);
constexpr int NCH5 = NT / 32;
constexpr size_t WS_S5P = al(WS_DTR + (size_t)NT * 8 * 4);
constexpr size_t WS_KLAG = al(WS_S5P + (size_t)2 * 2 * 16 * 64 * 33 * 2 * 4);
constexpr size_t WS_WY = al(WS_KLAG + (size_t)2 * 16 * 2 * 32 * 256 * 4);
constexpr size_t WS_WS = al(WS_WY + (size_t)2 * 16 * 768 * 512 * 2);
constexpr size_t WS_UH = al(WS_WS + (size_t)2 * 16 * 512 * 256 * 2);
constexpr size_t WS_SALL = al(WS_UH + (size_t)16 * NCH5 * 768 * 2);
constexpr int NCH = LT / 128;
constexpr size_t WS_XT = al(WS_SALL + (size_t)16 * NCH5 * 256 * 4);
constexpr size_t WS_BT = al(WS_XT + (size_t)NB * 256 * LT * 2);
constexpr size_t WS_ST = al(WS_BT + (size_t)NB * 256 * LT * 2);
constexpr size_t WS_HIN = al(WS_ST + (size_t)NB * NCH * 8 * 8192 * 4);
constexpr size_t WS_TOT = al(WS_HIN + (size_t)NB * NCH * 8 * 8192 * 2);
constexpr size_t WS_END = al(WS_TOT + (size_t)NB * NCH * 8 * 4);
constexpr int CW_CNT = 64;
constexpr int CW_BAR = 4096;

struct Params {
    const float* in[37];
    float* out;
    unsigned char* ws;
    int ph_lo, ph_hi;
};

typedef short bf16x8 __attribute__((ext_vector_type(8)));
typedef short s16x4 __attribute__((ext_vector_type(4)));
typedef float f32x4 __attribute__((ext_vector_type(4)));
typedef unsigned u32x4 __attribute__((ext_vector_type(4)));
__device__ __forceinline__ float bf2f(bf16 v) { return __uint_as_float(((unsigned)v) << 16); }
__device__ __forceinline__ bf16 f2bf(float f) { unsigned u = __float_as_uint(f); return (bf16)((u + 0x7fffu + ((u >> 16) & 1u)) >> 16); }
__device__ __forceinline__ float silu_f(float x) { return x / (1.f + __expf(-x)); }
__device__ __forceinline__ float sigmoid_f(float x) { return 1.f / (1.f + __expf(-x)); }
__device__ __forceinline__ float gelu_tanh(float x) { const float u = 0.7978845608028654f * (x + 0.044715f * x * x * x); return 0.5f * x * (1.f + tanhf(u)); }
__device__ __forceinline__ float softplus_f(float x) { return fmaxf(x, 0.f) + log1pf(__expf(-fabsf(x))); }
__device__ __forceinline__ float wave_sum(float v) {
#pragma unroll
    for (int o = 1; o < 64; o <<= 1) v += __shfl_xor(v, o);
    return v;
}
__device__ __forceinline__ float block_sum(float v, float* red) {
    v = wave_sum(v);
    __syncthreads();
    if ((threadIdx.x & 63) == 0) red[threadIdx.x >> 6] = v;
    __syncthreads();
    return red[0] + red[1] + red[2] + red[3];
}
__device__ __forceinline__ void unpack8(const uint4 v, float (&f)[8]) {
    f[0] = __uint_as_float(v.x << 16); f[1] = __uint_as_float(v.x & 0xffff0000u);
    f[2] = __uint_as_float(v.y << 16); f[3] = __uint_as_float(v.y & 0xffff0000u);
    f[4] = __uint_as_float(v.z << 16); f[5] = __uint_as_float(v.z & 0xffff0000u);
    f[6] = __uint_as_float(v.w << 16); f[7] = __uint_as_float(v.w & 0xffff0000u);
}

#define XB_TMO      128
#define XB_XCNT(j)  (256  + 64 * (j))
#define XB_XSUB(j)  (1280 + 64 * (j))
#define XB_XGEN(j)  (2304 + 64 * (j))
#define XB_TOP      3328
#define XB_TOPGEN   3392
#define XCD_BAR_WORDS 3456
#define XB_SPIN_CAP (1u << 22)
__device__ __forceinline__ unsigned xb_ld(unsigned* p)              { return __hip_atomic_load(p, __ATOMIC_RELAXED, __HIP_MEMORY_SCOPE_AGENT); }
__device__ __forceinline__ unsigned xb_add(unsigned* p, unsigned v) { return __hip_atomic_fetch_add(p, v, __ATOMIC_RELAXED, __HIP_MEMORY_SCOPE_AGENT); }
__device__ __forceinline__ unsigned xb_xcc_id() { return (unsigned)__builtin_amdgcn_s_getreg((3 << 11) | 20) & 0xFu; }
#define XB_SPIN(cond, bar) do { unsigned _sp = 0; while (cond) { __builtin_amdgcn_s_sleep(1); \
    if ((++_sp & 255u) == 0u) { if (xb_ld(&(bar)[XB_TMO])) break; if (_sp > XB_SPIN_CAP) { atomicAdd(&(bar)[XB_TMO], 1u); break; } } } } while (0)
struct XcdBarrier { unsigned* bar; unsigned x; volatile unsigned* st; };
__device__ __forceinline__ XcdBarrier xcd_barrier_post(unsigned* bar, volatile unsigned* st) {
    XcdBarrier b; b.bar = bar; b.x = xb_xcc_id(); b.st = st;
    if (threadIdx.x == 0) (void)xb_add(&bar[XB_XCNT(b.x)], 1u);
    return b;
}
__device__ __forceinline__ void xcd_barrier_complete(unsigned* bar, unsigned x, unsigned& nloc, unsigned& nx) {
    const unsigned G = gridDim.x * gridDim.y * gridDim.z;
    unsigned sum, cnt, mine, sp = 0u;
    for (;;) {
        sum = 0u; cnt = 0u; mine = 0u;
#pragma unroll
        for (unsigned j = 0; j < 16; ++j) { const unsigned c = xb_ld(&bar[XB_XCNT(j)]); sum += c; cnt += (c > 0u) ? 1u : 0u; mine = (j == x) ? c : mine; }
        if (sum == G) break;
        __builtin_amdgcn_s_sleep(1);
        if ((++sp & 255u) == 0u) { if (xb_ld(&bar[XB_TMO])) break; if (sp > XB_SPIN_CAP) { atomicAdd(&bar[XB_TMO], 1u); break; } }
    }
    nloc = mine > 0u ? mine : 1u; nx = cnt > 0u ? cnt : 1u;
}
__device__ __forceinline__ void xcd_barrier(const XcdBarrier& b) {
    asm volatile("s_waitcnt vmcnt(0)" ::: "memory");
    __syncthreads();
    if (threadIdx.x == 0) {
        unsigned* bar = b.bar;
        __builtin_amdgcn_s_waitcnt(0);
        unsigned nloc = b.st[0], nx = b.st[1];
        if (nloc == 0u) { xcd_barrier_complete(bar, b.x, nloc, nx); b.st[0] = nloc; b.st[1] = nx; }
        const unsigned old = xb_add(&bar[XB_XSUB(b.x)], 1u);
        const unsigned gen = old / nloc;
        if (old + 1u == (gen + 1u) * nloc) {
            __builtin_amdgcn_fence(__ATOMIC_RELEASE, "agent");
            asm volatile("s_waitcnt vmcnt(0)" ::: "memory");
            const unsigned og = xb_add(&bar[XB_TOP], 1u);
            const unsigned tg = og / nx;
            if (og + 1u == (tg + 1u) * nx) xb_add(&bar[XB_TOPGEN], 1u);
            else XB_SPIN(xb_ld(&bar[XB_TOPGEN]) == tg, bar);
            __builtin_amdgcn_fence(__ATOMIC_ACQUIRE, "agent");
            xb_add(&bar[XB_XGEN(b.x)], 1u);
            asm volatile("s_waitcnt vmcnt(0)" ::: "memory");
        } else {
            XB_SPIN(xb_ld(&bar[XB_XGEN(b.x)]) == gen, bar);
            __builtin_amdgcn_fence(__ATOMIC_ACQUIRE, "agent");
            asm volatile("s_waitcnt vmcnt(0)" ::: "memory");
        }
    }
    __syncthreads();
}

#define CAS __attribute__((address_space(4)))
struct Ctx {
    const CAS Params* p;
    float* smf;
    int tid;
    __device__ __forceinline__ const float* in(int i) const { return p->in[i]; }
    __device__ __forceinline__ float* out() const { return p->out; }
    template <class T> __device__ __forceinline__ T* w(size_t off) const { return (T*)(p->ws + off); }
};

__device__ __forceinline__ void ngemm8(const bf16* const (&ar)[8], const float* bcol, int ldb, int K, float (&acc)[8]) {
    for (int k0 = 0; k0 < K; k0 += 8) {
        float w[8];
#pragma unroll
        for (int kk = 0; kk < 8; ++kk) w[kk] = bcol[(size_t)(k0 + kk) * ldb];
#pragma unroll
        for (int r = 0; r < 8; ++r) {
            float a[8]; unpack8(*(const uint4*)(ar[r] + k0), a);
#pragma unroll
            for (int kk = 0; kk < 8; ++kk) acc[r] = fmaf(a[kk], w[kk], acc[r]);
        }
    }
}

__device__ __forceinline__ void ph_prep(const Ctx& c, int gtid, int gthreads) {
    float* MOD = c.w<float>(WS_MOD);
    for (int it = gtid; it < 2 * 6144; it += gthreads) {
        const int l = it / 6144, j = it % 6144;
        const float* aw = c.in(4) + (size_t)l * D * 6144 + j;
        float acc[5] = {0.f, 0.f, 0.f, 0.f, 0.f};
        for (int k = 0; k < D; ++k) {
            const float w = aw[(size_t)k * 6144];
#pragma unroll
            for (int r = 0; r < 4; ++r) acc[r] = fmaf(silu_f(c.in(1)[r * D + k]), w, acc[r]);
            acc[4] = fmaf(silu_f(c.in(3)[k]), w, acc[4]);
        }
        const float bb = c.in(5)[l * 6144 + j];
#pragma unroll
        for (int r = 0; r < 5; ++r) MOD[(l * 5 + r) * 6144 + j] = acc[r] + bb;
    }
    float* S5A = c.w<float>(WS_S5A); float* S5BB = c.w<float>(WS_S5BB);
    for (int it = gtid; it < 2 * 2 * 16 * 64; it += gthreads) {
        const int ldg = it / 64;
        const float lr = c.in(10)[it], li = c.in(11)[it], dt = expf(c.in(12)[ldg]);
        const float mag = expf(lr * dt), are = mag * cosf(li * dt), aim = mag * sinf(li * dt);
        const float den = lr * lr + li * li;
        const float fre = ((are - 1.f) * lr + aim * li) / den, fim = (aim * lr - (are - 1.f) * li) / den;
        S5A[it * 2] = are; S5A[it * 2 + 1] = aim;
        for (int ch = 0; ch < 16; ++ch) {
            const float br = c.in(13)[(size_t)it * 16 + ch], bi = c.in(14)[(size_t)it * 16 + ch];
            S5BB[((size_t)it * 16 + ch) * 2] = fre * br - fim * bi;
            S5BB[((size_t)it * 16 + ch) * 2 + 1] = fre * bi + fim * br;
        }
    }
    float* S5P = c.w<float>(WS_S5P);
    for (int it = gtid; it < 2 * 2 * 16 * 64 * 33; it += gthreads) {
        const int ldgp = it / 33, k = it % 33;
        const float lr = c.in(10)[ldgp], li = c.in(11)[ldgp], dt = expf(c.in(12)[ldgp / 64]);
        const float e = expf((float)k * lr * dt), ang = (float)k * li * dt;
        S5P[it * 2] = e * cosf(ang); S5P[it * 2 + 1] = e * sinf(ang);
    }
    float* KLAG = c.w<float>(WS_KLAG);
    for (int it = gtid; it < 2 * 16 * 2 * 256 * 4; it += gthreads) {
        const int kq = it & 3, cp = (it >> 2) & 15, cc = (it >> 6) & 15, d = (it >> 10) & 1, g = (it >> 11) & 15, l = it >> 15;
        const int ldg = (l * 2 + d) * 16 + g;
        const float dt = expf(c.in(12)[ldg]);
        float acc[8] = {0.f, 0.f, 0.f, 0.f, 0.f, 0.f, 0.f, 0.f};
        for (int p = 0; p < 64; ++p) {
            const int ldgp = ldg * 64 + p;
            const float lr = c.in(10)[ldgp], li = c.in(11)[ldgp];
            const float mag = expf(lr * dt), are = mag * cosf(li * dt), aim = mag * sinf(li * dt);
            const float den = lr * lr + li * li;
            const float fre = ((are - 1.f) * lr + aim * li) / den, fim = (aim * lr - (are - 1.f) * li) / den;
            const float br = c.in(13)[(size_t)ldgp * 16 + cp], bi = c.in(14)[(size_t)ldgp * 16 + cp];
            const float bbr = fre * br - fim * bi, bbi = fre * bi + fim * br;
            const float cr = c.in(15)[(size_t)ldg * 1024 + cc * 64 + p], ci = c.in(16)[(size_t)ldg * 1024 + cc * 64 + p];
            float zr = cr * bbr - ci * bbi, zi = cr * bbi + ci * bbr;
            const float e0 = expf((float)(8 * kq) * lr * dt), a0 = (float)(8 * kq) * li * dt, pr = e0 * cosf(a0), pi = e0 * sinf(a0);
            { const float tr = zr * pr - zi * pi, ti = zr * pi + zi * pr; zr = tr; zi = ti; }
#pragma unroll
            for (int kk = 0; kk < 8; ++kk) { acc[kk] += zr; const float tr = zr * are - zi * aim, ti = zr * aim + zi * are; zr = tr; zi = ti; }
        }
#pragma unroll
        for (int kk = 0; kk < 8; ++kk) KLAG[((size_t)((l * 16 + g) * 2 + d) * 32 + 8 * kq + kk) * 256 + cc * 16 + cp] = acc[kk];
    }
    float* ROPE = c.w<float>(WS_ROPE);
    for (int it = gtid; it < 64 * 16; it += gthreads) {
        const int pos = it / 16, f = it % 16;
        const float inv = powf(10000.0f, -(float)f / 16.0f);
        const float ang = (float)pos * inv;
        ROPE[it * 2] = cosf(ang); ROPE[it * 2 + 1] = sinf(ang);
    }
    float4* X4 = c.w<float4>(WS_X);
    for (size_t it = gtid; it < (size_t)NT * (D / 4); it += gthreads) {
        const int n = (int)(it / (D / 4)), q = (int)(it % (D / 4));
        const int b = n / LT, pos = n % LT;
        const float4* src = pos < CTX ? (const float4*)(c.in(2) + ((size_t)b * CTX + pos) * D) : (const float4*)(c.in(0) + ((size_t)b * SEQ + (pos - CTX)) * D);
        X4[it] = src[q];
    }
}

__device__ __forceinline__ void ph_norm1(const Ctx& c, int layer, int gw, int nwaves) {
    const int lane = c.tid & 63;
    const float* X = c.w<float>(WS_X); bf16* HA = c.w<bf16>(WS_HA);
    const float* MOD = c.w<float>(WS_MOD) + (size_t)layer * 5 * 6144;
    const float* g = c.in(6) + layer * D;
    for (int n = gw; n < NT; n += nwaves) {
        const int b = n / LT, pos = n % LT, mr = pos < CTX ? 4 : b;
        const float* x = X + (size_t)n * D;
        float v[16]; float ss = 0.f;
#pragma unroll
        for (int i = 0; i < 16; ++i) { v[i] = x[lane + 64 * i]; ss += v[i] * v[i]; }
        const float rstd = rsqrtf(wave_sum(ss) * (1.f / D) + EPS);
#pragma unroll
        for (int i = 0; i < 16; ++i) {
            const int k = lane + 64 * i;
            const float h = v[i] * rstd * g[k] * (1.f + MOD[mr * 6144 + 1024 + k]) + MOD[mr * 6144 + k];
            HA[(size_t)n * D + k] = f2bf(h);
        }
    }
}

__device__ __forceinline__ void ph_post(const Ctx& c, int layer, int n) {
    const int t = c.tid, lane = t & 63, wv = t >> 6;
    const int b = n / LT, pos = n % LT;
    const bf16* P = c.w<bf16>(WS_P) + (size_t)n * DIN;
    const float* ROPE = c.w<float>(WS_ROPE);
    const bool lat = pos >= CTX; const int l = pos - CTX;
    float cs = 1.f, sn = 0.f;
    if (lat) { const int a = lane >> 5, f = lane & 15; const int rp = a == 0 ? (l >> 6) : (l & 63); cs = ROPE[(rp * 16 + f) * 2]; sn = ROPE[(rp * 16 + f) * 2 + 1]; }
    const bool h2 = (lane >> 4) & 1;
    {
        float v = bf2f(P[C_GQ + t]);
        const float rstd = rsqrtf(wave_sum(v * v) * (1.f / 64.f) + EPS);
        v = v * rstd * c.in(20)[layer * 64 + lane];
        const float pr = __shfl_xor(v, 16);
        const float o = v * cs + (h2 ? pr : -pr) * sn;
        c.w<bf16>(WS_GQ)[(((size_t)b * 4 + wv) * LT + pos) * 64 + lane] = f2bf(o * 0.18033688011112042f);
    }
    if (wv < 2) {
        float v = bf2f(P[C_GK + t]);
        const float rstd = rsqrtf(wave_sum(v * v) * (1.f / 64.f) + EPS);
        v = v * rstd * c.in(21)[layer * 64 + lane];
        const float pr = __shfl_xor(v, 16);
        const float o = v * cs + (h2 ? pr : -pr) * sn;
        c.w<bf16>(WS_GK)[(((size_t)b * 2 + wv) * LT + pos) * 64 + lane] = f2bf(o);
    } else {
        const float v = bf2f(P[C_GV + (t - 128)]);
        c.w<bf16>(WS_GV)[(((size_t)b * 2 + (wv - 2)) * 64 + lane) * LT + pos] = f2bf(v);
    }
    {
        const float v = bf2f(P[C_WQ + t]);
        const float pr = __shfl_xor(v, 16);
        const float o = v * cs + (h2 ? pr : -pr) * sn;
        c.w<bf16>(WS_WQ)[(((size_t)b * 4 + wv) * LT + pos) * 64 + lane] = f2bf(o * 0.18033688011112042f);
    }
    if (wv < 2) {
        const float v = bf2f(P[C_WK + t]);
        const float pr = __shfl_xor(v, 16);
        const float o = v * cs + (h2 ? pr : -pr) * sn;
        c.w<bf16>(WS_WK)[(((size_t)b * 2 + wv) * LT + pos) * 64 + lane] = f2bf(o);
    } else {
        const float v = bf2f(P[C_WV + (t - 128)]);
        c.w<bf16>(WS_WV)[(((size_t)b * 2 + (wv - 2)) * 64 + lane) * LT + pos] = f2bf(v);
    }
    { const int J = b * 136 + (pos >> 5), tt = pos & 31;
      c.w<bf16>(WS_UH)[((size_t)(t >> 4) * NCH5 + J) * 768 + tt * 16 + (t & 15)] = P[C_U + t]; }
    const bool hasL = (pos != 0) && (pos != CTX), hasR = (pos != CTX - 1) && (pos != LT - 1);
    const float* cw = c.in(22) + (size_t)layer * 3 * 768; const float* cb = c.in(23) + layer * 768;
    bf16* XS = c.w<bf16>(WS_XBCS) + (size_t)n * 768;
#pragma unroll
    for (int r = 0; r < 3; ++r) {
        const int ch = r * 256 + t;
        float y = cw[768 + ch] * bf2f(P[C_XBC + ch]) + cb[ch];
        if (hasL) y += cw[ch] * bf2f(P[C_XBC + ch - DIN]);
        if (hasR) y += cw[2 * 768 + ch] * bf2f(P[C_XBC + ch + DIN]);
        const bf16 yv = f2bf(silu_f(y));
        XS[ch] = yv;
        if (r == 0) c.w<bf16>(WS_XT)[((size_t)b * 256 + t) * LT + pos] = yv;
        if (r == 1) c.w<bf16>(WS_BT)[((size_t)b * 256 + t) * LT + pos] = yv;
    }
}

__device__ __forceinline__ void ph_gates(const Ctx& c, int layer, int n) {
    const int t = c.tid;
    const bf16* P = c.w<bf16>(WS_P) + (size_t)n * DIN;
    const float* YS = c.w<float>(WS_YSSD);
    {
        const float x = bf2f(c.w<bf16>(WS_XBCS)[(size_t)n * 768 + t]);
        float y = YS[(size_t)n * 256 + t] + x * c.in(26)[layer * 4 + (t >> 6)];
        y *= silu_f(bf2f(P[C_Z + t]));
        const float ss = block_sum(y * y, c.smf);
        const float o = y * rsqrtf(ss * (1.f / 256.f) + EPS) * c.in(27)[layer * 256 + t];
        c.w<bf16>(WS_MIX)[(size_t)n * D + 512 + t] = f2bf(o);
    }
}

__device__ __forceinline__ void ph_norm2(const Ctx& c, int layer, int gw, int nwaves) {
    const int lane = c.tid & 63;
    const float* X = c.w<float>(WS_X); bf16* HA = c.w<bf16>(WS_HA);
    const float* MOD = c.w<float>(WS_MOD) + (size_t)layer * 5 * 6144;
    const float* g = c.in(7) + layer * D;
    const float* cw = c.in(29) + (size_t)layer * D * 4; const float* fw = c.in(31) + (size_t)layer * D * 32;
    unsigned* cnt = c.w<unsigned>(WS_CTL) + CW_CNT + layer * 32;
    for (int n = gw; n < NT; n += nwaves) {
        const int b = n / LT, pos = n % LT, mr = pos < CTX ? 4 : b;
        const float* x = X + (size_t)n * D;
        float v[16]; float ss = 0.f;
#pragma unroll
        for (int i = 0; i < 16; ++i) { v[i] = x[lane + 64 * i]; ss += v[i] * v[i]; }
        const float rstd = rsqrtf(wave_sum(ss) * (1.f / D) + EPS);
        float hv[16]; float cg[4] = {0.f, 0.f, 0.f, 0.f};
#pragma unroll
        for (int i = 0; i < 16; ++i) {
            const int k = lane + 64 * i;
            const float h = v[i] * rstd * g[k] * (1.f + MOD[mr * 6144 + 4096 + k]) + MOD[mr * 6144 + 3072 + k];
            hv[i] = h;
            HA[(size_t)n * D + k] = f2bf(h);
            const f32x4 c4 = *(const f32x4*)(cw + (size_t)k * 4);
            cg[0] = fmaf(h, c4[0], cg[0]); cg[1] = fmaf(h, c4[1], cg[1]); cg[2] = fmaf(h, c4[2], cg[2]); cg[3] = fmaf(h, c4[3], cg[3]);
        }
        float mx = -1e30f; int gi = 0; float cl[4];
#pragma unroll
        for (int e = 0; e < 4; ++e) { cl[e] = wave_sum(cg[e]) + c.in(30)[layer * 4 + e]; if (cl[e] > mx) { mx = cl[e]; gi = e; } }
        gi = __builtin_amdgcn_readfirstlane(gi);
        float fg[8] = {0.f, 0.f, 0.f, 0.f, 0.f, 0.f, 0.f, 0.f};
#pragma unroll
        for (int i = 0; i < 16; ++i) {
            const int k = lane + 64 * i;
            const f32x4 f0 = *(const f32x4*)(fw + (size_t)k * 32 + gi * 8), f1_ = *(const f32x4*)(fw + (size_t)k * 32 + gi * 8 + 4);
#pragma unroll
            for (int q = 0; q < 4; ++q) { fg[q] = fmaf(hv[i], f0[q], fg[q]); fg[4 + q] = fmaf(hv[i], f1_[q], fg[4 + q]); }
        }
#pragma unroll
        for (int e = 0; e < 8; ++e) fg[e] = wave_sum(fg[e]);
        if (lane == 0) {
            float den = 0.f;
#pragma unroll
            for (int e = 0; e < 4; ++e) den += expf(cl[e] - mx);
            const float pg = 1.f / den;
            float f1 = -1e30f, f2 = -1e30f; int i1 = 0, i2 = 0;
#pragma unroll
            for (int e = 0; e < 8; ++e) {
                const float fv = fg[e] + c.in(32)[layer * 32 + gi * 8 + e];
                if (fv > f1) { f2 = f1; i2 = i1; f1 = fv; i1 = e; } else if (fv > f2) { f2 = fv; i2 = e; }
            }
            const float e2 = expf(f2 - f1), w1 = pg / (1.f + e2), w2 = pg * e2 / (1.f + e2);
            const int ex1 = gi * 8 + i1, ex2 = gi * 8 + i2;
            const unsigned p1 = atomicAdd(&cnt[ex1], 1u), p2 = atomicAdd(&cnt[ex2], 1u);
            int* TE = c.w<int>(WS_TOKE); int* TP = c.w<int>(WS_TOKP); float* TW = c.w<float>(WS_TOKW); int* LI = c.w<int>(WS_LIST);
            TE[n * 2] = ex1; TE[n * 2 + 1] = ex2; TP[n * 2] = (int)p1; TP[n * 2 + 1] = (int)p2; TW[n * 2] = w1; TW[n * 2 + 1] = w2;
            LI[(size_t)ex1 * NT + p1] = n; LI[(size_t)ex2 * NT + p2] = n;
        }
    }
}

__device__ __forceinline__ void moe_offsets(const Ctx& c, int layer, int* sm) {
    __syncthreads();
    if (c.tid == 0) {
        const unsigned* cnt = c.w<unsigned>(WS_CTL) + CW_CNT + layer * 32;
        int acc = 0;
        for (int e = 0; e < 32; ++e) { const int ce = (int)__hip_atomic_load(cnt + e, __ATOMIC_RELAXED, __HIP_MEMORY_SCOPE_AGENT); sm[e] = acc; sm[33 + e] = ce; acc += (ce + 127) & ~127; }
        sm[32] = acc;
    }
    __syncthreads();
}
__device__ __forceinline__ int slot_expert(const int* sm, int slot) { int e = 0;
#pragma unroll 1
    for (int i = 1; i < 32; ++i) if (slot >= sm[i]) e = i;
    return e; }

__device__ __forceinline__ void ph_combine(const Ctx& c, int layer, int n, const int* sm) {
    const int t = c.tid;
    const int b = n / LT, pos = n % LT, mr = pos < CTX ? 4 : b;
    const int* TE = c.w<int>(WS_TOKE); const int* TP = c.w<int>(WS_TOKP); const float* TW = c.w<float>(WS_TOKW);
    const int s0 = sm[TE[n * 2]] + TP[n * 2], s1 = sm[TE[n * 2 + 1]] + TP[n * 2 + 1];
    const float w0 = TW[n * 2], w1 = TW[n * 2 + 1];
    const bf16* OUT = c.w<bf16>(WS_OUT);
    const float* MOD = c.w<float>(WS_MOD) + (size_t)layer * 5 * 6144 + mr * 6144 + 5120;
    float* X = c.w<float>(WS_X) + (size_t)n * D;
    float v[4]; float ss = 0.f;
#pragma unroll
    for (int i = 0; i < 4; ++i) {
        const int k = t + 256 * i;
        v[i] = X[k] + MOD[k] * (w0 * bf2f(OUT[(size_t)s0 * D + k]) + w1 * bf2f(OUT[(size_t)s1 * D + k]));
        X[k] = v[i]; ss += v[i] * v[i];
    }
    if (layer == 1 && pos >= CTX) {
        ss = block_sum(ss, c.smf);
        const float rstd = rsqrtf(ss * (1.f / D) + EPS);
        float* o = c.out() + ((size_t)b * SEQ + (pos - CTX)) * D;
#pragma unroll
        for (int i = 0; i < 4; ++i) { const int k = t + 256 * i; o[k] = v[i] * rstd * c.in(36)[k]; }
    }
}


typedef LAS const char* lds_cptr;
constexpr int GEMM_LDS = 32768;
__device__ __forceinline__ unsigned pk2bf(float lo, float hi) { return (unsigned)f2bf(lo) | ((unsigned)f2bf(hi) << 16); }
__device__ __forceinline__ s16x4 lds_tr(lds_cptr p) { return __builtin_bit_cast(s16x4, __builtin_amdgcn_ds_read_tr16_b64_v4i16((LAS s16x4*)p)); }

template <bool B_F32, class ARow>
__device__ __forceinline__ void gemm_tile(const int tid, unsigned char* lds, ARow arow, const void* Bp  , int ldb, bool bval, int K, f32x4 (&acc)[4][4]) {
    const int lane = tid & 63, wid = tid >> 6, wr = wid >> 1, wc = wid & 1, fr = lane & 15, fq = lane >> 4;
#pragma unroll
    for (int m = 0; m < 4; ++m)
#pragma unroll
        for (int n = 0; n < 4; ++n) acc[m][n] = (f32x4){0.f, 0.f, 0.f, 0.f};
    const bf16* ap[4];
#pragma unroll
    for (int i = 0; i < 4; ++i) ap[i] = arow((tid >> 3) + 32 * i) + (tid & 7) * 8;
    const int bk = tid >> 4, bnc = tid & 15;
    u32x4 ra[4]; u32x4 rb[4]; f32x4 rbf[8];
    auto gload = [&](int kt) __attribute__((always_inline)) {
#pragma unroll
        for (int i = 0; i < 4; ++i) ra[i] = *(const u32x4*)(ap[i] + kt * 64);
        if (B_F32) {
            const float* bp = (const float*)Bp + (size_t)(kt * 64 + bk) * ldb;
#pragma unroll
            for (int i = 0; i < 4; ++i) {
                if (bval) { rbf[2 * i] = *(const f32x4*)(bp + (size_t)(16 * i) * ldb); rbf[2 * i + 1] = *(const f32x4*)(bp + (size_t)(16 * i) * ldb + 4); }
                else { rbf[2 * i] = (f32x4){0.f, 0.f, 0.f, 0.f}; rbf[2 * i + 1] = rbf[2 * i]; }
            }
        } else {
            const bf16* bp = (const bf16*)Bp + (size_t)(kt * 64 + bk) * ldb;
#pragma unroll
            for (int i = 0; i < 4; ++i) rb[i] = bval ? *(const u32x4*)(bp + (size_t)(16 * i) * ldb) : (u32x4){0u, 0u, 0u, 0u};
        }
    };
    auto lstore = [&]() __attribute__((always_inline)) {
#pragma unroll
        for (int i = 0; i < 4; ++i) { const int row = (tid >> 3) + 32 * i, kc = tid & 7;
            *(u32x4*)(lds + (kc >> 2) * 8192 + row * 64 + (kc & 3) * 16) = ra[i]; }
#pragma unroll
        for (int i = 0; i < 4; ++i) { const int k = bk + 16 * i;
            u32x4 v;
            if (B_F32) { v.x = pk2bf(rbf[2 * i].x, rbf[2 * i].y); v.y = pk2bf(rbf[2 * i].z, rbf[2 * i].w); v.z = pk2bf(rbf[2 * i + 1].x, rbf[2 * i + 1].y); v.w = pk2bf(rbf[2 * i + 1].z, rbf[2 * i + 1].w); }
            else v = rb[i];
            *(u32x4*)(lds + 16384 + ((k >> 3) * 8 + (bnc >> 1)) * 256 + (k & 7) * 32 + (bnc & 1) * 16) = v; }
    };
    const lds_cptr la = (lds_cptr)lds + (wr * 64 + fr) * 64 + fq * 16;
    const lds_cptr lb = (lds_cptr)lds + 16384 + (fq * 8 + wc * 4) * 256 + (fr >> 2) * 32 + (fr & 3) * 8;
    const int nk = K / 64;
    gload(0);
    for (int kt = 0; kt < nk; ++kt) {
        __syncthreads();
        lstore();
        __syncthreads();
        if (kt + 1 < nk) gload(kt + 1);
#pragma unroll
        for (int kh = 0; kh < 2; ++kh) {
            bf16x8 af[4], bfr[4];
#pragma unroll
            for (int m = 0; m < 4; ++m) af[m] = *(const LAS bf16x8*)(la + kh * 8192 + m * 1024);
#pragma unroll
            for (int n = 0; n < 4; ++n) {
                const s16x4 lo = lds_tr(lb + kh * 8192 + n * 256), hi = lds_tr(lb + kh * 8192 + n * 256 + 128);
                bfr[n] = (bf16x8){lo[0], lo[1], lo[2], lo[3], hi[0], hi[1], hi[2], hi[3]};
            }
#pragma unroll
            for (int m = 0; m < 4; ++m)
#pragma unroll
                for (int n = 0; n < 4; ++n) acc[m][n] = __builtin_amdgcn_mfma_f32_16x16x32_bf16(bfr[n], af[m], acc[m][n], 0, 0, 0);
        }
    }
}

__device__ __forceinline__ void ph_inproj_mfma(const Ctx& c, int layer, int tile, unsigned char* lds) {
    const int mt = tile / 19, nt = tile % 19;
    const bf16* HA = c.w<bf16>(WS_HA) + (size_t)mt * 128 * D;
    f32x4 acc[4][4];
    const int bc = nt * 128 + (c.tid & 15) * 8;
    gemm_tile<true>(c.tid, lds, [&](int r) __attribute__((always_inline)) { return HA + (size_t)r * D; }, c.in(8) + (size_t)layer * D * DIN + bc, DIN, bc < DIN, D, acc);
    const int lane = c.tid & 63, wid = c.tid >> 6, wr = wid >> 1, wc = wid & 1, fr = lane & 15, fq = lane >> 4;
    bf16* P = c.w<bf16>(WS_P); float* DTR = c.w<float>(WS_DTR);
#pragma unroll
    for (int m = 0; m < 4; ++m)
#pragma unroll
        for (int n = 0; n < 4; ++n) {
            const int row = mt * 128 + wr * 64 + m * 16 + fr, col = nt * 128 + wc * 64 + n * 16 + fq * 4;
            if (col < DIN) { uint2 o; o.x = pk2bf(acc[m][n][0], acc[m][n][1]); o.y = pk2bf(acc[m][n][2], acc[m][n][3]); *(uint2*)(P + (size_t)row * DIN + col) = o; }
            if (col >= C_DT && col < C_DT + 8) *(f32x4*)(DTR + (size_t)row * 8 + (col - C_DT)) = acc[m][n];
        }
}


#define EPI_COORDS const int lane = c.tid & 63, wid = c.tid >> 6, wr = wid >> 1, wc = wid & 1, fr = lane & 15, fq = lane >> 4
__device__ __forceinline__ void ph_glu_mfma(const Ctx& c, int layer, int tile, unsigned char* lds) {
    const int mt = tile >> 1, nt = tile & 1;
    const bf16* G5 = c.w<bf16>(WS_G5) + (size_t)mt * 128 * 256;
    f32x4 acc[4][4];
    const int bc = nt * 128 + (c.tid & 15) * 8;
    gemm_tile<true>(c.tid, lds, [&](int r) __attribute__((always_inline)) { return G5 + (size_t)r * 256; }, c.in(18) + (size_t)layer * 256 * 256 + bc, 256, true, 256, acc);
    EPI_COORDS;
    bf16* MIX = c.w<bf16>(WS_MIX);
#pragma unroll
    for (int m = 0; m < 4; ++m)
#pragma unroll
        for (int n = 0; n < 4; ++n) {
            const int rl = wr * 64 + m * 16 + fr, col = nt * 128 + wc * 64 + n * 16 + fq * 4;
            const f32x4 bb = *(const f32x4*)(c.in(19) + layer * 256 + col);
            const uint2 gv = *(const uint2*)(G5 + (size_t)rl * 256 + col);
            const float g0 = __uint_as_float(gv.x << 16), g1 = __uint_as_float(gv.x & 0xffff0000u), g2 = __uint_as_float(gv.y << 16), g3 = __uint_as_float(gv.y & 0xffff0000u);
            uint2 o;
            o.x = pk2bf(g0 * sigmoid_f(acc[m][n][0] + bb[0]), g1 * sigmoid_f(acc[m][n][1] + bb[1]));
            o.y = pk2bf(g2 * sigmoid_f(acc[m][n][2] + bb[2]), g3 * sigmoid_f(acc[m][n][3] + bb[3]));
            *(uint2*)(MIX + (size_t)(mt * 128 + rl) * D + col) = o;
        }
}
__device__ __forceinline__ void ph_outproj_mfma(const Ctx& c, int layer, int tile, unsigned char* lds) {
    const int mt = tile >> 3, nt = tile & 7;
    const bf16* MIX = c.w<bf16>(WS_MIX) + (size_t)mt * 128 * D;
    f32x4 acc[4][4];
    const int bc = nt * 128 + (c.tid & 15) * 8;
    gemm_tile<true>(c.tid, lds, [&](int r) __attribute__((always_inline)) { return MIX + (size_t)r * D; }, c.in(9) + (size_t)layer * D * D + bc, D, true, D, acc);
    EPI_COORDS;
    const float* MOD = c.w<float>(WS_MOD) + (size_t)layer * 5 * 6144;
    float* X = c.w<float>(WS_X);
#pragma unroll
    for (int m = 0; m < 4; ++m) {
        const int row = mt * 128 + wr * 64 + m * 16 + fr, b = row / LT, pos = row % LT, mr = pos < CTX ? 4 : b;
#pragma unroll
        for (int n = 0; n < 4; ++n) {
            const int col = nt * 128 + wc * 64 + n * 16 + fq * 4;
            const f32x4 g1 = *(const f32x4*)(MOD + mr * 6144 + 2048 + col);
            f32x4* xp = (f32x4*)(X + (size_t)row * D + col);
            *xp = *xp + g1 * acc[m][n];
        }
    }
}
__device__ __forceinline__ void ph_moe1_mfma(const Ctx& c, int layer, int tile, const int* sm, unsigned char* lds) {
    const int st = tile >> 3, nt = tile & 7;
    const int s0 = st * 128;
    if (s0 >= sm[32]) return;
    const int e = slot_expert(sm, s0), base = s0 - sm[e], ce = sm[33 + e];
    if (base >= ce) return;
    const bf16* HA = c.w<bf16>(WS_HA); const int* LI = c.w<int>(WS_LIST) + (size_t)e * NT;
    f32x4 acc[4][4];
    const int bnc = c.tid & 15, seg = bnc >> 2;
    const float* wsel = c.in((seg & 1) ? 34 : 33) + ((size_t)layer * NEXP + e) * D * DE + nt * 64 + (seg >> 1) * 32 + (bnc & 3) * 8;
    gemm_tile<true>(c.tid, lds, [&](int r) __attribute__((always_inline)) { const int tok = LI[(base + r < ce) ? (base + r) : base]; return HA + (size_t)tok * D; }, wsel, DE, true, D, acc);
    EPI_COORDS;
    bf16* ACT = c.w<bf16>(WS_ACT);
#pragma unroll
    for (int m = 0; m < 4; ++m) {
        const int rl = wr * 64 + m * 16 + fr;
#pragma unroll
        for (int n = 0; n < 2; ++n) {
            const int col = nt * 64 + wc * 32 + n * 16 + fq * 4;
            const f32x4 g = acc[m][n], u = acc[m][n + 2];
            uint2 o; o.x = pk2bf(silu_f(g[0]) * u[0], silu_f(g[1]) * u[1]); o.y = pk2bf(silu_f(g[2]) * u[2], silu_f(g[3]) * u[3]);
            *(uint2*)(ACT + (size_t)(s0 + rl) * DE + col) = o;
        }
    }
}
__device__ __forceinline__ void ph_moe2_mfma(const Ctx& c, int layer, int tile, const int* sm, unsigned char* lds) {
    const int st = tile >> 3, nt = tile & 7;
    const int s0 = st * 128;
    if (s0 >= sm[32]) return;
    const int e = slot_expert(sm, s0), base = s0 - sm[e], ce = sm[33 + e];
    if (base >= ce) return;
    const bf16* ACT = c.w<bf16>(WS_ACT) + (size_t)s0 * DE;
    f32x4 acc[4][4];
    const int bc = nt * 128 + (c.tid & 15) * 8;
    gemm_tile<true>(c.tid, lds, [&](int r) __attribute__((always_inline)) { return ACT + (size_t)r * DE; }, c.in(35) + ((size_t)layer * NEXP + e) * DE * D + bc, D, true, DE, acc);
    EPI_COORDS;
    bf16* OUT = c.w<bf16>(WS_OUT);
#pragma unroll
    for (int m = 0; m < 4; ++m)
#pragma unroll
        for (int n = 0; n < 4; ++n) {
            const int rl = wr * 64 + m * 16 + fr, col = nt * 128 + wc * 64 + n * 16 + fq * 4;
            uint2 o; o.x = pk2bf(acc[m][n][0], acc[m][n][1]); o.y = pk2bf(acc[m][n][2], acc[m][n][3]);
            *(uint2*)(OUT + (size_t)(s0 + rl) * D + col) = o;
        }
}


typedef float f32x16 __attribute__((ext_vector_type(16)));
constexpr int AT_KST = 144, AT_VST = 136;
constexpr int AT_KOFF = 0, AT_VOFF = 64 * AT_KST, AT_SOFF = AT_VOFF + 64 * AT_VST;
constexpr float AT_THR = 5.0f;
__device__ __forceinline__ int crow(int r, int hi) { return (r & 3) + 8 * (r >> 2) + 4 * hi; }

__device__ __forceinline__ void attn_tile(const Ctx& c, int layer, int idx, unsigned char* lds) {
    const int tid = c.tid, lane = tid & 63, wid = tid >> 6, r32 = lane & 31, hi = lane >> 5;
    int kind, b, h, qt;
    if (idx < 1024) { kind = idx >> 9; const int r = idx & 511; b = r >> 7; h = (r >> 5) & 3; qt = 2 + (r & 31); }
    else { const int r = idx - 1024; kind = r >> 5; b = (r >> 3) & 3; h = (r >> 1) & 3; qt = r & 1; }
    const int kvh = h >> 1;
    const bf16* Q = c.w<bf16>(kind ? WS_WQ : WS_GQ) + ((size_t)b * 4 + h) * LT * 64;
    const bf16* K = c.w<bf16>(kind ? WS_WK : WS_GK) + ((size_t)b * 2 + kvh) * LT * 64;
    const bf16* Vt = c.w<bf16>(kind ? WS_WV : WS_GV) + ((size_t)b * 2 + kvh) * 64 * LT;
    const int q0 = qt * 128;
    const int qpos = q0 + wid * 32 + r32;
    int b0 = CTX, b1 = CTX;
    if (qt >= 2) { if (kind == 0) { b0 = CTX; b1 = LT; } else { b0 = q0 - 128 < CTX ? CTX : q0 - 128; b1 = q0 + 256 > LT ? LT : q0 + 256; } }
    const int nA = CTX / 64, ntile = nA + (b1 - b0) / 64;
    bf16x8 qf[4];
#pragma unroll
    for (int d0 = 0; d0 < 4; ++d0) qf[d0] = *(const bf16x8*)(Q + (size_t)qpos * 64 + d0 * 16 + hi * 8);
    f32x16 o0, o1;
#pragma unroll
    for (int r = 0; r < 16; ++r) { o0[r] = 0.f; o1[r] = 0.f; }
    float m = -1e30f, l = 0.f;
    if (kind == 1) { m = c.in(28)[layer * 4 + h] * 1.4426950408889634f; l = (hi == 0) ? 1.f : 0.f; }
    float* wsf = (float*)(lds + AT_SOFF) + wid * 32;
    u32x4 rk[2], rv[2];
    auto gload = [&](int ti) __attribute__((always_inline)) {
        const int kb = ti < nA ? ti * 64 : b0 + (ti - nA) * 64;
#pragma unroll
        for (int i = 0; i < 2; ++i) { const int cc = tid + 256 * i;
            rk[i] = *(const u32x4*)(K + (size_t)(kb + (cc >> 3)) * 64 + (cc & 7) * 8);
            rv[i] = *(const u32x4*)(Vt + (size_t)(cc >> 3) * LT + kb + (cc & 7) * 8); }
    };
    const lds_cptr lk = (lds_cptr)lds + AT_KOFF + r32 * AT_KST + hi * 16;
    const lds_cptr lv = (lds_cptr)lds + AT_VOFF + r32 * AT_VST + hi * 8;
    gload(0);
    for (int ti = 0; ti < ntile; ++ti) {
        const int kb = ti < nA ? ti * 64 : b0 + (ti - nA) * 64;
        __syncthreads();
#pragma unroll
        for (int i = 0; i < 2; ++i) { const int cc = tid + 256 * i;
            *(u32x4*)(lds + AT_KOFF + (cc >> 3) * AT_KST + (cc & 7) * 16) = rk[i];
            unsigned char* vp = lds + AT_VOFF + (cc >> 3) * AT_VST + (cc & 7) * 16;
            *(uint2*)vp = make_uint2(rv[i][0], rv[i][1]); *(uint2*)(vp + 8) = make_uint2(rv[i][2], rv[i][3]); }
        __syncthreads();
        if (ti + 1 < ntile) gload(ti + 1);
        f32x16 p0, p1;
#pragma unroll
        for (int r = 0; r < 16; ++r) { p0[r] = 0.f; p1[r] = 0.f; }
#pragma unroll
        for (int d0 = 0; d0 < 4; ++d0) {
            const bf16x8 k0 = *(const LAS bf16x8*)(lk + d0 * 32), k1 = *(const LAS bf16x8*)(lk + 32 * AT_KST + d0 * 32);
            p0 = __builtin_amdgcn_mfma_f32_32x32x16_bf16(k0, qf[d0], p0, 0, 0, 0);
            p1 = __builtin_amdgcn_mfma_f32_32x32x16_bf16(k1, qf[d0], p1, 0, 0, 0);
        }
        if (kind == 1 && ti >= nA) {
#pragma unroll
            for (int r = 0; r < 16; ++r) {
                const int d0_ = kb + crow(r, hi) - qpos, d1_ = d0_ + 32;
                if (d0_ > 128 || d0_ < -128) p0[r] = -INFINITY;
                if (d1_ > 128 || d1_ < -128) p1[r] = -INFINITY;
            }
        }
        float rm = fmaxf(p0[0], p1[0]);
#pragma unroll
        for (int r = 1; r < 16; ++r) rm = fmaxf(rm, fmaxf(p0[r], p1[r]));
        rm = fmaxf(rm, __shfl_xor(rm, 32));
        if (__any(rm > m + AT_THR)) {
            const float mn = fmaxf(m, rm), f = __builtin_amdgcn_exp2f(m - mn);
            m = mn; l *= f;
            if (hi == 0) wsf[r32] = f;
#pragma unroll
            for (int g = 0; g < 4; ++g) { const f32x4 fv = *(const f32x4*)(wsf + 8 * g + 4 * hi);
#pragma unroll
                for (int j = 0; j < 4; ++j) { o0[4 * g + j] *= fv[j]; o1[4 * g + j] *= fv[j]; } }
        }
        float ls = 0.f;
#pragma unroll
        for (int r = 0; r < 16; ++r) { p0[r] = __builtin_amdgcn_exp2f(p0[r] - m); p1[r] = __builtin_amdgcn_exp2f(p1[r] - m); ls += p0[r] + p1[r]; }
        l += ls;
#pragma unroll
        for (int t = 0; t < 2; ++t)
#pragma unroll
            for (int s = 0; s < 2; ++s) {
                bf16x8 pa;
#pragma unroll
                for (int j = 0; j < 8; ++j) pa[j] = (short)f2bf(t == 0 ? p0[8 * s + j] : p1[8 * s + j]);
#pragma unroll
                for (int d0 = 0; d0 < 2; ++d0) {
                    const lds_cptr vp = lv + d0 * 32 * AT_VST + (32 * t + 16 * s) * 2;
                    const s16x4 lo = *(const LAS s16x4*)vp, hv = *(const LAS s16x4*)(vp + 16);
                    const bf16x8 vf = (bf16x8){lo[0], lo[1], lo[2], lo[3], hv[0], hv[1], hv[2], hv[3]};
                    if (d0 == 0) o0 = __builtin_amdgcn_mfma_f32_32x32x16_bf16(pa, vf, o0, 0, 0, 0);
                    else o1 = __builtin_amdgcn_mfma_f32_32x32x16_bf16(pa, vf, o1, 0, 0, 0);
                }
            }
    }
    l += __shfl_xor(l, 32);
    if (hi == 0) wsf[r32] = 1.f / l;
    bf16* MIX = c.w<bf16>(WS_MIX) + ((size_t)b * LT + q0 + wid * 32) * D + (kind ? 768 : 256) + h * 64 + r32;
#pragma unroll
    for (int g = 0; g < 4; ++g) { const f32x4 fv = *(const f32x4*)(wsf + 8 * g + 4 * hi);
#pragma unroll
        for (int j = 0; j < 4; ++j) { const int r = 4 * g + j; bf16* mp = MIX + (size_t)crow(r, hi) * D;
            mp[0] = f2bf(o0[r] * fv[j]); mp[32] = f2bf(o1[r] * fv[j]); } }
}


__device__ __forceinline__ void ph_prepB(const Ctx& c, int gtid, int gthreads) {
    const float* KLAG = c.w<float>(WS_KLAG); const float* S5P = c.w<float>(WS_S5P); const float* S5BB = c.w<float>(WS_S5BB);
    bf16* WY = c.w<bf16>(WS_WY); bf16* WSm = c.w<bf16>(WS_WS);
    for (size_t it = gtid; it < (size_t)2 * 16 * 768 * 512; it += gthreads) {
        const int nc = (int)(it & 511), kr = (int)((it >> 9) % 768), lg = (int)(it / (768 * 512)), l = lg >> 4, g = lg & 15;
        const int t = nc >> 4, cc = nc & 15;
        float val;
        if (kr < 512) {
            const int s = kr >> 4, cp = kr & 15;
            val = 0.f;
            if (s <= t) val += KLAG[((size_t)(lg * 2 + 0) * 32 + (t - s)) * 256 + cc * 16 + cp];
            if (s >= t) val += KLAG[((size_t)(lg * 2 + 1) * 32 + (s - t)) * 256 + cc * 16 + cp];
            if (s == t && cc == cp) val += c.in(17)[l * 256 + g * 16 + cc];
        } else {
            const int q = kr - 512, d = q >> 7, p = (q >> 1) & 63, ri = q & 1, e = d == 0 ? t + 1 : 32 - t;
            const int ldg = (l * 2 + d) * 16 + g;
            const float pr = S5P[((size_t)(ldg * 64 + p) * 33 + e) * 2], pi = S5P[((size_t)(ldg * 64 + p) * 33 + e) * 2 + 1];
            const float cr = c.in(15)[(size_t)ldg * 1024 + cc * 64 + p], ci = c.in(16)[(size_t)ldg * 1024 + cc * 64 + p];
            val = ri == 0 ? (cr * pr - ci * pi) : -(cr * pi + ci * pr);
        }
        WY[it] = f2bf(val);
    }
    for (size_t it = gtid; it < (size_t)2 * 16 * 512 * 256; it += gthreads) {
        const int nc = (int)(it & 255), kr = (int)((it >> 8) & 511), lg = (int)(it >> 17), l = lg >> 4, g = lg & 15;
        const int s = kr >> 4, cp = kr & 15, d = nc >> 7, p = (nc >> 1) & 63, ri = nc & 1, e = d == 0 ? 31 - s : s;
        const int ldg = (l * 2 + d) * 16 + g;
        const float pr = S5P[((size_t)(ldg * 64 + p) * 33 + e) * 2], pi = S5P[((size_t)(ldg * 64 + p) * 33 + e) * 2 + 1];
        const float br = S5BB[((size_t)(ldg * 64 + p) * 16 + cp) * 2], bi = S5BB[((size_t)(ldg * 64 + p) * 16 + cp) * 2 + 1];
        WSm[it] = f2bf(ri == 0 ? (pr * br - pi * bi) : (pr * bi + pi * br));
    }
}
__device__ __forceinline__ void s5_gemm_s(const Ctx& c, int layer, int tile, unsigned char* lds) {
    const int nt = tile & 1, mt = (tile >> 1) % 5, g = tile / 10;
    const bf16* UH = c.w<bf16>(WS_UH) + (size_t)g * NCH5 * 768;
    f32x4 acc[4][4];
    const int bc = nt * 128 + (c.tid & 15) * 8;
    gemm_tile<false>(c.tid, lds, [&](int r) __attribute__((always_inline)) { int row = mt * 128 + r; row = row < NCH5 ? row : NCH5 - 1; return UH + (size_t)row * 768; },
                     c.w<bf16>(WS_WS) + (size_t)(layer * 16 + g) * 512 * 256 + bc, 256, true, 512, acc);
    EPI_COORDS;
    float* SALL = c.w<float>(WS_SALL) + (size_t)g * NCH5 * 256;
#pragma unroll
    for (int m = 0; m < 4; ++m)
#pragma unroll
        for (int n = 0; n < 4; ++n) {
            const int row = mt * 128 + wr * 64 + m * 16 + fr, col = nt * 128 + wc * 64 + n * 16 + fq * 4;
            if (row < NCH5) *(f32x4*)(SALL + (size_t)row * 256 + col) = acc[m][n];
        }
}
__device__ __forceinline__ void s5_recur(const Ctx& c, int layer, int gtid, int gthreads) {
    const float* S5P = c.w<float>(WS_S5P);
    for (int it = gtid; it < 4 * 16 * 2 * 64; it += gthreads) {
        const int p = it & 63, d = (it >> 6) & 1, g = (it >> 7) & 15, b = it >> 11;
        const int ldg = (layer * 2 + d) * 16 + g;
        const float ar = S5P[((size_t)(ldg * 64 + p) * 33 + 32) * 2], ai = S5P[((size_t)(ldg * 64 + p) * 33 + 32) * 2 + 1];
        const float* S = c.w<float>(WS_SALL) + ((size_t)g * NCH5 + b * 136) * 256 + d * 128 + p * 2;
        bf16* H = c.w<bf16>(WS_UH) + ((size_t)g * NCH5 + b * 136) * 768 + 512 + d * 128 + p * 2;
        float hr = 0.f, hi = 0.f;
        for (int s0 = 0; s0 < 136; s0 += 8) {
            float2 sv[8]; int jj[8];
#pragma unroll
            for (int i = 0; i < 8; ++i) { const int s = s0 + i; jj[i] = d == 0 ? s : (s < 8 ? 7 - s : 143 - s); sv[i] = *(const float2*)(S + (size_t)jj[i] * 256); }
#pragma unroll
            for (int i = 0; i < 8; ++i) {
                *(unsigned*)(H + (size_t)jj[i] * 768) = pk2bf(hr, hi);
                const float nr = ar * hr - ai * hi + sv[i].x, ni = ar * hi + ai * hr + sv[i].y; hr = nr; hi = ni;
            }
        }
    }
}
__device__ __forceinline__ void s5_gemm_y(const Ctx& c, int layer, int tile, unsigned char* lds) {
    const int nt = tile & 3, mt = (tile >> 2) % 5, g = tile / 20;
    const bf16* UH = c.w<bf16>(WS_UH) + (size_t)g * NCH5 * 768;
    f32x4 acc[4][4];
    const int bc = nt * 128 + (c.tid & 15) * 8;
    gemm_tile<false>(c.tid, lds, [&](int r) __attribute__((always_inline)) { int row = mt * 128 + r; row = row < NCH5 ? row : NCH5 - 1; return UH + (size_t)row * 768; },
                     c.w<bf16>(WS_WY) + (size_t)(layer * 16 + g) * 768 * 512 + bc, 512, true, 768, acc);
    EPI_COORDS;
    bf16* G5 = c.w<bf16>(WS_G5);
#pragma unroll
    for (int m = 0; m < 4; ++m) {
        const int row = mt * 128 + wr * 64 + m * 16 + fr;
        if (row < NCH5) {
            const int b = row / 136, jj = row % 136;
#pragma unroll
            for (int n = 0; n < 4; ++n) {
                const int col = nt * 128 + wc * 64 + n * 16 + fq * 4, t = col >> 4, cc = col & 15;
                const size_t tok = (size_t)b * LT + jj * 32 + t;
                uint2 o; o.x = pk2bf(gelu_tanh(acc[m][n][0]), gelu_tanh(acc[m][n][1])); o.y = pk2bf(gelu_tanh(acc[m][n][2]), gelu_tanh(acc[m][n][3]));
                *(uint2*)(G5 + tok * 256 + g * 16 + cc) = o;
            }
        }
    }
}


__device__ __forceinline__ void unpack8v(const u32x4 v, float (&f)[8]) {
    f[0] = __uint_as_float(v[0] << 16); f[1] = __uint_as_float(v[0] & 0xffff0000u);
    f[2] = __uint_as_float(v[1] << 16); f[3] = __uint_as_float(v[1] & 0xffff0000u);
    f[4] = __uint_as_float(v[2] << 16); f[5] = __uint_as_float(v[2] & 0xffff0000u);
    f[6] = __uint_as_float(v[3] << 16); f[7] = __uint_as_float(v[3] & 0xffff0000u);
}
__device__ __forceinline__ bf16x8 pack8(const float (&f)[8]) {
    u32x4 v; v[0] = pk2bf(f[0], f[1]); v[1] = pk2bf(f[2], f[3]); v[2] = pk2bf(f[4], f[5]); v[3] = pk2bf(f[6], f[7]);
    return __builtin_bit_cast(bf16x8, v);
}
__device__ __forceinline__ void ssd_vectors(const Ctx& c, int layer, int b, int j, int h, float* vec) {
    const int tid = c.tid, lane = tid & 63;
    __syncthreads();
    float dtf = 0.f, dtr = 0.f, af = 0.f, ar = 0.f;
    if (tid < 128) {
        const float* DTR = c.w<float>(WS_DTR) + ((size_t)b * LT + j * 128 + tid) * 8;
        dtf = softplus_f(DTR[h] + c.in(24)[(layer * 2 + 0) * 4 + h]);
        dtr = softplus_f(DTR[4 + h] + c.in(24)[(layer * 2 + 1) * 4 + h]);
        af = -dtf * expf(c.in(25)[(layer * 2 + 0) * 4 + h]); ar = -dtr * expf(c.in(25)[(layer * 2 + 1) * 4 + h]);
    }
    float sf = af, sr = ar;
#pragma unroll
    for (int o = 1; o < 64; o <<= 1) { const float tf = __shfl_up(sf, o), tr = __shfl_up(sr, o); if (lane >= o) { sf += tf; sr += tr; } }
    if (tid == 63) { vec[1026] = sf; vec[1027] = sr; }
    __syncthreads();
    if (tid >= 64 && tid < 128) { sf += vec[1026]; sr += vec[1027]; }
    if (tid == 127) { vec[1024] = sf; vec[1025] = sr; }
    __syncthreads();
    if (tid < 128) {
        const float totf = vec[1024], totr = vec[1025], cer = sr - ar;
        vec[tid] = dtf; vec[128 + tid] = dtr; vec[256 + tid] = sf; vec[384 + tid] = cer;
        vec[512 + tid] = dtf * __expf(totf - sf); vec[640 + tid] = dtr * __expf(cer);
        vec[768 + tid] = __expf(sf); vec[896 + tid] = __expf(totr - cer);
    }
    __syncthreads();
}
__device__ __forceinline__ void ssd_s1(const Ctx& c, int layer, int tile, unsigned char* lds) {
    const int h = tile & 3, j = (tile >> 2) % NCH, b = tile / (4 * NCH);
    float* vec = (float*)lds;
    ssd_vectors(c, layer, b, j, h, vec);
    const int tid = c.tid, lane = tid & 63, wid = tid >> 6, fr = lane & 15, fq = lane >> 4, grp = h >> 1;
    const bf16* XT = c.w<bf16>(WS_XT) + ((size_t)b * 256 + h * 64 + wid * 16 + fr) * LT + j * 128;
    const bf16* BT = c.w<bf16>(WS_BT) + ((size_t)b * 256 + grp * 128 + fr) * LT + j * 128;
    f32x4 acc[2][8];
#pragma unroll
    for (int d = 0; d < 2; ++d)
#pragma unroll
        for (int ns = 0; ns < 8; ++ns) acc[d][ns] = (f32x4){0.f, 0.f, 0.f, 0.f};
#pragma unroll
    for (int kk = 0; kk < 4; ++kk) {
        float xv[8], xa[8], xb[8];
        unpack8v(*(const u32x4*)(XT + 32 * kk + 8 * fq), xv);
        const f32x4 w0 = *(const f32x4*)(vec + 512 + 32 * kk + 8 * fq), w1 = *(const f32x4*)(vec + 512 + 32 * kk + 8 * fq + 4);
        const f32x4 r0 = *(const f32x4*)(vec + 640 + 32 * kk + 8 * fq), r1 = *(const f32x4*)(vec + 640 + 32 * kk + 8 * fq + 4);
#pragma unroll
        for (int i = 0; i < 4; ++i) { xa[i] = xv[i] * w0[i]; xa[4 + i] = xv[4 + i] * w1[i]; xb[i] = xv[i] * r0[i]; xb[4 + i] = xv[4 + i] * r1[i]; }
        const bf16x8 xf = pack8(xa), xr = pack8(xb);
#pragma unroll
        for (int ns = 0; ns < 8; ++ns) {
            const bf16x8 bfrag = *(const bf16x8*)(BT + (size_t)ns * 16 * LT + 32 * kk + 8 * fq);
            acc[0][ns] = __builtin_amdgcn_mfma_f32_16x16x32_bf16(bfrag, xf, acc[0][ns], 0, 0, 0);
            acc[1][ns] = __builtin_amdgcn_mfma_f32_16x16x32_bf16(bfrag, xr, acc[1][ns], 0, 0, 0);
        }
    }
    const size_t sidx = (size_t)((b * NCH + j) * 4 + h) * 2;
    float* ST = c.w<float>(WS_ST);
#pragma unroll
    for (int d = 0; d < 2; ++d)
#pragma unroll
        for (int ns = 0; ns < 8; ++ns) *(f32x4*)(ST + ((sidx + d) * 64 + wid * 16 + fr) * 128 + ns * 16 + 4 * fq) = acc[d][ns];
    if (tid == 0) { float* TOT = c.w<float>(WS_TOT); TOT[sidx] = __expf(vec[1024]); TOT[sidx + 1] = __expf(vec[1025]); }
}
__device__ __forceinline__ void ssd_recur(const Ctx& c, int gtid, int gthreads) {
    const float* ST = c.w<float>(WS_ST); bf16* HIN = c.w<bf16>(WS_HIN); const float* TOT = c.w<float>(WS_TOT);
    for (int it = gtid; it < 4 * 4 * 2 * 64 * 32; it += gthreads) {
        const int n4 = it & 31, p = (it >> 5) & 63, d = (it >> 11) & 1, h = (it >> 12) & 3, b = it >> 14;
        f32x4 H = (f32x4){0.f, 0.f, 0.f, 0.f};
#pragma unroll 1
        for (int s0 = 0; s0 < NCH; s0 += 17) {
            f32x4 sv[17]; float tv[17];
#pragma unroll
            for (int i = 0; i < 17; ++i) { const int s = s0 + i, jj = d == 0 ? s : (s < 2 ? 1 - s : 35 - s);
                const size_t idx = (size_t)((b * NCH + jj) * 4 + h) * 2 + d;
                sv[i] = *(const f32x4*)(ST + (idx * 64 + p) * 128 + n4 * 4); tv[i] = TOT[idx]; }
#pragma unroll
            for (int i = 0; i < 17; ++i) { const int s = s0 + i, jj = d == 0 ? s : (s < 2 ? 1 - s : 35 - s);
                const size_t idx = (size_t)((b * NCH + jj) * 4 + h) * 2 + d;
                uint2 o; o.x = pk2bf(H[0], H[1]); o.y = pk2bf(H[2], H[3]);
                *(uint2*)(HIN + (idx * 64 + p) * 128 + n4 * 4) = o;
                H = H * tv[i] + sv[i]; }
        }
    }
}
__device__ __forceinline__ void ssd_s3(const Ctx& c, int layer, int tile, unsigned char* lds) {
    const int half = tile & 1, h = (tile >> 1) & 3, j = (tile >> 3) % NCH, b = tile / (8 * NCH);
    float* vec = (float*)lds;
    ssd_vectors(c, layer, b, j, h, vec);
    const int tid = c.tid, lane = tid & 63, wid = tid >> 6, fr = lane & 15, fq = lane >> 4, grp = h >> 1;
    const size_t tok0 = (size_t)b * LT + j * 128;
    const bf16* XS = c.w<bf16>(WS_XBCS) + tok0 * 768;
    const int l = 64 * half + 16 * wid + fr;
    bf16x8 cf[4];
#pragma unroll
    for (int k = 0; k < 4; ++k) cf[k] = *(const bf16x8*)(XS + (size_t)l * 768 + 512 + grp * 128 + 32 * k + 8 * fq);
    f32x4 G[8];
#pragma unroll
    for (int st = 0; st < 8; ++st) {
        G[st] = (f32x4){0.f, 0.f, 0.f, 0.f};
#pragma unroll
        for (int k = 0; k < 4; ++k) {
            const bf16x8 bfrag = *(const bf16x8*)(XS + (size_t)(16 * st + fr) * 768 + 256 + grp * 128 + 32 * k + 8 * fq);
            G[st] = __builtin_amdgcn_mfma_f32_16x16x32_bf16(bfrag, cf[k], G[st], 0, 0, 0);
        }
    }
    {
        const float csf_l = vec[256 + l], cer_l = vec[384 + l];
#pragma unroll
        for (int st = 0; st < 8; ++st) {
            const int sb = 16 * st + 4 * fq;
            const f32x4 dtf_s = *(const f32x4*)(vec + sb), dtr_s = *(const f32x4*)(vec + 128 + sb), csf_s = *(const f32x4*)(vec + 256 + sb), cer_s = *(const f32x4*)(vec + 384 + sb);
#pragma unroll
            for (int jj = 0; jj < 4; ++jj) {
                const int s = sb + jj;
                float w = 0.f;
                if (s <= l) w += dtf_s[jj] * __expf(csf_l - csf_s[jj]);
                if (s >= l) w += dtr_s[jj] * __expf(cer_s[jj] - cer_l);
                G[st][jj] *= w;
            }
        }
    }
    f32x4 y[4];
#pragma unroll
    for (int pt = 0; pt < 4; ++pt) y[pt] = (f32x4){0.f, 0.f, 0.f, 0.f};
    const bf16* XT = c.w<bf16>(WS_XT) + ((size_t)b * 256 + h * 64 + fr) * LT + j * 128;
#pragma unroll
    for (int kk = 0; kk < 4; ++kk) {
        float t8[8];
#pragma unroll
        for (int i = 0; i < 4; ++i) { t8[i] = G[2 * kk][i]; t8[4 + i] = G[2 * kk + 1][i]; }
        const bf16x8 pf = pack8(t8);
#pragma unroll
        for (int pt = 0; pt < 4; ++pt) {
            const bf16* xp = XT + (size_t)pt * 16 * LT + 32 * kk + 4 * fq;
            const s16x4 lo = *(const s16x4*)xp, hv = *(const s16x4*)(xp + 16);
            const bf16x8 xf = (bf16x8){lo[0], lo[1], lo[2], lo[3], hv[0], hv[1], hv[2], hv[3]};
            y[pt] = __builtin_amdgcn_mfma_f32_16x16x32_bf16(xf, pf, y[pt], 0, 0, 0);
        }
    }
    const bf16* HIN = c.w<bf16>(WS_HIN) + (size_t)((b * NCH + j) * 4 + h) * 2 * 8192;
#pragma unroll
    for (int d = 0; d < 2; ++d) {
        const float e = vec[(d == 0 ? 768 : 896) + l];
#pragma unroll
        for (int k = 0; k < 4; ++k) {
            float t8[8]; unpack8v(__builtin_bit_cast(u32x4, cf[k]), t8);
#pragma unroll
            for (int i = 0; i < 8; ++i) t8[i] *= e;
            const bf16x8 cs = pack8(t8);
#pragma unroll
            for (int pt = 0; pt < 4; ++pt) {
                const bf16x8 hf = *(const bf16x8*)(HIN + ((size_t)d * 64 + 16 * pt + fr) * 128 + 32 * k + 8 * fq);
                y[pt] = __builtin_amdgcn_mfma_f32_16x16x32_bf16(hf, cs, y[pt], 0, 0, 0);
            }
        }
    }
    float* Y = c.w<float>(WS_YSSD) + tok0 * 256;
#pragma unroll
    for (int pt = 0; pt < 4; ++pt) *(f32x4*)(Y + (size_t)l * 256 + h * 64 + 16 * pt + 4 * fq) = y[pt];
}

constexpr int PH_PER_LAYER = 13, N_PHASES = 2 + 2 * PH_PER_LAYER;

__global__ void __launch_bounds__(NTHR, 2) mk_fwd(Params prm) {
    __shared__ __attribute__((aligned(16))) unsigned char smem_raw[GEMM_LDS + 512];
    float* smem = (float*)(smem_raw + GEMM_LDS);
    Ctx c; c.p = (const CAS Params*)__builtin_amdgcn_kernarg_segment_ptr(); c.smf = smem; c.tid = threadIdx.x;
    const int G = gridDim.x, bid = blockIdx.x;
    const int gtid = bid * NTHR + c.tid, gthreads = G * NTHR;
    const int gw = gtid >> 6, nwaves = gthreads >> 6;
    int* smi = (int*)(smem + 16);
#if MK_SINGLE
    volatile unsigned* bst = (volatile unsigned*)(smem + 120);
    if (c.tid == 0) { bst[0] = 0u; bst[1] = 0u; }
    __syncthreads();
    XcdBarrier bar = xcd_barrier_post(c.w<unsigned>(WS_CTL) + CW_BAR, bst);
#endif
    for (int ph = prm.ph_lo; ph < prm.ph_hi; ++ph) {
        asm volatile("" : "+s"(c.p));
        { int t_ = threadIdx.x; asm volatile("" : "+v"(t_)); c.tid = t_; }
        if (ph == 0) ph_prep(c, gtid, gthreads);
        else if (ph == 1) ph_prepB(c, gtid, gthreads);
        else {
            const int layer = (ph - 2) / PH_PER_LAYER, sp = (ph - 2) % PH_PER_LAYER;
            switch (sp) {
            case 0: ph_norm1(c, layer, gw, nwaves); break;
            case 1: for (int t = bid; t < 136 * 19; t += G) ph_inproj_mfma(c, layer, t, smem_raw); break;
            case 2: for (int t = bid; t < NT; t += G) ph_post(c, layer, t); break;
            case 3: for (int t = bid; t < 512 + 544 + 160 + 576; t += G) { asm volatile("" : "+v"(c.tid)); if (t < 512) attn_tile(c, layer, t, smem_raw); else if (t < 1056) ssd_s1(c, layer, t - 512, smem_raw); else if (t < 1216) s5_gemm_s(c, layer, t - 1056, smem_raw); else attn_tile(c, layer, t - 1216 + 512, smem_raw); } break;
            case 4: s5_recur(c, layer, gtid, gthreads); ssd_recur(c, gtid, gthreads); break;
            case 5: for (int t = bid; t < 1088 + 320; t += G) { asm volatile("" : "+v"(c.tid)); if (t < 1088) ssd_s3(c, layer, t, smem_raw); else s5_gemm_y(c, layer, t - 1088, smem_raw); } break;
            case 6: for (int t = bid; t < NT; t += G) ph_gates(c, layer, t); break;
            case 7: for (int t = bid; t < 136 * 2; t += G) ph_glu_mfma(c, layer, t, smem_raw); break;
            case 8: for (int t = bid; t < 136 * 8; t += G) ph_outproj_mfma(c, layer, t, smem_raw); break;
            case 9: ph_norm2(c, layer, gw, nwaves); break;
            case 10: moe_offsets(c, layer, smi); for (int t = bid; t < (NSLOT / 128) * 8; t += G) ph_moe1_mfma(c, layer, t, smi, smem_raw); break;
            case 11: moe_offsets(c, layer, smi); for (int t = bid; t < (NSLOT / 128) * 8; t += G) ph_moe2_mfma(c, layer, t, smi, smem_raw); break;
            case 12: moe_offsets(c, layer, smi); for (int t = bid; t < NT; t += G) ph_combine(c, layer, t, smi); break;
            }
        }
#if MK_SINGLE
        if (ph + 1 < prm.ph_hi) xcd_barrier(bar);
#endif
    }
}
}

extern "C" void kernel_launch(void* const* d_in, const int* in_sizes, int n_in, void* d_out, int out_size, void* d_ws, size_t ws_size, hipStream_t stream) {
    static int grid = 0;
    if (grid == 0) {
        if (n_in != 37 || ws_size < WS_END) { fprintf(stderr, "kernel_launch: need 37 inputs and %zu bytes of workspace; got %d, %zu\n", (size_t)WS_END, n_in, ws_size); grid = -1; return; }
        int dev = 0, cus = 0, per_cu = 0;
        hipGetDevice(&dev); hipDeviceGetAttribute(&cus, hipDeviceAttributeMultiprocessorCount, dev);
        if (hipOccupancyMaxActiveBlocksPerMultiprocessor(&per_cu, (const void*)mk_fwd, NTHR, 0) != hipSuccess || per_cu < 1) per_cu = 1;
        if (per_cu > 4) per_cu = 4;
        grid = cus * per_cu;
    }
    if (grid < 0) return;
    hipMemsetAsync((char*)d_ws + WS_CTL, 0, CTL_BYTES, stream);
    Params p{};
    for (int i = 0; i < 37; ++i) p.in[i] = (const float*)d_in[i];
    p.out = (float*)d_out; p.ws = (unsigned char*)d_ws;
#if MK_SINGLE
    p.ph_lo = 0; p.ph_hi = N_PHASES;
    void* args[] = {&p};
    hipError_t e = hipLaunchCooperativeKernel((const void*)mk_fwd, dim3(grid), dim3(NTHR), args, 0, stream);
    if (e != hipSuccess) fprintf(stderr, "cooperative launch failed: %s (grid %d)\n", hipGetErrorString(e), grid);
#else
    for (int ph = 0; ph < N_PHASES; ++ph) {
        p.ph_lo = ph; p.ph_hi = ph + 1;
        hipLaunchKernelGGL(mk_fwd, dim3(grid), dim3(NTHR), 0, stream, p);
    }
#endif
}
```

```cpp
#include <hip/hip_runtime.h>
#include <cstdio>
#include <cstdint>

#ifndef PROBE_SP
#define PROBE_SP -1
#endif
#ifndef MK_SINGLE
#define MK_SINGLE 1
#endif

namespace {
typedef unsigned short bf16;
#define LAS __attribute__((address_space(3)))

constexpr int D = 1024, NB = 4, SEQ = 4096, CTX = 256, LT = SEQ + CTX, NT = NB * LT;
constexpr int DIN = 2312;
constexpr int C_U = 0, C_GQ = 256, C_GK = 512, C_GV = 640, C_Z = 768, C_XBC = 1024, C_DT = 1792, C_WQ = 1800, C_WK = 2056, C_WV = 2184;
constexpr int NEXP = 32, DE = 512;
constexpr int NSLOT = 2 * NT + NEXP * 128;
constexpr float EPS = 1e-6f;
constexpr int NTHR = 256;

constexpr size_t al(size_t x) { return (x + 255) & ~(size_t)255; }
constexpr size_t WS_CTL = 0, CTL_BYTES = 1u << 20;
constexpr size_t WS_MOD = WS_CTL + CTL_BYTES;
constexpr size_t WS_S5A = al(WS_MOD + 2 * 5 * 6144 * 4);
constexpr size_t WS_S5BB = al(WS_S5A + 2 * 2 * 16 * 64 * 2 * 4);
constexpr size_t WS_ROPE = al(WS_S5BB + 2 * 2 * 16 * 64 * 16 * 2 * 4);
constexpr size_t WS_X = al(WS_ROPE + 64 * 16 * 2 * 4);
constexpr size_t WS_HA = al(WS_X + (size_t)NT * D * 4);
constexpr size_t WS_OUT = al(WS_HA + (size_t)NT * D * 2);
constexpr size_t WS_Z = al(WS_OUT + (size_t)NSLOT * D * 2);
constexpr size_t WS_XBR = al(WS_Z + (size_t)NT * 256 * 2);
constexpr size_t WS_GQ = al(WS_XBR + (size_t)NT * 768 * 2);
constexpr size_t WS_GK = al(WS_GQ + (size_t)NT * 256 * 2);
constexpr size_t WS_GV = al(WS_GK + (size_t)NT * 128 * 2);
constexpr size_t WS_WQ = al(WS_GV + (size_t)NT * 128 * 2);
constexpr size_t WS_WK = al(WS_WQ + (size_t)NT * 256 * 2);
constexpr size_t WS_WV = al(WS_WK + (size_t)NT * 128 * 2);
constexpr size_t WS_XBCS = al(WS_WV + (size_t)NT * 128 * 2);
constexpr size_t WS_YSSD = al(WS_XBCS + (size_t)NT * 768 * 2);
constexpr size_t WS_G5 = al(WS_YSSD + (size_t)NT * 256 * 4);
constexpr size_t WS_MIX = al(WS_G5 + (size_t)NT * 256 * 2);
constexpr size_t WS_TOKE = al(WS_MIX + (size_t)NT * D * 2);
constexpr size_t WS_TOKP = al(WS_TOKE + (size_t)NT * 2 * 4);
constexpr size_t WS_TOKW = al(WS_TOKP + (size_t)NT * 2 * 4);
constexpr size_t WS_LIST = al(WS_TOKW + (size_t)NT * 2 * 4);
constexpr size_t WS_ACT = al(WS_LIST + (size_t)NEXP * NT * 4);
constexpr size_t WS_DTR = al(WS_ACT + (size_t)NSLOT * DE * 2);
constexpr int NCH5 = NT / 32;
constexpr size_t WS_S5P = al(WS_DTR + (size_t)NT * 8 * 4);
constexpr size_t WS_KLAG = al(WS_S5P + (size_t)2 * 2 * 16 * 64 * 33 * 2 * 4);
constexpr size_t WS_WY = al(WS_KLAG + (size_t)2 * 16 * 2 * 32 * 256 * 4);
constexpr size_t WS_WS = al(WS_WY + (size_t)2 * 16 * 768 * 512 * 2);
constexpr size_t WS_UH = al(WS_WS + (size_t)2 * 16 * 512 * 256 * 2);
constexpr size_t WS_SALL = al(WS_UH + (size_t)16 * NCH5 * 768 * 2);
constexpr int NCH = LT / 128;
constexpr size_t WS_XT = al(WS_SALL + (size_t)16 * NCH5 * 256 * 4);
constexpr size_t WS_BT = al(WS_XT + (size_t)NB * 256 * LT * 2);
constexpr size_t WS_ST = al(WS_BT + (size_t)NB * 256 * LT * 2);
constexpr size_t WS_HIN = al(WS_ST + (size_t)NB * NCH * 8 * 8192 * 4);
constexpr size_t WS_TOT = al(WS_HIN + (size_t)NB * NCH * 8 * 8192 * 2);
constexpr size_t WS_BCNT = al(WS_TOT + (size_t)NB * NCH * 8 * 4);
constexpr size_t WS_WDT = al(WS_BCNT + 1024 * 32 * 4);
constexpr size_t WS_RWT = al(WS_WDT + 2 * 8 * 1024 * 4);
constexpr size_t WS_END = al(WS_RWT + 2 * 36 * 1024 * 4);
constexpr int CW_CNT = 8192;
constexpr int CW_BAR = 4096;

struct Params {
    const float* in[37];
    float* out;
    unsigned char* ws;
    int ph_lo, ph_hi;
};

typedef short bf16x8 __attribute__((ext_vector_type(8)));
typedef short s16x4 __attribute__((ext_vector_type(4)));
typedef float f32x4 __attribute__((ext_vector_type(4)));
typedef unsigned u32x4 __attribute__((ext_vector_type(4)));
__device__ __forceinline__ float bf2f(bf16 v) { return __uint_as_float(((unsigned)v) << 16); }
__device__ __forceinline__ bf16 f2bf(float f) { unsigned u = __float_as_uint(f); return (bf16)((u + 0x7fffu + ((u >> 16) & 1u)) >> 16); }
__device__ __forceinline__ float silu_f(float x) { return x / (1.f + __expf(-x)); }
__device__ __forceinline__ float sigmoid_f(float x) { return 1.f / (1.f + __expf(-x)); }
__device__ __forceinline__ float gelu_tanh(float x) { const float u = 0.7978845608028654f * (x + 0.044715f * x * x * x); return 0.5f * x * (1.f + tanhf(u)); }
__device__ __forceinline__ float softplus_f(float x) { return fmaxf(x, 0.f) + log1pf(__expf(-fabsf(x))); }
__device__ __forceinline__ float wave_sum(float v) {
#pragma unroll
    for (int o = 1; o < 64; o <<= 1) v += __shfl_xor(v, o);
    return v;
}
__device__ __forceinline__ float block_sum(float v, float* red) {
    v = wave_sum(v);
    __syncthreads();
    if ((threadIdx.x & 63) == 0) red[threadIdx.x >> 6] = v;
    __syncthreads();
    return red[0] + red[1] + red[2] + red[3];
}
__device__ __forceinline__ unsigned pk2bf(float lo, float hi) { return (unsigned)f2bf(lo) | ((unsigned)f2bf(hi) << 16); }
__device__ __forceinline__ void unpack8v(const u32x4 v, float (&f)[8]) {
    f[0] = __uint_as_float(v[0] << 16); f[1] = __uint_as_float(v[0] & 0xffff0000u);
    f[2] = __uint_as_float(v[1] << 16); f[3] = __uint_as_float(v[1] & 0xffff0000u);
    f[4] = __uint_as_float(v[2] << 16); f[5] = __uint_as_float(v[2] & 0xffff0000u);
    f[6] = __uint_as_float(v[3] << 16); f[7] = __uint_as_float(v[3] & 0xffff0000u);
}
__device__ __forceinline__ bf16x8 pack8(const float (&f)[8]) {
    u32x4 v; v[0] = pk2bf(f[0], f[1]); v[1] = pk2bf(f[2], f[3]); v[2] = pk2bf(f[4], f[5]); v[3] = pk2bf(f[6], f[7]);
    return __builtin_bit_cast(bf16x8, v);
}
__device__ __forceinline__ uint2 pack4(const f32x4 v) { uint2 o; o.x = pk2bf(v[0], v[1]); o.y = pk2bf(v[2], v[3]); return o; }
__device__ __forceinline__ void unpack8(const uint4 v, float (&f)[8]) {
    f[0] = __uint_as_float(v.x << 16); f[1] = __uint_as_float(v.x & 0xffff0000u);
    f[2] = __uint_as_float(v.y << 16); f[3] = __uint_as_float(v.y & 0xffff0000u);
    f[4] = __uint_as_float(v.z << 16); f[5] = __uint_as_float(v.z & 0xffff0000u);
    f[6] = __uint_as_float(v.w << 16); f[7] = __uint_as_float(v.w & 0xffff0000u);
}

#define XB_TMO      128
#define XB_XCNT(j)  (256  + 64 * (j))
#define XB_XSUB(j)  (1280 + 64 * (j))
#define XB_XGEN(j)  (2304 + 64 * (j))
#define XB_TOP      3328
#define XB_TOPGEN   3392
#define XCD_BAR_WORDS 3456
#define XB_SPIN_CAP (1u << 22)
__device__ __forceinline__ unsigned xb_ld(unsigned* p)              { return __hip_atomic_load(p, __ATOMIC_RELAXED, __HIP_MEMORY_SCOPE_AGENT); }
__device__ __forceinline__ unsigned xb_add(unsigned* p, unsigned v) { return __hip_atomic_fetch_add(p, v, __ATOMIC_RELAXED, __HIP_MEMORY_SCOPE_AGENT); }
__device__ __forceinline__ unsigned xb_xcc_id() { return (unsigned)__builtin_amdgcn_s_getreg((3 << 11) | 20) & 0xFu; }
#define XB_SPIN(cond, bar) do { unsigned _sp = 0; while (cond) { __builtin_amdgcn_s_sleep(1); \
    if ((++_sp & 255u) == 0u) { if (xb_ld(&(bar)[XB_TMO])) break; if (_sp > XB_SPIN_CAP) { atomicAdd(&(bar)[XB_TMO], 1u); break; } } } } while (0)
struct XcdBarrier { unsigned* bar; unsigned x; volatile unsigned* st; };
__device__ __forceinline__ XcdBarrier xcd_barrier_post(unsigned* bar, volatile unsigned* st) {
    XcdBarrier b; b.bar = bar; b.x = xb_xcc_id(); b.st = st;
    if (threadIdx.x == 0) (void)xb_add(&bar[XB_XCNT(b.x)], 1u);
    return b;
}
__device__ __forceinline__ void xcd_barrier_complete(unsigned* bar, unsigned x, unsigned& nloc, unsigned& nx) {
    const unsigned G = gridDim.x * gridDim.y * gridDim.z;
    unsigned sum, cnt, mine, sp = 0u;
    for (;;) {
        sum = 0u; cnt = 0u; mine = 0u;
#pragma unroll
        for (unsigned j = 0; j < 16; ++j) { const unsigned c = xb_ld(&bar[XB_XCNT(j)]); sum += c; cnt += (c > 0u) ? 1u : 0u; mine = (j == x) ? c : mine; }
        if (sum == G) break;
        __builtin_amdgcn_s_sleep(1);
        if ((++sp & 255u) == 0u) { if (xb_ld(&bar[XB_TMO])) break; if (sp > XB_SPIN_CAP) { atomicAdd(&bar[XB_TMO], 1u); break; } }
    }
    nloc = mine > 0u ? mine : 1u; nx = cnt > 0u ? cnt : 1u;
}
__device__ __forceinline__ void xcd_barrier(const XcdBarrier& b) {
    asm volatile("s_waitcnt vmcnt(0)" ::: "memory");
    __syncthreads();
    if (threadIdx.x == 0) {
        unsigned* bar = b.bar;
        __builtin_amdgcn_s_waitcnt(0);
        unsigned nloc = b.st[0], nx = b.st[1];
        if (nloc == 0u) { xcd_barrier_complete(bar, b.x, nloc, nx); b.st[0] = nloc; b.st[1] = nx; }
        const unsigned old = xb_add(&bar[XB_XSUB(b.x)], 1u);
        const unsigned gen = old / nloc;
        if (old + 1u == (gen + 1u) * nloc) {
            __builtin_amdgcn_fence(__ATOMIC_RELEASE, "agent");
            asm volatile("s_waitcnt vmcnt(0)" ::: "memory");
            const unsigned og = xb_add(&bar[XB_TOP], 1u);
            const unsigned tg = og / nx;
            if (og + 1u == (tg + 1u) * nx) xb_add(&bar[XB_TOPGEN], 1u);
            else XB_SPIN(xb_ld(&bar[XB_TOPGEN]) == tg, bar);
            __builtin_amdgcn_fence(__ATOMIC_ACQUIRE, "agent");
            xb_add(&bar[XB_XGEN(b.x)], 1u);
            asm volatile("s_waitcnt vmcnt(0)" ::: "memory");
        } else {
            XB_SPIN(xb_ld(&bar[XB_XGEN(b.x)]) == gen, bar);
            __builtin_amdgcn_fence(__ATOMIC_ACQUIRE, "agent");
            asm volatile("s_waitcnt vmcnt(0)" ::: "memory");
        }
    }
    __syncthreads();
}

#define CAS __attribute__((address_space(4)))
#define PR_BEGIN(id) do { if (PROBE_SP == (id)) c.prt = __builtin_amdgcn_s_memrealtime(); } while (0)
#define PR_END(id) do { if (PROBE_SP == (id)) c.pracc += __builtin_amdgcn_s_memrealtime() - c.prt; } while (0)
struct Ctx {
    const CAS Params* p;
    float* smf;
    int tid;
    mutable unsigned long long pracc, prt;
    __device__ __forceinline__ const float* in(int i) const { return p->in[i]; }
    __device__ __forceinline__ float* out() const { return p->out; }
    template <class T> __device__ __forceinline__ T* w(size_t off) const { return (T*)(p->ws + off); }
};

__device__ __forceinline__ const float* xsrc(const Ctx& c, int layer, int n) {
    if (layer == 0) { const int b = n / LT, pos = n % LT; return pos < CTX ? c.in(2) + ((size_t)b * CTX + pos) * D : c.in(0) + ((size_t)b * SEQ + (pos - CTX)) * D; }
    return c.w<float>(WS_X) + (size_t)n * D;
}
__device__ __forceinline__ void ngemm8(const bf16* const (&ar)[8], const float* bcol, int ldb, int K, float (&acc)[8]) {
    for (int k0 = 0; k0 < K; k0 += 8) {
        float w[8];
#pragma unroll
        for (int kk = 0; kk < 8; ++kk) w[kk] = bcol[(size_t)(k0 + kk) * ldb];
#pragma unroll
        for (int r = 0; r < 8; ++r) {
            float a[8]; unpack8(*(const uint4*)(ar[r] + k0), a);
#pragma unroll
            for (int kk = 0; kk < 8; ++kk) acc[r] = fmaf(a[kk], w[kk], acc[r]);
        }
    }
}

__device__ __forceinline__ void ph_prep(const Ctx& c, int gtid, int gthreads, int bid, int G, float* lds) {
    float* MOD = c.w<float>(WS_MOD);
    const int tid = c.tid;
    for (int tile = bid; tile < 192; tile += G) {
        const int l = tile / 96, j0 = (tile % 96) * 64;
        __syncthreads();
        for (int idx = tid; idx < 5 * D; idx += NTHR) { const int r = idx >> 10, k = idx & 1023; lds[idx] = silu_f(r < 4 ? c.in(1)[r * D + k] : c.in(3)[k]); }
        __syncthreads();
        const int jj = tid & 63, kq = tid >> 6;
        const float* aw = c.in(4) + (size_t)l * D * 6144 + j0 + jj;
        float acc[5] = {0.f, 0.f, 0.f, 0.f, 0.f};
#pragma unroll 32
        for (int k = kq * 256; k < kq * 256 + 256; ++k) {
            const float w = aw[(size_t)k * 6144];
#pragma unroll
            for (int r = 0; r < 5; ++r) acc[r] = fmaf(lds[r * D + k], w, acc[r]);
        }
#pragma unroll
        for (int r = 0; r < 5; ++r) lds[5 * D + (kq * 64 + jj) * 5 + r] = acc[r];
        __syncthreads();
        for (int idx = tid; idx < 320; idx += NTHR) { const int j2 = idx / 5, r = idx % 5;
            const float s = lds[5 * D + j2 * 5 + r] + lds[5 * D + (64 + j2) * 5 + r] + lds[5 * D + (128 + j2) * 5 + r] + lds[5 * D + (192 + j2) * 5 + r];
            MOD[(l * 5 + r) * 6144 + j0 + j2] = s + c.in(5)[l * 6144 + j0 + j2]; }
    }
    float* S5A = c.w<float>(WS_S5A); float* S5BB = c.w<float>(WS_S5BB);
    for (int it = gtid; it < 2 * 2 * 16 * 64; it += gthreads) {
        const int ldg = it / 64;
        const float lr = c.in(10)[it], li = c.in(11)[it], dt = expf(c.in(12)[ldg]);
        const float mag = expf(lr * dt), are = mag * cosf(li * dt), aim = mag * sinf(li * dt);
        const float den = lr * lr + li * li;
        const float fre = ((are - 1.f) * lr + aim * li) / den, fim = (aim * lr - (are - 1.f) * li) / den;
        S5A[it * 2] = are; S5A[it * 2 + 1] = aim;
        for (int ch = 0; ch < 16; ++ch) {
            const float br = c.in(13)[(size_t)it * 16 + ch], bi = c.in(14)[(size_t)it * 16 + ch];
            S5BB[((size_t)it * 16 + ch) * 2] = fre * br - fim * bi;
            S5BB[((size_t)it * 16 + ch) * 2 + 1] = fre * bi + fim * br;
        }
    }
    float* S5P = c.w<float>(WS_S5P);
    for (int it = gtid; it < 2 * 2 * 16 * 64 * 33; it += gthreads) {
        const int ldgp = it / 33, k = it % 33;
        const float lr = c.in(10)[ldgp], li = c.in(11)[ldgp], dt = expf(c.in(12)[ldgp / 64]);
        const float e = expf((float)k * lr * dt), ang = (float)k * li * dt;
        S5P[it * 2] = e * cosf(ang); S5P[it * 2 + 1] = e * sinf(ang);
    }
    float* KLAG = c.w<float>(WS_KLAG);
    for (int tile = bid; tile < 64; tile += G) {
        const int d = tile & 1, g = (tile >> 1) & 15, l = tile >> 5, ldg = (l * 2 + d) * 16 + g;
        float* LA = lds;
        float* LB = lds + 256;
        float* LC = lds + 2304;
        __syncthreads();
        if (tid < 64) {
            const int ldgp = ldg * 64 + tid;
            const float lr = c.in(10)[ldgp], li = c.in(11)[ldgp], dt = expf(c.in(12)[ldg]);
            const float mag = expf(lr * dt), are = mag * cosf(li * dt), aim = mag * sinf(li * dt), den = lr * lr + li * li;
            LA[tid * 4] = are; LA[tid * 4 + 1] = aim; LA[tid * 4 + 2] = ((are - 1.f) * lr + aim * li) / den; LA[tid * 4 + 3] = (aim * lr - (are - 1.f) * li) / den;
        }
        __syncthreads();
        for (int idx = tid; idx < 1024; idx += NTHR) {
            const int p = idx >> 4, cp = idx & 15;
            const float fre = LA[p * 4 + 2], fim = LA[p * 4 + 3];
            const float br = c.in(13)[((size_t)ldg * 64 + p) * 16 + cp], bi = c.in(14)[((size_t)ldg * 64 + p) * 16 + cp];
            LB[idx * 2] = fre * br - fim * bi; LB[idx * 2 + 1] = fre * bi + fim * br;
            const int cc = idx >> 6, p2 = idx & 63;
            LC[idx * 2] = c.in(15)[(size_t)ldg * 1024 + cc * 64 + p2]; LC[idx * 2 + 1] = c.in(16)[(size_t)ldg * 1024 + cc * 64 + p2];
        }
        __syncthreads();
        const int cp = tid >> 4, cc = tid & 15;
        float acc[32];
#pragma unroll
        for (int k = 0; k < 32; ++k) acc[k] = 0.f;
        for (int p = 0; p < 64; ++p) {
            const float are = LA[p * 4], aim = LA[p * 4 + 1];
            const float bbr = LB[(p * 16 + cp) * 2], bbi = LB[(p * 16 + cp) * 2 + 1], cr = LC[(cc * 64 + p) * 2], ci = LC[(cc * 64 + p) * 2 + 1];
            float zr = cr * bbr - ci * bbi, zi = cr * bbi + ci * bbr;
#pragma unroll
            for (int k = 0; k < 32; ++k) { acc[k] += zr; const float tr = zr * are - zi * aim, ti = zr * aim + zi * are; zr = tr; zi = ti; }
        }
#pragma unroll
        for (int k = 0; k < 32; ++k) KLAG[((size_t)((l * 16 + g) * 2 + d) * 32 + k) * 256 + cp * 16 + cc] = acc[k];
    }
    float* RWT = c.w<float>(WS_RWT);
    for (int it = gtid; it < 2 * 36 * 1024; it += gthreads) { const int k = it & 1023, o = (it >> 10) % 36, l = it / (36 * 1024);
        RWT[it] = o < 4 ? c.in(29)[((size_t)l * D + k) * 4 + o] : c.in(31)[((size_t)l * D + k) * 32 + (o - 4)]; }
    float* WDT = c.w<float>(WS_WDT);
    for (int it = gtid; it < 2 * 8 * 1024; it += gthreads) { const int k = it & 1023, j = (it >> 10) & 7, l = it >> 13; WDT[it] = c.in(8)[((size_t)l * D + k) * DIN + C_DT + j]; }
    float* ROPE = c.w<float>(WS_ROPE);
    for (int it = gtid; it < 64 * 16; it += gthreads) {
        const int pos = it / 16, f = it % 16;
        const float inv = powf(10000.0f, -(float)f / 16.0f);
        const float ang = (float)pos * inv;
        ROPE[it * 2] = cosf(ang); ROPE[it * 2 + 1] = sinf(ang);
    }
}

__device__ __forceinline__ void dt_project(const LAS float* wdt, const f32x4 (&h)[4], int lane, float* dst) {
    float mine = 0.f;
#pragma unroll 2
    for (int q = 0; q < 8; ++q) {
        float s = 0.f;
#pragma unroll
        for (int i = 0; i < 4; ++i) { const f32x4 w = *(const LAS f32x4*)(wdt + q * 1024 + (lane + 64 * i) * 4); s += h[i][0] * w[0] + h[i][1] * w[1] + h[i][2] * w[2] + h[i][3] * w[3]; }
        s = wave_sum(s);
        if (lane == q) mine = s;
    }
    if (lane < 8) dst[lane] = mine;
}
__device__ __forceinline__ void ph_norm1(const Ctx& c, int layer, int gw, int nwaves, unsigned char* lds) {
    const int lane = c.tid & 63;
    bf16* HA = c.w<bf16>(WS_HA); float* DTR = c.w<float>(WS_DTR);
    const float* MOD = c.w<float>(WS_MOD) + (size_t)layer * 5 * 6144;
    const float* g = c.in(6) + layer * D;
    __syncthreads();
    for (int i = c.tid; i < 2048; i += NTHR) ((f32x4*)lds)[i] = ((const f32x4*)(c.w<float>(WS_WDT) + (size_t)layer * 8 * 1024))[i];
    __syncthreads();
    const LAS float* wdt = (const LAS float*)lds;
    for (int n = gw; n < NT; n += nwaves) {
        const int b = n / LT, pos = n % LT, mr = pos < CTX ? 4 : b;
        const float* x = xsrc(c, layer, n);
        f32x4 v[4]; float ss = 0.f;
#pragma unroll
        for (int i = 0; i < 4; ++i) { v[i] = *(const f32x4*)(x + (lane + 64 * i) * 4); ss += v[i][0] * v[i][0] + v[i][1] * v[i][1] + v[i][2] * v[i][2] + v[i][3] * v[i][3]; }
        const float rstd = rsqrtf(wave_sum(ss) * (1.f / D) + EPS);
#pragma unroll
        for (int i = 0; i < 4; ++i) {
            const int k = (lane + 64 * i) * 4;
            const f32x4 gv = *(const f32x4*)(g + k), sc = *(const f32x4*)(MOD + mr * 6144 + 1024 + k), sh = *(const f32x4*)(MOD + mr * 6144 + k);
            v[i] = v[i] * rstd * gv * (sc + 1.f) + sh;
            *(uint2*)(HA + (size_t)n * D + k) = pack4(v[i]);
        }
        dt_project(wdt, v, lane, DTR + (size_t)n * 8);
    }
}

template <bool TRANS>
__device__ __forceinline__ void minipost_body(const Ctx& c, int layer, int r, int tb) {
    const int tid = c.tid, t = tid & 63, cqb = tid >> 6;
    const int n = tb * 64 + t, b = n / LT, pos = n % LT;
    const bool hasL = (pos != 0) && (pos != CTX), hasR = (pos != CTX - 1) && (pos != LT - 1);
    const float mL = hasL ? 1.f : 0.f, mR = hasR ? 1.f : 0.f;
    const bf16* XB = c.w<bf16>(WS_XBR) + (size_t)n * 768 + r * 256;
    const bf16* XL = hasL ? XB - 768 : XB; const bf16* XR = hasR ? XB + 768 : XB;
    bf16* XS = c.w<bf16>(WS_XBCS) + (size_t)n * 768 + r * 256;
    const float* cw = c.in(22) + (size_t)layer * 3 * 768 + r * 256; const float* cb = c.in(23) + layer * 768 + r * 256;
    bf16* TR = (r == 0 ? c.w<bf16>(WS_XT) : c.w<bf16>(WS_BT)) + (size_t)b * 256 * LT + pos;
#pragma unroll 2
    for (int i = 0; i < 8; ++i) {
        const int ch0 = (cqb * 8 + i) * 8;
        float xc[8], xl[8], xr[8];
        unpack8v(*(const u32x4*)(XB + ch0), xc); unpack8v(*(const u32x4*)(XL + ch0), xl); unpack8v(*(const u32x4*)(XR + ch0), xr);
        float y[8];
#pragma unroll
        for (int q = 0; q < 2; ++q) {
            const f32x4 w0 = *(const f32x4*)(cw + ch0 + 4 * q), w1 = *(const f32x4*)(cw + 768 + ch0 + 4 * q), w2 = *(const f32x4*)(cw + 1536 + ch0 + 4 * q), bb = *(const f32x4*)(cb + ch0 + 4 * q);
#pragma unroll
            for (int j = 0; j < 4; ++j) y[4 * q + j] = silu_f(w1[j] * xc[4 * q + j] + w0[j] * mL * xl[4 * q + j] + w2[j] * mR * xr[4 * q + j] + bb[j]);
        }
        const bf16x8 yb = pack8(y);
        *(bf16x8*)(XS + ch0) = yb;
        if (TRANS) {
#pragma unroll
            for (int j = 0; j < 8; ++j) TR[(size_t)(ch0 + j) * LT] = (bf16)yb[j];
        }
    }
}
__device__ __forceinline__ void ph_minipost(const Ctx& c, int layer, int tile) {
    const int r = tile % 3, tb = tile / 3;
    if (r < 2) minipost_body<true>(c, layer, r, tb); else minipost_body<false>(c, layer, r, tb);
}

__device__ __forceinline__ void ph_gates(const Ctx& c, int layer, int tile) {
    const int lane = c.tid & 63, n = tile * 4 + (c.tid >> 6), t4 = lane * 4;
    const f32x4 ys = *(const f32x4*)(c.w<float>(WS_YSSD) + (size_t)n * 256 + t4);
    const uint2 xr = *(const uint2*)(c.w<bf16>(WS_XBCS) + (size_t)n * 768 + t4), zr = *(const uint2*)(c.w<bf16>(WS_Z) + (size_t)n * 256 + t4);
    const float dsk = c.in(26)[layer * 4 + (lane >> 4)];
    float y[4];
    y[0] = (ys[0] + __uint_as_float(xr.x << 16) * dsk) * silu_f(__uint_as_float(zr.x << 16));
    y[1] = (ys[1] + __uint_as_float(xr.x & 0xffff0000u) * dsk) * silu_f(__uint_as_float(zr.x & 0xffff0000u));
    y[2] = (ys[2] + __uint_as_float(xr.y << 16) * dsk) * silu_f(__uint_as_float(zr.y << 16));
    y[3] = (ys[3] + __uint_as_float(xr.y & 0xffff0000u) * dsk) * silu_f(__uint_as_float(zr.y & 0xffff0000u));
    const float ss = wave_sum(y[0] * y[0] + y[1] * y[1] + y[2] * y[2] + y[3] * y[3]);
    const float rstd = rsqrtf(ss * (1.f / 256.f) + EPS);
    const f32x4 gn = *(const f32x4*)(c.in(27) + layer * 256 + t4);
    uint2 o; o.x = pk2bf(y[0] * rstd * gn[0], y[1] * rstd * gn[1]); o.y = pk2bf(y[2] * rstd * gn[2], y[3] * rstd * gn[3]);
    *(uint2*)(c.w<bf16>(WS_MIX) + (size_t)n * D + 512 + t4) = o;
}

__device__ __forceinline__ float half_sum(float v) {
#pragma unroll
    for (int o = 1; o < 32; o <<= 1) v += __shfl_xor(v, o);
    return v;
}
__device__ __forceinline__ void ph_norm2(const Ctx& c, int layer, int bid, int G, unsigned char* hbuf, int* lsm) {
    const int lane = c.tid & 63, wid = c.tid >> 6, hl = lane & 31, half = lane >> 5;
    const int per = (NT + G - 1) / G, n0 = bid * per, n1 = (n0 + per < NT) ? n0 + per : NT;
    __syncthreads();
    const float* X = c.w<float>(WS_X); bf16* HA = c.w<bf16>(WS_HA);
    const float* MOD = c.w<float>(WS_MOD) + (size_t)layer * 5 * 6144;
    const float* g = c.in(7) + layer * D;
    int* TE = c.w<int>(WS_TOKE); float* TW = c.w<float>(WS_TOKW);
    float* hb = (float*)hbuf + (wid * 2 + half) * D;
    const float* rwt = c.w<float>(WS_RWT) + (size_t)layer * 36 * 1024;
    for (int nb = n0 + wid * 2; nb < n1; nb += 8) {
        const bool act = nb + half < n1;
        const int n = act ? nb + half : n1 - 1;
        const int b = n / LT, pos = n % LT, mr = pos < CTX ? 4 : b;
        const float* x = X + (size_t)n * D;
        float ss = 0.f;
        PR_BEGIN(110);
        f32x4 v[8];
#pragma unroll
        for (int i = 0; i < 8; ++i) { v[i] = *(const f32x4*)(x + (hl + 32 * i) * 4); ss += v[i][0] * v[i][0] + v[i][1] * v[i][1] + v[i][2] * v[i][2] + v[i][3] * v[i][3]; }
        const float rstd = rsqrtf(half_sum(ss) * (1.f / D) + EPS);
        PR_END(110); PR_BEGIN(111);
        float cg[4] = {0.f, 0.f, 0.f, 0.f};
#pragma unroll
        for (int i = 0; i < 8; ++i) {
            const int k = (hl + 32 * i) * 4;
            const f32x4 h = v[i] * rstd * *(const f32x4*)(g + k) * (*(const f32x4*)(MOD + mr * 6144 + 4096 + k) + 1.f) + *(const f32x4*)(MOD + mr * 6144 + 3072 + k);
            *(f32x4*)(hb + k) = h;
            *(uint2*)(HA + (size_t)n * D + k) = pack4(h);
#pragma unroll
            for (int e = 0; e < 4; ++e) { const f32x4 w = *(const f32x4*)(rwt + e * 1024 + k); cg[e] += h[0] * w[0] + h[1] * w[1] + h[2] * w[2] + h[3] * w[3]; }
        }
        float mx = -1e30f; int gi = 0; float cl[4];
#pragma unroll
        for (int e = 0; e < 4; ++e) { cl[e] = half_sum(cg[e]) + c.in(30)[layer * 4 + e]; if (cl[e] > mx) { mx = cl[e]; gi = e; } }
        PR_END(111); PR_BEGIN(112);
        float fg[8] = {0.f, 0.f, 0.f, 0.f, 0.f, 0.f, 0.f, 0.f};
        const float* fwt = rwt + (4 + gi * 8) * 1024;
#pragma unroll 2
        for (int i = 0; i < 8; ++i) {
            const int k = (hl + 32 * i) * 4;
            const f32x4 h = *(const f32x4*)(hb + k);
#pragma unroll
            for (int e = 0; e < 8; ++e) { const f32x4 w = *(const f32x4*)(fwt + e * 1024 + k); fg[e] += h[0] * w[0] + h[1] * w[1] + h[2] * w[2] + h[3] * w[3]; }
        }
#pragma unroll
        for (int e = 0; e < 8; ++e) fg[e] = half_sum(fg[e]);
        PR_END(112); PR_BEGIN(113);
        if (hl == 0 && act) {
            float den = 0.f;
#pragma unroll
            for (int e = 0; e < 4; ++e) den += expf(cl[e] - mx);
            const float pg = 1.f / den;
            float f1 = -1e30f, f2 = -1e30f; int i1 = 0, i2 = 0;
#pragma unroll
            for (int e = 0; e < 8; ++e) {
                const float fv = fg[e] + c.in(32)[layer * 32 + gi * 8 + e];
                if (fv > f1) { f2 = f1; i2 = i1; f1 = fv; i1 = e; } else if (fv > f2) { f2 = fv; i2 = e; }
            }
            const float e2 = expf(f2 - f1), w1 = pg / (1.f + e2), w2 = pg * e2 / (1.f + e2);
            const int ex1 = gi * 8 + i1, ex2 = gi * 8 + i2;
            lsm[(n - n0) * 2] = ex1; lsm[(n - n0) * 2 + 1] = ex2;
            TE[n * 2] = ex1; TE[n * 2 + 1] = ex2; TW[n * 2] = w1; TW[n * 2 + 1] = w2;
        }
        PR_END(113);
    }
    PR_BEGIN(114);
    __syncthreads();
    if (c.tid < 32) {
        const int e = c.tid, ne = (n1 > n0 ? n1 - n0 : 0) * 2;
        int cl_ = 0;
        for (int i = 0; i < ne; ++i) cl_ += (lsm[i] == e) ? 1 : 0;
        c.w<int>(WS_BCNT)[bid * 32 + e] = cl_;
    }
    PR_END(114);
}
__device__ __forceinline__ void ph_assign(const Ctx& c, int layer, int bid, int G, int* wk, const int* lsm) {
    const int e = c.tid & 31, part = c.tid >> 5;
    const int per = (NT + G - 1) / G, n0 = bid * per, n1 = (n0 + per < NT) ? n0 + per : NT;
    const int* BC = c.w<int>(WS_BCNT);
    int before = 0, all = 0;
#pragma unroll 16
    for (int blk = part; blk < G; blk += 8) { const int v = BC[blk * 32 + e]; all += v; before += blk < bid ? v : 0; }
    __syncthreads();
    wk[(part * 32 + e) * 2] = before; wk[(part * 32 + e) * 2 + 1] = all;
    __syncthreads();
    if (c.tid < 32) {
        int base = 0, tot = 0;
#pragma unroll
        for (int p = 0; p < 8; ++p) { base += wk[(p * 32 + e) * 2]; tot += wk[(p * 32 + e) * 2 + 1]; }
        if (bid == 0) c.w<unsigned>(WS_CTL)[CW_CNT + (layer * 32 + e) * 64] = (unsigned)tot;
        int* TP = c.w<int>(WS_TOKP); int* LI = c.w<int>(WS_LIST);
        const int ne = (n1 > n0 ? n1 - n0 : 0) * 2;
        int r = 0;
        for (int i = 0; i < ne; ++i) if (lsm[i] == e) { const int n = n0 + (i >> 1); const int ps = base + r; ++r; TP[n * 2 + (i & 1)] = ps; LI[(size_t)e * NT + ps] = n; }
    }
}

__device__ __forceinline__ void moe_offsets(const Ctx& c, int layer, int* sm) {
    __syncthreads();
    if (c.tid == 0) {
        const unsigned* cnt = c.w<unsigned>(WS_CTL) + CW_CNT + layer * 32 * 64;
        int acc = 0;
        for (int e = 0; e < 32; ++e) { const int ce = (int)__hip_atomic_load(cnt + e * 64, __ATOMIC_RELAXED, __HIP_MEMORY_SCOPE_AGENT); sm[e] = acc; sm[33 + e] = ce; acc += (ce + 127) & ~127; }
        sm[32] = acc;
    }
    __syncthreads();
}
__device__ __forceinline__ int slot_expert(const int* sm, int slot) { int e = 0;
#pragma unroll 1
    for (int i = 1; i < 32; ++i) if (slot >= sm[i]) e = i;
    return e; }

__device__ __forceinline__ f32x4 bf4(const uint2 u) { return (f32x4){__uint_as_float(u.x << 16), __uint_as_float(u.x & 0xffff0000u), __uint_as_float(u.y << 16), __uint_as_float(u.y & 0xffff0000u)}; }
__device__ __forceinline__ void ph_combine(const Ctx& c, int layer, int gw, int nwaves, const int* sm, unsigned char* lds) {
    const int lane = c.tid & 63;
    __syncthreads();
    for (int i = c.tid; i < 2048; i += NTHR) ((f32x4*)lds)[i] = ((const f32x4*)(c.w<float>(WS_WDT) + (size_t)8 * 1024))[i];
    __syncthreads();
    const LAS float* wdt = (const LAS float*)lds;
    const int* TE = c.w<int>(WS_TOKE); const int* TP = c.w<int>(WS_TOKP); const float* TW = c.w<float>(WS_TOKW);
    const bf16* OUT = c.w<bf16>(WS_OUT);
    bf16* HA = c.w<bf16>(WS_HA); float* DTR = c.w<float>(WS_DTR);
    const float* MODn = c.w<float>(WS_MOD) + (size_t)1 * 5 * 6144;
    const float* gnext = c.in(6) + D;
    for (int n = gw; n < NT; n += nwaves) {
        const int b = n / LT, pos = n % LT, mr = pos < CTX ? 4 : b;
        if (layer == 1 && pos < CTX) continue;
        const int s0 = sm[TE[n * 2]] + TP[n * 2], s1 = sm[TE[n * 2 + 1]] + TP[n * 2 + 1];
        const float w0 = TW[n * 2], w1 = TW[n * 2 + 1];
        const float* g2 = c.w<float>(WS_MOD) + (size_t)layer * 5 * 6144 + mr * 6144 + 5120;
        float* X = c.w<float>(WS_X) + (size_t)n * D;
        f32x4 v[4]; float ss = 0.f;
#pragma unroll
        for (int i = 0; i < 4; ++i) {
            const int k = (lane + 64 * i) * 4;
            const f32x4 o0 = bf4(*(const uint2*)(OUT + (size_t)s0 * D + k)), o1 = bf4(*(const uint2*)(OUT + (size_t)s1 * D + k));
            v[i] = *(const f32x4*)(X + k) + *(const f32x4*)(g2 + k) * (o0 * w0 + o1 * w1);
            ss += v[i][0] * v[i][0] + v[i][1] * v[i][1] + v[i][2] * v[i][2] + v[i][3] * v[i][3];
        }
        const float rstd = rsqrtf(wave_sum(ss) * (1.f / D) + EPS);
        if (layer == 1) {
            float* o = c.out() + ((size_t)b * SEQ + (pos - CTX)) * D;
#pragma unroll
            for (int i = 0; i < 4; ++i) { const int k = (lane + 64 * i) * 4; *(f32x4*)(o + k) = v[i] * rstd * *(const f32x4*)(c.in(36) + k); }
        } else {
#pragma unroll
            for (int i = 0; i < 4; ++i) {
                const int k = (lane + 64 * i) * 4;
                *(f32x4*)(X + k) = v[i];
                v[i] = v[i] * rstd * *(const f32x4*)(gnext + k) * (*(const f32x4*)(MODn + mr * 6144 + 1024 + k) + 1.f) + *(const f32x4*)(MODn + mr * 6144 + k);
                *(uint2*)(HA + (size_t)n * D + k) = pack4(v[i]);
            }
            dt_project(wdt, v, lane, DTR + (size_t)n * 8);
        }
    }
}

typedef LAS const char* lds_cptr;
constexpr int GEMM_LDS = 32768;
__device__ __forceinline__ s16x4 lds_tr(lds_cptr p) { return __builtin_bit_cast(s16x4, __builtin_amdgcn_ds_read_tr16_b64_v4i16((LAS s16x4*)p)); }

template <bool B_F32, class ARow>
__device__ __forceinline__ void gemm_tile(const int tid, unsigned char* lds, ARow arow, const void* Bp  , int ldb, bool bval, int K, f32x4 (&acc)[4][4]) {
    const int lane = tid & 63, wid = tid >> 6, wr = wid >> 1, wc = wid & 1, fr = lane & 15, fq = lane >> 4;
#pragma unroll
    for (int m = 0; m < 4; ++m)
#pragma unroll
        for (int n = 0; n < 4; ++n) acc[m][n] = (f32x4){0.f, 0.f, 0.f, 0.f};
    const bf16* ap[4];
#pragma unroll
    for (int i = 0; i < 4; ++i) ap[i] = arow((tid >> 3) + 32 * i) + (tid & 7) * 8;
    const int bk = tid >> 4, bnc = tid & 15;
    u32x4 ra[4]; u32x4 rb[4]; f32x4 rbf[8];
    auto gload = [&](int kt) __attribute__((always_inline)) {
#pragma unroll
        for (int i = 0; i < 4; ++i) ra[i] = *(const u32x4*)(ap[i] + kt * 64);
        if (B_F32) {
            const float* bp = (const float*)Bp + (size_t)(kt * 64 + bk) * ldb;
#pragma unroll
            for (int i = 0; i < 4; ++i) {
                if (bval) { rbf[2 * i] = *(const f32x4*)(bp + (size_t)(16 * i) * ldb); rbf[2 * i + 1] = *(const f32x4*)(bp + (size_t)(16 * i) * ldb + 4); }
                else { rbf[2 * i] = (f32x4){0.f, 0.f, 0.f, 0.f}; rbf[2 * i + 1] = rbf[2 * i]; }
            }
        } else {
            const bf16* bp = (const bf16*)Bp + (size_t)(kt * 64 + bk) * ldb;
#pragma unroll
            for (int i = 0; i < 4; ++i) rb[i] = bval ? *(const u32x4*)(bp + (size_t)(16 * i) * ldb) : (u32x4){0u, 0u, 0u, 0u};
        }
    };
    auto lstore = [&]() __attribute__((always_inline)) {
#pragma unroll
        for (int i = 0; i < 4; ++i) { const int row = (tid >> 3) + 32 * i, kc = tid & 7;
            *(u32x4*)(lds + (kc >> 2) * 8192 + row * 64 + (kc & 3) * 16) = ra[i]; }
#pragma unroll
        for (int i = 0; i < 4; ++i) { const int k = bk + 16 * i;
            u32x4 v;
            if (B_F32) { v.x = pk2bf(rbf[2 * i].x, rbf[2 * i].y); v.y = pk2bf(rbf[2 * i].z, rbf[2 * i].w); v.z = pk2bf(rbf[2 * i + 1].x, rbf[2 * i + 1].y); v.w = pk2bf(rbf[2 * i + 1].z, rbf[2 * i + 1].w); }
            else v = rb[i];
            *(u32x4*)(lds + 16384 + ((k >> 3) * 8 + (bnc >> 1)) * 256 + (k & 7) * 32 + (bnc & 1) * 16) = v; }
    };
    const lds_cptr la = (lds_cptr)lds + (wr * 64 + fr) * 64 + fq * 16;
    const lds_cptr lb = (lds_cptr)lds + 16384 + (fq * 8 + wc * 4) * 256 + (fr >> 2) * 32 + (fr & 3) * 8;
    const int nk = K / 64;
    gload(0);
    for (int kt = 0; kt < nk; ++kt) {
        __syncthreads();
        lstore();
        __syncthreads();
        if (kt + 1 < nk) gload(kt + 1);
#pragma unroll
        for (int kh = 0; kh < 2; ++kh) {
            bf16x8 af[4], bfr[4];
#pragma unroll
            for (int m = 0; m < 4; ++m) af[m] = *(const LAS bf16x8*)(la + kh * 8192 + m * 1024);
#pragma unroll
            for (int n = 0; n < 4; ++n) {
                const s16x4 lo = lds_tr(lb + kh * 8192 + n * 256), hi = lds_tr(lb + kh * 8192 + n * 256 + 128);
                bfr[n] = (bf16x8){lo[0], lo[1], lo[2], lo[3], hi[0], hi[1], hi[2], hi[3]};
            }
#pragma unroll
            for (int m = 0; m < 4; ++m)
#pragma unroll
                for (int n = 0; n < 4; ++n) acc[m][n] = __builtin_amdgcn_mfma_f32_16x16x32_bf16(bfr[n], af[m], acc[m][n], 0, 0, 0);
        }
    }
}

typedef float f32x2 __attribute__((ext_vector_type(2)));
__device__ __forceinline__ void ph_inproj_mfma(const Ctx& c, int layer, int tile, unsigned char* lds) {
    const int mt = tile / 18, nt = tile % 18;
    const bf16* HA = c.w<bf16>(WS_HA) + (size_t)mt * 128 * D;
    f32x4 acc[4][4];
    const int vc = nt * 128 + (c.tid & 15) * 8, ac = vc < C_DT ? vc : vc + 8;
    gemm_tile<true>(c.tid, lds, [&](int r) __attribute__((always_inline)) { return HA + (size_t)r * D; }, c.in(8) + (size_t)layer * D * DIN + ac, DIN, true, D, acc);
    const int lane = c.tid & 63, wid = c.tid >> 6, wr = wid >> 1, wc = wid & 1, fr = lane & 15, fq = lane >> 4;
    const int n0 = mt * 128, b = n0 / LT, pos0 = n0 % LT;
    if (nt < 2) {
        bf16* UH = c.w<bf16>(WS_UH);
#pragma unroll
        for (int m = 0; m < 4; ++m) {
            const int pos = pos0 + wr * 64 + m * 16 + fr, J = b * 136 + (pos >> 5), tt = pos & 31;
#pragma unroll
            for (int n = 0; n < 4; ++n) { const int col = nt * 128 + wc * 64 + n * 16 + fq * 4;
                *(uint2*)(UH + ((size_t)(col >> 4) * NCH5 + J) * 768 + tt * 16 + (col & 15)) = pack4(acc[m][n]); }
        }
    } else if (nt < 6 || nt >= 14) {
        const int kind = nt >= 14 ? 1 : 0, sub = nt - (kind ? 14 : 2);
        if (sub == 3) {
            bf16* Vt = c.w<bf16>(kind ? WS_WV : WS_GV) + ((size_t)b * 2 + wc) * 64 * LT;
#pragma unroll
            for (int m = 0; m < 4; ++m) { const int pos = pos0 + wr * 64 + m * 16 + fr;
#pragma unroll
                for (int n = 0; n < 4; ++n)
#pragma unroll
                    for (int jj = 0; jj < 4; ++jj) Vt[(size_t)(n * 16 + fq * 4 + jj) * LT + pos] = f2bf(acc[m][n][jj]); }
        } else {
            const bool isq = sub < 2; const int head = isq ? sub * 2 + wc : wc;
            bf16* dst = isq ? c.w<bf16>(kind ? WS_WQ : WS_GQ) + ((size_t)b * 4 + head) * LT * 64 : c.w<bf16>(kind ? WS_WK : WS_GK) + ((size_t)b * 2 + head) * LT * 64;
            const float* gain = (isq ? c.in(20) : c.in(21)) + layer * 64;
            const float qs = isq ? 0.18033688011112042f : 1.f;
            const float* ROPE = c.w<float>(WS_ROPE);
#pragma unroll
            for (int m = 0; m < 4; ++m) {
                const int pos = pos0 + wr * 64 + m * 16 + fr;
                f32x4 v[4];
#pragma unroll
                for (int n = 0; n < 4; ++n) v[n] = acc[m][n];
                if (kind == 0) {
                    float ss = 0.f;
#pragma unroll
                    for (int n = 0; n < 4; ++n) ss += v[n][0] * v[n][0] + v[n][1] * v[n][1] + v[n][2] * v[n][2] + v[n][3] * v[n][3];
                    ss += __shfl_xor(ss, 16); ss += __shfl_xor(ss, 32);
                    const float rstd = rsqrtf(ss * (1.f / 64.f) + EPS);
#pragma unroll
                    for (int n = 0; n < 4; ++n) v[n] = v[n] * rstd * *(const f32x4*)(gain + n * 16 + fq * 4);
                }
                if (pos >= CTX) {
                    const int l = pos - CTX;
#pragma unroll
                    for (int a = 0; a < 2; ++a) { const int rp = a == 0 ? (l >> 6) : (l & 63);
#pragma unroll
                        for (int jj = 0; jj < 4; ++jj) { const f32x2 cs = *(const f32x2*)(ROPE + (rp * 16 + fq * 4 + jj) * 2);
                            const float x0 = v[2 * a][jj], x1 = v[2 * a + 1][jj];
                            v[2 * a][jj] = x0 * cs[0] - x1 * cs[1]; v[2 * a + 1][jj] = x1 * cs[0] + x0 * cs[1]; } }
                }
#pragma unroll
                for (int n = 0; n < 4; ++n) *(uint2*)(dst + (size_t)pos * 64 + n * 16 + fq * 4) = pack4(v[n] * qs);
            }
        }
    } else {
        bf16* dst; int ld, col0;
        if (nt < 8) { dst = c.w<bf16>(WS_Z); ld = 256; col0 = (nt - 6) * 128; } else { dst = c.w<bf16>(WS_XBR); ld = 768; col0 = (nt - 8) * 128; }
#pragma unroll
        for (int m = 0; m < 4; ++m) { const size_t row = (size_t)n0 + wr * 64 + m * 16 + fr;
#pragma unroll
            for (int n = 0; n < 4; ++n) *(uint2*)(dst + row * ld + col0 + wc * 64 + n * 16 + fq * 4) = pack4(acc[m][n]); }
    }
}

#define EPI_COORDS const int lane = c.tid & 63, wid = c.tid >> 6, wr = wid >> 1, wc = wid & 1, fr = lane & 15, fq = lane >> 4
__device__ __forceinline__ void ph_glu_mfma(const Ctx& c, int layer, int tile, unsigned char* lds) {
    const int mt = tile >> 1, nt = tile & 1;
    const bf16* G5 = c.w<bf16>(WS_G5) + (size_t)mt * 128 * 256;
    f32x4 acc[4][4];
    const int bc = nt * 128 + (c.tid & 15) * 8;
    gemm_tile<true>(c.tid, lds, [&](int r) __attribute__((always_inline)) { return G5 + (size_t)r * 256; }, c.in(18) + (size_t)layer * 256 * 256 + bc, 256, true, 256, acc);
    EPI_COORDS;
    bf16* MIX = c.w<bf16>(WS_MIX);
#pragma unroll
    for (int m = 0; m < 4; ++m)
#pragma unroll
        for (int n = 0; n < 4; ++n) {
            const int rl = wr * 64 + m * 16 + fr, col = nt * 128 + wc * 64 + n * 16 + fq * 4;
            const f32x4 bb = *(const f32x4*)(c.in(19) + layer * 256 + col);
            const uint2 gv = *(const uint2*)(G5 + (size_t)rl * 256 + col);
            const float g0 = __uint_as_float(gv.x << 16), g1 = __uint_as_float(gv.x & 0xffff0000u), g2 = __uint_as_float(gv.y << 16), g3 = __uint_as_float(gv.y & 0xffff0000u);
            uint2 o;
            o.x = pk2bf(g0 * sigmoid_f(acc[m][n][0] + bb[0]), g1 * sigmoid_f(acc[m][n][1] + bb[1]));
            o.y = pk2bf(g2 * sigmoid_f(acc[m][n][2] + bb[2]), g3 * sigmoid_f(acc[m][n][3] + bb[3]));
            *(uint2*)(MIX + (size_t)(mt * 128 + rl) * D + col) = o;
        }
}
__device__ __forceinline__ void ph_outproj_mfma(const Ctx& c, int layer, int tile, unsigned char* lds) {
    const int mt = tile >> 3, nt = tile & 7;
    const bf16* MIX = c.w<bf16>(WS_MIX) + (size_t)mt * 128 * D;
    f32x4 acc[4][4];
    const int bc = nt * 128 + (c.tid & 15) * 8;
    gemm_tile<true>(c.tid, lds, [&](int r) __attribute__((always_inline)) { return MIX + (size_t)r * D; }, c.in(9) + (size_t)layer * D * D + bc, D, true, D, acc);
    EPI_COORDS;
    const float* MOD = c.w<float>(WS_MOD) + (size_t)layer * 5 * 6144;
    float* X = c.w<float>(WS_X);
#pragma unroll
    for (int m = 0; m < 4; ++m) {
        const int row = mt * 128 + wr * 64 + m * 16 + fr, b = row / LT, pos = row % LT, mr = pos < CTX ? 4 : b;
        const float* xs = xsrc(c, layer, row);
#pragma unroll
        for (int n = 0; n < 4; ++n) {
            const int col = nt * 128 + wc * 64 + n * 16 + fq * 4;
            const f32x4 g1 = *(const f32x4*)(MOD + mr * 6144 + 2048 + col);
            *(f32x4*)(X + (size_t)row * D + col) = *(const f32x4*)(xs + col) + g1 * acc[m][n];
        }
    }
}
__device__ __forceinline__ void ph_moe1_mfma(const Ctx& c, int layer, int tile, const int* sm, unsigned char* lds) {
    const int st = tile >> 3, nt = tile & 7;
    const int s0 = st * 128;
    if (s0 >= sm[32]) return;
    const int e = slot_expert(sm, s0), base = s0 - sm[e], ce = sm[33 + e];
    if (base >= ce) return;
    const bf16* HA = c.w<bf16>(WS_HA); const int* LI = c.w<int>(WS_LIST) + (size_t)e * NT;
    f32x4 acc[4][4];
    const int bnc = c.tid & 15, seg = bnc >> 2;
    const float* wsel = c.in((seg & 1) ? 34 : 33) + ((size_t)layer * NEXP + e) * D * DE + nt * 64 + (seg >> 1) * 32 + (bnc & 3) * 8;
    gemm_tile<true>(c.tid, lds, [&](int r) __attribute__((always_inline)) { const int tok = LI[(base + r < ce) ? (base + r) : base]; return HA + (size_t)tok * D; }, wsel, DE, true, D, acc);
    EPI_COORDS;
    bf16* ACT = c.w<bf16>(WS_ACT);
#pragma unroll
    for (int m = 0; m < 4; ++m) {
        const int rl = wr * 64 + m * 16 + fr;
#pragma unroll
        for (int n = 0; n < 2; ++n) {
            const int col = nt * 64 + wc * 32 + n * 16 + fq * 4;
            const f32x4 g = acc[m][n], u = acc[m][n + 2];
            uint2 o; o.x = pk2bf(silu_f(g[0]) * u[0], silu_f(g[1]) * u[1]); o.y = pk2bf(silu_f(g[2]) * u[2], silu_f(g[3]) * u[3]);
            *(uint2*)(ACT + (size_t)(s0 + rl) * DE + col) = o;
        }
    }
}
__device__ __forceinline__ void ph_moe2_mfma(const Ctx& c, int layer, int tile, const int* sm, unsigned char* lds) {
    const int st = tile >> 3, nt = tile & 7;
    const int s0 = st * 128;
    if (s0 >= sm[32]) return;
    const int e = slot_expert(sm, s0), base = s0 - sm[e], ce = sm[33 + e];
    if (base >= ce) return;
    const bf16* ACT = c.w<bf16>(WS_ACT) + (size_t)s0 * DE;
    f32x4 acc[4][4];
    const int bc = nt * 128 + (c.tid & 15) * 8;
    gemm_tile<true>(c.tid, lds, [&](int r) __attribute__((always_inline)) { return ACT + (size_t)r * DE; }, c.in(35) + ((size_t)layer * NEXP + e) * DE * D + bc, D, true, DE, acc);
    EPI_COORDS;
    bf16* OUT = c.w<bf16>(WS_OUT);
#pragma unroll
    for (int m = 0; m < 4; ++m)
#pragma unroll
        for (int n = 0; n < 4; ++n) {
            const int rl = wr * 64 + m * 16 + fr, col = nt * 128 + wc * 64 + n * 16 + fq * 4;
            uint2 o; o.x = pk2bf(acc[m][n][0], acc[m][n][1]); o.y = pk2bf(acc[m][n][2], acc[m][n][3]);
            *(uint2*)(OUT + (size_t)(s0 + rl) * D + col) = o;
        }
}


typedef float f32x16 __attribute__((ext_vector_type(16)));
constexpr int AT_KST = 144, AT_VST = 136;
constexpr int AT_KOFF = 0, AT_VOFF = 64 * AT_KST, AT_SOFF = AT_VOFF + 64 * AT_VST;
constexpr float AT_THR = 5.0f;
__device__ __forceinline__ int crow(int r, int hi) { return (r & 3) + 8 * (r >> 2) + 4 * hi; }

__device__ __forceinline__ void attn_tile(const Ctx& c, int layer, int idx, unsigned char* lds) {
    const int tid = c.tid, lane = tid & 63, wid = tid >> 6, r32 = lane & 31, hi = lane >> 5;
    int kind, b, h, qt;
    if (idx < 1024) { kind = idx >> 9; const int r = idx & 511; b = r >> 7; h = (r >> 5) & 3; qt = 2 + (r & 31); }
    else { const int r = idx - 1024; kind = r >> 5; b = (r >> 3) & 3; h = (r >> 1) & 3; qt = r & 1; }
    const int kvh = h >> 1;
    const bf16* Q = c.w<bf16>(kind ? WS_WQ : WS_GQ) + ((size_t)b * 4 + h) * LT * 64;
    const bf16* K = c.w<bf16>(kind ? WS_WK : WS_GK) + ((size_t)b * 2 + kvh) * LT * 64;
    const bf16* Vt = c.w<bf16>(kind ? WS_WV : WS_GV) + ((size_t)b * 2 + kvh) * 64 * LT;
    const int q0 = qt * 128;
    const int qpos = q0 + wid * 32 + r32;
    int b0 = CTX, b1 = CTX;
    if (qt >= 2) { if (kind == 0) { b0 = CTX; b1 = LT; } else { b0 = q0 - 128 < CTX ? CTX : q0 - 128; b1 = q0 + 256 > LT ? LT : q0 + 256; } }
    const int nA = CTX / 64, ntile = nA + (b1 - b0) / 64;
    bf16x8 qf[4];
#pragma unroll
    for (int d0 = 0; d0 < 4; ++d0) qf[d0] = *(const bf16x8*)(Q + (size_t)qpos * 64 + d0 * 16 + hi * 8);
    f32x16 o0, o1;
#pragma unroll
    for (int r = 0; r < 16; ++r) { o0[r] = 0.f; o1[r] = 0.f; }
    float m = -1e30f, l = 0.f;
    if (kind == 1) { m = c.in(28)[layer * 4 + h] * 1.4426950408889634f; l = (hi == 0) ? 1.f : 0.f; }
    float* wsf = (float*)(lds + AT_SOFF) + wid * 32;
    u32x4 rk[2], rv[2];
    auto gload = [&](int ti) __attribute__((always_inline)) {
        const int kb = ti < nA ? ti * 64 : b0 + (ti - nA) * 64;
#pragma unroll
        for (int i = 0; i < 2; ++i) { const int cc = tid + 256 * i;
            rk[i] = *(const u32x4*)(K + (size_t)(kb + (cc >> 3)) * 64 + (cc & 7) * 8);
            rv[i] = *(const u32x4*)(Vt + (size_t)(cc >> 3) * LT + kb + (cc & 7) * 8); }
    };
    const lds_cptr lk = (lds_cptr)lds + AT_KOFF + r32 * AT_KST + hi * 16;
    const lds_cptr lv = (lds_cptr)lds + AT_VOFF + r32 * AT_VST + hi * 8;
    gload(0);
    for (int ti = 0; ti < ntile; ++ti) {
        const int kb = ti < nA ? ti * 64 : b0 + (ti - nA) * 64;
        __syncthreads();
#pragma unroll
        for (int i = 0; i < 2; ++i) { const int cc = tid + 256 * i;
            *(u32x4*)(lds + AT_KOFF + (cc >> 3) * AT_KST + (cc & 7) * 16) = rk[i];
            unsigned char* vp = lds + AT_VOFF + (cc >> 3) * AT_VST + (cc & 7) * 16;
            *(uint2*)vp = make_uint2(rv[i][0], rv[i][1]); *(uint2*)(vp + 8) = make_uint2(rv[i][2], rv[i][3]); }
        __syncthreads();
        if (ti + 1 < ntile) gload(ti + 1);
        f32x16 p0, p1;
#pragma unroll
        for (int r = 0; r < 16; ++r) { p0[r] = 0.f; p1[r] = 0.f; }
#pragma unroll
        for (int d0 = 0; d0 < 4; ++d0) {
            const bf16x8 k0 = *(const LAS bf16x8*)(lk + d0 * 32), k1 = *(const LAS bf16x8*)(lk + 32 * AT_KST + d0 * 32);
            p0 = __builtin_amdgcn_mfma_f32_32x32x16_bf16(k0, qf[d0], p0, 0, 0, 0);
            p1 = __builtin_amdgcn_mfma_f32_32x32x16_bf16(k1, qf[d0], p1, 0, 0, 0);
        }
        if (kind == 1 && ti >= nA) {
#pragma unroll
            for (int r = 0; r < 16; ++r) {
                const int d0_ = kb + crow(r, hi) - qpos, d1_ = d0_ + 32;
                if (d0_ > 128 || d0_ < -128) p0[r] = -INFINITY;
                if (d1_ > 128 || d1_ < -128) p1[r] = -INFINITY;
            }
        }
        float rm = fmaxf(p0[0], p1[0]);
#pragma unroll
        for (int r = 1; r < 16; ++r) rm = fmaxf(rm, fmaxf(p0[r], p1[r]));
        rm = fmaxf(rm, __shfl_xor(rm, 32));
        if (__any(rm > m + AT_THR)) {
            const float mn = fmaxf(m, rm), f = __builtin_amdgcn_exp2f(m - mn);
            m = mn; l *= f;
            if (hi == 0) wsf[r32] = f;
#pragma unroll
            for (int g = 0; g < 4; ++g) { const f32x4 fv = *(const f32x4*)(wsf + 8 * g + 4 * hi);
#pragma unroll
                for (int j = 0; j < 4; ++j) { o0[4 * g + j] *= fv[j]; o1[4 * g + j] *= fv[j]; } }
        }
        float ls = 0.f;
#pragma unroll
        for (int r = 0; r < 16; ++r) { p0[r] = __builtin_amdgcn_exp2f(p0[r] - m); p1[r] = __builtin_amdgcn_exp2f(p1[r] - m); ls += p0[r] + p1[r]; }
        l += ls;
#pragma unroll
        for (int t = 0; t < 2; ++t)
#pragma unroll
            for (int s = 0; s < 2; ++s) {
                bf16x8 pa;
#pragma unroll
                for (int j = 0; j < 8; ++j) pa[j] = (short)f2bf(t == 0 ? p0[8 * s + j] : p1[8 * s + j]);
#pragma unroll
                for (int d0 = 0; d0 < 2; ++d0) {
                    const lds_cptr vp = lv + d0 * 32 * AT_VST + (32 * t + 16 * s) * 2;
                    const s16x4 lo = *(const LAS s16x4*)vp, hv = *(const LAS s16x4*)(vp + 16);
                    const bf16x8 vf = (bf16x8){lo[0], lo[1], lo[2], lo[3], hv[0], hv[1], hv[2], hv[3]};
                    if (d0 == 0) o0 = __builtin_amdgcn_mfma_f32_32x32x16_bf16(pa, vf, o0, 0, 0, 0);
                    else o1 = __builtin_amdgcn_mfma_f32_32x32x16_bf16(pa, vf, o1, 0, 0, 0);
                }
            }
    }
    l += __shfl_xor(l, 32);
    if (hi == 0) wsf[r32] = 1.f / l;
    bf16* MIX = c.w<bf16>(WS_MIX) + ((size_t)b * LT + q0 + wid * 32) * D + (kind ? 768 : 256) + h * 64 + r32;
#pragma unroll
    for (int g = 0; g < 4; ++g) { const f32x4 fv = *(const f32x4*)(wsf + 8 * g + 4 * hi);
#pragma unroll
        for (int j = 0; j < 4; ++j) { const int r = 4 * g + j; bf16* mp = MIX + (size_t)crow(r, hi) * D;
            mp[0] = f2bf(o0[r] * fv[j]); mp[32] = f2bf(o1[r] * fv[j]); } }
}


__device__ __forceinline__ void ph_prepB(const Ctx& c, int tile) {
    const float* KLAG = c.w<float>(WS_KLAG); const float* S5P = c.w<float>(WS_S5P); const float* S5BB = c.w<float>(WS_S5BB);
    bf16* WY = c.w<bf16>(WS_WY); bf16* WSm = c.w<bf16>(WS_WS);
    if (tile < 3072) {
        const int it = tile * NTHR + c.tid;
        const int t = it & 31, kr = (it >> 5) % 768, lg = it / (768 * 32), l = lg >> 4, g = lg & 15;
        float v[16];
        if (kr < 512) {
            const int s = kr >> 4, cp = kr & 15;
#pragma unroll
            for (int i = 0; i < 16; ++i) v[i] = 0.f;
            if (s <= t) { const f32x4* kp = (const f32x4*)(KLAG + ((size_t)(lg * 2 + 0) * 32 + (t - s)) * 256 + cp * 16);
#pragma unroll
                for (int q = 0; q < 4; ++q) { const f32x4 x = kp[q]; v[4 * q] += x[0]; v[4 * q + 1] += x[1]; v[4 * q + 2] += x[2]; v[4 * q + 3] += x[3]; } }
            if (s >= t) { const f32x4* kp = (const f32x4*)(KLAG + ((size_t)(lg * 2 + 1) * 32 + (s - t)) * 256 + cp * 16);
#pragma unroll
                for (int q = 0; q < 4; ++q) { const f32x4 x = kp[q]; v[4 * q] += x[0]; v[4 * q + 1] += x[1]; v[4 * q + 2] += x[2]; v[4 * q + 3] += x[3]; } }
            if (s == t) { const float dsk = c.in(17)[l * 256 + g * 16 + cp];
#pragma unroll
                for (int i = 0; i < 16; ++i) if (i == cp) v[i] += dsk; }
        } else {
            const int q = kr - 512, d = q >> 7, p = (q >> 1) & 63, ri = q & 1, e = d == 0 ? t + 1 : 32 - t;
            const int ldg = (l * 2 + d) * 16 + g;
            const float pr = S5P[((size_t)(ldg * 64 + p) * 33 + e) * 2], pi = S5P[((size_t)(ldg * 64 + p) * 33 + e) * 2 + 1];
#pragma unroll
            for (int i = 0; i < 16; ++i) {
                const float cr = c.in(15)[(size_t)ldg * 1024 + i * 64 + p], ci = c.in(16)[(size_t)ldg * 1024 + i * 64 + p];
                v[i] = ri == 0 ? (cr * pr - ci * pi) : -(cr * pi + ci * pr);
            }
        }
        u32x4 o0, o1;
        o0[0] = pk2bf(v[0], v[1]); o0[1] = pk2bf(v[2], v[3]); o0[2] = pk2bf(v[4], v[5]); o0[3] = pk2bf(v[6], v[7]);
        o1[0] = pk2bf(v[8], v[9]); o1[1] = pk2bf(v[10], v[11]); o1[2] = pk2bf(v[12], v[13]); o1[3] = pk2bf(v[14], v[15]);
        u32x4* op = (u32x4*)(WY + ((size_t)lg * 768 + kr) * 512 + t * 16);
        op[0] = o0; op[1] = o1;
    }
    else {
        const int it = (tile - 3072) * NTHR + c.tid;
        const int ncq = it & 31, kr = (it >> 5) & 511, lg = it >> 14, l = lg >> 4, g = lg & 15;
        const int s = kr >> 4, cp = kr & 15, d = ncq >> 4, p0 = (ncq & 15) * 4, e = d == 0 ? 31 - s : s;
        const int ldg = (l * 2 + d) * 16 + g;
        float v[8];
#pragma unroll
        for (int i = 0; i < 4; ++i) {
            const int p = p0 + i;
            const float pr = S5P[((size_t)(ldg * 64 + p) * 33 + e) * 2], pi = S5P[((size_t)(ldg * 64 + p) * 33 + e) * 2 + 1];
            const float br = S5BB[((size_t)(ldg * 64 + p) * 16 + cp) * 2], bi = S5BB[((size_t)(ldg * 64 + p) * 16 + cp) * 2 + 1];
            v[2 * i] = pr * br - pi * bi; v[2 * i + 1] = pr * bi + pi * br;
        }
        u32x4 o; o[0] = pk2bf(v[0], v[1]); o[1] = pk2bf(v[2], v[3]); o[2] = pk2bf(v[4], v[5]); o[3] = pk2bf(v[6], v[7]);
        *(u32x4*)(WSm + ((size_t)lg * 512 + kr) * 256 + ncq * 8) = o;
    }
}
__device__ __forceinline__ void s5_gemm_s(const Ctx& c, int layer, int tile, unsigned char* lds) {
    const int nt = tile & 1, mt = (tile >> 1) % 5, g = tile / 10;
    const bf16* UH = c.w<bf16>(WS_UH) + (size_t)g * NCH5 * 768;
    f32x4 acc[4][4];
    const int bc = nt * 128 + (c.tid & 15) * 8;
    gemm_tile<false>(c.tid, lds, [&](int r) __attribute__((always_inline)) { int row = mt * 128 + r; row = row < NCH5 ? row : NCH5 - 1; return UH + (size_t)row * 768; },
                     c.w<bf16>(WS_WS) + (size_t)(layer * 16 + g) * 512 * 256 + bc, 256, true, 512, acc);
    EPI_COORDS;
    float* SALL = c.w<float>(WS_SALL) + (size_t)g * NCH5 * 256;
#pragma unroll
    for (int m = 0; m < 4; ++m)
#pragma unroll
        for (int n = 0; n < 4; ++n) {
            const int row = mt * 128 + wr * 64 + m * 16 + fr, col = nt * 128 + wc * 64 + n * 16 + fq * 4;
            if (row < NCH5) *(f32x4*)(SALL + (size_t)row * 256 + col) = acc[m][n];
        }
}
__device__ __forceinline__ void s5_recur(const Ctx& c, int layer, int gtid, int gthreads) {
    const float* S5P = c.w<float>(WS_S5P);
    for (int it = gtid; it < 4 * 16 * 2 * 64; it += gthreads) {
        const int p = it & 63, d = (it >> 6) & 1, g = (it >> 7) & 15, b = it >> 11;
        const int ldg = (layer * 2 + d) * 16 + g;
        const float ar = S5P[((size_t)(ldg * 64 + p) * 33 + 32) * 2], ai = S5P[((size_t)(ldg * 64 + p) * 33 + 32) * 2 + 1];
        const float* S = c.w<float>(WS_SALL) + ((size_t)g * NCH5 + b * 136) * 256 + d * 128 + p * 2;
        bf16* H = c.w<bf16>(WS_UH) + ((size_t)g * NCH5 + b * 136) * 768 + 512 + d * 128 + p * 2;
        float hr = 0.f, hi = 0.f;
        for (int s0 = 0; s0 < 136; s0 += 8) {
            float2 sv[8]; int jj[8];
#pragma unroll
            for (int i = 0; i < 8; ++i) { const int s = s0 + i; jj[i] = d == 0 ? s : (s < 8 ? 7 - s : 143 - s); sv[i] = *(const float2*)(S + (size_t)jj[i] * 256); }
#pragma unroll
            for (int i = 0; i < 8; ++i) {
                *(unsigned*)(H + (size_t)jj[i] * 768) = pk2bf(hr, hi);
                const float nr = ar * hr - ai * hi + sv[i].x, ni = ar * hi + ai * hr + sv[i].y; hr = nr; hi = ni;
            }
        }
    }
}
__device__ __forceinline__ void s5_gemm_y(const Ctx& c, int layer, int tile, unsigned char* lds) {
    const int nt = tile & 3, mt = (tile >> 2) % 5, g = tile / 20;
    const bf16* UH = c.w<bf16>(WS_UH) + (size_t)g * NCH5 * 768;
    f32x4 acc[4][4];
    const int bc = nt * 128 + (c.tid & 15) * 8;
    gemm_tile<false>(c.tid, lds, [&](int r) __attribute__((always_inline)) { int row = mt * 128 + r; row = row < NCH5 ? row : NCH5 - 1; return UH + (size_t)row * 768; },
                     c.w<bf16>(WS_WY) + (size_t)(layer * 16 + g) * 768 * 512 + bc, 512, true, 768, acc);
    EPI_COORDS;
    bf16* G5 = c.w<bf16>(WS_G5);
#pragma unroll
    for (int m = 0; m < 4; ++m) {
        const int row = mt * 128 + wr * 64 + m * 16 + fr;
        if (row < NCH5) {
            const int b = row / 136, jj = row % 136;
#pragma unroll
            for (int n = 0; n < 4; ++n) {
                const int col = nt * 128 + wc * 64 + n * 16 + fq * 4, t = col >> 4, cc = col & 15;
                const size_t tok = (size_t)b * LT + jj * 32 + t;
                uint2 o; o.x = pk2bf(gelu_tanh(acc[m][n][0]), gelu_tanh(acc[m][n][1])); o.y = pk2bf(gelu_tanh(acc[m][n][2]), gelu_tanh(acc[m][n][3]));
                *(uint2*)(G5 + tok * 256 + g * 16 + cc) = o;
            }
        }
    }
}


__device__ __forceinline__ void ssd_vectors(const Ctx& c, int layer, int b, int j, int h, float* vec) {
    const int tid = c.tid, lane = tid & 63;
    __syncthreads();
    float dtf = 0.f, dtr = 0.f, af = 0.f, ar = 0.f;
    if (tid < 128) {
        const float* DTR = c.w<float>(WS_DTR) + ((size_t)b * LT + j * 128 + tid) * 8;
        dtf = softplus_f(DTR[h] + c.in(24)[(layer * 2 + 0) * 4 + h]);
        dtr = softplus_f(DTR[4 + h] + c.in(24)[(layer * 2 + 1) * 4 + h]);
        af = -dtf * expf(c.in(25)[(layer * 2 + 0) * 4 + h]); ar = -dtr * expf(c.in(25)[(layer * 2 + 1) * 4 + h]);
    }
    float sf = af, sr = ar;
#pragma unroll
    for (int o = 1; o < 64; o <<= 1) { const float tf = __shfl_up(sf, o), tr = __shfl_up(sr, o); if (lane >= o) { sf += tf; sr += tr; } }
    if (tid == 63) { vec[1026] = sf; vec[1027] = sr; }
    __syncthreads();
    if (tid >= 64 && tid < 128) { sf += vec[1026]; sr += vec[1027]; }
    if (tid == 127) { vec[1024] = sf; vec[1025] = sr; }
    __syncthreads();
    if (tid < 128) {
        const float totf = vec[1024], totr = vec[1025], cer = sr - ar;
        vec[tid] = dtf; vec[128 + tid] = dtr; vec[256 + tid] = sf; vec[384 + tid] = cer;
        vec[512 + tid] = dtf * __expf(totf - sf); vec[640 + tid] = dtr * __expf(cer);
        vec[768 + tid] = __expf(sf); vec[896 + tid] = __expf(totr - cer);
    }
    __syncthreads();
}
__device__ __forceinline__ void ssd_s1(const Ctx& c, int layer, int tile, unsigned char* lds) {
    const int h = tile & 3, j = (tile >> 2) % NCH, b = tile / (4 * NCH);
    float* vec = (float*)lds;
    ssd_vectors(c, layer, b, j, h, vec);
    const int tid = c.tid, lane = tid & 63, wid = tid >> 6, fr = lane & 15, fq = lane >> 4, grp = h >> 1;
    const bf16* XT = c.w<bf16>(WS_XT) + ((size_t)b * 256 + h * 64 + wid * 16 + fr) * LT + j * 128;
    const bf16* BT = c.w<bf16>(WS_BT) + ((size_t)b * 256 + grp * 128 + fr) * LT + j * 128;
    f32x4 acc[2][8];
#pragma unroll
    for (int d = 0; d < 2; ++d)
#pragma unroll
        for (int ns = 0; ns < 8; ++ns) acc[d][ns] = (f32x4){0.f, 0.f, 0.f, 0.f};
#pragma unroll
    for (int kk = 0; kk < 4; ++kk) {
        float xv[8], xa[8], xb[8];
        unpack8v(*(const u32x4*)(XT + 32 * kk + 8 * fq), xv);
        const f32x4 w0 = *(const f32x4*)(vec + 512 + 32 * kk + 8 * fq), w1 = *(const f32x4*)(vec + 512 + 32 * kk + 8 * fq + 4);
        const f32x4 r0 = *(const f32x4*)(vec + 640 + 32 * kk + 8 * fq), r1 = *(const f32x4*)(vec + 640 + 32 * kk + 8 * fq + 4);
#pragma unroll
        for (int i = 0; i < 4; ++i) { xa[i] = xv[i] * w0[i]; xa[4 + i] = xv[4 + i] * w1[i]; xb[i] = xv[i] * r0[i]; xb[4 + i] = xv[4 + i] * r1[i]; }
        const bf16x8 xf = pack8(xa), xr = pack8(xb);
#pragma unroll
        for (int ns = 0; ns < 8; ++ns) {
            const bf16x8 bfrag = *(const bf16x8*)(BT + (size_t)ns * 16 * LT + 32 * kk + 8 * fq);
            acc[0][ns] = __builtin_amdgcn_mfma_f32_16x16x32_bf16(bfrag, xf, acc[0][ns], 0, 0, 0);
            acc[1][ns] = __builtin_amdgcn_mfma_f32_16x16x32_bf16(bfrag, xr, acc[1][ns], 0, 0, 0);
        }
    }
    const size_t sidx = (size_t)((b * NCH + j) * 4 + h) * 2;
    float* ST = c.w<float>(WS_ST);
#pragma unroll
    for (int d = 0; d < 2; ++d)
#pragma unroll
        for (int ns = 0; ns < 8; ++ns) *(f32x4*)(ST + ((sidx + d) * 64 + wid * 16 + fr) * 128 + ns * 16 + 4 * fq) = acc[d][ns];
    if (tid == 0) { float* TOT = c.w<float>(WS_TOT); TOT[sidx] = __expf(vec[1024]); TOT[sidx + 1] = __expf(vec[1025]); }
}
__device__ __forceinline__ void ssd_recur(const Ctx& c, int gtid, int gthreads) {
    const float* ST = c.w<float>(WS_ST); bf16* HIN = c.w<bf16>(WS_HIN); const float* TOT = c.w<float>(WS_TOT);
    for (int it = gtid; it < 4 * 4 * 2 * 64 * 32; it += gthreads) {
        const int n4 = it & 31, p = (it >> 5) & 63, d = (it >> 11) & 1, h = (it >> 12) & 3, b = it >> 14;
        f32x4 H = (f32x4){0.f, 0.f, 0.f, 0.f};
#pragma unroll 1
        for (int s0 = 0; s0 < NCH; s0 += 17) {
            f32x4 sv[17]; float tv[17];
#pragma unroll
            for (int i = 0; i < 17; ++i) { const int s = s0 + i, jj = d == 0 ? s : (s < 2 ? 1 - s : 35 - s);
                const size_t idx = (size_t)((b * NCH + jj) * 4 + h) * 2 + d;
                sv[i] = *(const f32x4*)(ST + (idx * 64 + p) * 128 + n4 * 4); tv[i] = TOT[idx]; }
#pragma unroll
            for (int i = 0; i < 17; ++i) { const int s = s0 + i, jj = d == 0 ? s : (s < 2 ? 1 - s : 35 - s);
                const size_t idx = (size_t)((b * NCH + jj) * 4 + h) * 2 + d;
                uint2 o; o.x = pk2bf(H[0], H[1]); o.y = pk2bf(H[2], H[3]);
                *(uint2*)(HIN + (idx * 64 + p) * 128 + n4 * 4) = o;
                H = H * tv[i] + sv[i]; }
        }
    }
}
__device__ __forceinline__ void ssd_s3(const Ctx& c, int layer, int tile, unsigned char* lds) {
    const int half = tile & 1, h = (tile >> 1) & 3, j = (tile >> 3) % NCH, b = tile / (8 * NCH);
    float* vec = (float*)lds;
    ssd_vectors(c, layer, b, j, h, vec);
    const int tid = c.tid, lane = tid & 63, wid = tid >> 6, fr = lane & 15, fq = lane >> 4, grp = h >> 1;
    const size_t tok0 = (size_t)b * LT + j * 128;
    const bf16* XS = c.w<bf16>(WS_XBCS) + tok0 * 768;
    const int l = 64 * half + 16 * wid + fr;
    bf16x8 cf[4];
#pragma unroll
    for (int k = 0; k < 4; ++k) cf[k] = *(const bf16x8*)(XS + (size_t)l * 768 + 512 + grp * 128 + 32 * k + 8 * fq);
    f32x4 G[8];
#pragma unroll
    for (int st = 0; st < 8; ++st) {
        G[st] = (f32x4){0.f, 0.f, 0.f, 0.f};
#pragma unroll
        for (int k = 0; k < 4; ++k) {
            const bf16x8 bfrag = *(const bf16x8*)(XS + (size_t)(16 * st + fr) * 768 + 256 + grp * 128 + 32 * k + 8 * fq);
            G[st] = __builtin_amdgcn_mfma_f32_16x16x32_bf16(bfrag, cf[k], G[st], 0, 0, 0);
        }
    }
    {
        const float csf_l = vec[256 + l], cer_l = vec[384 + l];
#pragma unroll
        for (int st = 0; st < 8; ++st) {
            const int sb = 16 * st + 4 * fq;
            const f32x4 dtf_s = *(const f32x4*)(vec + sb), dtr_s = *(const f32x4*)(vec + 128 + sb), csf_s = *(const f32x4*)(vec + 256 + sb), cer_s = *(const f32x4*)(vec + 384 + sb);
#pragma unroll
            for (int jj = 0; jj < 4; ++jj) {
                const int s = sb + jj;
                float w = 0.f;
                if (s <= l) w += dtf_s[jj] * __expf(csf_l - csf_s[jj]);
                if (s >= l) w += dtr_s[jj] * __expf(cer_s[jj] - cer_l);
                G[st][jj] *= w;
            }
        }
    }
    f32x4 y[4];
#pragma unroll
    for (int pt = 0; pt < 4; ++pt) y[pt] = (f32x4){0.f, 0.f, 0.f, 0.f};
    const bf16* XT = c.w<bf16>(WS_XT) + ((size_t)b * 256 + h * 64 + fr) * LT + j * 128;
#pragma unroll
    for (int kk = 0; kk < 4; ++kk) {
        float t8[8];
#pragma unroll
        for (int i = 0; i < 4; ++i) { t8[i] = G[2 * kk][i]; t8[4 + i] = G[2 * kk + 1][i]; }
        const bf16x8 pf = pack8(t8);
#pragma unroll
        for (int pt = 0; pt < 4; ++pt) {
            const bf16* xp = XT + (size_t)pt * 16 * LT + 32 * kk + 4 * fq;
            const s16x4 lo = *(const s16x4*)xp, hv = *(const s16x4*)(xp + 16);
            const bf16x8 xf = (bf16x8){lo[0], lo[1], lo[2], lo[3], hv[0], hv[1], hv[2], hv[3]};
            y[pt] = __builtin_amdgcn_mfma_f32_16x16x32_bf16(xf, pf, y[pt], 0, 0, 0);
        }
    }
    const bf16* HIN = c.w<bf16>(WS_HIN) + (size_t)((b * NCH + j) * 4 + h) * 2 * 8192;
#pragma unroll
    for (int d = 0; d < 2; ++d) {
        const float e = vec[(d == 0 ? 768 : 896) + l];
#pragma unroll
        for (int k = 0; k < 4; ++k) {
            float t8[8]; unpack8v(__builtin_bit_cast(u32x4, cf[k]), t8);
#pragma unroll
            for (int i = 0; i < 8; ++i) t8[i] *= e;
            const bf16x8 cs = pack8(t8);
#pragma unroll
            for (int pt = 0; pt < 4; ++pt) {
                const bf16x8 hf = *(const bf16x8*)(HIN + ((size_t)d * 64 + 16 * pt + fr) * 128 + 32 * k + 8 * fq);
                y[pt] = __builtin_amdgcn_mfma_f32_16x16x32_bf16(hf, cs, y[pt], 0, 0, 0);
            }
        }
    }
    float* Y = c.w<float>(WS_YSSD) + tok0 * 256;
#pragma unroll
    for (int pt = 0; pt < 4; ++pt) *(f32x4*)(Y + (size_t)l * 256 + h * 64 + 16 * pt + 4 * fq) = y[pt];
}

constexpr int PH_PER_LAYER = 12, N_PHASES = 2 + 2 * PH_PER_LAYER;

__global__ void __launch_bounds__(NTHR, 2) mk_fwd(Params prm) {
    __shared__ __attribute__((aligned(16))) unsigned char smem_raw[GEMM_LDS + 512 + 1536];
    float* smem = (float*)(smem_raw + GEMM_LDS);
    Ctx c; c.p = (const CAS Params*)__builtin_amdgcn_kernarg_segment_ptr(); c.smf = smem; c.tid = threadIdx.x;
    const int G = gridDim.x, bid = blockIdx.x;
    const int gtid = bid * NTHR + c.tid, gthreads = G * NTHR;
    const int gw = gtid >> 6, nwaves = gthreads >> 6;
    int* smi = (int*)(smem + 16);
#if MK_SINGLE
    volatile unsigned* bst = (volatile unsigned*)(smem + 120);
    if (c.tid == 0) { bst[0] = 0u; bst[1] = 0u; }
    __syncthreads();
    XcdBarrier bar = xcd_barrier_post(c.w<unsigned>(WS_CTL) + CW_BAR, bst);
#endif
    unsigned long long pr_t0 = 0ull; c.pracc = 0ull; c.prt = 0ull;
#define pr_acc c.pracc
#if MK_SINGLE
    if (PROBE_SP == 102) { pr_t0 = __builtin_amdgcn_s_memrealtime(); xcd_barrier(bar); pr_acc += __builtin_amdgcn_s_memrealtime() - pr_t0; }
#endif
    for (int ph = prm.ph_lo; ph < prm.ph_hi; ++ph) {
        if (PROBE_SP >= 0) pr_t0 = __builtin_amdgcn_s_memrealtime();
        asm volatile("" : "+s"(c.p));
        { int t_ = threadIdx.x; asm volatile("" : "+v"(t_)); c.tid = t_; }
        if (ph == 0) ph_prep(c, gtid, gthreads, bid, G, (float*)smem_raw);
        else if (ph == 1) ph_norm1(c, 0, gw, nwaves, smem_raw);
        else {
            const int layer = (ph - 2) / PH_PER_LAYER, sp = (ph - 2) % PH_PER_LAYER;
            switch (sp) {
            case 0: for (int t = bid; t < 136 * 18 + (layer == 0 ? 5120 : 0); t += G) { asm volatile("" : "+v"(c.tid)); if (t < 136 * 18) ph_inproj_mfma(c, layer, t, smem_raw); else ph_prepB(c, t - 136 * 18); } break;
            case 1: for (int t = bid; t < 272 * 3; t += G) ph_minipost(c, layer, t); break;
            case 2: for (int t = bid; t < 512 + 544 + 160 + 576; t += G) { asm volatile("" : "+v"(c.tid)); if (t < 512) attn_tile(c, layer, t, smem_raw); else if (t < 1056) ssd_s1(c, layer, t - 512, smem_raw); else if (t < 1216) s5_gemm_s(c, layer, t - 1056, smem_raw); else attn_tile(c, layer, t - 1216 + 512, smem_raw); } break;
            case 3: s5_recur(c, layer, gtid, gthreads); ssd_recur(c, gtid, gthreads); break;
            case 4: for (int t = bid; t < 1088 + 320; t += G) { asm volatile("" : "+v"(c.tid)); if (t < 1088) ssd_s3(c, layer, t, smem_raw); else s5_gemm_y(c, layer, t - 1088, smem_raw); } break;
            case 5: for (int t = bid; t < 136 * 2 + NT / 4; t += G) { asm volatile("" : "+v"(c.tid)); if (t < 136 * 2) ph_glu_mfma(c, layer, t, smem_raw); else ph_gates(c, layer, t - 136 * 2); } break;
            case 6: for (int t = bid; t < 136 * 8; t += G) ph_outproj_mfma(c, layer, t, smem_raw); break;
            case 7: ph_norm2(c, layer, bid, G, smem_raw, (int*)(smem_raw + GEMM_LDS + 512)); break;
            case 8: ph_assign(c, layer, bid, G, (int*)smem_raw, (const int*)(smem_raw + GEMM_LDS + 512)); break;
            case 9: moe_offsets(c, layer, smi); for (int t = bid; t < (NSLOT / 128) * 8; t += G) ph_moe1_mfma(c, layer, t, smi, smem_raw); break;
            case 10: moe_offsets(c, layer, smi); for (int t = bid; t < (NSLOT / 128) * 8; t += G) ph_moe2_mfma(c, layer, t, smi, smem_raw); break;
            case 11: moe_offsets(c, layer, smi); ph_combine(c, layer, gw, nwaves, smi, smem_raw); break;
            }
        }
#if MK_SINGLE
        if (ph + 1 < prm.ph_hi) xcd_barrier(bar);
#endif
        if (PROBE_SP >= 0 && ((PROBE_SP < 100 && ph >= 2 && (ph - 2) % PH_PER_LAYER == PROBE_SP) || (PROBE_SP == 100 && ph == 0) || (PROBE_SP == 101 && ph == 1))) pr_acc += __builtin_amdgcn_s_memrealtime() - pr_t0;
    }
#if MK_SINGLE
    if (PROBE_SP == 200) { for (int i = 0; i < 16; ++i) xcd_barrier(bar); }
#endif
    if (PROBE_SP >= 0 && PROBE_SP < 200 && bid == 0 && c.tid == 0) { const unsigned long long t1 = __builtin_amdgcn_s_memrealtime(); while (__builtin_amdgcn_s_memrealtime() - t1 < 8ull * pr_acc) __builtin_amdgcn_s_sleep(8); }
}
}

extern "C" void kernel_launch(void* const* d_in, const int* in_sizes, int n_in, void* d_out, int out_size, void* d_ws, size_t ws_size, hipStream_t stream) {
    static int grid = 0;
    if (grid == 0) {
        if (n_in != 37 || ws_size < WS_END) { fprintf(stderr, "kernel_launch: need 37 inputs and %zu bytes of workspace; got %d, %zu\n", (size_t)WS_END, n_in, ws_size); grid = -1; return; }
        int dev = 0, cus = 0, per_cu = 0;
        hipGetDevice(&dev); hipDeviceGetAttribute(&cus, hipDeviceAttributeMultiprocessorCount, dev);
        if (hipOccupancyMaxActiveBlocksPerMultiprocessor(&per_cu, (const void*)mk_fwd, NTHR, 0) != hipSuccess || per_cu < 1) per_cu = 1;
        if (per_cu > 4) per_cu = 4;
        grid = cus * per_cu;
    }
    if (grid < 0) return;
    hipMemsetAsync((char*)d_ws + WS_CTL, 0, CTL_BYTES, stream);
    Params p{};
    for (int i = 0; i < 37; ++i) p.in[i] = (const float*)d_in[i];
    p.out = (float*)d_out; p.ws = (unsigned char*)d_ws;
#if MK_SINGLE
    p.ph_lo = 0; p.ph_hi = N_PHASES;
    void* args[] = {&p};
    hipError_t e = hipLaunchCooperativeKernel((const void*)mk_fwd, dim3(grid), dim3(NTHR), args, 0, stream);
    if (e != hipSuccess) fprintf(stderr, "cooperative launch failed: %s (grid %d)\n", hipGetErrorString(e), grid);
#else
    for (int ph = 0; ph < N_PHASES; ++ph) {
        p.ph_lo = ph; p.ph_hi = ph + 1;
        hipLaunchKernelGGL(mk_fwd, dim3(grid), dim3(NTHR), 0, stream, p);
    }
#endif
}
```

```cpp
#include <hip/hip_runtime.h>
#include <cstdio>
#include <cstdint>

#ifndef PROBE_SP
#define PROBE_SP -1
#endif
#ifndef MK_SINGLE
#define MK_SINGLE 1
#endif

namespace {
typedef unsigned short bf16;
#define LAS __attribute__((address_space(3)))

constexpr int D = 1024, NB = 4, SEQ = 4096, CTX = 256, LT = SEQ + CTX, NT = NB * LT;
constexpr int DIN = 2312;
constexpr int C_U = 0, C_GQ = 256, C_GK = 512, C_GV = 640, C_Z = 768, C_XBC = 1024, C_DT = 1792, C_WQ = 1800, C_WK = 2056, C_WV = 2184;
constexpr int NEXP = 32, DE = 512;
constexpr int NSLOT = 2 * NT + NEXP * 128;
constexpr float EPS = 1e-6f;
constexpr int NTHR = 256;

constexpr size_t al(size_t x) { return (x + 255) & ~(size_t)255; }
constexpr size_t WS_CTL = 0, CTL_BYTES = 1u << 20;
constexpr size_t WS_MOD = WS_CTL + CTL_BYTES;
constexpr size_t WS_S5A = al(WS_MOD + 2 * 5 * 6144 * 4);
constexpr size_t WS_S5BB = al(WS_S5A + 2 * 2 * 16 * 64 * 2 * 4);
constexpr size_t WS_ROPE = al(WS_S5BB + 2 * 2 * 16 * 64 * 16 * 2 * 4);
constexpr size_t WS_X = al(WS_ROPE + 64 * 16 * 2 * 4);
constexpr size_t WS_HA = al(WS_X + (size_t)NT * D * 4);
constexpr size_t WS_Z = al(WS_HA + (size_t)NT * D * 2);
constexpr size_t WS_XBR = al(WS_Z + (size_t)NT * 256 * 2);
constexpr size_t WS_GQ = al(WS_XBR + (size_t)NT * 768 * 2);
constexpr size_t WS_GK = al(WS_GQ + (size_t)NT * 256 * 2);
constexpr size_t WS_GV = al(WS_GK + (size_t)NT * 128 * 2);
constexpr size_t WS_WQ = al(WS_GV + (size_t)NT * 128 * 2);
constexpr size_t WS_WK = al(WS_WQ + (size_t)NT * 256 * 2);
constexpr size_t WS_WV = al(WS_WK + (size_t)NT * 128 * 2);
constexpr size_t WS_XBCS = al(WS_WV + (size_t)NT * 128 * 2);
constexpr size_t WS_YSSD = al(WS_XBCS + (size_t)NT * 768 * 2);
constexpr size_t WS_G5 = al(WS_YSSD + (size_t)NT * 256 * 4);
constexpr size_t WS_MIX = al(WS_G5 + (size_t)NT * 256 * 2);
constexpr size_t WS_OUT = WS_Z;
constexpr size_t WS_ACT = al(WS_OUT + (size_t)NSLOT * D * 2);
static_assert(WS_ACT + (size_t)NSLOT * DE * 2 <= WS_MIX, "MoE-stage alias must end before MIX");
constexpr size_t WS_TOKE = al(WS_MIX + (size_t)NT * D * 2);
constexpr size_t WS_TOKP = al(WS_TOKE + (size_t)NT * 2 * 4);
constexpr size_t WS_TOKW = al(WS_TOKP + (size_t)NT * 2 * 4);
constexpr size_t WS_LIST = al(WS_TOKW + (size_t)NT * 2 * 4);
constexpr size_t WS_DTR = al(WS_LIST + (size_t)NEXP * NT * 4);
constexpr int NCH5 = NT / 32;
constexpr size_t WS_S5P = al(WS_DTR + (size_t)NT * 8 * 4);
constexpr size_t WS_KLAG = al(WS_S5P + (size_t)2 * 2 * 16 * 64 * 33 * 2 * 4);
constexpr size_t WS_WY = al(WS_KLAG + (size_t)2 * 16 * 2 * 32 * 256 * 4);
constexpr size_t WS_WS = al(WS_WY + (size_t)2 * 16 * 768 * 512 * 2);
constexpr size_t WS_UH = al(WS_WS + (size_t)2 * 16 * 512 * 256 * 2);
constexpr size_t WS_SALL = al(WS_UH + (size_t)16 * NCH5 * 768 * 2);
constexpr int NCH = LT / 128;
constexpr size_t WS_XT = al(WS_SALL + (size_t)16 * NCH5 * 256 * 4);
constexpr size_t WS_BT = al(WS_XT + (size_t)NB * 256 * LT * 2);
constexpr size_t WS_ST = al(WS_BT + (size_t)NB * 256 * LT * 2);
constexpr size_t WS_HIN = al(WS_ST + (size_t)NB * NCH * 8 * 8192 * 4);
constexpr size_t WS_TOT = al(WS_HIN + (size_t)NB * NCH * 8 * 8192 * 2);
constexpr size_t WS_BCNT = al(WS_TOT + (size_t)NB * NCH * 8 * 4);
constexpr size_t WS_WDT = al(WS_BCNT + 1024 * 32 * 4);
constexpr size_t WS_RWT = al(WS_WDT + 2 * 8 * 1024 * 4);
constexpr int DINV = 2304;
constexpr size_t WS_BIN = al(WS_RWT + 2 * 36 * 1024 * 4);
constexpr size_t WS_BOUT = al(WS_BIN + (size_t)2 * D * DINV * 2);
constexpr size_t WS_BGLU = al(WS_BOUT + (size_t)2 * D * D * 2);
constexpr size_t WS_BGU = al(WS_BGLU + (size_t)2 * 256 * 256 * 2);
constexpr size_t WS_BDN = al(WS_BGU + (size_t)NEXP * D * 1024 * 2);
constexpr size_t WS_END = al(WS_BDN + (size_t)NEXP * DE * D * 2);
constexpr int CW_CNT = 8192;
constexpr int CW_BAR = 4096;

struct Params {
    const float* in[37];
    float* out;
    unsigned char* ws;
    int ph_lo, ph_hi;
};

typedef short bf16x8 __attribute__((ext_vector_type(8)));
typedef short s16x4 __attribute__((ext_vector_type(4)));
typedef float f32x4 __attribute__((ext_vector_type(4)));
typedef unsigned u32x4 __attribute__((ext_vector_type(4)));
__device__ __forceinline__ float bf2f(bf16 v) { return __uint_as_float(((unsigned)v) << 16); }
typedef float f32x2 __attribute__((ext_vector_type(2)));
typedef __bf16 bf16x2_t __attribute__((ext_vector_type(2)));
__device__ __forceinline__ bf16 f2bf(float f) { return __builtin_bit_cast(bf16, (__bf16)f); }
__device__ __forceinline__ float silu_f(float x) { return x / (1.f + __expf(-x)); }
__device__ __forceinline__ float sigmoid_f(float x) { return 1.f / (1.f + __expf(-x)); }
__device__ __forceinline__ float gelu_tanh(float x) { const float u = 0.7978845608028654f * (x + 0.044715f * x * x * x); return 0.5f * x * (1.f + tanhf(u)); }
__device__ __forceinline__ float softplus_f(float x) { return fmaxf(x, 0.f) + log1pf(__expf(-fabsf(x))); }
__device__ __forceinline__ float wave_sum(float v) {
#pragma unroll
    for (int o = 1; o < 64; o <<= 1) v += __shfl_xor(v, o);
    return v;
}
__device__ __forceinline__ float block_sum(float v, float* red) {
    v = wave_sum(v);
    __syncthreads();
    if ((threadIdx.x & 63) == 0) red[threadIdx.x >> 6] = v;
    __syncthreads();
    return red[0] + red[1] + red[2] + red[3];
}
__device__ __forceinline__ unsigned pk2bf(float lo, float hi) { const f32x2 v = {lo, hi}; return __builtin_bit_cast(unsigned, __builtin_convertvector(v, bf16x2_t)); }
__device__ __forceinline__ void unpack8v(const u32x4 v, float (&f)[8]) {
    f[0] = __uint_as_float(v[0] << 16); f[1] = __uint_as_float(v[0] & 0xffff0000u);
    f[2] = __uint_as_float(v[1] << 16); f[3] = __uint_as_float(v[1] & 0xffff0000u);
    f[4] = __uint_as_float(v[2] << 16); f[5] = __uint_as_float(v[2] & 0xffff0000u);
    f[6] = __uint_as_float(v[3] << 16); f[7] = __uint_as_float(v[3] & 0xffff0000u);
}
__device__ __forceinline__ bf16x8 pack8(const float (&f)[8]) {
    u32x4 v; v[0] = pk2bf(f[0], f[1]); v[1] = pk2bf(f[2], f[3]); v[2] = pk2bf(f[4], f[5]); v[3] = pk2bf(f[6], f[7]);
    return __builtin_bit_cast(bf16x8, v);
}
__device__ __forceinline__ uint2 pack4(const f32x4 v) { uint2 o; o.x = pk2bf(v[0], v[1]); o.y = pk2bf(v[2], v[3]); return o; }
__device__ __forceinline__ void unpack8(const uint4 v, float (&f)[8]) {
    f[0] = __uint_as_float(v.x << 16); f[1] = __uint_as_float(v.x & 0xffff0000u);
    f[2] = __uint_as_float(v.y << 16); f[3] = __uint_as_float(v.y & 0xffff0000u);
    f[4] = __uint_as_float(v.z << 16); f[5] = __uint_as_float(v.z & 0xffff0000u);
    f[6] = __uint_as_float(v.w << 16); f[7] = __uint_as_float(v.w & 0xffff0000u);
}

#define XB_TMO      128
#define XB_XCNT(j)  (256  + 64 * (j))
#define XB_XSUB(j)  (1280 + 64 * (j))
#define XB_XGEN(j)  (2304 + 64 * (j))
#define XB_TOP      3328
#define XB_TOPGEN   3392
#define XCD_BAR_WORDS 3456
#define XB_SPIN_CAP (1u << 22)
__device__ __forceinline__ unsigned xb_ld(unsigned* p)              { return __hip_atomic_load(p, __ATOMIC_RELAXED, __HIP_MEMORY_SCOPE_AGENT); }
__device__ __forceinline__ unsigned xb_add(unsigned* p, unsigned v) { return __hip_atomic_fetch_add(p, v, __ATOMIC_RELAXED, __HIP_MEMORY_SCOPE_AGENT); }
__device__ __forceinline__ unsigned xb_xcc_id() { return (unsigned)__builtin_amdgcn_s_getreg((3 << 11) | 20) & 0xFu; }
#define XB_SPIN(cond, bar) do { unsigned _sp = 0; while (cond) { __builtin_amdgcn_s_sleep(1); \
    if ((++_sp & 255u) == 0u) { if (xb_ld(&(bar)[XB_TMO])) break; if (_sp > XB_SPIN_CAP) { atomicAdd(&(bar)[XB_TMO], 1u); break; } } } } while (0)
struct XcdBarrier { unsigned* bar; unsigned x; volatile unsigned* st; };
__device__ __forceinline__ XcdBarrier xcd_barrier_post(unsigned* bar, volatile unsigned* st) {
    XcdBarrier b; b.bar = bar; b.x = xb_xcc_id(); b.st = st;
    if (threadIdx.x == 0) (void)xb_add(&bar[XB_XCNT(b.x)], 1u);
    return b;
}
__device__ __forceinline__ void xcd_barrier_complete(unsigned* bar, unsigned x, unsigned& nloc, unsigned& nx) {
    const unsigned G = gridDim.x * gridDim.y * gridDim.z;
    unsigned sum, cnt, mine, sp = 0u;
    for (;;) {
        sum = 0u; cnt = 0u; mine = 0u;
#pragma unroll
        for (unsigned j = 0; j < 16; ++j) { const unsigned c = xb_ld(&bar[XB_XCNT(j)]); sum += c; cnt += (c > 0u) ? 1u : 0u; mine = (j == x) ? c : mine; }
        if (sum == G) break;
        __builtin_amdgcn_s_sleep(1);
        if ((++sp & 255u) == 0u) { if (xb_ld(&bar[XB_TMO])) break; if (sp > XB_SPIN_CAP) { atomicAdd(&bar[XB_TMO], 1u); break; } }
    }
    nloc = mine > 0u ? mine : 1u; nx = cnt > 0u ? cnt : 1u;
}
__device__ __forceinline__ void xcd_barrier(const XcdBarrier& b) {
    asm volatile("s_waitcnt vmcnt(0)" ::: "memory");
    __syncthreads();
    if (threadIdx.x == 0) {
        unsigned* bar = b.bar;
        __builtin_amdgcn_s_waitcnt(0);
        unsigned nloc = b.st[0], nx = b.st[1];
        if (nloc == 0u) { xcd_barrier_complete(bar, b.x, nloc, nx); b.st[0] = nloc; b.st[1] = nx; }
        const unsigned old = xb_add(&bar[XB_XSUB(b.x)], 1u);
        const unsigned gen = old / nloc;
        if (old + 1u == (gen + 1u) * nloc) {
            __builtin_amdgcn_fence(__ATOMIC_RELEASE, "agent");
            asm volatile("s_waitcnt vmcnt(0)" ::: "memory");
            const unsigned og = xb_add(&bar[XB_TOP], 1u);
            const unsigned tg = og / nx;
            if (og + 1u == (tg + 1u) * nx) xb_add(&bar[XB_TOPGEN], 1u);
            else XB_SPIN(xb_ld(&bar[XB_TOPGEN]) == tg, bar);
            __builtin_amdgcn_fence(__ATOMIC_ACQUIRE, "agent");
            xb_add(&bar[XB_XGEN(b.x)], 1u);
            asm volatile("s_waitcnt vmcnt(0)" ::: "memory");
        } else {
            XB_SPIN(xb_ld(&bar[XB_XGEN(b.x)]) == gen, bar);
            __builtin_amdgcn_fence(__ATOMIC_ACQUIRE, "agent");
            asm volatile("s_waitcnt vmcnt(0)" ::: "memory");
        }
    }
    __syncthreads();
}

#define CAS __attribute__((address_space(4)))
#define PR_BEGIN(id) do { if (PROBE_SP == (id)) c.prt = __builtin_amdgcn_s_memrealtime(); } while (0)
#define PR_END(id) do { if (PROBE_SP == (id)) c.pracc += __builtin_amdgcn_s_memrealtime() - c.prt; } while (0)
struct Ctx {
    const CAS Params* p;
    float* smf;
    int tid;
    mutable unsigned long long pracc, prt;
    __device__ __forceinline__ const float* in(int i) const { return p->in[i]; }
    __device__ __forceinline__ float* out() const { return p->out; }
    template <class T> __device__ __forceinline__ T* w(size_t off) const { return (T*)(p->ws + off); }
};

__device__ __forceinline__ const float* xsrc(const Ctx& c, int layer, int n) {
    if (layer == 0) { const int b = n / LT, pos = n % LT; return pos < CTX ? c.in(2) + ((size_t)b * CTX + pos) * D : c.in(0) + ((size_t)b * SEQ + (pos - CTX)) * D; }
    return c.w<float>(WS_X) + (size_t)n * D;
}
__device__ __forceinline__ void ngemm8(const bf16* const (&ar)[8], const float* bcol, int ldb, int K, float (&acc)[8]) {
    for (int k0 = 0; k0 < K; k0 += 8) {
        float w[8];
#pragma unroll
        for (int kk = 0; kk < 8; ++kk) w[kk] = bcol[(size_t)(k0 + kk) * ldb];
#pragma unroll
        for (int r = 0; r < 8; ++r) {
            float a[8]; unpack8(*(const uint4*)(ar[r] + k0), a);
#pragma unroll
            for (int kk = 0; kk < 8; ++kk) acc[r] = fmaf(a[kk], w[kk], acc[r]);
        }
    }
}

__device__ __forceinline__ void ph_prep(Ctx& c, int gtid, int gthreads, int bid, int G, float* lds) {
    float* MOD = c.w<float>(WS_MOD);
    const int tid = c.tid;
    for (int tile = bid; tile < 192; tile += G) {
        const int l = tile / 96, j0 = (tile % 96) * 64;
        __syncthreads();
        for (int idx = tid; idx < 5 * D; idx += NTHR) { const int r = idx >> 10, k = idx & 1023; lds[idx] = silu_f(r < 4 ? c.in(1)[r * D + k] : c.in(3)[k]); }
        __syncthreads();
        const int jj = tid & 63, kq = tid >> 6;
        const float* aw = c.in(4) + (size_t)l * D * 6144 + j0 + jj;
        float acc[5] = {0.f, 0.f, 0.f, 0.f, 0.f};
#pragma unroll 32
        for (int k = kq * 256; k < kq * 256 + 256; ++k) {
            const float w = aw[(size_t)k * 6144];
#pragma unroll
            for (int r = 0; r < 5; ++r) acc[r] = fmaf(lds[r * D + k], w, acc[r]);
        }
#pragma unroll
        for (int r = 0; r < 5; ++r) lds[5 * D + (kq * 64 + jj) * 5 + r] = acc[r];
        __syncthreads();
        for (int idx = tid; idx < 320; idx += NTHR) { const int j2 = idx / 5, r = idx % 5;
            const float s = lds[5 * D + j2 * 5 + r] + lds[5 * D + (64 + j2) * 5 + r] + lds[5 * D + (128 + j2) * 5 + r] + lds[5 * D + (192 + j2) * 5 + r];
            MOD[(l * 5 + r) * 6144 + j0 + j2] = s + c.in(5)[l * 6144 + j0 + j2]; }
    }
    asm volatile("" : "+s"(c.p));
    float* S5A = c.w<float>(WS_S5A); float* S5BB = c.w<float>(WS_S5BB);
    for (int it = gtid; it < 2 * 2 * 16 * 64; it += gthreads) {
        const int ldg = it / 64;
        const float lr = c.in(10)[it], li = c.in(11)[it], dt = expf(c.in(12)[ldg]);
        const float mag = expf(lr * dt), are = mag * cosf(li * dt), aim = mag * sinf(li * dt);
        const float den = lr * lr + li * li;
        const float fre = ((are - 1.f) * lr + aim * li) / den, fim = (aim * lr - (are - 1.f) * li) / den;
        S5A[it * 2] = are; S5A[it * 2 + 1] = aim;
        for (int ch = 0; ch < 16; ++ch) {
            const float br = c.in(13)[(size_t)it * 16 + ch], bi = c.in(14)[(size_t)it * 16 + ch];
            S5BB[((size_t)it * 16 + ch) * 2] = fre * br - fim * bi;
            S5BB[((size_t)it * 16 + ch) * 2 + 1] = fre * bi + fim * br;
        }
    }
    asm volatile("" : "+s"(c.p));
    float* S5P = c.w<float>(WS_S5P);
    for (int it = gtid; it < 2 * 2 * 16 * 64 * 33; it += gthreads) {
        const int ldgp = it / 33, k = it % 33;
        const float lr = c.in(10)[ldgp], li = c.in(11)[ldgp], dt = expf(c.in(12)[ldgp / 64]);
        const float e = expf((float)k * lr * dt), ang = (float)k * li * dt;
        S5P[it * 2] = e * cosf(ang); S5P[it * 2 + 1] = e * sinf(ang);
    }
    asm volatile("" : "+s"(c.p));
    float* KLAG = c.w<float>(WS_KLAG);
    for (int tile = bid; tile < 64; tile += G) {
        const int d = tile & 1, g = (tile >> 1) & 15, l = tile >> 5, ldg = (l * 2 + d) * 16 + g;
        float* LA = lds;
        float* LB = lds + 256;
        float* LC = lds + 2304;
        __syncthreads();
        if (tid < 64) {
            const int ldgp = ldg * 64 + tid;
            const float lr = c.in(10)[ldgp], li = c.in(11)[ldgp], dt = expf(c.in(12)[ldg]);
            const float mag = expf(lr * dt), are = mag * cosf(li * dt), aim = mag * sinf(li * dt), den = lr * lr + li * li;
            LA[tid * 4] = are; LA[tid * 4 + 1] = aim; LA[tid * 4 + 2] = ((are - 1.f) * lr + aim * li) / den; LA[tid * 4 + 3] = (aim * lr - (are - 1.f) * li) / den;
        }
        __syncthreads();
        for (int idx = tid; idx < 1024; idx += NTHR) {
            const int p = idx >> 4, cp = idx & 15;
            const float fre = LA[p * 4 + 2], fim = LA[p * 4 + 3];
            const float br = c.in(13)[((size_t)ldg * 64 + p) * 16 + cp], bi = c.in(14)[((size_t)ldg * 64 + p) * 16 + cp];
            LB[idx * 2] = fre * br - fim * bi; LB[idx * 2 + 1] = fre * bi + fim * br;
            const int cc = idx >> 6, p2 = idx & 63;
            LC[idx * 2] = c.in(15)[(size_t)ldg * 1024 + cc * 64 + p2]; LC[idx * 2 + 1] = c.in(16)[(size_t)ldg * 1024 + cc * 64 + p2];
        }
        __syncthreads();
        const int cp = tid >> 4, cc = tid & 15;
        float acc[32];
#pragma unroll
        for (int k = 0; k < 32; ++k) acc[k] = 0.f;
        for (int p = 0; p < 64; ++p) {
            const float are = LA[p * 4], aim = LA[p * 4 + 1];
            const float bbr = LB[(p * 16 + cp) * 2], bbi = LB[(p * 16 + cp) * 2 + 1], cr = LC[(cc * 64 + p) * 2], ci = LC[(cc * 64 + p) * 2 + 1];
            float zr = cr * bbr - ci * bbi, zi = cr * bbi + ci * bbr;
#pragma unroll
            for (int k = 0; k < 32; ++k) { acc[k] += zr; const float tr = zr * are - zi * aim, ti = zr * aim + zi * are; zr = tr; zi = ti; }
        }
#pragma unroll
        for (int k = 0; k < 32; ++k) KLAG[((size_t)((l * 16 + g) * 2 + d) * 32 + k) * 256 + cp * 16 + cc] = acc[k];
    }
    asm volatile("" : "+s"(c.p));
    float* RWT = c.w<float>(WS_RWT);
    for (int it = gtid; it < 2 * 36 * 1024; it += gthreads) { const int k = it & 1023, o = (it >> 10) % 36, l = it / (36 * 1024);
        RWT[it] = o < 4 ? c.in(29)[((size_t)l * D + k) * 4 + o] : c.in(31)[((size_t)l * D + k) * 32 + (o - 4)]; }
    asm volatile("" : "+s"(c.p));
    float* WDT = c.w<float>(WS_WDT);
    for (int it = gtid; it < 2 * 8 * 1024; it += gthreads) { const int k = it & 1023, j = (it >> 10) & 7, l = it >> 13; WDT[it] = c.in(8)[((size_t)l * D + k) * DIN + C_DT + j]; }
    asm volatile("" : "+s"(c.p));
    float* ROPE = c.w<float>(WS_ROPE);
    for (int it = gtid; it < 64 * 16; it += gthreads) {
        const int pos = it / 16, f = it % 16;
        const float inv = powf(10000.0f, -(float)f / 16.0f);
        const float ang = (float)pos * inv;
        ROPE[it * 2] = cosf(ang); ROPE[it * 2 + 1] = sinf(ang);
    }
}

__device__ __forceinline__ void dt_project(const LAS float* wdt, const f32x4 (&h)[4], int lane, float* dst) {
    float mine = 0.f;
#pragma unroll 2
    for (int q = 0; q < 8; ++q) {
        float s = 0.f;
#pragma unroll
        for (int i = 0; i < 4; ++i) { const f32x4 w = *(const LAS f32x4*)(wdt + q * 1024 + (lane + 64 * i) * 4); s += h[i][0] * w[0] + h[i][1] * w[1] + h[i][2] * w[2] + h[i][3] * w[3]; }
        s = wave_sum(s);
        if (lane == q) mine = s;
    }
    if (lane < 8) dst[lane] = mine;
}
__device__ __forceinline__ void ph_norm1(const Ctx& c, int layer, int gw, int nwaves, unsigned char* lds) {
    const int lane = c.tid & 63;
    bf16* HA = c.w<bf16>(WS_HA); float* DTR = c.w<float>(WS_DTR);
    const float* MOD = c.w<float>(WS_MOD) + (size_t)layer * 5 * 6144;
    const float* g = c.in(6) + layer * D;
    __syncthreads();
    for (int i = c.tid; i < 2048; i += NTHR) ((f32x4*)lds)[i] = ((const f32x4*)(c.w<float>(WS_WDT) + (size_t)layer * 8 * 1024))[i];
    __syncthreads();
    const LAS float* wdt = (const LAS float*)lds;
    for (int n = gw; n < NT; n += nwaves) {
        const int b = n / LT, pos = n % LT, mr = pos < CTX ? 4 : b;
        const float* x = xsrc(c, layer, n);
        f32x4 v[4]; float ss = 0.f;
#pragma unroll
        for (int i = 0; i < 4; ++i) { v[i] = *(const f32x4*)(x + (lane + 64 * i) * 4); ss += v[i][0] * v[i][0] + v[i][1] * v[i][1] + v[i][2] * v[i][2] + v[i][3] * v[i][3]; }
        const float rstd = rsqrtf(wave_sum(ss) * (1.f / D) + EPS);
#pragma unroll
        for (int i = 0; i < 4; ++i) {
            const int k = (lane + 64 * i) * 4;
            const f32x4 gv = *(const f32x4*)(g + k), sc = *(const f32x4*)(MOD + mr * 6144 + 1024 + k), sh = *(const f32x4*)(MOD + mr * 6144 + k);
            v[i] = v[i] * rstd * gv * (sc + 1.f) + sh;
            *(uint2*)(HA + (size_t)n * D + k) = pack4(v[i]);
        }
        dt_project(wdt, v, lane, DTR + (size_t)n * 8);
    }
}

template <bool TRANS>
__device__ __forceinline__ void minipost_body(const Ctx& c, int layer, int r, int tb) {
    const int tid = c.tid, t = tid & 63, cqb = tid >> 6;
    const int n = tb * 64 + t, b = n / LT, pos = n % LT;
    const bool hasL = (pos != 0) && (pos != CTX), hasR = (pos != CTX - 1) && (pos != LT - 1);
    const float mL = hasL ? 1.f : 0.f, mR = hasR ? 1.f : 0.f;
    const bf16* XB = c.w<bf16>(WS_XBR) + (size_t)n * 768 + r * 256;
    const bf16* XL = hasL ? XB - 768 : XB; const bf16* XR = hasR ? XB + 768 : XB;
    bf16* XS = c.w<bf16>(WS_XBCS) + (size_t)n * 768 + r * 256;
    const float* cw = c.in(22) + (size_t)layer * 3 * 768 + r * 256; const float* cb = c.in(23) + layer * 768 + r * 256;
    bf16* TR = (r == 0 ? c.w<bf16>(WS_XT) : c.w<bf16>(WS_BT)) + (size_t)b * 256 * LT + pos;
#pragma unroll 2
    for (int i = 0; i < 8; ++i) {
        const int ch0 = (cqb * 8 + i) * 8;
        float xc[8], xl[8], xr[8];
        unpack8v(*(const u32x4*)(XB + ch0), xc); unpack8v(*(const u32x4*)(XL + ch0), xl); unpack8v(*(const u32x4*)(XR + ch0), xr);
        float y[8];
#pragma unroll
        for (int q = 0; q < 2; ++q) {
            const f32x4 w0 = *(const f32x4*)(cw + ch0 + 4 * q), w1 = *(const f32x4*)(cw + 768 + ch0 + 4 * q), w2 = *(const f32x4*)(cw + 1536 + ch0 + 4 * q), bb = *(const f32x4*)(cb + ch0 + 4 * q);
#pragma unroll
            for (int j = 0; j < 4; ++j) y[4 * q + j] = silu_f(w1[j] * xc[4 * q + j] + w0[j] * mL * xl[4 * q + j] + w2[j] * mR * xr[4 * q + j] + bb[j]);
        }
        const bf16x8 yb = pack8(y);
        *(bf16x8*)(XS + ch0) = yb;
        if (TRANS) {
#pragma unroll
            for (int j = 0; j < 8; ++j) TR[(size_t)(ch0 + j) * LT] = (bf16)yb[j];
        }
    }
}
__device__ __forceinline__ void ph_minipost(const Ctx& c, int layer, int tile) {
    const int r = tile % 3, tb = tile / 3;
    if (r < 2) minipost_body<true>(c, layer, r, tb); else minipost_body<false>(c, layer, r, tb);
}

__device__ __forceinline__ void ph_gates(const Ctx& c, int layer, int tile) {
    const int lane = c.tid & 63, n = tile * 4 + (c.tid >> 6), t4 = lane * 4;
    const f32x4 ys = *(const f32x4*)(c.w<float>(WS_YSSD) + (size_t)n * 256 + t4);
    const uint2 xr = *(const uint2*)(c.w<bf16>(WS_XBCS) + (size_t)n * 768 + t4), zr = *(const uint2*)(c.w<bf16>(WS_Z) + (size_t)n * 256 + t4);
    const float dsk = c.in(26)[layer * 4 + (lane >> 4)];
    float y[4];
    y[0] = (ys[0] + __uint_as_float(xr.x << 16) * dsk) * silu_f(__uint_as_float(zr.x << 16));
    y[1] = (ys[1] + __uint_as_float(xr.x & 0xffff0000u) * dsk) * silu_f(__uint_as_float(zr.x & 0xffff0000u));
    y[2] = (ys[2] + __uint_as_float(xr.y << 16) * dsk) * silu_f(__uint_as_float(zr.y << 16));
    y[3] = (ys[3] + __uint_as_float(xr.y & 0xffff0000u) * dsk) * silu_f(__uint_as_float(zr.y & 0xffff0000u));
    const float ss = wave_sum(y[0] * y[0] + y[1] * y[1] + y[2] * y[2] + y[3] * y[3]);
    const float rstd = rsqrtf(ss * (1.f / 256.f) + EPS);
    const f32x4 gn = *(const f32x4*)(c.in(27) + layer * 256 + t4);
    uint2 o; o.x = pk2bf(y[0] * rstd * gn[0], y[1] * rstd * gn[1]); o.y = pk2bf(y[2] * rstd * gn[2], y[3] * rstd * gn[3]);
    *(uint2*)(c.w<bf16>(WS_MIX) + (size_t)n * D + 512 + t4) = o;
}

__device__ __forceinline__ float half_sum(float v) {
#pragma unroll
    for (int o = 1; o < 32; o <<= 1) v += __shfl_xor(v, o);
    return v;
}
__device__ __forceinline__ void ph_norm2(const Ctx& c, int layer, int bid, int G, unsigned char* hbuf, int* lsm) {
    const int lane = c.tid & 63, wid = c.tid >> 6, hl = lane & 31, half = lane >> 5;
    const int per = (NT + G - 1) / G, n0 = bid * per, n1 = (n0 + per < NT) ? n0 + per : NT;
    __syncthreads();
    const float* X = c.w<float>(WS_X); bf16* HA = c.w<bf16>(WS_HA);
    const float* MOD = c.w<float>(WS_MOD) + (size_t)layer * 5 * 6144;
    const float* g = c.in(7) + layer * D;
    int* TE = c.w<int>(WS_TOKE); float* TW = c.w<float>(WS_TOKW);
    float* hb = (float*)hbuf + (wid * 2 + half) * D;
    const float* rwt = c.w<float>(WS_RWT) + (size_t)layer * 36 * 1024;
    for (int nb = n0 + wid * 2; nb < n1; nb += 8) {
        const bool act = nb + half < n1;
        const int n = act ? nb + half : n1 - 1;
        const int b = n / LT, pos = n % LT, mr = pos < CTX ? 4 : b;
        const float* x = X + (size_t)n * D;
        float ss = 0.f;
        PR_BEGIN(110);
        f32x4 v[8];
#pragma unroll
        for (int i = 0; i < 8; ++i) { v[i] = *(const f32x4*)(x + (hl + 32 * i) * 4); ss += v[i][0] * v[i][0] + v[i][1] * v[i][1] + v[i][2] * v[i][2] + v[i][3] * v[i][3]; }
        const float rstd = rsqrtf(half_sum(ss) * (1.f / D) + EPS);
        PR_END(110); PR_BEGIN(111);
        float cg[4] = {0.f, 0.f, 0.f, 0.f};
#pragma unroll
        for (int i = 0; i < 8; ++i) {
            const int k = (hl + 32 * i) * 4;
            const f32x4 h = v[i] * rstd * *(const f32x4*)(g + k) * (*(const f32x4*)(MOD + mr * 6144 + 4096 + k) + 1.f) + *(const f32x4*)(MOD + mr * 6144 + 3072 + k);
            *(f32x4*)(hb + k) = h;
            *(uint2*)(HA + (size_t)n * D + k) = pack4(h);
#pragma unroll
            for (int e = 0; e < 4; ++e) { const f32x4 w = *(const f32x4*)(rwt + e * 1024 + k); cg[e] += h[0] * w[0] + h[1] * w[1] + h[2] * w[2] + h[3] * w[3]; }
        }
        float mx = -1e30f; int gi = 0; float cl[4];
#pragma unroll
        for (int e = 0; e < 4; ++e) { cl[e] = half_sum(cg[e]) + c.in(30)[layer * 4 + e]; if (cl[e] > mx) { mx = cl[e]; gi = e; } }
        PR_END(111); PR_BEGIN(112);
        float fg[8] = {0.f, 0.f, 0.f, 0.f, 0.f, 0.f, 0.f, 0.f};
        const float* fwt = rwt + (4 + gi * 8) * 1024;
#pragma unroll 2
        for (int i = 0; i < 8; ++i) {
            const int k = (hl + 32 * i) * 4;
            const f32x4 h = *(const f32x4*)(hb + k);
#pragma unroll
            for (int e = 0; e < 8; ++e) { const f32x4 w = *(const f32x4*)(fwt + e * 1024 + k); fg[e] += h[0] * w[0] + h[1] * w[1] + h[2] * w[2] + h[3] * w[3]; }
        }
#pragma unroll
        for (int e = 0; e < 8; ++e) fg[e] = half_sum(fg[e]);
        PR_END(112); PR_BEGIN(113);
        if (hl == 0 && act) {
            float den = 0.f;
#pragma unroll
            for (int e = 0; e < 4; ++e) den += expf(cl[e] - mx);
            const float pg = 1.f / den;
            float f1 = -1e30f, f2 = -1e30f; int i1 = 0, i2 = 0;
#pragma unroll
            for (int e = 0; e < 8; ++e) {
                const float fv = fg[e] + c.in(32)[layer * 32 + gi * 8 + e];
                if (fv > f1) { f2 = f1; i2 = i1; f1 = fv; i1 = e; } else if (fv > f2) { f2 = fv; i2 = e; }
            }
            const float e2 = expf(f2 - f1), w1 = pg / (1.f + e2), w2 = pg * e2 / (1.f + e2);
            const int ex1 = gi * 8 + i1, ex2 = gi * 8 + i2;
            lsm[(n - n0) * 2] = ex1; lsm[(n - n0) * 2 + 1] = ex2;
            TE[n * 2] = ex1; TE[n * 2 + 1] = ex2; TW[n * 2] = w1; TW[n * 2 + 1] = w2;
        }
        PR_END(113);
    }
    PR_BEGIN(114);
    __syncthreads();
    if (c.tid < 32) {
        const int e = c.tid, ne = (n1 > n0 ? n1 - n0 : 0) * 2;
        int cl_ = 0;
        for (int i = 0; i < ne; ++i) cl_ += (lsm[i] == e) ? 1 : 0;
        c.w<int>(WS_BCNT)[bid * 32 + e] = cl_;
    }
    PR_END(114);
}
__device__ __forceinline__ void ph_assign(const Ctx& c, int layer, int bid, int G, int* wk, const int* lsm) {
    const int e = c.tid & 31, part = c.tid >> 5;
    const int per = (NT + G - 1) / G, n0 = bid * per, n1 = (n0 + per < NT) ? n0 + per : NT;
    const int* BC = c.w<int>(WS_BCNT);
    int before = 0, all = 0;
#pragma unroll 16
    for (int blk = part; blk < G; blk += 8) { const int v = BC[blk * 32 + e]; all += v; before += blk < bid ? v : 0; }
    __syncthreads();
    wk[(part * 32 + e) * 2] = before; wk[(part * 32 + e) * 2 + 1] = all;
    __syncthreads();
    if (c.tid < 32) {
        int base = 0, tot = 0;
#pragma unroll
        for (int p = 0; p < 8; ++p) { base += wk[(p * 32 + e) * 2]; tot += wk[(p * 32 + e) * 2 + 1]; }
        if (bid == 0) c.w<unsigned>(WS_CTL)[CW_CNT + (layer * 32 + e) * 64] = (unsigned)tot;
        int* TP = c.w<int>(WS_TOKP); int* LI = c.w<int>(WS_LIST);
        const int ne = (n1 > n0 ? n1 - n0 : 0) * 2;
        int r = 0;
        for (int i = 0; i < ne; ++i) if (lsm[i] == e) { const int n = n0 + (i >> 1); const int ps = base + r; ++r; TP[n * 2 + (i & 1)] = ps; LI[(size_t)e * NT + ps] = n; }
    }
}

__device__ __forceinline__ void moe_offsets(const Ctx& c, int layer, int* sm) {
    __syncthreads();
    if (c.tid == 0) {
        const unsigned* cnt = c.w<unsigned>(WS_CTL) + CW_CNT + layer * 32 * 64;
        int acc = 0;
        for (int e = 0; e < 32; ++e) { const int ce = (int)__hip_atomic_load(cnt + e * 64, __ATOMIC_RELAXED, __HIP_MEMORY_SCOPE_AGENT); sm[e] = acc; sm[33 + e] = ce; acc += (ce + 127) & ~127; }
        sm[32] = acc;
    }
    __syncthreads();
}
__device__ __forceinline__ int slot_expert(const int* sm, int slot) { int e = 0;
#pragma unroll 1
    for (int i = 1; i < 32; ++i) if (slot >= sm[i]) e = i;
    return e; }

__device__ __forceinline__ f32x4 bf4(const uint2 u) { return (f32x4){__uint_as_float(u.x << 16), __uint_as_float(u.x & 0xffff0000u), __uint_as_float(u.y << 16), __uint_as_float(u.y & 0xffff0000u)}; }
__device__ __forceinline__ void ph_combine(const Ctx& c, int layer, int gw, int nwaves, const int* sm, unsigned char* lds) {
    const int lane = c.tid & 63;
    __syncthreads();
    for (int i = c.tid; i < 2048; i += NTHR) ((f32x4*)lds)[i] = ((const f32x4*)(c.w<float>(WS_WDT) + (size_t)8 * 1024))[i];
    __syncthreads();
    const LAS float* wdt = (const LAS float*)lds;
    const int* TE = c.w<int>(WS_TOKE); const int* TP = c.w<int>(WS_TOKP); const float* TW = c.w<float>(WS_TOKW);
    const bf16* OUT = c.w<bf16>(WS_OUT);
    bf16* HA = c.w<bf16>(WS_HA); float* DTR = c.w<float>(WS_DTR);
    const float* MODn = c.w<float>(WS_MOD) + (size_t)1 * 5 * 6144;
    const float* gnext = c.in(6) + D;
    for (int n = gw; n < NT; n += nwaves) {
        const int b = n / LT, pos = n % LT, mr = pos < CTX ? 4 : b;
        if (layer == 1 && pos < CTX) continue;
        const int s0 = sm[TE[n * 2]] + TP[n * 2], s1 = sm[TE[n * 2 + 1]] + TP[n * 2 + 1];
        const float w0 = TW[n * 2], w1 = TW[n * 2 + 1];
        const float* g2 = c.w<float>(WS_MOD) + (size_t)layer * 5 * 6144 + mr * 6144 + 5120;
        float* X = c.w<float>(WS_X) + (size_t)n * D;
        f32x4 v[4]; float ss = 0.f;
#pragma unroll
        for (int i = 0; i < 4; ++i) {
            const int k = (lane + 64 * i) * 4;
            const f32x4 o0 = bf4(*(const uint2*)(OUT + (size_t)s0 * D + k)), o1 = bf4(*(const uint2*)(OUT + (size_t)s1 * D + k));
            v[i] = *(const f32x4*)(X + k) + *(const f32x4*)(g2 + k) * (o0 * w0 + o1 * w1);
            ss += v[i][0] * v[i][0] + v[i][1] * v[i][1] + v[i][2] * v[i][2] + v[i][3] * v[i][3];
        }
        const float rstd = rsqrtf(wave_sum(ss) * (1.f / D) + EPS);
        if (layer == 1) {
            float* o = c.out() + ((size_t)b * SEQ + (pos - CTX)) * D;
#pragma unroll
            for (int i = 0; i < 4; ++i) { const int k = (lane + 64 * i) * 4; *(f32x4*)(o + k) = v[i] * rstd * *(const f32x4*)(c.in(36) + k); }
        } else {
#pragma unroll
            for (int i = 0; i < 4; ++i) {
                const int k = (lane + 64 * i) * 4;
                *(f32x4*)(X + k) = v[i];
                v[i] = v[i] * rstd * *(const f32x4*)(gnext + k) * (*(const f32x4*)(MODn + mr * 6144 + 1024 + k) + 1.f) + *(const f32x4*)(MODn + mr * 6144 + k);
                *(uint2*)(HA + (size_t)n * D + k) = pack4(v[i]);
            }
            dt_project(wdt, v, lane, DTR + (size_t)n * 8);
        }
    }
}

typedef LAS const char* lds_cptr;
constexpr int GEMM_LDS = 35840;
constexpr int GA_KH = 8256, GB_OFF = 16512, GB_ST = 288;
__device__ __forceinline__ s16x4 lds_tr(lds_cptr p) { return __builtin_bit_cast(s16x4, __builtin_amdgcn_ds_read_tr16_b64_v4i16((LAS s16x4*)p)); }

template <bool B_F32, bool DEEP = true, class ARow>
__device__ __forceinline__ void gemm_tile(const int tid, unsigned char* lds, const bf16* Abase, ARow arow  , const void* Bbase, unsigned boff  , int ldb, bool bval, int K, f32x4 (&acc)[4][4]) {
    const int lane = tid & 63, wid = tid >> 6, wr = wid >> 1, wc = wid & 1, fr = lane & 15, fq = lane >> 4;
#pragma unroll
    for (int m = 0; m < 4; ++m)
#pragma unroll
        for (int n = 0; n < 4; ++n) acc[m][n] = (f32x4){0.f, 0.f, 0.f, 0.f};
    unsigned ao[4];
#pragma unroll
    for (int i = 0; i < 4; ++i) ao[i] = arow((tid >> 3) + 32 * i) + (tid & 7) * 8;
    const int bk = tid >> 4, bnc = tid & 15;
    constexpr int NRB = B_F32 ? 8 : 4;
    u32x4 ra0[4]; u32x4 rb0[NRB], rb1[NRB];
    auto gloadA = [&](int kt, u32x4 (&ra)[4]) __attribute__((always_inline)) {
#pragma unroll
        for (int i = 0; i < 4; ++i) ra[i] = *(const u32x4*)(Abase + (ao[i] + kt * 64));
    };
    auto gloadB = [&](int kt, u32x4 (&rb)[NRB]) __attribute__((always_inline)) {
        if (B_F32) {
            const float* bp = (const float*)Bbase + (boff + (unsigned)((kt * 64 + bk) * ldb));
#pragma unroll
            for (int i = 0; i < 4; ++i) {
                if (bval) { rb[2 * i] = *(const u32x4*)(bp + (unsigned)(16 * i * ldb)); rb[2 * i + 1] = *(const u32x4*)(bp + (unsigned)(16 * i * ldb) + 4); }
                else { rb[2 * i] = (u32x4){0u, 0u, 0u, 0u}; rb[2 * i + 1] = rb[2 * i]; }
            }
        } else {
            const bf16* bp = (const bf16*)Bbase + (boff + (unsigned)((kt * 64 + bk) * ldb));
#pragma unroll
            for (int i = 0; i < 4; ++i) rb[i] = bval ? *(const u32x4*)(bp + (unsigned)(16 * i * ldb)) : (u32x4){0u, 0u, 0u, 0u};
        }
    };
    auto lstore = [&](const u32x4 (&ra)[4], const u32x4 (&rb)[NRB]) __attribute__((always_inline)) {
#pragma unroll
        for (int i = 0; i < 4; ++i) { const int row = (tid >> 3) + 32 * i, kc = tid & 7;
            const u32x4 v = (kc & 1) ? (u32x4){ra[i][2], ra[i][3], ra[i][0], ra[i][1]} : ra[i];
            *(u32x4*)(lds + (kc >> 2) * GA_KH + row * 64 + (kc & 3) * 16) = v; }
#pragma unroll
        for (int i = 0; i < 4; ++i) { const int k = bk + 16 * i;
            u32x4 v;
            if (B_F32) { const f32x4 x = __builtin_bit_cast(f32x4, rb[2 * i]), y = __builtin_bit_cast(f32x4, rb[2 * i + 1]);
                v[0] = pk2bf(x[0], x[1]); v[1] = pk2bf(x[2], x[3]); v[2] = pk2bf(y[0], y[1]); v[3] = pk2bf(y[2], y[3]); }
            else v = rb[i];
            *(u32x4*)(lds + GB_OFF + k * GB_ST + bnc * 16) = v; }
    };
    const lds_cptr la = (lds_cptr)lds + (wr * 64 + fr) * 64 + fq * 16;
    const lds_cptr lb = (lds_cptr)lds + GB_OFF + (8 * fq + (fr >> 2) + (fq & 1) * 4) * GB_ST + wc * 128 + (fr & 3) * 8;
    const int bsw = (fq & 1) ? -4 * GB_ST : 4 * GB_ST;
    auto compute = [&]() __attribute__((always_inline)) {
#pragma unroll
        for (int kh = 0; kh < 2; ++kh) {
            bf16x8 af[4], bfr[4];
#pragma unroll
            for (int m = 0; m < 4; ++m) af[m] = *(const LAS bf16x8*)(la + kh * GA_KH + m * 1024);
#pragma unroll
            for (int n = 0; n < 4; ++n) {
                const s16x4 r0 = lds_tr(lb + kh * 32 * GB_ST + n * 32), r1 = lds_tr(lb + kh * 32 * GB_ST + n * 32 + bsw);
                bfr[n] = (bf16x8){r0[0], r0[1], r0[2], r0[3], r1[0], r1[1], r1[2], r1[3]};
            }
#pragma unroll
            for (int m = 0; m < 4; ++m)
#pragma unroll
                for (int n = 0; n < 4; ++n) acc[m][n] = __builtin_amdgcn_mfma_f32_16x16x32_bf16(bfr[n], af[m], acc[m][n], 0, 0, 0);
        }
    };
    const int nk = K / 64;
    if (!DEEP) {
        gloadA(0, ra0); gloadB(0, rb0);
        for (int kt = 0; kt < nk; ++kt) {
            __syncthreads();
            lstore(ra0, rb0);
            __syncthreads();
            if (kt + 1 < nk) { gloadA(kt + 1, ra0); gloadB(kt + 1, rb0); }
            compute();
        }
        return;
    }
    gloadB(0, rb0); gloadA(0, ra0); gloadB(1, rb1);
    for (int kt = 0; kt < nk; kt += 2) {
        __syncthreads();
        lstore(ra0, rb0);
        __syncthreads();
        gloadA(kt + 1, ra0);
        if (kt + 2 < nk) gloadB(kt + 2, rb0);
        compute();
        __syncthreads();
        lstore(ra0, rb1);
        __syncthreads();
        if (kt + 2 < nk) gloadA(kt + 2, ra0);
        if (kt + 3 < nk) gloadB(kt + 3, rb1);
        compute();
    }
}


__device__ __forceinline__ void cvt8(const float* s, bf16* d) {
    const f32x4 a = *(const f32x4*)s, b = *(const f32x4*)(s + 4);
    u32x4 o; o[0] = pk2bf(a[0], a[1]); o[1] = pk2bf(a[2], a[3]); o[2] = pk2bf(b[0], b[1]); o[3] = pk2bf(b[2], b[3]);
    *(u32x4*)d = o;
}
__device__ __forceinline__ void cvt_small(Ctx& c, int gtid, int gthreads) {
    asm volatile("" : "+s"(c.p));

    constexpr int N_IN = 2 * D * (DINV / 8), N_OUT = 2 * D * (D / 8), N_GLU = 2 * 256 * 32;
    for (int it = gtid; it < N_IN + N_OUT + N_GLU; it += gthreads) {
        if (it < N_IN) { const int ch = it % (DINV / 8), lk = it / (DINV / 8), vc = ch * 8, ac = vc < C_DT ? vc : vc + 8;
            cvt8(c.in(8) + (size_t)lk * DIN + ac, c.w<bf16>(WS_BIN) + (size_t)lk * DINV + vc); }
        else if (it < N_IN + N_OUT) { const int j = it - N_IN; cvt8(c.in(9) + (size_t)j * 8, c.w<bf16>(WS_BOUT) + (size_t)j * 8); }
        else { const int j = it - N_IN - N_OUT; cvt8(c.in(18) + (size_t)j * 8, c.w<bf16>(WS_BGLU) + (size_t)j * 8); }
    }
}
constexpr int CVT_MOE_TILES = 1536;
__device__ __forceinline__ void cvt_moe(const Ctx& c, int layer, int tile) {
#pragma unroll 4
    for (int i = 0; i < 16; ++i) {
        const int it = tile * 4096 + i * 256 + c.tid;
        if (it < 32 * 1024 * 128) {
            const int ch = it & 127, ek = it >> 7;
            const int blk = ch >> 3, w = (ch & 7) * 8;
            const float* s = (w < 32 ? c.in(33) : c.in(34)) + ((size_t)layer * NEXP * D + ek) * DE + blk * 32 + (w & 31);
            cvt8(s, c.w<bf16>(WS_BGU) + (size_t)ek * 1024 + ch * 8);
        } else {
            const int j = it - 32 * 1024 * 128;
            cvt8(c.in(35) + (size_t)layer * NEXP * DE * D + (size_t)j * 8, c.w<bf16>(WS_BDN) + (size_t)j * 8);
        }
    }
}

__device__ __forceinline__ void ph_inproj_mfma(const Ctx& c, int layer, int tile, unsigned char* lds) {
    const int mt = tile / 18, nt = tile % 18;
    const bf16* HA = c.w<bf16>(WS_HA) + (size_t)mt * 128 * D;
    f32x4 acc[4][4];
    const int vc = nt * 128 + (c.tid & 15) * 8;
    gemm_tile<false>(c.tid, lds, HA, [&](int r) __attribute__((always_inline)) { return (unsigned)(r * D); }, c.w<bf16>(WS_BIN) + (size_t)layer * D * DINV, (unsigned)vc, DINV, true, D, acc);
    const int lane = c.tid & 63, wid = c.tid >> 6, wr = wid >> 1, wc = wid & 1, fr = lane & 15, fq = lane >> 4;
    const int n0 = mt * 128, b = n0 / LT, pos0 = n0 % LT;
    if (nt < 2) {
        bf16* UH = c.w<bf16>(WS_UH);
#pragma unroll
        for (int m = 0; m < 4; ++m) {
            const int pos = pos0 + wr * 64 + m * 16 + fr, J = b * 136 + (pos >> 5), tt = pos & 31;
#pragma unroll
            for (int n = 0; n < 4; ++n) { const int col = nt * 128 + wc * 64 + n * 16 + fq * 4;
                *(uint2*)(UH + ((size_t)(col >> 4) * NCH5 + J) * 768 + tt * 16 + (col & 15)) = pack4(acc[m][n]); }
        }
    } else if (nt < 6 || nt >= 14) {
        const int kind = nt >= 14 ? 1 : 0, sub = nt - (kind ? 14 : 2);
        if (sub == 3) {
            bf16* Vt = c.w<bf16>(kind ? WS_WV : WS_GV) + ((size_t)b * 2 + wc) * 64 * LT;
#pragma unroll
            for (int m = 0; m < 4; ++m) { const int pos = pos0 + wr * 64 + m * 16 + fr;
#pragma unroll
                for (int n = 0; n < 4; ++n)
#pragma unroll
                    for (int jj = 0; jj < 4; ++jj) Vt[(size_t)(n * 16 + fq * 4 + jj) * LT + pos] = f2bf(acc[m][n][jj]); }
        } else {
            const bool isq = sub < 2; const int head = isq ? sub * 2 + wc : wc;
            bf16* dst = isq ? c.w<bf16>(kind ? WS_WQ : WS_GQ) + ((size_t)b * 4 + head) * LT * 64 : c.w<bf16>(kind ? WS_WK : WS_GK) + ((size_t)b * 2 + head) * LT * 64;
            const float* gain = (isq ? c.in(20) : c.in(21)) + layer * 64;
            const float qs = isq ? 0.18033688011112042f : 1.f;
            const float* ROPE = c.w<float>(WS_ROPE);
#pragma unroll
            for (int m = 0; m < 4; ++m) {
                const int pos = pos0 + wr * 64 + m * 16 + fr;
                f32x4 v[4];
#pragma unroll
                for (int n = 0; n < 4; ++n) v[n] = acc[m][n];
                if (kind == 0) {
                    float ss = 0.f;
#pragma unroll
                    for (int n = 0; n < 4; ++n) ss += v[n][0] * v[n][0] + v[n][1] * v[n][1] + v[n][2] * v[n][2] + v[n][3] * v[n][3];
                    ss += __shfl_xor(ss, 16); ss += __shfl_xor(ss, 32);
                    const float rstd = rsqrtf(ss * (1.f / 64.f) + EPS);
#pragma unroll
                    for (int n = 0; n < 4; ++n) v[n] = v[n] * rstd * *(const f32x4*)(gain + n * 16 + fq * 4);
                }
                if (pos >= CTX) {
                    const int l = pos - CTX;
#pragma unroll
                    for (int a = 0; a < 2; ++a) { const int rp = a == 0 ? (l >> 6) : (l & 63);
#pragma unroll
                        for (int jj = 0; jj < 4; ++jj) { const f32x2 cs = *(const f32x2*)(ROPE + (rp * 16 + fq * 4 + jj) * 2);
                            const float x0 = v[2 * a][jj], x1 = v[2 * a + 1][jj];
                            v[2 * a][jj] = x0 * cs[0] - x1 * cs[1]; v[2 * a + 1][jj] = x1 * cs[0] + x0 * cs[1]; } }
                }
#pragma unroll
                for (int n = 0; n < 4; ++n) *(uint2*)(dst + (size_t)pos * 64 + n * 16 + fq * 4) = pack4(v[n] * qs);
            }
        }
    } else {
        bf16* dst; int ld, col0;
        if (nt < 8) { dst = c.w<bf16>(WS_Z); ld = 256; col0 = (nt - 6) * 128; } else { dst = c.w<bf16>(WS_XBR); ld = 768; col0 = (nt - 8) * 128; }
#pragma unroll
        for (int m = 0; m < 4; ++m) { const size_t row = (size_t)n0 + wr * 64 + m * 16 + fr;
#pragma unroll
            for (int n = 0; n < 4; ++n) *(uint2*)(dst + row * ld + col0 + wc * 64 + n * 16 + fq * 4) = pack4(acc[m][n]); }
    }
}

#define EPI_COORDS const int lane = c.tid & 63, wid = c.tid >> 6, wr = wid >> 1, wc = wid & 1, fr = lane & 15, fq = lane >> 4
__device__ __forceinline__ void ph_glu_mfma(const Ctx& c, int layer, int tile, unsigned char* lds) {
    const int mt = tile >> 1, nt = tile & 1;
    const bf16* G5 = c.w<bf16>(WS_G5) + (size_t)mt * 128 * 256;
    f32x4 acc[4][4];
    const int bc = nt * 128 + (c.tid & 15) * 8;
    gemm_tile<false>(c.tid, lds, G5, [&](int r) __attribute__((always_inline)) { return (unsigned)(r * 256); }, c.w<bf16>(WS_BGLU) + (size_t)layer * 256 * 256, (unsigned)bc, 256, true, 256, acc);
    EPI_COORDS;
    bf16* MIX = c.w<bf16>(WS_MIX);
#pragma unroll
    for (int m = 0; m < 4; ++m)
#pragma unroll
        for (int n = 0; n < 4; ++n) {
            const int rl = wr * 64 + m * 16 + fr, col = nt * 128 + wc * 64 + n * 16 + fq * 4;
            const f32x4 bb = *(const f32x4*)(c.in(19) + layer * 256 + col);
            const uint2 gv = *(const uint2*)(G5 + (size_t)rl * 256 + col);
            const float g0 = __uint_as_float(gv.x << 16), g1 = __uint_as_float(gv.x & 0xffff0000u), g2 = __uint_as_float(gv.y << 16), g3 = __uint_as_float(gv.y & 0xffff0000u);
            uint2 o;
            o.x = pk2bf(g0 * sigmoid_f(acc[m][n][0] + bb[0]), g1 * sigmoid_f(acc[m][n][1] + bb[1]));
            o.y = pk2bf(g2 * sigmoid_f(acc[m][n][2] + bb[2]), g3 * sigmoid_f(acc[m][n][3] + bb[3]));
            *(uint2*)(MIX + (size_t)(mt * 128 + rl) * D + col) = o;
        }
}
__device__ __forceinline__ void ph_outproj_mfma(const Ctx& c, int layer, int tile, unsigned char* lds) {
    const int mt = tile >> 3, nt = tile & 7;
    const bf16* MIX = c.w<bf16>(WS_MIX) + (size_t)mt * 128 * D;
    f32x4 acc[4][4];
    const int bc = nt * 128 + (c.tid & 15) * 8;
    gemm_tile<false>(c.tid, lds, MIX, [&](int r) __attribute__((always_inline)) { return (unsigned)(r * D); }, c.w<bf16>(WS_BOUT) + (size_t)layer * D * D, (unsigned)bc, D, true, D, acc);
    EPI_COORDS;
    const float* MOD = c.w<float>(WS_MOD) + (size_t)layer * 5 * 6144;
    float* X = c.w<float>(WS_X);
#pragma unroll
    for (int m = 0; m < 4; ++m) {
        const int row = mt * 128 + wr * 64 + m * 16 + fr, b = row / LT, pos = row % LT, mr = pos < CTX ? 4 : b;
        const float* xs = xsrc(c, layer, row);
#pragma unroll
        for (int n = 0; n < 4; ++n) {
            const int col = nt * 128 + wc * 64 + n * 16 + fq * 4;
            const f32x4 g1 = *(const f32x4*)(MOD + mr * 6144 + 2048 + col);
            *(f32x4*)(X + (size_t)row * D + col) = *(const f32x4*)(xs + col) + g1 * acc[m][n];
        }
    }
}
__device__ __forceinline__ void ph_moe1_mfma(const Ctx& c, int layer, int tile, const int* sm, unsigned char* lds) {
    const int st = tile >> 3, nt = tile & 7;
    const int s0 = st * 128;
    if (s0 >= sm[32]) return;
    const int e = slot_expert(sm, s0), base = s0 - sm[e], ce = sm[33 + e];
    if (base >= ce) return;
    const bf16* HA = c.w<bf16>(WS_HA); const int* LI = c.w<int>(WS_LIST) + (size_t)e * NT;
    f32x4 acc[4][4];
    gemm_tile<false>(c.tid, lds, HA, [&](int r) __attribute__((always_inline)) { const int tok = LI[(base + r < ce) ? (base + r) : base]; return (unsigned)(tok * D); }, c.w<bf16>(WS_BGU) + (size_t)e * D * 1024, (unsigned)(nt * 128 + (c.tid & 15) * 8), 1024, true, D, acc);
    EPI_COORDS;
    bf16* ACT = c.w<bf16>(WS_ACT);
#pragma unroll
    for (int m = 0; m < 4; ++m) {
        const int rl = wr * 64 + m * 16 + fr;
#pragma unroll
        for (int n = 0; n < 2; ++n) {
            const int col = nt * 64 + wc * 32 + n * 16 + fq * 4;
            const f32x4 g = acc[m][n], u = acc[m][n + 2];
            uint2 o; o.x = pk2bf(silu_f(g[0]) * u[0], silu_f(g[1]) * u[1]); o.y = pk2bf(silu_f(g[2]) * u[2], silu_f(g[3]) * u[3]);
            *(uint2*)(ACT + (size_t)(s0 + rl) * DE + col) = o;
        }
    }
}
__device__ __forceinline__ void ph_moe2_mfma(const Ctx& c, int layer, int tile, const int* sm, unsigned char* lds) {
    const int st = tile >> 3, nt = tile & 7;
    const int s0 = st * 128;
    if (s0 >= sm[32]) return;
    const int e = slot_expert(sm, s0), base = s0 - sm[e], ce = sm[33 + e];
    if (base >= ce) return;
    const bf16* ACT = c.w<bf16>(WS_ACT) + (size_t)s0 * DE;
    f32x4 acc[4][4];
    const int bc = nt * 128 + (c.tid & 15) * 8;
    gemm_tile<false>(c.tid, lds, ACT, [&](int r) __attribute__((always_inline)) { return (unsigned)(r * DE); }, c.w<bf16>(WS_BDN) + (size_t)e * DE * D, (unsigned)bc, D, true, DE, acc);
    EPI_COORDS;
    bf16* OUT = c.w<bf16>(WS_OUT);
#pragma unroll
    for (int m = 0; m < 4; ++m)
#pragma unroll
        for (int n = 0; n < 4; ++n) {
            const int rl = wr * 64 + m * 16 + fr, col = nt * 128 + wc * 64 + n * 16 + fq * 4;
            uint2 o; o.x = pk2bf(acc[m][n][0], acc[m][n][1]); o.y = pk2bf(acc[m][n][2], acc[m][n][3]);
            *(uint2*)(OUT + (size_t)(s0 + rl) * D + col) = o;
        }
}


typedef float f32x16 __attribute__((ext_vector_type(16)));
constexpr int AT_KST = 144, AT_VST = 136;
constexpr int AT_KOFF = 0, AT_VOFF = 64 * AT_KST, AT_SOFF = AT_VOFF + 64 * AT_VST;
constexpr float AT_THR = 5.0f;
__device__ __forceinline__ int crow(int r, int hi) { return (r & 3) + 8 * (r >> 2) + 4 * hi; }

__device__ __forceinline__ void attn_tile(const Ctx& c, int layer, int idx, unsigned char* lds) {
    const int tid = c.tid, lane = tid & 63, wid = tid >> 6, r32 = lane & 31, hi = lane >> 5;
    int kind, b, h, qt;
    if (idx < 1024) { kind = idx >> 9; const int r = idx & 511; b = r >> 7; h = (r >> 5) & 3; qt = 2 + (r & 31); }
    else { const int r = idx - 1024; kind = r >> 5; b = (r >> 3) & 3; h = (r >> 1) & 3; qt = r & 1; }
    const int kvh = h >> 1;
    const bf16* Q = c.w<bf16>(kind ? WS_WQ : WS_GQ) + ((size_t)b * 4 + h) * LT * 64;
    const bf16* K = c.w<bf16>(kind ? WS_WK : WS_GK) + ((size_t)b * 2 + kvh) * LT * 64;
    const bf16* Vt = c.w<bf16>(kind ? WS_WV : WS_GV) + ((size_t)b * 2 + kvh) * 64 * LT;
    const int q0 = qt * 128;
    const int qpos = q0 + wid * 32 + r32;
    int b0 = CTX, b1 = CTX;
    if (qt >= 2) { if (kind == 0) { b0 = CTX; b1 = LT; } else { b0 = q0 - 128 < CTX ? CTX : q0 - 128; b1 = q0 + 256 > LT ? LT : q0 + 256; } }
    const int nA = CTX / 64, ntile = nA + (b1 - b0) / 64;
    bf16x8 qf[4];
#pragma unroll
    for (int d0 = 0; d0 < 4; ++d0) qf[d0] = *(const bf16x8*)(Q + (size_t)qpos * 64 + d0 * 16 + hi * 8);
    f32x16 o0, o1;
#pragma unroll
    for (int r = 0; r < 16; ++r) { o0[r] = 0.f; o1[r] = 0.f; }
    float m = -1e30f, l = 0.f;
    if (kind == 1) { m = c.in(28)[layer * 4 + h] * 1.4426950408889634f; l = (hi == 0) ? 1.f : 0.f; }
    float* wsf = (float*)(lds + AT_SOFF) + wid * 32;
    u32x4 rk[2], rv[2];
    auto gload = [&](int ti) __attribute__((always_inline)) {
        const int kb = ti < nA ? ti * 64 : b0 + (ti - nA) * 64;
#pragma unroll
        for (int i = 0; i < 2; ++i) { const int cc = tid + 256 * i;
            rk[i] = *(const u32x4*)(K + (size_t)(kb + (cc >> 3)) * 64 + (cc & 7) * 8);
            rv[i] = *(const u32x4*)(Vt + (size_t)(cc >> 3) * LT + kb + (cc & 7) * 8); }
    };
    const lds_cptr lk = (lds_cptr)lds + AT_KOFF + r32 * AT_KST + hi * 16;
    const lds_cptr lv = (lds_cptr)lds + AT_VOFF + r32 * AT_VST + hi * 8;
    gload(0);
    for (int ti = 0; ti < ntile; ++ti) {
        const int kb = ti < nA ? ti * 64 : b0 + (ti - nA) * 64;
        __syncthreads();
#pragma unroll
        for (int i = 0; i < 2; ++i) { const int cc = tid + 256 * i;
            *(u32x4*)(lds + AT_KOFF + (cc >> 3) * AT_KST + (cc & 7) * 16) = rk[i];
            unsigned char* vp = lds + AT_VOFF + (cc >> 3) * AT_VST + (cc & 7) * 16;
            *(uint2*)vp = make_uint2(rv[i][0], rv[i][1]); *(uint2*)(vp + 8) = make_uint2(rv[i][2], rv[i][3]); }
        __syncthreads();
        if (ti + 1 < ntile) gload(ti + 1);
        f32x16 p0, p1;
#pragma unroll
        for (int r = 0; r < 16; ++r) { p0[r] = 0.f; p1[r] = 0.f; }
#pragma unroll
        for (int d0 = 0; d0 < 4; ++d0) {
            const bf16x8 k0 = *(const LAS bf16x8*)(lk + d0 * 32), k1 = *(const LAS bf16x8*)(lk + 32 * AT_KST + d0 * 32);
            p0 = __builtin_amdgcn_mfma_f32_32x32x16_bf16(k0, qf[d0], p0, 0, 0, 0);
            p1 = __builtin_amdgcn_mfma_f32_32x32x16_bf16(k1, qf[d0], p1, 0, 0, 0);
        }
        if (kind == 1 && ti >= nA) {
#pragma unroll
            for (int r = 0; r < 16; ++r) {
                const int d0_ = kb + crow(r, hi) - qpos, d1_ = d0_ + 32;
                if (d0_ > 128 || d0_ < -128) p0[r] = -INFINITY;
                if (d1_ > 128 || d1_ < -128) p1[r] = -INFINITY;
            }
        }
        float rm = fmaxf(p0[0], p1[0]);
#pragma unroll
        for (int r = 1; r < 16; ++r) rm = fmaxf(rm, fmaxf(p0[r], p1[r]));
        rm = fmaxf(rm, __shfl_xor(rm, 32));
        if (__any(rm > m + AT_THR)) {
            const float mn = fmaxf(m, rm), f = __builtin_amdgcn_exp2f(m - mn);
            m = mn; l *= f;
            if (hi == 0) wsf[r32] = f;
#pragma unroll
            for (int g = 0; g < 4; ++g) { const f32x4 fv = *(const f32x4*)(wsf + 8 * g + 4 * hi);
#pragma unroll
                for (int j = 0; j < 4; ++j) { o0[4 * g + j] *= fv[j]; o1[4 * g + j] *= fv[j]; } }
        }
        float ls = 0.f;
#pragma unroll
        for (int r = 0; r < 16; ++r) { p0[r] = __builtin_amdgcn_exp2f(p0[r] - m); p1[r] = __builtin_amdgcn_exp2f(p1[r] - m); ls += p0[r] + p1[r]; }
        l += ls;
#pragma unroll
        for (int t = 0; t < 2; ++t)
#pragma unroll
            for (int s = 0; s < 2; ++s) {
                bf16x8 pa;
#pragma unroll
                for (int j = 0; j < 8; ++j) pa[j] = (short)f2bf(t == 0 ? p0[8 * s + j] : p1[8 * s + j]);
#pragma unroll
                for (int d0 = 0; d0 < 2; ++d0) {
                    const lds_cptr vp = lv + d0 * 32 * AT_VST + (32 * t + 16 * s) * 2;
                    const s16x4 lo = *(const LAS s16x4*)vp, hv = *(const LAS s16x4*)(vp + 16);
                    const bf16x8 vf = (bf16x8){lo[0], lo[1], lo[2], lo[3], hv[0], hv[1], hv[2], hv[3]};
                    if (d0 == 0) o0 = __builtin_amdgcn_mfma_f32_32x32x16_bf16(pa, vf, o0, 0, 0, 0);
                    else o1 = __builtin_amdgcn_mfma_f32_32x32x16_bf16(pa, vf, o1, 0, 0, 0);
                }
            }
    }
    l += __shfl_xor(l, 32);
    if (hi == 0) wsf[r32] = 1.f / l;
    bf16* MIX = c.w<bf16>(WS_MIX) + ((size_t)b * LT + q0 + wid * 32) * D + (kind ? 768 : 256) + h * 64 + r32;
#pragma unroll
    for (int g = 0; g < 4; ++g) { const f32x4 fv = *(const f32x4*)(wsf + 8 * g + 4 * hi);
#pragma unroll
        for (int j = 0; j < 4; ++j) { const int r = 4 * g + j; bf16* mp = MIX + (size_t)crow(r, hi) * D;
            mp[0] = f2bf(o0[r] * fv[j]); mp[32] = f2bf(o1[r] * fv[j]); } }
}


__device__ __forceinline__ void ph_prepB(const Ctx& c, int tile) {
    const float* KLAG = c.w<float>(WS_KLAG); const float* S5P = c.w<float>(WS_S5P); const float* S5BB = c.w<float>(WS_S5BB);
    bf16* WY = c.w<bf16>(WS_WY); bf16* WSm = c.w<bf16>(WS_WS);
    if (tile < 3072) {
        const int it = tile * NTHR + c.tid;
        const int t = it & 31, kr = (it >> 5) % 768, lg = it / (768 * 32), l = lg >> 4, g = lg & 15;
        float v[16];
        if (kr < 512) {
            const int s = kr >> 4, cp = kr & 15;
#pragma unroll
            for (int i = 0; i < 16; ++i) v[i] = 0.f;
            if (s <= t) { const f32x4* kp = (const f32x4*)(KLAG + ((size_t)(lg * 2 + 0) * 32 + (t - s)) * 256 + cp * 16);
#pragma unroll
                for (int q = 0; q < 4; ++q) { const f32x4 x = kp[q]; v[4 * q] += x[0]; v[4 * q + 1] += x[1]; v[4 * q + 2] += x[2]; v[4 * q + 3] += x[3]; } }
            if (s >= t) { const f32x4* kp = (const f32x4*)(KLAG + ((size_t)(lg * 2 + 1) * 32 + (s - t)) * 256 + cp * 16);
#pragma unroll
                for (int q = 0; q < 4; ++q) { const f32x4 x = kp[q]; v[4 * q] += x[0]; v[4 * q + 1] += x[1]; v[4 * q + 2] += x[2]; v[4 * q + 3] += x[3]; } }
            if (s == t) { const float dsk = c.in(17)[l * 256 + g * 16 + cp];
#pragma unroll
                for (int i = 0; i < 16; ++i) if (i == cp) v[i] += dsk; }
        } else {
            const int q = kr - 512, d = q >> 7, p = (q >> 1) & 63, ri = q & 1, e = d == 0 ? t + 1 : 32 - t;
            const int ldg = (l * 2 + d) * 16 + g;
            const float pr = S5P[((size_t)(ldg * 64 + p) * 33 + e) * 2], pi = S5P[((size_t)(ldg * 64 + p) * 33 + e) * 2 + 1];
#pragma unroll
            for (int i = 0; i < 16; ++i) {
                const float cr = c.in(15)[(size_t)ldg * 1024 + i * 64 + p], ci = c.in(16)[(size_t)ldg * 1024 + i * 64 + p];
                v[i] = ri == 0 ? (cr * pr - ci * pi) : -(cr * pi + ci * pr);
            }
        }
        u32x4 o0, o1;
        o0[0] = pk2bf(v[0], v[1]); o0[1] = pk2bf(v[2], v[3]); o0[2] = pk2bf(v[4], v[5]); o0[3] = pk2bf(v[6], v[7]);
        o1[0] = pk2bf(v[8], v[9]); o1[1] = pk2bf(v[10], v[11]); o1[2] = pk2bf(v[12], v[13]); o1[3] = pk2bf(v[14], v[15]);
        u32x4* op = (u32x4*)(WY + ((size_t)lg * 768 + kr) * 512 + t * 16);
        op[0] = o0; op[1] = o1;
    }
    else {
        const int it = (tile - 3072) * NTHR + c.tid;
        const int ncq = it & 31, kr = (it >> 5) & 511, lg = it >> 14, l = lg >> 4, g = lg & 15;
        const int s = kr >> 4, cp = kr & 15, d = ncq >> 4, p0 = (ncq & 15) * 4, e = d == 0 ? 31 - s : s;
        const int ldg = (l * 2 + d) * 16 + g;
        float v[8];
#pragma unroll
        for (int i = 0; i < 4; ++i) {
            const int p = p0 + i;
            const float pr = S5P[((size_t)(ldg * 64 + p) * 33 + e) * 2], pi = S5P[((size_t)(ldg * 64 + p) * 33 + e) * 2 + 1];
            const float br = S5BB[((size_t)(ldg * 64 + p) * 16 + cp) * 2], bi = S5BB[((size_t)(ldg * 64 + p) * 16 + cp) * 2 + 1];
            v[2 * i] = pr * br - pi * bi; v[2 * i + 1] = pr * bi + pi * br;
        }
        u32x4 o; o[0] = pk2bf(v[0], v[1]); o[1] = pk2bf(v[2], v[3]); o[2] = pk2bf(v[4], v[5]); o[3] = pk2bf(v[6], v[7]);
        *(u32x4*)(WSm + ((size_t)lg * 512 + kr) * 256 + ncq * 8) = o;
    }
}
__device__ __forceinline__ void s5_gemm_s(const Ctx& c, int layer, int tile, unsigned char* lds) {
    const int nt = tile & 1, mt = (tile >> 1) % 5, g = tile / 10;
    const bf16* UH = c.w<bf16>(WS_UH) + (size_t)g * NCH5 * 768;
    f32x4 acc[4][4];
    const int bc = nt * 128 + (c.tid & 15) * 8;
    gemm_tile<false, false>(c.tid, lds, UH, [&](int r) __attribute__((always_inline)) { int row = mt * 128 + r; row = row < NCH5 ? row : NCH5 - 1; return (unsigned)(row * 768); },
                     c.w<bf16>(WS_WS) + (size_t)(layer * 16 + g) * 512 * 256, (unsigned)bc, 256, true, 512, acc);
    EPI_COORDS;
    float* SALL = c.w<float>(WS_SALL) + (size_t)g * NCH5 * 256;
#pragma unroll
    for (int m = 0; m < 4; ++m)
#pragma unroll
        for (int n = 0; n < 4; ++n) {
            const int row = mt * 128 + wr * 64 + m * 16 + fr, col = nt * 128 + wc * 64 + n * 16 + fq * 4;
            if (row < NCH5) *(f32x4*)(SALL + (size_t)row * 256 + col) = acc[m][n];
        }
}
__device__ __forceinline__ void s5_recur(const Ctx& c, int layer, int gtid, int gthreads) {
    const float* S5P = c.w<float>(WS_S5P);
    for (int it = gtid; it < 4 * 16 * 2 * 64; it += gthreads) {
        const int p = it & 63, d = (it >> 6) & 1, g = (it >> 7) & 15, b = it >> 11;
        const int ldg = (layer * 2 + d) * 16 + g;
        const float ar = S5P[((size_t)(ldg * 64 + p) * 33 + 32) * 2], ai = S5P[((size_t)(ldg * 64 + p) * 33 + 32) * 2 + 1];
        const float* S = c.w<float>(WS_SALL) + ((size_t)g * NCH5 + b * 136) * 256 + d * 128 + p * 2;
        bf16* H = c.w<bf16>(WS_UH) + ((size_t)g * NCH5 + b * 136) * 768 + 512 + d * 128 + p * 2;
        float hr = 0.f, hi = 0.f;
        for (int s0 = 0; s0 < 136; s0 += 8) {
            float2 sv[8]; int jj[8];
#pragma unroll
            for (int i = 0; i < 8; ++i) { const int s = s0 + i; jj[i] = d == 0 ? s : (s < 8 ? 7 - s : 143 - s); sv[i] = *(const float2*)(S + (size_t)jj[i] * 256); }
#pragma unroll
            for (int i = 0; i < 8; ++i) {
                *(unsigned*)(H + (size_t)jj[i] * 768) = pk2bf(hr, hi);
                const float nr = ar * hr - ai * hi + sv[i].x, ni = ar * hi + ai * hr + sv[i].y; hr = nr; hi = ni;
            }
        }
    }
}
__device__ __forceinline__ void s5_gemm_y(const Ctx& c, int layer, int tile, unsigned char* lds) {
    const int nt = tile & 3, mt = (tile >> 2) % 5, g = tile / 20;
    const bf16* UH = c.w<bf16>(WS_UH) + (size_t)g * NCH5 * 768;
    f32x4 acc[4][4];
    const int bc = nt * 128 + (c.tid & 15) * 8;
    gemm_tile<false, false>(c.tid, lds, UH, [&](int r) __attribute__((always_inline)) { int row = mt * 128 + r; row = row < NCH5 ? row : NCH5 - 1; return (unsigned)(row * 768); },
                     c.w<bf16>(WS_WY) + (size_t)(layer * 16 + g) * 768 * 512, (unsigned)bc, 512, true, 768, acc);
    EPI_COORDS;
    bf16* G5 = c.w<bf16>(WS_G5);
#pragma unroll
    for (int m = 0; m < 4; ++m) {
        const int row = mt * 128 + wr * 64 + m * 16 + fr;
        if (row < NCH5) {
            const int b = row / 136, jj = row % 136;
#pragma unroll
            for (int n = 0; n < 4; ++n) {
                const int col = nt * 128 + wc * 64 + n * 16 + fq * 4, t = col >> 4, cc = col & 15;
                const size_t tok = (size_t)b * LT + jj * 32 + t;
                uint2 o; o.x = pk2bf(gelu_tanh(acc[m][n][0]), gelu_tanh(acc[m][n][1])); o.y = pk2bf(gelu_tanh(acc[m][n][2]), gelu_tanh(acc[m][n][3]));
                *(uint2*)(G5 + tok * 256 + g * 16 + cc) = o;
            }
        }
    }
}


__device__ __forceinline__ void ssd_vectors(const Ctx& c, int layer, int b, int j, int h, float* vec) {
    const int tid = c.tid, lane = tid & 63;
    __syncthreads();
    float dtf = 0.f, dtr = 0.f, af = 0.f, ar = 0.f;
    if (tid < 128) {
        const float* DTR = c.w<float>(WS_DTR) + ((size_t)b * LT + j * 128 + tid) * 8;
        dtf = softplus_f(DTR[h] + c.in(24)[(layer * 2 + 0) * 4 + h]);
        dtr = softplus_f(DTR[4 + h] + c.in(24)[(layer * 2 + 1) * 4 + h]);
        af = -dtf * expf(c.in(25)[(layer * 2 + 0) * 4 + h]); ar = -dtr * expf(c.in(25)[(layer * 2 + 1) * 4 + h]);
    }
    float sf = af, sr = ar;
#pragma unroll
    for (int o = 1; o < 64; o <<= 1) { const float tf = __shfl_up(sf, o), tr = __shfl_up(sr, o); if (lane >= o) { sf += tf; sr += tr; } }
    if (tid == 63) { vec[1026] = sf; vec[1027] = sr; }
    __syncthreads();
    if (tid >= 64 && tid < 128) { sf += vec[1026]; sr += vec[1027]; }
    if (tid == 127) { vec[1024] = sf; vec[1025] = sr; }
    __syncthreads();
    if (tid < 128) {
        const float totf = vec[1024], totr = vec[1025], cer = sr - ar;
        vec[tid] = dtf; vec[128 + tid] = dtr; vec[256 + tid] = sf; vec[384 + tid] = cer;
        vec[512 + tid] = dtf * __expf(totf - sf); vec[640 + tid] = dtr * __expf(cer);
        vec[768 + tid] = __expf(sf); vec[896 + tid] = __expf(totr - cer);
    }
    __syncthreads();
}
__device__ __forceinline__ void ssd_s1(const Ctx& c, int layer, int tile, unsigned char* lds) {
    const int h = tile & 3, j = (tile >> 2) % NCH, b = tile / (4 * NCH);
    float* vec = (float*)lds;
    ssd_vectors(c, layer, b, j, h, vec);
    const int tid = c.tid, lane = tid & 63, wid = tid >> 6, fr = lane & 15, fq = lane >> 4, grp = h >> 1;
    const bf16* XT = c.w<bf16>(WS_XT) + ((size_t)b * 256 + h * 64 + wid * 16 + fr) * LT + j * 128;
    const bf16* BT = c.w<bf16>(WS_BT) + ((size_t)b * 256 + grp * 128 + fr) * LT + j * 128;
    f32x4 acc[2][8];
#pragma unroll
    for (int d = 0; d < 2; ++d)
#pragma unroll
        for (int ns = 0; ns < 8; ++ns) acc[d][ns] = (f32x4){0.f, 0.f, 0.f, 0.f};
#pragma unroll
    for (int kk = 0; kk < 4; ++kk) {
        float xv[8], xa[8], xb[8];
        unpack8v(*(const u32x4*)(XT + 32 * kk + 8 * fq), xv);
        const f32x4 w0 = *(const f32x4*)(vec + 512 + 32 * kk + 8 * fq), w1 = *(const f32x4*)(vec + 512 + 32 * kk + 8 * fq + 4);
        const f32x4 r0 = *(const f32x4*)(vec + 640 + 32 * kk + 8 * fq), r1 = *(const f32x4*)(vec + 640 + 32 * kk + 8 * fq + 4);
#pragma unroll
        for (int i = 0; i < 4; ++i) { xa[i] = xv[i] * w0[i]; xa[4 + i] = xv[4 + i] * w1[i]; xb[i] = xv[i] * r0[i]; xb[4 + i] = xv[4 + i] * r1[i]; }
        const bf16x8 xf = pack8(xa), xr = pack8(xb);
#pragma unroll
        for (int ns = 0; ns < 8; ++ns) {
            const bf16x8 bfrag = *(const bf16x8*)(BT + (size_t)ns * 16 * LT + 32 * kk + 8 * fq);
            acc[0][ns] = __builtin_amdgcn_mfma_f32_16x16x32_bf16(bfrag, xf, acc[0][ns], 0, 0, 0);
            acc[1][ns] = __builtin_amdgcn_mfma_f32_16x16x32_bf16(bfrag, xr, acc[1][ns], 0, 0, 0);
        }
    }
    const size_t sidx = (size_t)((b * NCH + j) * 4 + h) * 2;
    float* ST = c.w<float>(WS_ST);
#pragma unroll
    for (int d = 0; d < 2; ++d)
#pragma unroll
        for (int ns = 0; ns < 8; ++ns) *(f32x4*)(ST + ((sidx + d) * 64 + wid * 16 + fr) * 128 + ns * 16 + 4 * fq) = acc[d][ns];
    if (tid == 0) { float* TOT = c.w<float>(WS_TOT); TOT[sidx] = __expf(vec[1024]); TOT[sidx + 1] = __expf(vec[1025]); }
}
__device__ __forceinline__ void ssd_recur(const Ctx& c, int gtid, int gthreads) {
    const float* ST = c.w<float>(WS_ST); bf16* HIN = c.w<bf16>(WS_HIN); const float* TOT = c.w<float>(WS_TOT);
    for (int it = gtid; it < 4 * 4 * 2 * 64 * 32; it += gthreads) {
        const int n4 = it & 31, p = (it >> 5) & 63, d = (it >> 11) & 1, h = (it >> 12) & 3, b = it >> 14;
        f32x4 H = (f32x4){0.f, 0.f, 0.f, 0.f};
#pragma unroll 1
        for (int s0 = 0; s0 < NCH; s0 += 17) {
            f32x4 sv[17]; float tv[17];
#pragma unroll
            for (int i = 0; i < 17; ++i) { const int s = s0 + i, jj = d == 0 ? s : (s < 2 ? 1 - s : 35 - s);
                const size_t idx = (size_t)((b * NCH + jj) * 4 + h) * 2 + d;
                sv[i] = *(const f32x4*)(ST + (idx * 64 + p) * 128 + n4 * 4); tv[i] = TOT[idx]; }
#pragma unroll
            for (int i = 0; i < 17; ++i) { const int s = s0 + i, jj = d == 0 ? s : (s < 2 ? 1 - s : 35 - s);
                const size_t idx = (size_t)((b * NCH + jj) * 4 + h) * 2 + d;
                uint2 o; o.x = pk2bf(H[0], H[1]); o.y = pk2bf(H[2], H[3]);
                *(uint2*)(HIN + (idx * 64 + p) * 128 + n4 * 4) = o;
                H = H * tv[i] + sv[i]; }
        }
    }
}
__device__ __forceinline__ void ssd_s3(const Ctx& c, int layer, int tile, unsigned char* lds) {
    const int half = tile & 1, h = (tile >> 1) & 3, j = (tile >> 3) % NCH, b = tile / (8 * NCH);
    float* vec = (float*)lds;
    ssd_vectors(c, layer, b, j, h, vec);
    const int tid = c.tid, lane = tid & 63, wid = tid >> 6, fr = lane & 15, fq = lane >> 4, grp = h >> 1;
    const size_t tok0 = (size_t)b * LT + j * 128;
    const bf16* XS = c.w<bf16>(WS_XBCS) + tok0 * 768;
    const int l = 64 * half + 16 * wid + fr;
    bf16x8 cf[4];
#pragma unroll
    for (int k = 0; k < 4; ++k) cf[k] = *(const bf16x8*)(XS + (size_t)l * 768 + 512 + grp * 128 + 32 * k + 8 * fq);
    f32x4 G[8];
#pragma unroll
    for (int st = 0; st < 8; ++st) {
        G[st] = (f32x4){0.f, 0.f, 0.f, 0.f};
#pragma unroll
        for (int k = 0; k < 4; ++k) {
            const bf16x8 bfrag = *(const bf16x8*)(XS + (size_t)(16 * st + fr) * 768 + 256 + grp * 128 + 32 * k + 8 * fq);
            G[st] = __builtin_amdgcn_mfma_f32_16x16x32_bf16(bfrag, cf[k], G[st], 0, 0, 0);
        }
    }
    {
        const float csf_l = vec[256 + l], cer_l = vec[384 + l];
#pragma unroll
        for (int st = 0; st < 8; ++st) {
            const int sb = 16 * st + 4 * fq;
            const f32x4 dtf_s = *(const f32x4*)(vec + sb), dtr_s = *(const f32x4*)(vec + 128 + sb), csf_s = *(const f32x4*)(vec + 256 + sb), cer_s = *(const f32x4*)(vec + 384 + sb);
#pragma unroll
            for (int jj = 0; jj < 4; ++jj) {
                const int s = sb + jj;
                float w = 0.f;
                if (s <= l) w += dtf_s[jj] * __expf(csf_l - csf_s[jj]);
                if (s >= l) w += dtr_s[jj] * __expf(cer_s[jj] - cer_l);
                G[st][jj] *= w;
            }
        }
    }
    f32x4 y[4];
#pragma unroll
    for (int pt = 0; pt < 4; ++pt) y[pt] = (f32x4){0.f, 0.f, 0.f, 0.f};
    const bf16* XT = c.w<bf16>(WS_XT) + ((size_t)b * 256 + h * 64 + fr) * LT + j * 128;
#pragma unroll
    for (int kk = 0; kk < 4; ++kk) {
        float t8[8];
#pragma unroll
        for (int i = 0; i < 4; ++i) { t8[i] = G[2 * kk][i]; t8[4 + i] = G[2 * kk + 1][i]; }
        const bf16x8 pf = pack8(t8);
#pragma unroll
        for (int pt = 0; pt < 4; ++pt) {
            const bf16* xp = XT + (size_t)pt * 16 * LT + 32 * kk + 4 * fq;
            const s16x4 lo = *(const s16x4*)xp, hv = *(const s16x4*)(xp + 16);
            const bf16x8 xf = (bf16x8){lo[0], lo[1], lo[2], lo[3], hv[0], hv[1], hv[2], hv[3]};
            y[pt] = __builtin_amdgcn_mfma_f32_16x16x32_bf16(xf, pf, y[pt], 0, 0, 0);
        }
    }
    const bf16* HIN = c.w<bf16>(WS_HIN) + (size_t)((b * NCH + j) * 4 + h) * 2 * 8192;
#pragma unroll
    for (int d = 0; d < 2; ++d) {
        const float e = vec[(d == 0 ? 768 : 896) + l];
#pragma unroll
        for (int k = 0; k < 4; ++k) {
            float t8[8]; unpack8v(__builtin_bit_cast(u32x4, cf[k]), t8);
#pragma unroll
            for (int i = 0; i < 8; ++i) t8[i] *= e;
            const bf16x8 cs = pack8(t8);
#pragma unroll
            for (int pt = 0; pt < 4; ++pt) {
                const bf16x8 hf = *(const bf16x8*)(HIN + ((size_t)d * 64 + 16 * pt + fr) * 128 + 32 * k + 8 * fq);
                y[pt] = __builtin_amdgcn_mfma_f32_16x16x32_bf16(hf, cs, y[pt], 0, 0, 0);
            }
        }
    }
    float* Y = c.w<float>(WS_YSSD) + tok0 * 256;
#pragma unroll
    for (int pt = 0; pt < 4; ++pt) *(f32x4*)(Y + (size_t)l * 256 + h * 64 + 16 * pt + 4 * fq) = y[pt];
}

__device__ __forceinline__ void ph_mix1(Ctx& c, int layer, int bid, int G, unsigned char* lds) {
    for (int i = 0; (i >> 1) * G + bid < 1792; ++i) {
        asm volatile("" : "+v"(c.tid)); asm volatile("" : "+s"(c.p));
        const int t = (i >> 1) * G + bid;
        if (i & 1) { if (t < CVT_MOE_TILES) cvt_moe(c, layer, t); }
        else if (t < 512) attn_tile(c, layer, t, lds); else if (t < 1056) ssd_s1(c, layer, t - 512, lds); else if (t < 1216) s5_gemm_s(c, layer, t - 1056, lds); else attn_tile(c, layer, t - 1216 + 512, lds);
    }
}

constexpr int PH_PER_LAYER = 12, N_PHASES = 2 + 2 * PH_PER_LAYER;

__global__ void __launch_bounds__(NTHR, 2) mk_fwd(Params prm) {
    __shared__ __attribute__((aligned(16))) unsigned char smem_raw[GEMM_LDS + 512 + 1536];
    float* smem = (float*)(smem_raw + GEMM_LDS);
    Ctx c; c.p = (const CAS Params*)__builtin_amdgcn_kernarg_segment_ptr(); c.smf = smem; c.tid = threadIdx.x;
    const int G = gridDim.x, bid = blockIdx.x;
    const int gtid = bid * NTHR + c.tid, gthreads = G * NTHR;
    const int gw = gtid >> 6, nwaves = gthreads >> 6;
    int* smi = (int*)(smem + 16);
#if MK_SINGLE
    volatile unsigned* bst = (volatile unsigned*)(smem + 120);
    if (c.tid == 0) { bst[0] = 0u; bst[1] = 0u; }
    __syncthreads();
    XcdBarrier bar = xcd_barrier_post(c.w<unsigned>(WS_CTL) + CW_BAR, bst);
#endif
    unsigned long long pr_t0 = 0ull; c.pracc = 0ull; c.prt = 0ull;
#define pr_acc c.pracc
#if MK_SINGLE
    if (PROBE_SP == 102) { pr_t0 = __builtin_amdgcn_s_memrealtime(); xcd_barrier(bar); pr_acc += __builtin_amdgcn_s_memrealtime() - pr_t0; }
#endif
    for (int ph = prm.ph_lo; ph < prm.ph_hi; ++ph) {
        if (PROBE_SP >= 0) pr_t0 = __builtin_amdgcn_s_memrealtime();
        asm volatile("" : "+s"(c.p));
        { int t_ = threadIdx.x; asm volatile("" : "+v"(t_)); c.tid = t_; }
        if (ph == 0) { ph_prep(c, gtid, gthreads, bid, G, (float*)smem_raw); cvt_small(c, gtid, gthreads); }
        else if (ph == 1) ph_norm1(c, 0, gw, nwaves, smem_raw);
        else {
            const int layer = (ph - 2) / PH_PER_LAYER, sp = (ph - 2) % PH_PER_LAYER;
            switch (sp) {
            case 0: for (int t = bid; t < 136 * 18 + (layer == 0 ? 5120 : 0); t += G) { asm volatile("" : "+v"(c.tid)); if (t < 136 * 18) ph_inproj_mfma(c, layer, t, smem_raw); else ph_prepB(c, t - 136 * 18); } break;
            case 1: for (int t = bid; t < 272 * 3; t += G) ph_minipost(c, layer, t); break;
            case 2: ph_mix1(c, layer, bid, G, smem_raw); break;
            case 3: s5_recur(c, layer, gtid, gthreads); ssd_recur(c, gtid, gthreads); break;
            case 4: for (int t = bid; t < 1088 + 320; t += G) { asm volatile("" : "+v"(c.tid)); asm volatile("" : "+s"(c.p)); if (t < 1088) ssd_s3(c, layer, t, smem_raw); else s5_gemm_y(c, layer, t - 1088, smem_raw); } break;
            case 5: for (int t = bid; t < 136 * 2 + NT / 4; t += G) { asm volatile("" : "+v"(c.tid)); if (t < 136 * 2) ph_glu_mfma(c, layer, t, smem_raw); else ph_gates(c, layer, t - 136 * 2); } break;
            case 6: for (int t = bid; t < 136 * 8; t += G) ph_outproj_mfma(c, layer, t, smem_raw); break;
            case 7: ph_norm2(c, layer, bid, G, smem_raw, (int*)(smem_raw + GEMM_LDS + 512)); break;
            case 8: ph_assign(c, layer, bid, G, (int*)smem_raw, (const int*)(smem_raw + GEMM_LDS + 512)); break;
            case 9: moe_offsets(c, layer, smi); for (int t = bid; t < (NSLOT / 128) * 8; t += G) ph_moe1_mfma(c, layer, t, smi, smem_raw); break;
            case 10: moe_offsets(c, layer, smi); for (int t = bid; t < (NSLOT / 128) * 8; t += G) ph_moe2_mfma(c, layer, t, smi, smem_raw); break;
            case 11: moe_offsets(c, layer, smi); ph_combine(c, layer, gw, nwaves, smi, smem_raw); break;
            }
        }
#if MK_SINGLE
        if (ph + 1 < prm.ph_hi) xcd_barrier(bar);
#endif
        if (PROBE_SP >= 0 && ((PROBE_SP < 100 && ph >= 2 && (ph - 2) % PH_PER_LAYER == PROBE_SP) || (PROBE_SP == 100 && ph == 0) || (PROBE_SP == 101 && ph == 1))) pr_acc += __builtin_amdgcn_s_memrealtime() - pr_t0;
    }
#if MK_SINGLE
    if (PROBE_SP == 200) { for (int i = 0; i < 16; ++i) xcd_barrier(bar); }
#endif
    if (PROBE_SP >= 0 && PROBE_SP < 200 && bid == 0 && c.tid == 0) { const unsigned long long t1 = __builtin_amdgcn_s_memrealtime(); while (__builtin_amdgcn_s_memrealtime() - t1 < 8ull * pr_acc) __builtin_amdgcn_s_sleep(8); }
}
}

extern "C" void kernel_launch(void* const* d_in, const int* in_sizes, int n_in, void* d_out, int out_size, void* d_ws, size_t ws_size, hipStream_t stream) {
    static int grid = 0;
    if (grid == 0) {
        if (n_in != 37 || ws_size < WS_END) { fprintf(stderr, "kernel_launch: need 37 inputs and %zu bytes of workspace; got %d, %zu\n", (size_t)WS_END, n_in, ws_size); grid = -1; return; }
        int dev = 0, cus = 0, per_cu = 0;
        hipGetDevice(&dev); hipDeviceGetAttribute(&cus, hipDeviceAttributeMultiprocessorCount, dev);
        if (hipOccupancyMaxActiveBlocksPerMultiprocessor(&per_cu, (const void*)mk_fwd, NTHR, 0) != hipSuccess || per_cu < 1) per_cu = 1;
        if (per_cu > 4) per_cu = 4;
        grid = cus * per_cu;
    }
    if (grid < 0) return;
    hipMemsetAsync((char*)d_ws + WS_CTL, 0, CTL_BYTES, stream);
    Params p{};
    for (int i = 0; i < 37; ++i) p.in[i] = (const float*)d_in[i];
    p.out = (float*)d_out; p.ws = (unsigned char*)d_ws;
#if MK_SINGLE
    p.ph_lo = 0; p.ph_hi = N_PHASES;
    void* args[] = {&p};
    hipError_t e = hipLaunchCooperativeKernel((const void*)mk_fwd, dim3(grid), dim3(NTHR), args, 0, stream);
    if (e != hipSuccess) fprintf(stderr, "cooperative launch failed: %s (grid %d)\n", hipGetErrorString(e), grid);
#else
    for (int ph = 0; ph < N_PHASES; ++ph) {
        p.ph_lo = ph; p.ph_hi = ph + 1;
        hipLaunchKernelGGL(mk_fwd, dim3(grid), dim3(NTHR), 0, stream, p);
    }
#endif
}
```

```cpp
#include <hip/hip_runtime.h>
#include <cstdio>
#include <cstdint>

#ifndef PROBE_SP
#define PROBE_SP -1
#endif
#ifndef MK_SINGLE
#define MK_SINGLE 1
#endif

namespace {
typedef unsigned short bf16;
#define LAS __attribute__((address_space(3)))

constexpr int D = 1024, NB = 4, SEQ = 4096, CTX = 256, LT = SEQ + CTX, NT = NB * LT;
constexpr int DIN = 2312;
constexpr int C_U = 0, C_GQ = 256, C_GK = 512, C_GV = 640, C_Z = 768, C_XBC = 1024, C_DT = 1792, C_WQ = 1800, C_WK = 2056, C_WV = 2184;
constexpr int NEXP = 32, DE = 512;
constexpr int NSLOT = 2 * NT + NEXP * 128;
constexpr float EPS = 1e-6f;
constexpr int NTHR = 256;

constexpr size_t al(size_t x) { return (x + 255) & ~(size_t)255; }
constexpr size_t WS_CTL = 0, CTL_BYTES = 1u << 20;
constexpr size_t WS_MOD = WS_CTL + CTL_BYTES;
constexpr size_t WS_S5A = al(WS_MOD + 2 * 5 * 6144 * 4);
constexpr size_t WS_S5BB = al(WS_S5A + 2 * 2 * 16 * 64 * 2 * 4);
constexpr size_t WS_ROPE = al(WS_S5BB + 2 * 2 * 16 * 64 * 16 * 2 * 4);
constexpr size_t WS_X = al(WS_ROPE + 64 * 16 * 2 * 4);
constexpr size_t WS_HA = al(WS_X + (size_t)NT * D * 4);
constexpr size_t WS_Z = al(WS_HA + (size_t)NT * D * 2);
constexpr size_t WS_XBR = al(WS_Z + (size_t)NT * 256 * 2);
constexpr size_t WS_GQ = al(WS_XBR + (size_t)NT * 768 * 2);
constexpr size_t WS_GK = al(WS_GQ + (size_t)NT * 256 * 2);
constexpr size_t WS_GV = al(WS_GK + (size_t)NT * 128 * 2);
constexpr size_t WS_WQ = al(WS_GV + (size_t)NT * 128 * 2);
constexpr size_t WS_WK = al(WS_WQ + (size_t)NT * 256 * 2);
constexpr size_t WS_WV = al(WS_WK + (size_t)NT * 128 * 2);
constexpr size_t WS_XBCS = al(WS_WV + (size_t)NT * 128 * 2);
constexpr size_t WS_YSSD = al(WS_XBCS + (size_t)NT * 768 * 2);
constexpr size_t WS_G5 = al(WS_YSSD + (size_t)NT * 256 * 4);
constexpr size_t WS_MIX = al(WS_G5 + (size_t)NT * 256 * 2);
constexpr size_t WS_OUT = WS_Z;
constexpr size_t WS_ACT = al(WS_OUT + (size_t)NSLOT * D * 2);
static_assert(WS_ACT + (size_t)NSLOT * DE * 2 <= WS_MIX, "MoE-stage alias must end before MIX");
constexpr size_t WS_TOKE = al(WS_MIX + (size_t)NT * D * 2);
constexpr size_t WS_TOKP = al(WS_TOKE + (size_t)NT * 2 * 4);
constexpr size_t WS_TOKW = al(WS_TOKP + (size_t)NT * 2 * 4);
constexpr size_t WS_LIST = al(WS_TOKW + (size_t)NT * 2 * 4);
constexpr size_t WS_DTR = al(WS_LIST + (size_t)NEXP * NT * 4);
constexpr int NCH5 = NT / 32;
constexpr size_t WS_S5P = al(WS_DTR + (size_t)NT * 8 * 4);
constexpr size_t WS_KLAG = al(WS_S5P + (size_t)2 * 2 * 16 * 64 * 33 * 2 * 4);
constexpr size_t WS_WY = al(WS_KLAG + (size_t)2 * 16 * 2 * 32 * 256 * 4);
constexpr size_t WS_WS = al(WS_WY + (size_t)2 * 16 * 768 * 512 * 2);
constexpr size_t WS_UH = al(WS_WS + (size_t)2 * 16 * 512 * 256 * 2);
constexpr size_t WS_SALL = al(WS_UH + (size_t)16 * NCH5 * 768 * 2);
constexpr int NCH = LT / 128;
constexpr size_t WS_XT = al(WS_SALL + (size_t)16 * NCH5 * 256 * 4);
constexpr size_t WS_BT = al(WS_XT + (size_t)NB * 256 * LT * 2);
constexpr size_t WS_ST = al(WS_BT + (size_t)NB * 256 * LT * 2);
constexpr size_t WS_HIN = al(WS_ST + (size_t)NB * NCH * 8 * 8192 * 4);
constexpr size_t WS_TOT = al(WS_HIN + (size_t)NB * NCH * 8 * 8192 * 2);
constexpr size_t WS_BCNT = al(WS_TOT + (size_t)NB * NCH * 8 * 4);
constexpr size_t WS_WDT = al(WS_BCNT + 1024 * 32 * 4);
constexpr size_t WS_RWT = al(WS_WDT + 2 * 8 * 1024 * 4);
constexpr int DINV = 2304;
constexpr size_t WS_BIN = al(WS_RWT + 2 * 36 * 1024 * 4);
constexpr size_t WS_BOUT = al(WS_BIN + (size_t)2 * D * DINV * 2);
constexpr size_t WS_BGLU = al(WS_BOUT + (size_t)2 * D * D * 2);
constexpr size_t WS_BGU = al(WS_BGLU + (size_t)2 * 256 * 256 * 2);
constexpr size_t WS_BDN = al(WS_BGU + (size_t)NEXP * D * 1024 * 2);
constexpr size_t WS_END = al(WS_BDN + (size_t)NEXP * DE * D * 2);
constexpr int CW_CNT = 8192;
constexpr int CW_BAR = 4096;

struct Params {
    const float* in[37];
    float* out;
    unsigned char* ws;
    int ph_lo, ph_hi;
};

typedef short bf16x8 __attribute__((ext_vector_type(8)));
typedef short s16x4 __attribute__((ext_vector_type(4)));
typedef float f32x4 __attribute__((ext_vector_type(4)));
typedef unsigned u32x4 __attribute__((ext_vector_type(4)));
__device__ __forceinline__ float bf2f(bf16 v) { return __uint_as_float(((unsigned)v) << 16); }
typedef float f32x2 __attribute__((ext_vector_type(2)));
typedef __bf16 bf16x2_t __attribute__((ext_vector_type(2)));
__device__ __forceinline__ bf16 f2bf(float f) { return __builtin_bit_cast(bf16, (__bf16)f); }
__device__ __forceinline__ float silu_f(float x) { return x / (1.f + __expf(-x)); }
__device__ __forceinline__ float sigmoid_f(float x) { return 1.f / (1.f + __expf(-x)); }
__device__ __forceinline__ float gelu_tanh(float x) { const float u = 0.7978845608028654f * (x + 0.044715f * x * x * x); return 0.5f * x * (1.f + tanhf(u)); }
__device__ __forceinline__ float softplus_f(float x) { return fmaxf(x, 0.f) + log1pf(__expf(-fabsf(x))); }
__device__ __forceinline__ float wave_sum(float v) {
#pragma unroll
    for (int o = 1; o < 64; o <<= 1) v += __shfl_xor(v, o);
    return v;
}
__device__ __forceinline__ float block_sum(float v, float* red) {
    v = wave_sum(v);
    __syncthreads();
    if ((threadIdx.x & 63) == 0) red[threadIdx.x >> 6] = v;
    __syncthreads();
    return red[0] + red[1] + red[2] + red[3];
}
__device__ __forceinline__ unsigned pk2bf(float lo, float hi) { const f32x2 v = {lo, hi}; return __builtin_bit_cast(unsigned, __builtin_convertvector(v, bf16x2_t)); }
__device__ __forceinline__ void unpack8v(const u32x4 v, float (&f)[8]) {
    f[0] = __uint_as_float(v[0] << 16); f[1] = __uint_as_float(v[0] & 0xffff0000u);
    f[2] = __uint_as_float(v[1] << 16); f[3] = __uint_as_float(v[1] & 0xffff0000u);
    f[4] = __uint_as_float(v[2] << 16); f[5] = __uint_as_float(v[2] & 0xffff0000u);
    f[6] = __uint_as_float(v[3] << 16); f[7] = __uint_as_float(v[3] & 0xffff0000u);
}
__device__ __forceinline__ bf16x8 pack8(const float (&f)[8]) {
    u32x4 v; v[0] = pk2bf(f[0], f[1]); v[1] = pk2bf(f[2], f[3]); v[2] = pk2bf(f[4], f[5]); v[3] = pk2bf(f[6], f[7]);
    return __builtin_bit_cast(bf16x8, v);
}
__device__ __forceinline__ uint2 pack4(const f32x4 v) { uint2 o; o.x = pk2bf(v[0], v[1]); o.y = pk2bf(v[2], v[3]); return o; }
__device__ __forceinline__ void unpack8(const uint4 v, float (&f)[8]) {
    f[0] = __uint_as_float(v.x << 16); f[1] = __uint_as_float(v.x & 0xffff0000u);
    f[2] = __uint_as_float(v.y << 16); f[3] = __uint_as_float(v.y & 0xffff0000u);
    f[4] = __uint_as_float(v.z << 16); f[5] = __uint_as_float(v.z & 0xffff0000u);
    f[6] = __uint_as_float(v.w << 16); f[7] = __uint_as_float(v.w & 0xffff0000u);
}

#define XB_TMO      128
#define XB_XCNT(j)  (256  + 64 * (j))
#define XB_XSUB(j)  (1280 + 64 * (j))
#define XB_XGEN(j)  (2304 + 64 * (j))
#define XB_TOP      3328
#define XB_TOPGEN   3392
#define XCD_BAR_WORDS 3456
#define XB_SPIN_CAP (1u << 22)
__device__ __forceinline__ unsigned xb_ld(unsigned* p)              { return __hip_atomic_load(p, __ATOMIC_RELAXED, __HIP_MEMORY_SCOPE_AGENT); }
__device__ __forceinline__ unsigned xb_add(unsigned* p, unsigned v) { return __hip_atomic_fetch_add(p, v, __ATOMIC_RELAXED, __HIP_MEMORY_SCOPE_AGENT); }
__device__ __forceinline__ unsigned xb_xcc_id() { return (unsigned)__builtin_amdgcn_s_getreg((3 << 11) | 20) & 0xFu; }
#define XB_SPIN(cond, bar) do { unsigned _sp = 0; while (cond) { __builtin_amdgcn_s_sleep(1); \
    if ((++_sp & 255u) == 0u) { if (xb_ld(&(bar)[XB_TMO])) break; if (_sp > XB_SPIN_CAP) { atomicAdd(&(bar)[XB_TMO], 1u); break; } } } } while (0)
struct XcdBarrier { unsigned* bar; unsigned x; volatile unsigned* st; };
__device__ __forceinline__ XcdBarrier xcd_barrier_post(unsigned* bar, volatile unsigned* st) {
    XcdBarrier b; b.bar = bar; b.x = xb_xcc_id(); b.st = st;
    if (threadIdx.x == 0) (void)xb_add(&bar[XB_XCNT(b.x)], 1u);
    return b;
}
__device__ __forceinline__ void xcd_barrier_complete(unsigned* bar, unsigned x, unsigned& nloc, unsigned& nx) {
    const unsigned G = gridDim.x * gridDim.y * gridDim.z;
    unsigned sum, cnt, mine, sp = 0u;
    for (;;) {
        sum = 0u; cnt = 0u; mine = 0u;
#pragma unroll
        for (unsigned j = 0; j < 16; ++j) { const unsigned c = xb_ld(&bar[XB_XCNT(j)]); sum += c; cnt += (c > 0u) ? 1u : 0u; mine = (j == x) ? c : mine; }
        if (sum == G) break;
        __builtin_amdgcn_s_sleep(1);
        if ((++sp & 255u) == 0u) { if (xb_ld(&bar[XB_TMO])) break; if (sp > XB_SPIN_CAP) { atomicAdd(&bar[XB_TMO], 1u); break; } }
    }
    nloc = mine > 0u ? mine : 1u; nx = cnt > 0u ? cnt : 1u;
}
__device__ __forceinline__ void xcd_barrier(const XcdBarrier& b) {
    asm volatile("s_waitcnt vmcnt(0)" ::: "memory");
    __syncthreads();
    if (threadIdx.x == 0) {
        unsigned* bar = b.bar;
        __builtin_amdgcn_s_waitcnt(0);
        unsigned nloc = b.st[0], nx = b.st[1];
        if (nloc == 0u) { xcd_barrier_complete(bar, b.x, nloc, nx); b.st[0] = nloc; b.st[1] = nx; }
        const unsigned old = xb_add(&bar[XB_XSUB(b.x)], 1u);
        const unsigned gen = old / nloc;
        if (old + 1u == (gen + 1u) * nloc) {
            __builtin_amdgcn_fence(__ATOMIC_RELEASE, "agent");
            asm volatile("s_waitcnt vmcnt(0)" ::: "memory");
            const unsigned og = xb_add(&bar[XB_TOP], 1u);
            const unsigned tg = og / nx;
            if (og + 1u == (tg + 1u) * nx) xb_add(&bar[XB_TOPGEN], 1u);
            else XB_SPIN(xb_ld(&bar[XB_TOPGEN]) == tg, bar);
            __builtin_amdgcn_fence(__ATOMIC_ACQUIRE, "agent");
            xb_add(&bar[XB_XGEN(b.x)], 1u);
            asm volatile("s_waitcnt vmcnt(0)" ::: "memory");
        } else {
            XB_SPIN(xb_ld(&bar[XB_XGEN(b.x)]) == gen, bar);
            __builtin_amdgcn_fence(__ATOMIC_ACQUIRE, "agent");
            asm volatile("s_waitcnt vmcnt(0)" ::: "memory");
        }
    }
    __syncthreads();
}

#define CAS __attribute__((address_space(4)))
#define PR_BEGIN(id) do { if (PROBE_SP == (id)) c.prt = __builtin_amdgcn_s_memrealtime(); } while (0)
#define PR_END(id) do { if (PROBE_SP == (id)) c.pracc += __builtin_amdgcn_s_memrealtime() - c.prt; } while (0)
struct Ctx {
    const CAS Params* p;
    float* smf;
    int tid;
    mutable unsigned long long pracc, prt;
    __device__ __forceinline__ const float* in(int i) const { return p->in[i]; }
    __device__ __forceinline__ float* out() const { return p->out; }
    template <class T> __device__ __forceinline__ T* w(size_t off) const { return (T*)(p->ws + off); }
};

__device__ __forceinline__ const float* xsrc(const Ctx& c, int layer, int n) {
    if (layer == 0) { const int b = n / LT, pos = n % LT; return pos < CTX ? c.in(2) + ((size_t)b * CTX + pos) * D : c.in(0) + ((size_t)b * SEQ + (pos - CTX)) * D; }
    return c.w<float>(WS_X) + (size_t)n * D;
}
__device__ __forceinline__ void ngemm8(const bf16* const (&ar)[8], const float* bcol, int ldb, int K, float (&acc)[8]) {
    for (int k0 = 0; k0 < K; k0 += 8) {
        float w[8];
#pragma unroll
        for (int kk = 0; kk < 8; ++kk) w[kk] = bcol[(size_t)(k0 + kk) * ldb];
#pragma unroll
        for (int r = 0; r < 8; ++r) {
            float a[8]; unpack8(*(const uint4*)(ar[r] + k0), a);
#pragma unroll
            for (int kk = 0; kk < 8; ++kk) acc[r] = fmaf(a[kk], w[kk], acc[r]);
        }
    }
}

__device__ __forceinline__ void ph_prep(Ctx& c, int gtid, int gthreads, int bid, int G, float* lds) {
    float* MOD = c.w<float>(WS_MOD);
    const int tid = c.tid;
    PR_BEGIN(120);
    for (int tile = bid; tile < 192; tile += G) {
        const int l = tile / 96, j0 = (tile % 96) * 64;
        __syncthreads();
        for (int idx = tid; idx < 5 * D; idx += NTHR) { const int r = idx >> 10, k = idx & 1023; lds[idx] = silu_f(r < 4 ? c.in(1)[r * D + k] : c.in(3)[k]); }
        __syncthreads();
        const int jj = tid & 63, kq = tid >> 6;
        const float* aw = c.in(4) + (size_t)l * D * 6144 + j0 + jj;
        float acc[5] = {0.f, 0.f, 0.f, 0.f, 0.f};
        for (int k0 = kq * 256; k0 < kq * 256 + 256; k0 += 32) {
            float w[32];
#pragma unroll
            for (int i = 0; i < 32; ++i) w[i] = aw[(size_t)(k0 + i) * 6144];
#pragma unroll
            for (int i = 0; i < 32; ++i)
#pragma unroll
                for (int r = 0; r < 5; ++r) acc[r] = fmaf(lds[r * D + k0 + i], w[i], acc[r]);
        }
#pragma unroll
        for (int r = 0; r < 5; ++r) lds[5 * D + (kq * 64 + jj) * 5 + r] = acc[r];
        __syncthreads();
        for (int idx = tid; idx < 320; idx += NTHR) { const int j2 = idx / 5, r = idx % 5;
            const float s = lds[5 * D + j2 * 5 + r] + lds[5 * D + (64 + j2) * 5 + r] + lds[5 * D + (128 + j2) * 5 + r] + lds[5 * D + (192 + j2) * 5 + r];
            MOD[(l * 5 + r) * 6144 + j0 + j2] = s + c.in(5)[l * 6144 + j0 + j2]; }
    }
    PR_END(120); PR_BEGIN(121);
    asm volatile("" : "+s"(c.p));
    float* S5A = c.w<float>(WS_S5A); float* S5BB = c.w<float>(WS_S5BB);
    for (int it = gtid; it < 2 * 2 * 16 * 64; it += gthreads) {
        const int ldg = it / 64;
        const float lr = c.in(10)[it], li = c.in(11)[it], dt = expf(c.in(12)[ldg]);
        const float mag = expf(lr * dt), are = mag * cosf(li * dt), aim = mag * sinf(li * dt);
        const float den = lr * lr + li * li;
        const float fre = ((are - 1.f) * lr + aim * li) / den, fim = (aim * lr - (are - 1.f) * li) / den;
        S5A[it * 2] = are; S5A[it * 2 + 1] = aim;
        for (int ch = 0; ch < 16; ++ch) {
            const float br = c.in(13)[(size_t)it * 16 + ch], bi = c.in(14)[(size_t)it * 16 + ch];
            S5BB[((size_t)it * 16 + ch) * 2] = fre * br - fim * bi;
            S5BB[((size_t)it * 16 + ch) * 2 + 1] = fre * bi + fim * br;
        }
    }
    asm volatile("" : "+s"(c.p));
    float* S5P = c.w<float>(WS_S5P);
    for (int it = gtid; it < 2 * 2 * 16 * 64 * 33; it += gthreads) {
        const int ldgp = it / 33, k = it % 33;
        const float lr = c.in(10)[ldgp], li = c.in(11)[ldgp], dt = expf(c.in(12)[ldgp / 64]);
        const float e = expf((float)k * lr * dt), ang = (float)k * li * dt;
        S5P[it * 2] = e * cosf(ang); S5P[it * 2 + 1] = e * sinf(ang);
    }
    PR_END(121); PR_BEGIN(122);
    asm volatile("" : "+s"(c.p));
    float* KLAG = c.w<float>(WS_KLAG);
    for (int tile = bid; tile < 64; tile += G) {
        const int d = tile & 1, g = (tile >> 1) & 15, l = tile >> 5, ldg = (l * 2 + d) * 16 + g;
        float* LA = lds;
        float* LB = lds + 256;
        float* LC = lds + 2304;
        __syncthreads();
        if (tid < 64) {
            const int ldgp = ldg * 64 + tid;
            const float lr = c.in(10)[ldgp], li = c.in(11)[ldgp], dt = expf(c.in(12)[ldg]);
            const float mag = expf(lr * dt), are = mag * cosf(li * dt), aim = mag * sinf(li * dt), den = lr * lr + li * li;
            LA[tid * 4] = are; LA[tid * 4 + 1] = aim; LA[tid * 4 + 2] = ((are - 1.f) * lr + aim * li) / den; LA[tid * 4 + 3] = (aim * lr - (are - 1.f) * li) / den;
        }
        __syncthreads();
        for (int idx = tid; idx < 1024; idx += NTHR) {
            const int p = idx >> 4, cp = idx & 15;
            const float fre = LA[p * 4 + 2], fim = LA[p * 4 + 3];
            const float br = c.in(13)[((size_t)ldg * 64 + p) * 16 + cp], bi = c.in(14)[((size_t)ldg * 64 + p) * 16 + cp];
            LB[idx * 2] = fre * br - fim * bi; LB[idx * 2 + 1] = fre * bi + fim * br;
            const int cc = idx >> 6, p2 = idx & 63;
            LC[idx * 2] = c.in(15)[(size_t)ldg * 1024 + cc * 64 + p2]; LC[idx * 2 + 1] = c.in(16)[(size_t)ldg * 1024 + cc * 64 + p2];
        }
        __syncthreads();
        const int cp = tid >> 4, cc = tid & 15;
        float acc[32];
#pragma unroll
        for (int k = 0; k < 32; ++k) acc[k] = 0.f;
        for (int p = 0; p < 64; ++p) {
            const float are = LA[p * 4], aim = LA[p * 4 + 1];
            const float bbr = LB[(p * 16 + cp) * 2], bbi = LB[(p * 16 + cp) * 2 + 1], cr = LC[(cc * 64 + p) * 2], ci = LC[(cc * 64 + p) * 2 + 1];
            float zr = cr * bbr - ci * bbi, zi = cr * bbi + ci * bbr;
#pragma unroll
            for (int k = 0; k < 32; ++k) { acc[k] += zr; const float tr = zr * are - zi * aim, ti = zr * aim + zi * are; zr = tr; zi = ti; }
        }
#pragma unroll
        for (int k = 0; k < 32; ++k) KLAG[((size_t)((l * 16 + g) * 2 + d) * 32 + k) * 256 + cp * 16 + cc] = acc[k];
    }
    PR_END(122); PR_BEGIN(123);
    asm volatile("" : "+s"(c.p));
    float* RWT = c.w<float>(WS_RWT);
    for (int it = gtid; it < 2 * 36 * 1024; it += gthreads) { const int k = it & 1023, o = (it >> 10) % 36, l = it / (36 * 1024);
        RWT[it] = o < 4 ? c.in(29)[((size_t)l * D + k) * 4 + o] : c.in(31)[((size_t)l * D + k) * 32 + (o - 4)]; }
    asm volatile("" : "+s"(c.p));
    float* WDT = c.w<float>(WS_WDT);
    for (int it = gtid; it < 2 * 8 * 1024; it += gthreads) { const int k = it & 1023, j = (it >> 10) & 7, l = it >> 13; WDT[it] = c.in(8)[((size_t)l * D + k) * DIN + C_DT + j]; }
    asm volatile("" : "+s"(c.p));
    float* ROPE = c.w<float>(WS_ROPE);
    for (int it = gtid; it < 64 * 16; it += gthreads) {
        const int pos = it / 16, f = it % 16;
        const float inv = powf(10000.0f, -(float)f / 16.0f);
        const float ang = (float)pos * inv;
        ROPE[it * 2] = cosf(ang); ROPE[it * 2 + 1] = sinf(ang);
    }
    PR_END(123);
}

__device__ __forceinline__ void dt_project(const LAS float* wdt, const f32x4 (&h)[4], int lane, float* dst) {
    float mine = 0.f;
#pragma unroll 2
    for (int q = 0; q < 8; ++q) {
        float s = 0.f;
#pragma unroll
        for (int i = 0; i < 4; ++i) { const f32x4 w = *(const LAS f32x4*)(wdt + q * 1024 + (lane + 64 * i) * 4); s += h[i][0] * w[0] + h[i][1] * w[1] + h[i][2] * w[2] + h[i][3] * w[3]; }
        s = wave_sum(s);
        if (lane == q) mine = s;
    }
    if (lane < 8) dst[lane] = mine;
}
__device__ __forceinline__ void ph_norm1(const Ctx& c, int layer, int gw, int nwaves, unsigned char* lds) {
    const int lane = c.tid & 63;
    bf16* HA = c.w<bf16>(WS_HA); float* DTR = c.w<float>(WS_DTR);
    const float* MOD = c.w<float>(WS_MOD) + (size_t)layer * 5 * 6144;
    const float* g = c.in(6) + layer * D;
    __syncthreads();
    for (int i = c.tid; i < 2048; i += NTHR) ((f32x4*)lds)[i] = ((const f32x4*)(c.w<float>(WS_WDT) + (size_t)layer * 8 * 1024))[i];
    __syncthreads();
    const LAS float* wdt = (const LAS float*)lds;
    for (int n = gw; n < NT; n += nwaves) {
        const int b = n / LT, pos = n % LT, mr = pos < CTX ? 4 : b;
        const float* x = xsrc(c, layer, n);
        f32x4 v[4]; float ss = 0.f;
#pragma unroll
        for (int i = 0; i < 4; ++i) { v[i] = *(const f32x4*)(x + (lane + 64 * i) * 4); ss += v[i][0] * v[i][0] + v[i][1] * v[i][1] + v[i][2] * v[i][2] + v[i][3] * v[i][3]; }
        const float rstd = rsqrtf(wave_sum(ss) * (1.f / D) + EPS);
#pragma unroll
        for (int i = 0; i < 4; ++i) {
            const int k = (lane + 64 * i) * 4;
            const f32x4 gv = *(const f32x4*)(g + k), sc = *(const f32x4*)(MOD + mr * 6144 + 1024 + k), sh = *(const f32x4*)(MOD + mr * 6144 + k);
            v[i] = v[i] * rstd * gv * (sc + 1.f) + sh;
            *(uint2*)(HA + (size_t)n * D + k) = pack4(v[i]);
        }
        dt_project(wdt, v, lane, DTR + (size_t)n * 8);
    }
}

template <bool TRANS>
__device__ __forceinline__ void minipost_body(const Ctx& c, int layer, int r, int tb) {
    const int tid = c.tid, t = tid & 63, cqb = tid >> 6;
    const int n = tb * 64 + t, b = n / LT, pos = n % LT;
    const bool hasL = (pos != 0) && (pos != CTX), hasR = (pos != CTX - 1) && (pos != LT - 1);
    const float mL = hasL ? 1.f : 0.f, mR = hasR ? 1.f : 0.f;
    const bf16* XB = c.w<bf16>(WS_XBR) + (size_t)n * 768 + r * 256;
    const bf16* XL = hasL ? XB - 768 : XB; const bf16* XR = hasR ? XB + 768 : XB;
    bf16* XS = c.w<bf16>(WS_XBCS) + (size_t)n * 768 + r * 256;
    const float* cw = c.in(22) + (size_t)layer * 3 * 768 + r * 256; const float* cb = c.in(23) + layer * 768 + r * 256;
    bf16* TR = (r == 0 ? c.w<bf16>(WS_XT) : c.w<bf16>(WS_BT)) + (size_t)b * 256 * LT + pos;
#pragma unroll 1
    for (int ib = 0; ib < 8; ib += 4) {
    u32x4 lc[4], ll[4], lr[4];
#pragma unroll
    for (int i = 0; i < 4; ++i) { const int ch0 = (cqb * 8 + ib + i) * 8; lc[i] = *(const u32x4*)(XB + ch0); ll[i] = *(const u32x4*)(XL + ch0); lr[i] = *(const u32x4*)(XR + ch0); }
#pragma unroll
    for (int i = 0; i < 4; ++i) {
        const int ch0 = (cqb * 8 + ib + i) * 8;
        float xc[8], xl[8], xr[8];
        unpack8v(lc[i], xc); unpack8v(ll[i], xl); unpack8v(lr[i], xr);
        float y[8];
#pragma unroll
        for (int q = 0; q < 2; ++q) {
            const f32x4 w0 = *(const f32x4*)(cw + ch0 + 4 * q), w1 = *(const f32x4*)(cw + 768 + ch0 + 4 * q), w2 = *(const f32x4*)(cw + 1536 + ch0 + 4 * q), bb = *(const f32x4*)(cb + ch0 + 4 * q);
#pragma unroll
            for (int j = 0; j < 4; ++j) y[4 * q + j] = silu_f(w1[j] * xc[4 * q + j] + w0[j] * mL * xl[4 * q + j] + w2[j] * mR * xr[4 * q + j] + bb[j]);
        }
        const bf16x8 yb = pack8(y);
        *(bf16x8*)(XS + ch0) = yb;
        if (TRANS) {
#pragma unroll
            for (int j = 0; j < 8; ++j) TR[(size_t)(ch0 + j) * LT] = (bf16)yb[j];
        }
    }
    }
}
__device__ __forceinline__ void ph_minipost(const Ctx& c, int layer, int tile) {
    const int r = tile % 3, tb = tile / 3;
    if (r < 2) minipost_body<true>(c, layer, r, tb); else minipost_body<false>(c, layer, r, tb);
}

__device__ __forceinline__ void ph_gates(const Ctx& c, int layer, int tile) {
    const int lane = c.tid & 63, n = tile * 4 + (c.tid >> 6), t4 = lane * 4;
    const f32x4 ys = *(const f32x4*)(c.w<float>(WS_YSSD) + (size_t)n * 256 + t4);
    const uint2 xr = *(const uint2*)(c.w<bf16>(WS_XBCS) + (size_t)n * 768 + t4), zr = *(const uint2*)(c.w<bf16>(WS_Z) + (size_t)n * 256 + t4);
    const float dsk = c.in(26)[layer * 4 + (lane >> 4)];
    float y[4];
    y[0] = (ys[0] + __uint_as_float(xr.x << 16) * dsk) * silu_f(__uint_as_float(zr.x << 16));
    y[1] = (ys[1] + __uint_as_float(xr.x & 0xffff0000u) * dsk) * silu_f(__uint_as_float(zr.x & 0xffff0000u));
    y[2] = (ys[2] + __uint_as_float(xr.y << 16) * dsk) * silu_f(__uint_as_float(zr.y << 16));
    y[3] = (ys[3] + __uint_as_float(xr.y & 0xffff0000u) * dsk) * silu_f(__uint_as_float(zr.y & 0xffff0000u));
    const float ss = wave_sum(y[0] * y[0] + y[1] * y[1] + y[2] * y[2] + y[3] * y[3]);
    const float rstd = rsqrtf(ss * (1.f / 256.f) + EPS);
    const f32x4 gn = *(const f32x4*)(c.in(27) + layer * 256 + t4);
    uint2 o; o.x = pk2bf(y[0] * rstd * gn[0], y[1] * rstd * gn[1]); o.y = pk2bf(y[2] * rstd * gn[2], y[3] * rstd * gn[3]);
    *(uint2*)(c.w<bf16>(WS_MIX) + (size_t)n * D + 512 + t4) = o;
}

__device__ __forceinline__ float half_sum(float v) {
#pragma unroll
    for (int o = 1; o < 32; o <<= 1) v += __shfl_xor(v, o);
    return v;
}
__device__ __forceinline__ void ph_norm2(const Ctx& c, int layer, int bid, int G, unsigned char* hbuf, int* lsm) {
    const int lane = c.tid & 63, wid = c.tid >> 6, hl = lane & 31, half = lane >> 5;
    const int per = (NT + G - 1) / G, n0 = bid * per, n1 = (n0 + per < NT) ? n0 + per : NT;
    __syncthreads();
    const float* X = c.w<float>(WS_X); bf16* HA = c.w<bf16>(WS_HA);
    const float* MOD = c.w<float>(WS_MOD) + (size_t)layer * 5 * 6144;
    const float* g = c.in(7) + layer * D;
    int* TE = c.w<int>(WS_TOKE); float* TW = c.w<float>(WS_TOKW);
    float* Lg = (float*)hbuf; float* Lsc = Lg + D; float* Lsh = Lsc + D; float* Lcw = Lsh + D;
    const float* rwt = c.w<float>(WS_RWT) + (size_t)layer * 36 * 1024;
    const int mrA = (n0 % LT) < CTX ? 4 : n0 / LT;
    for (int i = c.tid; i < D / 4; i += NTHR) {
        ((f32x4*)Lg)[i] = ((const f32x4*)g)[i];
        ((f32x4*)Lsc)[i] = ((const f32x4*)(MOD + mrA * 6144 + 4096))[i];
        ((f32x4*)Lsh)[i] = ((const f32x4*)(MOD + mrA * 6144 + 3072))[i];
#pragma unroll
        for (int e = 0; e < 4; ++e) ((f32x4*)(Lcw + e * D))[i] = ((const f32x4*)(rwt + e * 1024))[i];
    }
    __syncthreads();
    for (int nb = n0 + wid * 2; nb < n1; nb += 8) {
        const bool inr = nb + half < n1;
        const int n = inr ? nb + half : n1 - 1;
        const int b = n / LT, pos = n % LT, mr = pos < CTX ? 4 : b;
        const bool act = inr && !(layer == 1 && pos < CTX);
        if (hl == 0 && inr && !act) { lsm[(n - n0) * 2] = -1; lsm[(n - n0) * 2 + 1] = -1; }
        const float* x = X + (size_t)n * D;
        const float* scp = mr == mrA ? Lsc : MOD + mr * 6144 + 4096;
        const float* shp = mr == mrA ? Lsh : MOD + mr * 6144 + 3072;
        float ss = 0.f;
        PR_BEGIN(110);
        f32x4 v[8];
#pragma unroll
        for (int i = 0; i < 8; ++i) { v[i] = *(const f32x4*)(x + (hl + 32 * i) * 4); ss += v[i][0] * v[i][0] + v[i][1] * v[i][1] + v[i][2] * v[i][2] + v[i][3] * v[i][3]; }
        const float rstd = rsqrtf(half_sum(ss) * (1.f / D) + EPS);
        PR_END(110); PR_BEGIN(111);
        float cg[4] = {0.f, 0.f, 0.f, 0.f};
#pragma unroll
        for (int i = 0; i < 8; ++i) {
            const int k = (hl + 32 * i) * 4;
            const f32x4 h = v[i] * rstd * *(const f32x4*)(Lg + k) * (*(const f32x4*)(scp + k) + 1.f) + *(const f32x4*)(shp + k);
            v[i] = h;
            *(uint2*)(HA + (size_t)n * D + k) = pack4(h);
#pragma unroll
            for (int e = 0; e < 4; ++e) { const f32x4 w = *(const f32x4*)(Lcw + e * D + k); cg[e] += h[0] * w[0] + h[1] * w[1] + h[2] * w[2] + h[3] * w[3]; }
        }
        float mx = -1e30f; int gi = 0; float cl[4];
#pragma unroll
        for (int e = 0; e < 4; ++e) { cl[e] = half_sum(cg[e]) + c.in(30)[layer * 4 + e]; if (cl[e] > mx) { mx = cl[e]; gi = e; } }
        PR_END(111); PR_BEGIN(112);
        float fg[8] = {0.f, 0.f, 0.f, 0.f, 0.f, 0.f, 0.f, 0.f};
        const float* fwt = rwt + (4 + gi * 8) * 1024;
#pragma unroll
        for (int ib = 0; ib < 8; ib += 2) {
            f32x4 w[2][8];
#pragma unroll
            for (int i = 0; i < 2; ++i)
#pragma unroll
                for (int e = 0; e < 8; ++e) w[i][e] = *(const f32x4*)(fwt + e * 1024 + (hl + 32 * (ib + i)) * 4);
#pragma unroll
            for (int i = 0; i < 2; ++i)
#pragma unroll
                for (int e = 0; e < 8; ++e) { const f32x4 h = v[ib + i]; fg[e] += h[0] * w[i][e][0] + h[1] * w[i][e][1] + h[2] * w[i][e][2] + h[3] * w[i][e][3]; }
            asm volatile("" ::: "memory");
        }
#pragma unroll
        for (int e = 0; e < 8; ++e) fg[e] = half_sum(fg[e]);
        PR_END(112); PR_BEGIN(113);
        if (hl == 0 && act) {
            float den = 0.f;
#pragma unroll
            for (int e = 0; e < 4; ++e) den += expf(cl[e] - mx);
            const float pg = 1.f / den;
            float f1 = -1e30f, f2 = -1e30f; int i1 = 0, i2 = 0;
#pragma unroll
            for (int e = 0; e < 8; ++e) {
                const float fv = fg[e] + c.in(32)[layer * 32 + gi * 8 + e];
                if (fv > f1) { f2 = f1; i2 = i1; f1 = fv; i1 = e; } else if (fv > f2) { f2 = fv; i2 = e; }
            }
            const float e2 = expf(f2 - f1), w1 = pg / (1.f + e2), w2 = pg * e2 / (1.f + e2);
            const int ex1 = gi * 8 + i1, ex2 = gi * 8 + i2;
            lsm[(n - n0) * 2] = ex1; lsm[(n - n0) * 2 + 1] = ex2;
            TE[n * 2] = ex1; TE[n * 2 + 1] = ex2; TW[n * 2] = w1; TW[n * 2 + 1] = w2;
        }
        PR_END(113);
    }
    PR_BEGIN(114);
    __syncthreads();
    if (c.tid < 32) {
        const int e = c.tid, ne = (n1 > n0 ? n1 - n0 : 0) * 2;
        int cl_ = 0;
        for (int i = 0; i < ne; ++i) cl_ += (lsm[i] == e) ? 1 : 0;
        c.w<int>(WS_BCNT)[bid * 32 + e] = cl_;
    }
    PR_END(114);
}
__device__ __forceinline__ void ph_assign(const Ctx& c, int layer, int bid, int G, int* wk, const int* lsm) {
    const int e = c.tid & 31, part = c.tid >> 5;
    const int per = (NT + G - 1) / G, n0 = bid * per, n1 = (n0 + per < NT) ? n0 + per : NT;
    const int* BC = c.w<int>(WS_BCNT);
    int before = 0, all = 0;
#pragma unroll 16
    for (int blk = part; blk < G; blk += 8) { const int v = BC[blk * 32 + e]; all += v; before += blk < bid ? v : 0; }
    __syncthreads();
    wk[(part * 32 + e) * 2] = before; wk[(part * 32 + e) * 2 + 1] = all;
    __syncthreads();
    if (c.tid < 32) {
        int base = 0, tot = 0;
#pragma unroll
        for (int p = 0; p < 8; ++p) { base += wk[(p * 32 + e) * 2]; tot += wk[(p * 32 + e) * 2 + 1]; }
        if (bid == 0) c.w<unsigned>(WS_CTL)[CW_CNT + (layer * 32 + e) * 64] = (unsigned)tot;
        int* TP = c.w<int>(WS_TOKP); int* LI = c.w<int>(WS_LIST);
        const int ne = (n1 > n0 ? n1 - n0 : 0) * 2;
        int r = 0;
        for (int i = 0; i < ne; ++i) if (lsm[i] == e) { const int n = n0 + (i >> 1); const int ps = base + r; ++r; TP[n * 2 + (i & 1)] = ps; LI[(size_t)e * NT + ps] = n; }
    }
}

__device__ __forceinline__ void moe_offsets(const Ctx& c, int layer, int* sm) {
    __syncthreads();
    if (c.tid == 0) {
        const unsigned* cnt = c.w<unsigned>(WS_CTL) + CW_CNT + layer * 32 * 64;
        int acc = 0;
        for (int e = 0; e < 32; ++e) { const int ce = (int)__hip_atomic_load(cnt + e * 64, __ATOMIC_RELAXED, __HIP_MEMORY_SCOPE_AGENT); sm[e] = acc; sm[33 + e] = ce; acc += (ce + 127) & ~127; }
        sm[32] = acc;
    }
    __syncthreads();
}
__device__ __forceinline__ int slot_expert(const int* sm, int slot) { int e = 0;
#pragma unroll 1
    for (int i = 1; i < 32; ++i) if (slot >= sm[i]) e = i;
    return e; }

__device__ __forceinline__ f32x4 bf4(const uint2 u) { return (f32x4){__uint_as_float(u.x << 16), __uint_as_float(u.x & 0xffff0000u), __uint_as_float(u.y << 16), __uint_as_float(u.y & 0xffff0000u)}; }
__device__ __forceinline__ void ph_combine(const Ctx& c, int layer, int gw, int nwaves, const int* sm, unsigned char* lds) {
    const int lane = c.tid & 63;
    __syncthreads();
    for (int i = c.tid; i < 2048; i += NTHR) ((f32x4*)lds)[i] = ((const f32x4*)(c.w<float>(WS_WDT) + (size_t)8 * 1024))[i];
    __syncthreads();
    const LAS float* wdt = (const LAS float*)lds;
    const int* TE = c.w<int>(WS_TOKE); const int* TP = c.w<int>(WS_TOKP); const float* TW = c.w<float>(WS_TOKW);
    const bf16* OUT = c.w<bf16>(WS_OUT);
    bf16* HA = c.w<bf16>(WS_HA); float* DTR = c.w<float>(WS_DTR);
    const float* MODn = c.w<float>(WS_MOD) + (size_t)1 * 5 * 6144;
    const float* gnext = c.in(6) + D;
    const int ntok = layer == 1 ? NB * SEQ : NT;
    for (int q = gw; q < ntok; q += 2 * nwaves) {
        int nn[2]; bool ok[2];
#pragma unroll
        for (int u = 0; u < 2; ++u) { int qq = q + u * nwaves; ok[u] = qq < ntok; qq = ok[u] ? qq : q; nn[u] = layer == 1 ? (qq / SEQ) * LT + CTX + (qq % SEQ) : qq; }
        int s0[2], s1[2]; float w0[2], w1[2]; int mr[2];
#pragma unroll
        for (int u = 0; u < 2; ++u) { const int n = nn[u]; mr[u] = (n % LT) < CTX ? 4 : n / LT;
            s0[u] = sm[TE[n * 2]] + TP[n * 2]; s1[u] = sm[TE[n * 2 + 1]] + TP[n * 2 + 1]; w0[u] = TW[n * 2]; w1[u] = TW[n * 2 + 1]; }
        f32x4 xv[2][4], gv[2][4]; uint2 oa[2][4], ob[2][4];
#pragma unroll
        for (int u = 0; u < 2; ++u) { const float* X = c.w<float>(WS_X) + (size_t)nn[u] * D; const float* g2 = c.w<float>(WS_MOD) + (size_t)layer * 5 * 6144 + mr[u] * 6144 + 5120;
#pragma unroll
            for (int i = 0; i < 4; ++i) { const int k = (lane + 64 * i) * 4;
                xv[u][i] = *(const f32x4*)(X + k); gv[u][i] = *(const f32x4*)(g2 + k);
                oa[u][i] = *(const uint2*)(OUT + (size_t)s0[u] * D + k); ob[u][i] = *(const uint2*)(OUT + (size_t)s1[u] * D + k); } }
        float ss[2] = {0.f, 0.f};
#pragma unroll
        for (int u = 0; u < 2; ++u)
#pragma unroll
            for (int i = 0; i < 4; ++i) { xv[u][i] = xv[u][i] + gv[u][i] * (bf4(oa[u][i]) * w0[u] + bf4(ob[u][i]) * w1[u]);
                ss[u] += xv[u][i][0] * xv[u][i][0] + xv[u][i][1] * xv[u][i][1] + xv[u][i][2] * xv[u][i][2] + xv[u][i][3] * xv[u][i][3]; }
        float rstd[2];
#pragma unroll
        for (int u = 0; u < 2; ++u) rstd[u] = rsqrtf(wave_sum(ss[u]) * (1.f / D) + EPS);
#pragma unroll
        for (int u = 0; u < 2; ++u) {
            if (!ok[u]) continue;
            const int n = nn[u];
            if (layer == 1) {
                float* o = c.out() + ((size_t)(n / LT) * SEQ + (n % LT - CTX)) * D;
#pragma unroll
                for (int i = 0; i < 4; ++i) { const int k = (lane + 64 * i) * 4; *(f32x4*)(o + k) = xv[u][i] * rstd[u] * *(const f32x4*)(c.in(36) + k); }
            } else {
                float* X = c.w<float>(WS_X) + (size_t)n * D;
                f32x4 hv[4];
#pragma unroll
                for (int i = 0; i < 4; ++i) {
                    const int k = (lane + 64 * i) * 4;
                    *(f32x4*)(X + k) = xv[u][i];
                    hv[i] = xv[u][i] * rstd[u] * *(const f32x4*)(gnext + k) * (*(const f32x4*)(MODn + mr[u] * 6144 + 1024 + k) + 1.f) + *(const f32x4*)(MODn + mr[u] * 6144 + k);
                    *(uint2*)(HA + (size_t)n * D + k) = pack4(hv[i]);
                }
                dt_project(wdt, hv, lane, DTR + (size_t)n * 8);
            }
        }
    }
}

typedef LAS const char* lds_cptr;
constexpr int GEMM_LDS = 35840;
constexpr int GA_KH = 8256, GB_OFF = 16512, GB_ST = 288;
__device__ __forceinline__ s16x4 lds_tr(lds_cptr p) { return __builtin_bit_cast(s16x4, __builtin_amdgcn_ds_read_tr16_b64_v4i16((LAS s16x4*)p)); }

template <bool B_F32, int DEEP = 2  , class ARow>
__device__ __forceinline__ void gemm_tile(const int tid, unsigned char* lds, const bf16* Abase, ARow arow  , const void* Bbase, unsigned boff  , int ldb, bool bval, int K, f32x4 (&acc)[4][4]) {
    const int lane = tid & 63, wid = tid >> 6, wr = wid >> 1, wc = wid & 1, fr = lane & 15, fq = lane >> 4;
#pragma unroll
    for (int m = 0; m < 4; ++m)
#pragma unroll
        for (int n = 0; n < 4; ++n) acc[m][n] = (f32x4){0.f, 0.f, 0.f, 0.f};
    unsigned ao[4];
#pragma unroll
    for (int i = 0; i < 4; ++i) ao[i] = arow((tid >> 3) + 32 * i) + (tid & 7) * 8;
    const int bk = tid >> 4, bnc = tid & 15;
    constexpr int NRB = B_F32 ? 8 : 4;
    u32x4 ra0[4], ra1[4]; u32x4 rb0[NRB], rb1[NRB];
    auto gloadA = [&](int kt, u32x4 (&ra)[4]) __attribute__((always_inline)) {
#pragma unroll
        for (int i = 0; i < 4; ++i) ra[i] = *(const u32x4*)(Abase + (ao[i] + kt * 64));
    };
    auto gloadB = [&](int kt, u32x4 (&rb)[NRB]) __attribute__((always_inline)) {
        if (B_F32) {
            const float* bp = (const float*)Bbase + (boff + (unsigned)((kt * 64 + bk) * ldb));
#pragma unroll
            for (int i = 0; i < 4; ++i) {
                if (bval) { rb[2 * i] = *(const u32x4*)(bp + (unsigned)(16 * i * ldb)); rb[2 * i + 1] = *(const u32x4*)(bp + (unsigned)(16 * i * ldb) + 4); }
                else { rb[2 * i] = (u32x4){0u, 0u, 0u, 0u}; rb[2 * i + 1] = rb[2 * i]; }
            }
        } else {
            const bf16* bp = (const bf16*)Bbase + (boff + (unsigned)((kt * 64 + bk) * ldb));
#pragma unroll
            for (int i = 0; i < 4; ++i) rb[i] = bval ? *(const u32x4*)(bp + (unsigned)(16 * i * ldb)) : (u32x4){0u, 0u, 0u, 0u};
        }
    };
    auto lstore = [&](const u32x4 (&ra)[4], const u32x4 (&rb)[NRB]) __attribute__((always_inline)) {
#pragma unroll
        for (int i = 0; i < 4; ++i) { const int row = (tid >> 3) + 32 * i, kc = tid & 7;
            const u32x4 v = (kc & 1) ? (u32x4){ra[i][2], ra[i][3], ra[i][0], ra[i][1]} : ra[i];
            *(u32x4*)(lds + (kc >> 2) * GA_KH + row * 64 + (kc & 3) * 16) = v; }
#pragma unroll
        for (int i = 0; i < 4; ++i) { const int k = bk + 16 * i;
            u32x4 v;
            if (B_F32) { const f32x4 x = __builtin_bit_cast(f32x4, rb[2 * i]), y = __builtin_bit_cast(f32x4, rb[2 * i + 1]);
                v[0] = pk2bf(x[0], x[1]); v[1] = pk2bf(x[2], x[3]); v[2] = pk2bf(y[0], y[1]); v[3] = pk2bf(y[2], y[3]); }
            else v = rb[i];
            *(u32x4*)(lds + GB_OFF + k * GB_ST + bnc * 16) = v; }
    };
    const lds_cptr la = (lds_cptr)lds + (wr * 64 + fr) * 64 + fq * 16;
    const lds_cptr lb = (lds_cptr)lds + GB_OFF + (8 * fq + (fr >> 2) + (fq & 1) * 4) * GB_ST + wc * 128 + (fr & 3) * 8;
    const int bsw = (fq & 1) ? -4 * GB_ST : 4 * GB_ST;
    auto compute = [&]() __attribute__((always_inline)) {
#pragma unroll
        for (int kh = 0; kh < 2; ++kh) {
            bf16x8 af[4], bfr[4];
#pragma unroll
            for (int m = 0; m < 4; ++m) af[m] = *(const LAS bf16x8*)(la + kh * GA_KH + m * 1024);
#pragma unroll
            for (int n = 0; n < 4; ++n) {
                const s16x4 r0 = lds_tr(lb + kh * 32 * GB_ST + n * 32), r1 = lds_tr(lb + kh * 32 * GB_ST + n * 32 + bsw);
                bfr[n] = (bf16x8){r0[0], r0[1], r0[2], r0[3], r1[0], r1[1], r1[2], r1[3]};
            }
#pragma unroll
            for (int m = 0; m < 4; ++m)
#pragma unroll
                for (int n = 0; n < 4; ++n) acc[m][n] = __builtin_amdgcn_mfma_f32_16x16x32_bf16(bfr[n], af[m], acc[m][n], 0, 0, 0);
        }
    };
    const int nk = K / 64;
    if (DEEP == 0) {
        gloadA(0, ra0); gloadB(0, rb0);
        for (int kt = 0; kt < nk; ++kt) {
            __syncthreads();
            lstore(ra0, rb0);
            __syncthreads();
            if (kt + 1 < nk) { gloadA(kt + 1, ra0); gloadB(kt + 1, rb0); }
            compute();
        }
        return;
    }
    if (DEEP == 1) {
        gloadA(0, ra0); gloadB(0, rb0); gloadA(1, ra1);
        for (int kt = 0; kt < nk; kt += 2) {
            __syncthreads();
            lstore(ra0, rb0);
            __syncthreads();
            gloadB(kt + 1, rb0);
            if (kt + 2 < nk) gloadA(kt + 2, ra0);
            compute();
            __syncthreads();
            lstore(ra1, rb0);
            __syncthreads();
            if (kt + 2 < nk) gloadB(kt + 2, rb0);
            if (kt + 3 < nk) gloadA(kt + 3, ra1);
            compute();
        }
        return;
    }
    gloadB(0, rb0); gloadA(0, ra0); gloadB(1, rb1);
    for (int kt = 0; kt < nk; kt += 2) {
        __syncthreads();
        lstore(ra0, rb0);
        __syncthreads();
        gloadA(kt + 1, ra0);
        if (kt + 2 < nk) gloadB(kt + 2, rb0);
        compute();
        __syncthreads();
        lstore(ra0, rb1);
        __syncthreads();
        if (kt + 2 < nk) gloadA(kt + 2, ra0);
        if (kt + 3 < nk) gloadB(kt + 3, rb1);
        compute();
    }
}


__device__ __forceinline__ void cvt8(const float* s, bf16* d) {
    const f32x4 a = *(const f32x4*)s, b = *(const f32x4*)(s + 4);
    u32x4 o; o[0] = pk2bf(a[0], a[1]); o[1] = pk2bf(a[2], a[3]); o[2] = pk2bf(b[0], b[1]); o[3] = pk2bf(b[2], b[3]);
    *(u32x4*)d = o;
}
__device__ __forceinline__ void cvt_small(Ctx& c, int gtid, int gthreads) {
    asm volatile("" : "+s"(c.p));

    constexpr int N_IN = 2 * D * (DINV / 8), N_OUT = 2 * D * (D / 8), N_GLU = 2 * 256 * 32;
    for (int it = gtid; it < N_IN + N_OUT + N_GLU; it += gthreads) {
        if (it < N_IN) { const int ch = it % (DINV / 8), lk = it / (DINV / 8), vc = ch * 8, ac = vc < C_DT ? vc : vc + 8;
            cvt8(c.in(8) + (size_t)lk * DIN + ac, c.w<bf16>(WS_BIN) + (size_t)lk * DINV + vc); }
        else if (it < N_IN + N_OUT) { const int j = it - N_IN; cvt8(c.in(9) + (size_t)j * 8, c.w<bf16>(WS_BOUT) + (size_t)j * 8); }
        else { const int j = it - N_IN - N_OUT; cvt8(c.in(18) + (size_t)j * 8, c.w<bf16>(WS_BGLU) + (size_t)j * 8); }
    }
}
constexpr int CVT_MOE_TILES = 1536;
__device__ __forceinline__ void cvt_moe(const Ctx& c, int layer, int tile) {
#pragma unroll 1
    for (int h = 0; h < 2; ++h) {
        const float* sp[8]; bf16* dp[8];
#pragma unroll
        for (int i = 0; i < 8; ++i) {
            const int it = tile * 4096 + (h * 8 + i) * 256 + c.tid;
            if (it < 32 * 1024 * 128) {
                const int ch = it & 127, ek = it >> 7;
                const int blk = ch >> 3, w = (ch & 7) * 8;
                sp[i] = (w < 32 ? c.in(33) : c.in(34)) + ((size_t)layer * NEXP * D + ek) * DE + blk * 32 + (w & 31);
                dp[i] = c.w<bf16>(WS_BGU) + (size_t)ek * 1024 + ch * 8;
            } else {
                const int j = it - 32 * 1024 * 128;
                sp[i] = c.in(35) + (size_t)layer * NEXP * DE * D + (size_t)j * 8; dp[i] = c.w<bf16>(WS_BDN) + (size_t)j * 8;
            }
        }
        f32x4 va[8], vb[8];
#pragma unroll
        for (int i = 0; i < 8; ++i) { va[i] = *(const f32x4*)sp[i]; vb[i] = *(const f32x4*)(sp[i] + 4); }
#pragma unroll
        for (int i = 0; i < 8; ++i) { u32x4 o; o[0] = pk2bf(va[i][0], va[i][1]); o[1] = pk2bf(va[i][2], va[i][3]); o[2] = pk2bf(vb[i][0], vb[i][1]); o[3] = pk2bf(vb[i][2], vb[i][3]); *(u32x4*)dp[i] = o; }
    }
}

__device__ __forceinline__ void ph_inproj_mfma(const Ctx& c, int layer, int tile, unsigned char* lds) {
    const int mt = tile / 18, nt = tile % 18;
    const bf16* HA = c.w<bf16>(WS_HA) + (size_t)mt * 128 * D;
    f32x4 acc[4][4];
    const int vc = nt * 128 + (c.tid & 15) * 8;
    gemm_tile<false, 1>(c.tid, lds, HA, [&](int r) __attribute__((always_inline)) { return (unsigned)(r * D); }, c.w<bf16>(WS_BIN) + (size_t)layer * D * DINV, (unsigned)vc, DINV, true, D, acc);
    const int lane = c.tid & 63, wid = c.tid >> 6, wr = wid >> 1, wc = wid & 1, fr = lane & 15, fq = lane >> 4;
    const int n0 = mt * 128, b = n0 / LT, pos0 = n0 % LT;
    if (nt < 2) {
        bf16* UH = c.w<bf16>(WS_UH);
#pragma unroll
        for (int m = 0; m < 4; ++m) {
            const int pos = pos0 + wr * 64 + m * 16 + fr, J = b * 136 + (pos >> 5), tt = pos & 31;
#pragma unroll
            for (int n = 0; n < 4; ++n) { const int col = nt * 128 + wc * 64 + n * 16 + fq * 4;
                *(uint2*)(UH + ((size_t)(col >> 4) * NCH5 + J) * 768 + tt * 16 + (col & 15)) = pack4(acc[m][n]); }
        }
    } else if (nt < 6 || nt >= 14) {
        const int kind = nt >= 14 ? 1 : 0, sub = nt - (kind ? 14 : 2);
        if (sub == 3) {
            bf16* Vt = c.w<bf16>(kind ? WS_WV : WS_GV) + ((size_t)b * 2 + wc) * 64 * LT;
#pragma unroll
            for (int m = 0; m < 4; ++m) { const int pos = pos0 + wr * 64 + m * 16 + fr;
#pragma unroll
                for (int n = 0; n < 4; ++n)
#pragma unroll
                    for (int jj = 0; jj < 4; ++jj) Vt[(size_t)(n * 16 + fq * 4 + jj) * LT + pos] = f2bf(acc[m][n][jj]); }
        } else {
            const bool isq = sub < 2; const int head = isq ? sub * 2 + wc : wc;
            bf16* dst = isq ? c.w<bf16>(kind ? WS_WQ : WS_GQ) + ((size_t)b * 4 + head) * LT * 64 : c.w<bf16>(kind ? WS_WK : WS_GK) + ((size_t)b * 2 + head) * LT * 64;
            const float* gain = (isq ? c.in(20) : c.in(21)) + layer * 64;
            const float qs = isq ? 0.18033688011112042f : 1.f;
            const float* ROPE = c.w<float>(WS_ROPE);
#pragma unroll
            for (int m = 0; m < 4; ++m) {
                const int pos = pos0 + wr * 64 + m * 16 + fr;
                f32x4 v[4];
#pragma unroll
                for (int n = 0; n < 4; ++n) v[n] = acc[m][n];
                if (kind == 0) {
                    float ss = 0.f;
#pragma unroll
                    for (int n = 0; n < 4; ++n) ss += v[n][0] * v[n][0] + v[n][1] * v[n][1] + v[n][2] * v[n][2] + v[n][3] * v[n][3];
                    ss += __shfl_xor(ss, 16); ss += __shfl_xor(ss, 32);
                    const float rstd = rsqrtf(ss * (1.f / 64.f) + EPS);
#pragma unroll
                    for (int n = 0; n < 4; ++n) v[n] = v[n] * rstd * *(const f32x4*)(gain + n * 16 + fq * 4);
                }
                if (pos >= CTX) {
                    const int l = pos - CTX;
#pragma unroll
                    for (int a = 0; a < 2; ++a) { const int rp = a == 0 ? (l >> 6) : (l & 63);
#pragma unroll
                        for (int jj = 0; jj < 4; ++jj) { const f32x2 cs = *(const f32x2*)(ROPE + (rp * 16 + fq * 4 + jj) * 2);
                            const float x0 = v[2 * a][jj], x1 = v[2 * a + 1][jj];
                            v[2 * a][jj] = x0 * cs[0] - x1 * cs[1]; v[2 * a + 1][jj] = x1 * cs[0] + x0 * cs[1]; } }
                }
#pragma unroll
                for (int n = 0; n < 4; ++n) *(uint2*)(dst + (size_t)pos * 64 + n * 16 + fq * 4) = pack4(v[n] * qs);
            }
        }
    } else {
        bf16* dst; int ld, col0;
        if (nt < 8) { dst = c.w<bf16>(WS_Z); ld = 256; col0 = (nt - 6) * 128; } else { dst = c.w<bf16>(WS_XBR); ld = 768; col0 = (nt - 8) * 128; }
#pragma unroll
        for (int m = 0; m < 4; ++m) { const size_t row = (size_t)n0 + wr * 64 + m * 16 + fr;
#pragma unroll
            for (int n = 0; n < 4; ++n) *(uint2*)(dst + row * ld + col0 + wc * 64 + n * 16 + fq * 4) = pack4(acc[m][n]); }
    }
}

#define EPI_COORDS const int lane = c.tid & 63, wid = c.tid >> 6, wr = wid >> 1, wc = wid & 1, fr = lane & 15, fq = lane >> 4
__device__ __forceinline__ void ph_glu_mfma(const Ctx& c, int layer, int tile, unsigned char* lds) {
    const int mt = tile >> 1, nt = tile & 1;
    const bf16* G5 = c.w<bf16>(WS_G5) + (size_t)mt * 128 * 256;
    f32x4 acc[4][4];
    const int bc = nt * 128 + (c.tid & 15) * 8;
    gemm_tile<false>(c.tid, lds, G5, [&](int r) __attribute__((always_inline)) { return (unsigned)(r * 256); }, c.w<bf16>(WS_BGLU) + (size_t)layer * 256 * 256, (unsigned)bc, 256, true, 256, acc);
    EPI_COORDS;
    bf16* MIX = c.w<bf16>(WS_MIX);
#pragma unroll
    for (int m = 0; m < 4; ++m)
#pragma unroll
        for (int n = 0; n < 4; ++n) {
            const int rl = wr * 64 + m * 16 + fr, col = nt * 128 + wc * 64 + n * 16 + fq * 4;
            const f32x4 bb = *(const f32x4*)(c.in(19) + layer * 256 + col);
            const uint2 gv = *(const uint2*)(G5 + (size_t)rl * 256 + col);
            const float g0 = __uint_as_float(gv.x << 16), g1 = __uint_as_float(gv.x & 0xffff0000u), g2 = __uint_as_float(gv.y << 16), g3 = __uint_as_float(gv.y & 0xffff0000u);
            uint2 o;
            o.x = pk2bf(g0 * sigmoid_f(acc[m][n][0] + bb[0]), g1 * sigmoid_f(acc[m][n][1] + bb[1]));
            o.y = pk2bf(g2 * sigmoid_f(acc[m][n][2] + bb[2]), g3 * sigmoid_f(acc[m][n][3] + bb[3]));
            *(uint2*)(MIX + (size_t)(mt * 128 + rl) * D + col) = o;
        }
}
__device__ __forceinline__ void ph_outproj_mfma(const Ctx& c, int layer, int tile, unsigned char* lds) {
    int mt = tile >> 3; const int nt = tile & 7;
    if (layer == 1) { if (mt >= 128) return; mt = (mt >> 5) * 34 + 2 + (mt & 31); }
    const bf16* MIX = c.w<bf16>(WS_MIX) + (size_t)mt * 128 * D;
    f32x4 acc[4][4];
    const int bc = nt * 128 + (c.tid & 15) * 8;
    gemm_tile<false, 1>(c.tid, lds, MIX, [&](int r) __attribute__((always_inline)) { return (unsigned)(r * D); }, c.w<bf16>(WS_BOUT) + (size_t)layer * D * D, (unsigned)bc, D, true, D, acc);
    EPI_COORDS;
    const float* MOD = c.w<float>(WS_MOD) + (size_t)layer * 5 * 6144;
    float* X = c.w<float>(WS_X);
#pragma unroll
    for (int m = 0; m < 4; ++m) {
        const int row = mt * 128 + wr * 64 + m * 16 + fr, b = row / LT, pos = row % LT, mr = pos < CTX ? 4 : b;
        const float* xs = xsrc(c, layer, row);
#pragma unroll
        for (int n = 0; n < 4; ++n) {
            const int col = nt * 128 + wc * 64 + n * 16 + fq * 4;
            const f32x4 g1 = *(const f32x4*)(MOD + mr * 6144 + 2048 + col);
            *(f32x4*)(X + (size_t)row * D + col) = *(const f32x4*)(xs + col) + g1 * acc[m][n];
        }
    }
}
__device__ __forceinline__ void ph_moe1_mfma(const Ctx& c, int layer, int tile, const int* sm, unsigned char* lds) {
    const int st = tile >> 3, nt = tile & 7;
    const int s0 = st * 128;
    if (s0 >= sm[32]) return;
    const int e = slot_expert(sm, s0), base = s0 - sm[e], ce = sm[33 + e];
    if (base >= ce) return;
    const bf16* HA = c.w<bf16>(WS_HA); const int* LI = c.w<int>(WS_LIST) + (size_t)e * NT;
    f32x4 acc[4][4];
    gemm_tile<false>(c.tid, lds, HA, [&](int r) __attribute__((always_inline)) { const int tok = LI[(base + r < ce) ? (base + r) : base]; return (unsigned)(tok * D); }, c.w<bf16>(WS_BGU) + (size_t)e * D * 1024, (unsigned)(nt * 128 + (c.tid & 15) * 8), 1024, true, D, acc);
    EPI_COORDS;
    bf16* ACT = c.w<bf16>(WS_ACT);
#pragma unroll
    for (int m = 0; m < 4; ++m) {
        const int rl = wr * 64 + m * 16 + fr;
#pragma unroll
        for (int n = 0; n < 2; ++n) {
            const int col = nt * 64 + wc * 32 + n * 16 + fq * 4;
            const f32x4 g = acc[m][n], u = acc[m][n + 2];
            uint2 o; o.x = pk2bf(silu_f(g[0]) * u[0], silu_f(g[1]) * u[1]); o.y = pk2bf(silu_f(g[2]) * u[2], silu_f(g[3]) * u[3]);
            *(uint2*)(ACT + (size_t)(s0 + rl) * DE + col) = o;
        }
    }
}
__device__ __forceinline__ void ph_moe2_mfma(const Ctx& c, int layer, int tile, const int* sm, unsigned char* lds) {
    const int st = tile >> 3, nt = tile & 7;
    const int s0 = st * 128;
    if (s0 >= sm[32]) return;
    const int e = slot_expert(sm, s0), base = s0 - sm[e], ce = sm[33 + e];
    if (base >= ce) return;
    const bf16* ACT = c.w<bf16>(WS_ACT) + (size_t)s0 * DE;
    f32x4 acc[4][4];
    const int bc = nt * 128 + (c.tid & 15) * 8;
    gemm_tile<false>(c.tid, lds, ACT, [&](int r) __attribute__((always_inline)) { return (unsigned)(r * DE); }, c.w<bf16>(WS_BDN) + (size_t)e * DE * D, (unsigned)bc, D, true, DE, acc);
    EPI_COORDS;
    bf16* OUT = c.w<bf16>(WS_OUT);
#pragma unroll
    for (int m = 0; m < 4; ++m)
#pragma unroll
        for (int n = 0; n < 4; ++n) {
            const int rl = wr * 64 + m * 16 + fr, col = nt * 128 + wc * 64 + n * 16 + fq * 4;
            uint2 o; o.x = pk2bf(acc[m][n][0], acc[m][n][1]); o.y = pk2bf(acc[m][n][2], acc[m][n][3]);
            *(uint2*)(OUT + (size_t)(s0 + rl) * D + col) = o;
        }
}


typedef float f32x16 __attribute__((ext_vector_type(16)));
constexpr int AT_KST = 144, AT_VST = 136;
constexpr int AT_KOFF = 0, AT_VOFF = 64 * AT_KST, AT_BUF = AT_VOFF + 64 * AT_VST;
constexpr int AT_SOFF = GEMM_LDS + 512;
static_assert(2 * AT_BUF <= GEMM_LDS, "attention double buffer must fit the GEMM LDS region");
constexpr float AT_THR = 5.0f;
__device__ __forceinline__ float vmax(float a, float b) { return __builtin_fmaxf(a, b); }
__device__ __forceinline__ float vmax3(float a, float b, float c) { return __builtin_fmaxf(__builtin_fmaxf(a, b), c); }
__device__ __forceinline__ float xhalf(float v) { const auto r = __builtin_amdgcn_permlane32_swap(__float_as_uint(v), __float_as_uint(v), false, false); return __uint_as_float((threadIdx.x & 32) ? r[0] : r[1]); }
__device__ __forceinline__ int crow(int r, int hi) { return (r & 3) + 8 * (r >> 2) + 4 * hi; }

__device__ __forceinline__ void attn_tile(const Ctx& c, int layer, int idx, unsigned char* lds) {
    const int tid = c.tid, lane = tid & 63, wid = tid >> 6, r32 = lane & 31, hi = lane >> 5;
    int kind, b, h, qt;
    if (idx < 1024) { kind = idx >> 9; const int r = idx & 511; b = r >> 7; h = (r >> 5) & 3; qt = 2 + (r & 31); }
    else { const int r = idx - 1024; kind = r >> 5; b = (r >> 3) & 3; h = (r >> 1) & 3; qt = r & 1; }
    const int kvh = h >> 1;
    const bf16* Q = c.w<bf16>(kind ? WS_WQ : WS_GQ) + ((size_t)b * 4 + h) * LT * 64;
    const bf16* K = c.w<bf16>(kind ? WS_WK : WS_GK) + ((size_t)b * 2 + kvh) * LT * 64;
    const bf16* Vt = c.w<bf16>(kind ? WS_WV : WS_GV) + ((size_t)b * 2 + kvh) * 64 * LT;
    const int q0 = qt * 128;
    const int qpos = q0 + wid * 32 + r32;
    int b0 = CTX, b1 = CTX;
    if (qt >= 2) { if (kind == 0) { b0 = CTX; b1 = LT; } else { b0 = q0 - 128 < CTX ? CTX : q0 - 128; b1 = q0 + 256 > LT ? LT : q0 + 256; } }
    const int nA = CTX / 64, ntile = nA + (b1 - b0) / 64;
    bf16x8 qf[4];
#pragma unroll
    for (int d0 = 0; d0 < 4; ++d0) qf[d0] = *(const bf16x8*)(Q + (size_t)qpos * 64 + d0 * 16 + hi * 8);
    f32x16 o0, o1;
#pragma unroll
    for (int r = 0; r < 16; ++r) { o0[r] = 0.f; o1[r] = 0.f; }
    float m = -1e30f, l = 0.f;
    if (kind == 1) { m = c.in(28)[layer * 4 + h] * 1.4426950408889634f; l = (hi == 0) ? 1.f : 0.f; }
    float* wsf = (float*)(lds + AT_SOFF) + wid * 32;
    u32x4 rk0[2], rv0[2];
    auto gload = [&](int ti, u32x4 (&rk)[2], u32x4 (&rv)[2]) __attribute__((always_inline)) {
        const int kb = ti < nA ? ti * 64 : b0 + (ti - nA) * 64;
#pragma unroll
        for (int i = 0; i < 2; ++i) { const int cc = tid + 256 * i;
            rk[i] = *(const u32x4*)(K + (size_t)(kb + (cc >> 3)) * 64 + (cc & 7) * 8);
            rv[i] = *(const u32x4*)(Vt + (size_t)(cc >> 3) * LT + kb + (cc & 7) * 8); }
    };
    auto lstore = [&](int buf, const u32x4 (&rk)[2], const u32x4 (&rv)[2]) __attribute__((always_inline)) {
#pragma unroll
        for (int i = 0; i < 2; ++i) { const int cc = tid + 256 * i;
            *(u32x4*)(lds + buf * AT_BUF + AT_KOFF + (cc >> 3) * AT_KST + (cc & 7) * 16) = rk[i];
            unsigned char* vp = lds + buf * AT_BUF + AT_VOFF + (cc >> 3) * AT_VST + (cc & 7) * 16;
            *(uint2*)vp = make_uint2(rv[i][0], rv[i][1]); *(uint2*)(vp + 8) = make_uint2(rv[i][2], rv[i][3]); }
    };
    const lds_cptr lk0 = (lds_cptr)lds + AT_KOFF + r32 * AT_KST + hi * 16;
    const lds_cptr lv0 = (lds_cptr)lds + AT_VOFF + r32 * AT_VST + hi * 8;
    auto compute = [&](int ti) __attribute__((always_inline)) {
        const int kb = ti < nA ? ti * 64 : b0 + (ti - nA) * 64;
        const lds_cptr lk = lk0 + (ti & 1) * AT_BUF, lv = lv0 + (ti & 1) * AT_BUF;
        f32x16 p0, p1;
#pragma unroll
        for (int r = 0; r < 16; ++r) { p0[r] = 0.f; p1[r] = 0.f; }
#pragma unroll
        for (int d0 = 0; d0 < 4; ++d0) {
            const bf16x8 k0 = *(const LAS bf16x8*)(lk + d0 * 32), k1 = *(const LAS bf16x8*)(lk + 32 * AT_KST + d0 * 32);
            p0 = __builtin_amdgcn_mfma_f32_32x32x16_bf16(k0, qf[d0], p0, 0, 0, 0);
            p1 = __builtin_amdgcn_mfma_f32_32x32x16_bf16(k1, qf[d0], p1, 0, 0, 0);
        }
        if (kind == 1 && ti >= nA) {
#pragma unroll
            for (int r = 0; r < 16; ++r) {
                const int d0_ = kb + crow(r, hi) - qpos, d1_ = d0_ + 32;
                if (d0_ > 128 || d0_ < -128) p0[r] = -INFINITY;
                if (d1_ > 128 || d1_ < -128) p1[r] = -INFINITY;
            }
        }
        s16x4 vlo[4], vhi[4];
#pragma unroll
        for (int s = 0; s < 2; ++s)
#pragma unroll
            for (int d0 = 0; d0 < 2; ++d0) { const lds_cptr vp = lv + d0 * 32 * AT_VST + (16 * s) * 2;
                vlo[s * 2 + d0] = *(const LAS s16x4*)vp; vhi[s * 2 + d0] = *(const LAS s16x4*)(vp + 16); }
        float ma[8];
#pragma unroll
        for (int r = 0; r < 8; ++r) ma[r] = vmax3(p0[2 * r], p0[2 * r + 1], vmax(p1[2 * r], p1[2 * r + 1]));
        float rm = vmax(vmax3(ma[0], ma[1], ma[2]), vmax3(ma[3], ma[4], vmax3(ma[5], ma[6], ma[7])));
        rm = vmax(rm, xhalf(rm));
        if (__any(rm > m + AT_THR)) {
            const float mn = fmaxf(m, rm), f = __builtin_amdgcn_exp2f(m - mn);
            m = mn; l *= f;
            if (hi == 0) wsf[r32] = f;
#pragma unroll
            for (int g = 0; g < 4; ++g) { const f32x4 fv = *(const f32x4*)(wsf + 8 * g + 4 * hi);
#pragma unroll
                for (int j = 0; j < 4; ++j) { o0[4 * g + j] *= fv[j]; o1[4 * g + j] *= fv[j]; } }
        }
        float ls = 0.f;
#pragma unroll
        for (int r = 0; r < 16; ++r) { p0[r] = __builtin_amdgcn_exp2f(p0[r] - m); p1[r] = __builtin_amdgcn_exp2f(p1[r] - m); ls += p0[r] + p1[r]; }
        l += ls;
#pragma unroll
        for (int t = 0; t < 2; ++t)
#pragma unroll
            for (int s = 0; s < 2; ++s) {
                float t8[8];
#pragma unroll
                for (int j = 0; j < 8; ++j) t8[j] = t == 0 ? p0[8 * s + j] : p1[8 * s + j];
                const bf16x8 pa = pack8(t8);
#pragma unroll
                for (int d0 = 0; d0 < 2; ++d0) {
                    const lds_cptr vp = lv + d0 * 32 * AT_VST + (32 * t + 16 * s) * 2;
                    const s16x4 lo = t == 0 ? vlo[s * 2 + d0] : *(const LAS s16x4*)vp, hv = t == 0 ? vhi[s * 2 + d0] : *(const LAS s16x4*)(vp + 16);
                    const bf16x8 vf = (bf16x8){lo[0], lo[1], lo[2], lo[3], hv[0], hv[1], hv[2], hv[3]};
                    if (d0 == 0) o0 = __builtin_amdgcn_mfma_f32_32x32x16_bf16(pa, vf, o0, 0, 0, 0);
                    else o1 = __builtin_amdgcn_mfma_f32_32x32x16_bf16(pa, vf, o1, 0, 0, 0);
                }
            }
    };
    gload(0, rk0, rv0);
    __syncthreads();
    lstore(0, rk0, rv0);
    gload(1, rk0, rv0);
    __syncthreads();
    for (int ti = 0; ti < ntile; ti += 2) {
        lstore(1, rk0, rv0);
        if (ti + 2 < ntile) gload(ti + 2, rk0, rv0);
        compute(ti);
        __syncthreads();
        if (ti + 2 < ntile) lstore(0, rk0, rv0);
        if (ti + 3 < ntile) gload(ti + 3, rk0, rv0);
        compute(ti + 1);
        __syncthreads();
    }
    l += __shfl_xor(l, 32);
    if (hi == 0) wsf[r32] = 1.f / l;
    bf16* MIX = c.w<bf16>(WS_MIX) + ((size_t)b * LT + q0 + wid * 32) * D + (kind ? 768 : 256) + h * 64 + r32;
#pragma unroll
    for (int g = 0; g < 4; ++g) { const f32x4 fv = *(const f32x4*)(wsf + 8 * g + 4 * hi);
#pragma unroll
        for (int j = 0; j < 4; ++j) { const int r = 4 * g + j; bf16* mp = MIX + (size_t)crow(r, hi) * D;
            mp[0] = f2bf(o0[r] * fv[j]); mp[32] = f2bf(o1[r] * fv[j]); } }
}


__device__ __forceinline__ void ph_prepB(const Ctx& c, int tile) {
    const float* KLAG = c.w<float>(WS_KLAG); const float* S5P = c.w<float>(WS_S5P); const float* S5BB = c.w<float>(WS_S5BB);
    bf16* WY = c.w<bf16>(WS_WY); bf16* WSm = c.w<bf16>(WS_WS);
    if (tile < 3072) {
        const int it = tile * NTHR + c.tid;
        const int t = it & 31, kr = (it >> 5) % 768, lg = it / (768 * 32), l = lg >> 4, g = lg & 15;
        float v[16];
        if (kr < 512) {
            const int s = kr >> 4, cp = kr & 15;
#pragma unroll
            for (int i = 0; i < 16; ++i) v[i] = 0.f;
            if (s <= t) { const f32x4* kp = (const f32x4*)(KLAG + ((size_t)(lg * 2 + 0) * 32 + (t - s)) * 256 + cp * 16);
#pragma unroll
                for (int q = 0; q < 4; ++q) { const f32x4 x = kp[q]; v[4 * q] += x[0]; v[4 * q + 1] += x[1]; v[4 * q + 2] += x[2]; v[4 * q + 3] += x[3]; } }
            if (s >= t) { const f32x4* kp = (const f32x4*)(KLAG + ((size_t)(lg * 2 + 1) * 32 + (s - t)) * 256 + cp * 16);
#pragma unroll
                for (int q = 0; q < 4; ++q) { const f32x4 x = kp[q]; v[4 * q] += x[0]; v[4 * q + 1] += x[1]; v[4 * q + 2] += x[2]; v[4 * q + 3] += x[3]; } }
            if (s == t) { const float dsk = c.in(17)[l * 256 + g * 16 + cp];
#pragma unroll
                for (int i = 0; i < 16; ++i) if (i == cp) v[i] += dsk; }
        } else {
            const int q = kr - 512, d = q >> 7, p = (q >> 1) & 63, ri = q & 1, e = d == 0 ? t + 1 : 32 - t;
            const int ldg = (l * 2 + d) * 16 + g;
            const float pr = S5P[((size_t)(ldg * 64 + p) * 33 + e) * 2], pi = S5P[((size_t)(ldg * 64 + p) * 33 + e) * 2 + 1];
#pragma unroll
            for (int i = 0; i < 16; ++i) {
                const float cr = c.in(15)[(size_t)ldg * 1024 + i * 64 + p], ci = c.in(16)[(size_t)ldg * 1024 + i * 64 + p];
                v[i] = ri == 0 ? (cr * pr - ci * pi) : -(cr * pi + ci * pr);
            }
        }
        u32x4 o0, o1;
        o0[0] = pk2bf(v[0], v[1]); o0[1] = pk2bf(v[2], v[3]); o0[2] = pk2bf(v[4], v[5]); o0[3] = pk2bf(v[6], v[7]);
        o1[0] = pk2bf(v[8], v[9]); o1[1] = pk2bf(v[10], v[11]); o1[2] = pk2bf(v[12], v[13]); o1[3] = pk2bf(v[14], v[15]);
        u32x4* op = (u32x4*)(WY + ((size_t)lg * 768 + kr) * 512 + t * 16);
        op[0] = o0; op[1] = o1;
    }
    else {
        const int it = (tile - 3072) * NTHR + c.tid;
        const int ncq = it & 31, kr = (it >> 5) & 511, lg = it >> 14, l = lg >> 4, g = lg & 15;
        const int s = kr >> 4, cp = kr & 15, d = ncq >> 4, p0 = (ncq & 15) * 4, e = d == 0 ? 31 - s : s;
        const int ldg = (l * 2 + d) * 16 + g;
        float v[8];
#pragma unroll
        for (int i = 0; i < 4; ++i) {
            const int p = p0 + i;
            const float pr = S5P[((size_t)(ldg * 64 + p) * 33 + e) * 2], pi = S5P[((size_t)(ldg * 64 + p) * 33 + e) * 2 + 1];
            const float br = S5BB[((size_t)(ldg * 64 + p) * 16 + cp) * 2], bi = S5BB[((size_t)(ldg * 64 + p) * 16 + cp) * 2 + 1];
            v[2 * i] = pr * br - pi * bi; v[2 * i + 1] = pr * bi + pi * br;
        }
        u32x4 o; o[0] = pk2bf(v[0], v[1]); o[1] = pk2bf(v[2], v[3]); o[2] = pk2bf(v[4], v[5]); o[3] = pk2bf(v[6], v[7]);
        *(u32x4*)(WSm + ((size_t)lg * 512 + kr) * 256 + ncq * 8) = o;
    }
}
__device__ __forceinline__ void s5_gemm_s(const Ctx& c, int layer, int tile, unsigned char* lds) {
    const int nt = tile & 1, mt = (tile >> 1) % 5, g = tile / 10;
    const bf16* UH = c.w<bf16>(WS_UH) + (size_t)g * NCH5 * 768;
    f32x4 acc[4][4];
    const int bc = nt * 128 + (c.tid & 15) * 8;
    gemm_tile<false, 0>(c.tid, lds, UH, [&](int r) __attribute__((always_inline)) { int row = mt * 128 + r; row = row < NCH5 ? row : NCH5 - 1; return (unsigned)(row * 768); },
                     c.w<bf16>(WS_WS) + (size_t)(layer * 16 + g) * 512 * 256, (unsigned)bc, 256, true, 512, acc);
    EPI_COORDS;
    float* SALL = c.w<float>(WS_SALL) + (size_t)g * NCH5 * 256;
#pragma unroll
    for (int m = 0; m < 4; ++m)
#pragma unroll
        for (int n = 0; n < 4; ++n) {
            const int row = mt * 128 + wr * 64 + m * 16 + fr, col = nt * 128 + wc * 64 + n * 16 + fq * 4;
            if (row < NCH5) *(f32x4*)(SALL + (size_t)row * 256 + col) = acc[m][n];
        }
}
__device__ __forceinline__ void s5_recur(const Ctx& c, int layer, int gtid, int gthreads) {
    const float* S5P = c.w<float>(WS_S5P);
    for (int it = gtid; it < 4 * 16 * 2 * 64; it += gthreads) {
        const int p = it & 63, d = (it >> 6) & 1, g = (it >> 7) & 15, b = it >> 11;
        const int ldg = (layer * 2 + d) * 16 + g;
        const float ar = S5P[((size_t)(ldg * 64 + p) * 33 + 32) * 2], ai = S5P[((size_t)(ldg * 64 + p) * 33 + 32) * 2 + 1];
        const float* S = c.w<float>(WS_SALL) + ((size_t)g * NCH5 + b * 136) * 256 + d * 128 + p * 2;
        bf16* H = c.w<bf16>(WS_UH) + ((size_t)g * NCH5 + b * 136) * 768 + 512 + d * 128 + p * 2;
        float hr = 0.f, hi = 0.f;
        for (int s0 = 0; s0 < 136; s0 += 8) {
            float2 sv[8]; int jj[8];
#pragma unroll
            for (int i = 0; i < 8; ++i) { const int s = s0 + i; jj[i] = d == 0 ? s : (s < 8 ? 7 - s : 143 - s); sv[i] = *(const float2*)(S + (size_t)jj[i] * 256); }
#pragma unroll
            for (int i = 0; i < 8; ++i) {
                *(unsigned*)(H + (size_t)jj[i] * 768) = pk2bf(hr, hi);
                const float nr = ar * hr - ai * hi + sv[i].x, ni = ar * hi + ai * hr + sv[i].y; hr = nr; hi = ni;
            }
        }
    }
}
__device__ __forceinline__ void s5_gemm_y(const Ctx& c, int layer, int tile, unsigned char* lds) {
    const int nt = tile & 3, mt = (tile >> 2) % 5, g = tile / 20;
    const bf16* UH = c.w<bf16>(WS_UH) + (size_t)g * NCH5 * 768;
    f32x4 acc[4][4];
    const int bc = nt * 128 + (c.tid & 15) * 8;
    gemm_tile<false, 0>(c.tid, lds, UH, [&](int r) __attribute__((always_inline)) { int row = mt * 128 + r; row = row < NCH5 ? row : NCH5 - 1; return (unsigned)(row * 768); },
                     c.w<bf16>(WS_WY) + (size_t)(layer * 16 + g) * 768 * 512, (unsigned)bc, 512, true, 768, acc);
    EPI_COORDS;
    bf16* G5 = c.w<bf16>(WS_G5);
#pragma unroll
    for (int m = 0; m < 4; ++m) {
        const int row = mt * 128 + wr * 64 + m * 16 + fr;
        if (row < NCH5) {
            const int b = row / 136, jj = row % 136;
#pragma unroll
            for (int n = 0; n < 4; ++n) {
                const int col = nt * 128 + wc * 64 + n * 16 + fq * 4, t = col >> 4, cc = col & 15;
                const size_t tok = (size_t)b * LT + jj * 32 + t;
                uint2 o; o.x = pk2bf(gelu_tanh(acc[m][n][0]), gelu_tanh(acc[m][n][1])); o.y = pk2bf(gelu_tanh(acc[m][n][2]), gelu_tanh(acc[m][n][3]));
                *(uint2*)(G5 + tok * 256 + g * 16 + cc) = o;
            }
        }
    }
}


__device__ __forceinline__ void ssd_vectors(const Ctx& c, int layer, int b, int j, int h, float* vec) {
    const int tid = c.tid, lane = tid & 63;
    __syncthreads();
    float dtf = 0.f, dtr = 0.f, af = 0.f, ar = 0.f;
    if (tid < 128) {
        const float* DTR = c.w<float>(WS_DTR) + ((size_t)b * LT + j * 128 + tid) * 8;
        dtf = softplus_f(DTR[h] + c.in(24)[(layer * 2 + 0) * 4 + h]);
        dtr = softplus_f(DTR[4 + h] + c.in(24)[(layer * 2 + 1) * 4 + h]);
        af = -dtf * expf(c.in(25)[(layer * 2 + 0) * 4 + h]); ar = -dtr * expf(c.in(25)[(layer * 2 + 1) * 4 + h]);
    }
    float sf = af, sr = ar;
#pragma unroll
    for (int o = 1; o < 64; o <<= 1) { const float tf = __shfl_up(sf, o), tr = __shfl_up(sr, o); if (lane >= o) { sf += tf; sr += tr; } }
    if (tid == 63) { vec[1026] = sf; vec[1027] = sr; }
    __syncthreads();
    if (tid >= 64 && tid < 128) { sf += vec[1026]; sr += vec[1027]; }
    if (tid == 127) { vec[1024] = sf; vec[1025] = sr; }
    __syncthreads();
    if (tid < 128) {
        const float totf = vec[1024], totr = vec[1025], cer = sr - ar;
        vec[tid] = dtf; vec[128 + tid] = dtr; vec[256 + tid] = sf; vec[384 + tid] = cer;
        vec[512 + tid] = dtf * __expf(totf - sf); vec[640 + tid] = dtr * __expf(cer);
        vec[768 + tid] = __expf(sf); vec[896 + tid] = __expf(totr - cer);
    }
    __syncthreads();
}
__device__ __forceinline__ void ssd_s1(const Ctx& c, int layer, int tile, unsigned char* lds) {
    const int h = tile & 3, j = (tile >> 2) % NCH, b = tile / (4 * NCH);
    float* vec = (float*)lds;
    ssd_vectors(c, layer, b, j, h, vec);
    const int tid = c.tid, lane = tid & 63, wid = tid >> 6, fr = lane & 15, fq = lane >> 4, grp = h >> 1;
    const bf16* XT = c.w<bf16>(WS_XT) + ((size_t)b * 256 + h * 64 + wid * 16 + fr) * LT + j * 128;
    const bf16* BT = c.w<bf16>(WS_BT) + ((size_t)b * 256 + grp * 128 + fr) * LT + j * 128;
    f32x4 acc[2][8];
#pragma unroll
    for (int d = 0; d < 2; ++d)
#pragma unroll
        for (int ns = 0; ns < 8; ++ns) acc[d][ns] = (f32x4){0.f, 0.f, 0.f, 0.f};
#pragma unroll
    for (int kk = 0; kk < 4; ++kk) {
        float xv[8], xa[8], xb[8];
        unpack8v(*(const u32x4*)(XT + 32 * kk + 8 * fq), xv);
        const f32x4 w0 = *(const f32x4*)(vec + 512 + 32 * kk + 8 * fq), w1 = *(const f32x4*)(vec + 512 + 32 * kk + 8 * fq + 4);
        const f32x4 r0 = *(const f32x4*)(vec + 640 + 32 * kk + 8 * fq), r1 = *(const f32x4*)(vec + 640 + 32 * kk + 8 * fq + 4);
#pragma unroll
        for (int i = 0; i < 4; ++i) { xa[i] = xv[i] * w0[i]; xa[4 + i] = xv[4 + i] * w1[i]; xb[i] = xv[i] * r0[i]; xb[4 + i] = xv[4 + i] * r1[i]; }
        const bf16x8 xf = pack8(xa), xr = pack8(xb);
#pragma unroll
        for (int ns = 0; ns < 8; ++ns) {
            const bf16x8 bfrag = *(const bf16x8*)(BT + (size_t)ns * 16 * LT + 32 * kk + 8 * fq);
            acc[0][ns] = __builtin_amdgcn_mfma_f32_16x16x32_bf16(bfrag, xf, acc[0][ns], 0, 0, 0);
            acc[1][ns] = __builtin_amdgcn_mfma_f32_16x16x32_bf16(bfrag, xr, acc[1][ns], 0, 0, 0);
        }
    }
    const size_t sidx = (size_t)((b * NCH + j) * 4 + h) * 2;
    float* ST = c.w<float>(WS_ST);
#pragma unroll
    for (int d = 0; d < 2; ++d)
#pragma unroll
        for (int ns = 0; ns < 8; ++ns) *(f32x4*)(ST + ((sidx + d) * 64 + wid * 16 + fr) * 128 + ns * 16 + 4 * fq) = acc[d][ns];
    if (tid == 0) { float* TOT = c.w<float>(WS_TOT); TOT[sidx] = __expf(vec[1024]); TOT[sidx + 1] = __expf(vec[1025]); }
}
__device__ __forceinline__ void ssd_recur(const Ctx& c, int gtid, int gthreads) {
    const float* ST = c.w<float>(WS_ST); bf16* HIN = c.w<bf16>(WS_HIN); const float* TOT = c.w<float>(WS_TOT);
    for (int it = gtid; it < 4 * 4 * 2 * 64 * 32; it += gthreads) {
        const int n4 = it & 31, p = (it >> 5) & 63, d = (it >> 11) & 1, h = (it >> 12) & 3, b = it >> 14;
        f32x4 H = (f32x4){0.f, 0.f, 0.f, 0.f};
#pragma unroll 1
        for (int s0 = 0; s0 < NCH; s0 += 17) {
            f32x4 sv[17]; float tv[17];
#pragma unroll
            for (int i = 0; i < 17; ++i) { const int s = s0 + i, jj = d == 0 ? s : (s < 2 ? 1 - s : 35 - s);
                const size_t idx = (size_t)((b * NCH + jj) * 4 + h) * 2 + d;
                sv[i] = *(const f32x4*)(ST + (idx * 64 + p) * 128 + n4 * 4); tv[i] = TOT[idx]; }
#pragma unroll
            for (int i = 0; i < 17; ++i) { const int s = s0 + i, jj = d == 0 ? s : (s < 2 ? 1 - s : 35 - s);
                const size_t idx = (size_t)((b * NCH + jj) * 4 + h) * 2 + d;
                uint2 o; o.x = pk2bf(H[0], H[1]); o.y = pk2bf(H[2], H[3]);
                *(uint2*)(HIN + (idx * 64 + p) * 128 + n4 * 4) = o;
                H = H * tv[i] + sv[i]; }
        }
    }
}
__device__ __forceinline__ void ssd_s3(const Ctx& c, int layer, int tile, unsigned char* lds) {
    const int half = tile & 1, h = (tile >> 1) & 3, j = (tile >> 3) % NCH, b = tile / (8 * NCH);
    float* vec = (float*)lds;
    ssd_vectors(c, layer, b, j, h, vec);
    const int tid = c.tid, lane = tid & 63, wid = tid >> 6, fr = lane & 15, fq = lane >> 4, grp = h >> 1;
    const size_t tok0 = (size_t)b * LT + j * 128;
    const bf16* XS = c.w<bf16>(WS_XBCS) + tok0 * 768;
    const int l = 64 * half + 16 * wid + fr;
    bf16x8 cf[4];
#pragma unroll
    for (int k = 0; k < 4; ++k) cf[k] = *(const bf16x8*)(XS + (size_t)l * 768 + 512 + grp * 128 + 32 * k + 8 * fq);
    f32x4 G[8];
#pragma unroll
    for (int st = 0; st < 8; ++st) {
        G[st] = (f32x4){0.f, 0.f, 0.f, 0.f};
#pragma unroll
        for (int k = 0; k < 4; ++k) {
            const bf16x8 bfrag = *(const bf16x8*)(XS + (size_t)(16 * st + fr) * 768 + 256 + grp * 128 + 32 * k + 8 * fq);
            G[st] = __builtin_amdgcn_mfma_f32_16x16x32_bf16(bfrag, cf[k], G[st], 0, 0, 0);
        }
    }
    {
        const float csf_l = vec[256 + l], cer_l = vec[384 + l];
#pragma unroll
        for (int st = 0; st < 8; ++st) {
            const int sb = 16 * st + 4 * fq;
            const f32x4 dtf_s = *(const f32x4*)(vec + sb), dtr_s = *(const f32x4*)(vec + 128 + sb), csf_s = *(const f32x4*)(vec + 256 + sb), cer_s = *(const f32x4*)(vec + 384 + sb);
#pragma unroll
            for (int jj = 0; jj < 4; ++jj) {
                const int s = sb + jj;
                float w = 0.f;
                if (s <= l) w += dtf_s[jj] * __expf(csf_l - csf_s[jj]);
                if (s >= l) w += dtr_s[jj] * __expf(cer_s[jj] - cer_l);
                G[st][jj] *= w;
            }
        }
    }
    f32x4 y[4];
#pragma unroll
    for (int pt = 0; pt < 4; ++pt) y[pt] = (f32x4){0.f, 0.f, 0.f, 0.f};
    const bf16* XT = c.w<bf16>(WS_XT) + ((size_t)b * 256 + h * 64 + fr) * LT + j * 128;
#pragma unroll
    for (int kk = 0; kk < 4; ++kk) {
        float t8[8];
#pragma unroll
        for (int i = 0; i < 4; ++i) { t8[i] = G[2 * kk][i]; t8[4 + i] = G[2 * kk + 1][i]; }
        const bf16x8 pf = pack8(t8);
#pragma unroll
        for (int pt = 0; pt < 4; ++pt) {
            const bf16* xp = XT + (size_t)pt * 16 * LT + 32 * kk + 4 * fq;
            const s16x4 lo = *(const s16x4*)xp, hv = *(const s16x4*)(xp + 16);
            const bf16x8 xf = (bf16x8){lo[0], lo[1], lo[2], lo[3], hv[0], hv[1], hv[2], hv[3]};
            y[pt] = __builtin_amdgcn_mfma_f32_16x16x32_bf16(xf, pf, y[pt], 0, 0, 0);
        }
    }
    const bf16* HIN = c.w<bf16>(WS_HIN) + (size_t)((b * NCH + j) * 4 + h) * 2 * 8192;
#pragma unroll
    for (int d = 0; d < 2; ++d) {
        const float e = vec[(d == 0 ? 768 : 896) + l];
#pragma unroll
        for (int k = 0; k < 4; ++k) {
            float t8[8]; unpack8v(__builtin_bit_cast(u32x4, cf[k]), t8);
#pragma unroll
            for (int i = 0; i < 8; ++i) t8[i] *= e;
            const bf16x8 cs = pack8(t8);
#pragma unroll
            for (int pt = 0; pt < 4; ++pt) {
                const bf16x8 hf = *(const bf16x8*)(HIN + ((size_t)d * 64 + 16 * pt + fr) * 128 + 32 * k + 8 * fq);
                y[pt] = __builtin_amdgcn_mfma_f32_16x16x32_bf16(hf, cs, y[pt], 0, 0, 0);
            }
        }
    }
    float* Y = c.w<float>(WS_YSSD) + tok0 * 256;
#pragma unroll
    for (int pt = 0; pt < 4; ++pt) *(f32x4*)(Y + (size_t)l * 256 + h * 64 + 16 * pt + 4 * fq) = y[pt];
}

__device__ __forceinline__ void ph_mix1(Ctx& c, int layer, int bid, int G, unsigned char* lds) {
    const int ncv = (CVT_MOE_TILES - bid + G - 1) / G;
    if (bid & 1) for (int j = 0; j < ncv; ++j) { asm volatile("" : "+v"(c.tid)); PR_BEGIN(131); cvt_moe(c, layer, bid + j * G); PR_END(131); }
    for (int t = bid; t < 1792; t += G) {
        asm volatile("" : "+v"(c.tid)); asm volatile("" : "+s"(c.p));
        if (t < 512) { PR_BEGIN(130); attn_tile(c, layer, t, lds); PR_END(130); } else if (t < 1056) { PR_BEGIN(132); ssd_s1(c, layer, t - 512, lds); PR_END(132); } else if (t < 1216) s5_gemm_s(c, layer, t - 1056, lds); else { PR_BEGIN(134); attn_tile(c, layer, t - 1216 + 512, lds); PR_END(134); }
    }
    if (!(bid & 1)) for (int j = 0; j < ncv; ++j) { asm volatile("" : "+v"(c.tid)); PR_BEGIN(131); cvt_moe(c, layer, bid + j * G); PR_END(131); }
}

constexpr int PH_PER_LAYER = 12, N_PHASES = 2 + 2 * PH_PER_LAYER;

__global__ void __launch_bounds__(NTHR, 2) mk_fwd(Params prm) {
    __shared__ __attribute__((aligned(16))) unsigned char smem_raw[GEMM_LDS + 512 + 1536];
    float* smem = (float*)(smem_raw + GEMM_LDS);
    Ctx c; c.p = (const CAS Params*)__builtin_amdgcn_kernarg_segment_ptr(); c.smf = smem; c.tid = threadIdx.x;
    const int G = gridDim.x, bid = blockIdx.x;
    const int gthreads = G * NTHR, nwaves = gthreads >> 6;
#define gtid (bid * NTHR + c.tid)
#define gw ((bid * NTHR + c.tid) >> 6)
    int* smi = (int*)(smem + 16);
#if MK_SINGLE
    volatile unsigned* bst = (volatile unsigned*)(smem + 120);
    if (c.tid == 0) { bst[0] = 0u; bst[1] = 0u; }
    __syncthreads();
    XcdBarrier bar = xcd_barrier_post(c.w<unsigned>(WS_CTL) + CW_BAR, bst);
#endif
    unsigned long long pr_t0 = 0ull; c.pracc = 0ull; c.prt = 0ull;
#define pr_acc c.pracc
#if MK_SINGLE
    if (PROBE_SP == 102) { pr_t0 = __builtin_amdgcn_s_memrealtime(); xcd_barrier(bar); pr_acc += __builtin_amdgcn_s_memrealtime() - pr_t0; }
#endif
    for (int ph = prm.ph_lo; ph < prm.ph_hi; ++ph) {
        if (PROBE_SP >= 0) pr_t0 = __builtin_amdgcn_s_memrealtime();
        asm volatile("" : "+s"(c.p));
        { int t_ = threadIdx.x; asm volatile("" : "+v"(t_)); c.tid = t_; }
        if (ph == 0) { ph_prep(c, gtid, gthreads, bid, G, (float*)smem_raw); PR_BEGIN(124); cvt_small(c, gtid, gthreads); PR_END(124); }
        else if (ph == 1) ph_norm1(c, 0, gw, nwaves, smem_raw);
        else {
            const int layer = (ph - 2) / PH_PER_LAYER, sp = (ph - 2) % PH_PER_LAYER;
            switch (sp) {
            case 0: for (int t = bid; t < 136 * 18 + (layer == 0 ? 5120 : 0); t += G) { asm volatile("" : "+v"(c.tid)); if (t < 136 * 18) ph_inproj_mfma(c, layer, t, smem_raw); else ph_prepB(c, t - 136 * 18); } break;
            case 1: for (int t = bid; t < 272 * 3; t += G) ph_minipost(c, layer, t); break;
            case 2: ph_mix1(c, layer, bid, G, smem_raw); break;
            case 3: s5_recur(c, layer, gtid, gthreads); ssd_recur(c, gtid, gthreads); break;
            case 4: for (int t = bid; t < 1088 + 320; t += G) { asm volatile("" : "+v"(c.tid)); asm volatile("" : "+s"(c.p)); if (t < 1088) ssd_s3(c, layer, t, smem_raw); else s5_gemm_y(c, layer, t - 1088, smem_raw); } break;
            case 5: for (int t = bid; t < 136 * 2 + NT / 4; t += G) { asm volatile("" : "+v"(c.tid)); if (t < 136 * 2) ph_glu_mfma(c, layer, t, smem_raw); else ph_gates(c, layer, t - 136 * 2); } break;
            case 6: for (int t = bid; t < 136 * 8; t += G) ph_outproj_mfma(c, layer, t, smem_raw); break;
            case 7: ph_norm2(c, layer, bid, G, smem_raw, (int*)(smem_raw + GEMM_LDS + 512)); break;
            case 8: ph_assign(c, layer, bid, G, (int*)smem_raw, (const int*)(smem_raw + GEMM_LDS + 512)); break;
            case 9: moe_offsets(c, layer, smi); for (int t = bid; t < (NSLOT / 128) * 8; t += G) ph_moe1_mfma(c, layer, t, smi, smem_raw); break;
            case 10: moe_offsets(c, layer, smi); for (int t = bid; t < (NSLOT / 128) * 8; t += G) ph_moe2_mfma(c, layer, t, smi, smem_raw); break;
            case 11: moe_offsets(c, layer, smi); ph_combine(c, layer, gw, nwaves, smi, smem_raw); break;
            }
        }
#if MK_SINGLE
        if (ph + 1 < prm.ph_hi) xcd_barrier(bar);
#endif
        if (PROBE_SP >= 0 && ((PROBE_SP < 100 && ph >= 2 && (ph - 2) % PH_PER_LAYER == PROBE_SP) || (PROBE_SP == 100 && ph == 0) || (PROBE_SP == 101 && ph == 1))) pr_acc += __builtin_amdgcn_s_memrealtime() - pr_t0;
    }
#if MK_SINGLE
    if (PROBE_SP == 200) { for (int i = 0; i < 16; ++i) xcd_barrier(bar); }
#endif
    if (PROBE_SP >= 0 && PROBE_SP < 200 && bid == 0 && c.tid == 0) { const unsigned long long t1 = __builtin_amdgcn_s_memrealtime(); while (__builtin_amdgcn_s_memrealtime() - t1 < 8ull * pr_acc) __builtin_amdgcn_s_sleep(8); }
}
}

extern "C" void kernel_launch(void* const* d_in, const int* in_sizes, int n_in, void* d_out, int out_size, void* d_ws, size_t ws_size, hipStream_t stream) {
    static int grid = 0;
    if (grid == 0) {
        if (n_in != 37 || ws_size < WS_END) { fprintf(stderr, "kernel_launch: need 37 inputs and %zu bytes of workspace; got %d, %zu\n", (size_t)WS_END, n_in, ws_size); grid = -1; return; }
        int dev = 0, cus = 0, per_cu = 0;
        hipGetDevice(&dev); hipDeviceGetAttribute(&cus, hipDeviceAttributeMultiprocessorCount, dev);
        if (hipOccupancyMaxActiveBlocksPerMultiprocessor(&per_cu, (const void*)mk_fwd, NTHR, 0) != hipSuccess || per_cu < 1) per_cu = 1;
        if (per_cu > 4) per_cu = 4;
        grid = cus * per_cu;
    }
    if (grid < 0) return;
    hipMemsetAsync((char*)d_ws + WS_CTL, 0, CTL_BYTES, stream);
    Params p{};
    for (int i = 0; i < 37; ++i) p.in[i] = (const float*)d_in[i];
    p.out = (float*)d_out; p.ws = (unsigned char*)d_ws;
#if MK_SINGLE
    p.ph_lo = 0; p.ph_hi = N_PHASES;
    void* args[] = {&p};
    hipError_t e = hipLaunchCooperativeKernel((const void*)mk_fwd, dim3(grid), dim3(NTHR), args, 0, stream);
    if (e != hipSuccess) fprintf(stderr, "cooperative launch failed: %s (grid %d)\n", hipGetErrorString(e), grid);
#else
    for (int ph = 0; ph < N_PHASES; ++ph) {
        p.ph_lo = ph; p.ph_hi = ph + 1;
        hipLaunchKernelGGL(mk_fwd, dim3(grid), dim3(NTHR), 0, stream, p);
    }
#endif
}
```

```cpp
#include <hip/hip_runtime.h>
#include <cstdio>
#include <cstdint>

#ifndef PROBE_SP
#define PROBE_SP -1
#endif
#ifndef MK_SINGLE
#define MK_SINGLE 1
#endif

namespace {
typedef unsigned short bf16;
#define LAS __attribute__((address_space(3)))

constexpr int D = 1024, NB = 4, SEQ = 4096, CTX = 256, LT = SEQ + CTX, NT = NB * LT;
constexpr int DIN = 2312;
constexpr int C_U = 0, C_GQ = 256, C_GK = 512, C_GV = 640, C_Z = 768, C_XBC = 1024, C_DT = 1792, C_WQ = 1800, C_WK = 2056, C_WV = 2184;
constexpr int NEXP = 32, DE = 512;
constexpr int NSLOT = 2 * NT + NEXP * 128;
constexpr float EPS = 1e-6f;
constexpr int NTHR = 256;

constexpr size_t al(size_t x) { return (x + 255) & ~(size_t)255; }
constexpr size_t WS_CTL = 0, CTL_BYTES = 1u << 20;
constexpr size_t WS_MOD = WS_CTL + CTL_BYTES;
constexpr size_t WS_S5A = al(WS_MOD + 2 * 5 * 6144 * 4);
constexpr size_t WS_S5BB = al(WS_S5A + 2 * 2 * 16 * 64 * 2 * 4);
constexpr size_t WS_ROPE = al(WS_S5BB + 2 * 2 * 16 * 64 * 16 * 2 * 4);
constexpr size_t WS_X = al(WS_ROPE + 64 * 16 * 2 * 4);
constexpr size_t WS_HA = al(WS_X + (size_t)NT * D * 4);
constexpr size_t WS_Z = al(WS_HA + (size_t)NT * D * 2);
constexpr size_t WS_XBR = al(WS_Z + (size_t)NT * 256 * 2);
constexpr size_t WS_GQ = al(WS_XBR + (size_t)NT * 768 * 2);
constexpr size_t WS_GK = al(WS_GQ + (size_t)NT * 256 * 2);
constexpr size_t WS_GV = al(WS_GK + (size_t)NT * 128 * 2);
constexpr size_t WS_WQ = al(WS_GV + (size_t)NT * 128 * 2);
constexpr size_t WS_WK = al(WS_WQ + (size_t)NT * 256 * 2);
constexpr size_t WS_WV = al(WS_WK + (size_t)NT * 128 * 2);
constexpr size_t WS_XBCS = al(WS_WV + (size_t)NT * 128 * 2);
constexpr size_t WS_YSSD = al(WS_XBCS + (size_t)NT * 768 * 2);
constexpr size_t WS_G5 = al(WS_YSSD + (size_t)NT * 256 * 4);
constexpr size_t WS_MIX = al(WS_G5 + (size_t)NT * 256 * 2);
constexpr size_t WS_OUT = WS_Z;
constexpr size_t WS_ACT = al(WS_OUT + (size_t)NSLOT * D * 2);
static_assert(WS_ACT + (size_t)NSLOT * DE * 2 <= WS_MIX, "MoE-stage alias must end before MIX");
constexpr size_t WS_TOKE = al(WS_MIX + (size_t)NT * D * 2);
constexpr size_t WS_TOKP = al(WS_TOKE + (size_t)NT * 2 * 4);
constexpr size_t WS_TOKW = al(WS_TOKP + (size_t)NT * 2 * 4);
constexpr size_t WS_LIST = al(WS_TOKW + (size_t)NT * 2 * 4);
constexpr size_t WS_DTR = al(WS_LIST + (size_t)NEXP * NT * 4);
constexpr int NCH5 = NT / 32;
constexpr size_t WS_S5P = al(WS_DTR + (size_t)NT * 8 * 4);
constexpr size_t WS_KLAG = al(WS_S5P + (size_t)2 * 2 * 16 * 64 * 33 * 2 * 4);
constexpr size_t WS_WY = al(WS_KLAG + (size_t)2 * 16 * 2 * 32 * 256 * 4);
constexpr size_t WS_WS = al(WS_WY + (size_t)2 * 16 * 768 * 512 * 2);
constexpr size_t WS_UH = al(WS_WS + (size_t)2 * 16 * 512 * 256 * 2);
constexpr size_t WS_SALL = al(WS_UH + (size_t)16 * NCH5 * 768 * 2);
constexpr int NCH = LT / 128;
constexpr size_t WS_XT = al(WS_SALL + (size_t)16 * NCH5 * 256 * 4);
constexpr size_t WS_BT = al(WS_XT + (size_t)NB * 256 * LT * 2);
constexpr size_t WS_ST = al(WS_BT + (size_t)NB * 256 * LT * 2);
constexpr size_t WS_HIN = al(WS_ST + (size_t)NB * NCH * 8 * 8192 * 4);
constexpr size_t WS_TOT = al(WS_HIN + (size_t)NB * NCH * 8 * 8192 * 2);
constexpr size_t WS_BCNT = al(WS_TOT + (size_t)NB * NCH * 8 * 4);
constexpr size_t WS_WDT = al(WS_BCNT + 1024 * 32 * 4);
constexpr size_t WS_RWT = al(WS_WDT + 2 * 8 * 1024 * 4);
constexpr int DINV = 2304;
constexpr size_t WS_BIN = al(WS_RWT + 2 * 36 * 1024 * 4);
constexpr size_t WS_BOUT = al(WS_BIN + (size_t)2 * D * DINV * 2);
constexpr size_t WS_BGLU = al(WS_BOUT + (size_t)2 * D * D * 2);
constexpr size_t WS_BGU = al(WS_BGLU + (size_t)2 * 256 * 256 * 2);
constexpr size_t WS_BDN = al(WS_BGU + (size_t)NEXP * D * 1024 * 2);
constexpr size_t WS_END = al(WS_BDN + (size_t)NEXP * DE * D * 2);
constexpr int CW_CNT = 8192;
constexpr int CW_BAR = 4096;
constexpr int CW_NROLE = 64;
constexpr int CW_CUKEY = 32768;

struct Params {
    const float* in[37];
    float* out;
    unsigned char* ws;
    int ph_lo, ph_hi;
};

typedef short bf16x8 __attribute__((ext_vector_type(8)));
typedef short s16x4 __attribute__((ext_vector_type(4)));
typedef float f32x4 __attribute__((ext_vector_type(4)));
typedef unsigned u32x4 __attribute__((ext_vector_type(4)));
__device__ __forceinline__ float bf2f(bf16 v) { return __uint_as_float(((unsigned)v) << 16); }
typedef float f32x2 __attribute__((ext_vector_type(2)));
typedef __bf16 bf16x2_t __attribute__((ext_vector_type(2)));
__device__ __forceinline__ bf16 f2bf(float f) { return __builtin_bit_cast(bf16, (__bf16)f); }
__device__ __forceinline__ float silu_f(float x) { return x / (1.f + __expf(-x)); }
__device__ __forceinline__ float sigmoid_f(float x) { return 1.f / (1.f + __expf(-x)); }
__device__ __forceinline__ float gelu_tanh(float x) { const float u = 0.7978845608028654f * (x + 0.044715f * x * x * x); return 0.5f * x * (1.f + tanhf(u)); }
__device__ __forceinline__ float softplus_f(float x) { return fmaxf(x, 0.f) + log1pf(__expf(-fabsf(x))); }
__device__ __forceinline__ float wave_sum(float v) {
#pragma unroll
    for (int o = 1; o < 64; o <<= 1) v += __shfl_xor(v, o);
    return v;
}
__device__ __forceinline__ float block_sum(float v, float* red) {
    v = wave_sum(v);
    __syncthreads();
    if ((threadIdx.x & 63) == 0) red[threadIdx.x >> 6] = v;
    __syncthreads();
    return red[0] + red[1] + red[2] + red[3];
}
__device__ __forceinline__ unsigned pk2bf(float lo, float hi) { const f32x2 v = {lo, hi}; return __builtin_bit_cast(unsigned, __builtin_convertvector(v, bf16x2_t)); }
__device__ __forceinline__ void unpack8v(const u32x4 v, float (&f)[8]) {
    f[0] = __uint_as_float(v[0] << 16); f[1] = __uint_as_float(v[0] & 0xffff0000u);
    f[2] = __uint_as_float(v[1] << 16); f[3] = __uint_as_float(v[1] & 0xffff0000u);
    f[4] = __uint_as_float(v[2] << 16); f[5] = __uint_as_float(v[2] & 0xffff0000u);
    f[6] = __uint_as_float(v[3] << 16); f[7] = __uint_as_float(v[3] & 0xffff0000u);
}
__device__ __forceinline__ bf16x8 pack8(const float (&f)[8]) {
    u32x4 v; v[0] = pk2bf(f[0], f[1]); v[1] = pk2bf(f[2], f[3]); v[2] = pk2bf(f[4], f[5]); v[3] = pk2bf(f[6], f[7]);
    return __builtin_bit_cast(bf16x8, v);
}
__device__ __forceinline__ f32x4 bf4(const uint2 u) { return (f32x4){__uint_as_float(u.x << 16), __uint_as_float(u.x & 0xffff0000u), __uint_as_float(u.y << 16), __uint_as_float(u.y & 0xffff0000u)}; }
__device__ __forceinline__ uint2 pack4(const f32x4 v) { uint2 o; o.x = pk2bf(v[0], v[1]); o.y = pk2bf(v[2], v[3]); return o; }
__device__ __forceinline__ void unpack8(const uint4 v, float (&f)[8]) {
    f[0] = __uint_as_float(v.x << 16); f[1] = __uint_as_float(v.x & 0xffff0000u);
    f[2] = __uint_as_float(v.y << 16); f[3] = __uint_as_float(v.y & 0xffff0000u);
    f[4] = __uint_as_float(v.z << 16); f[5] = __uint_as_float(v.z & 0xffff0000u);
    f[6] = __uint_as_float(v.w << 16); f[7] = __uint_as_float(v.w & 0xffff0000u);
}

#define XB_TMO      128
#define XB_XCNT(j)  (256  + 64 * (j))
#define XB_XSUB(j)  (1280 + 64 * (j))
#define XB_XGEN(j)  (2304 + 64 * (j))
#define XB_TOP      3328
#define XB_TOPGEN   3392
#define XCD_BAR_WORDS 3456
#define XB_SPIN_CAP (1u << 22)
__device__ __forceinline__ unsigned xb_ld(unsigned* p)              { return __hip_atomic_load(p, __ATOMIC_RELAXED, __HIP_MEMORY_SCOPE_AGENT); }
__device__ __forceinline__ unsigned xb_add(unsigned* p, unsigned v) { return __hip_atomic_fetch_add(p, v, __ATOMIC_RELAXED, __HIP_MEMORY_SCOPE_AGENT); }
__device__ __forceinline__ unsigned xb_xcc_id() { return (unsigned)__builtin_amdgcn_s_getreg((3 << 11) | 20) & 0xFu; }
#define XB_SPIN(cond, bar) do { unsigned _sp = 0; while (cond) { __builtin_amdgcn_s_sleep(1); \
    if ((++_sp & 255u) == 0u) { if (xb_ld(&(bar)[XB_TMO])) break; if (_sp > XB_SPIN_CAP) { atomicAdd(&(bar)[XB_TMO], 1u); break; } } } } while (0)
struct XcdBarrier { unsigned* bar; unsigned x; volatile unsigned* st; };
__device__ __forceinline__ XcdBarrier xcd_barrier_post(unsigned* bar, volatile unsigned* st) {
    XcdBarrier b; b.bar = bar; b.x = xb_xcc_id(); b.st = st;
    if (threadIdx.x == 0) (void)xb_add(&bar[XB_XCNT(b.x)], 1u);
    return b;
}
__device__ __forceinline__ void xcd_barrier_complete(unsigned* bar, unsigned x, unsigned& nloc, unsigned& nx) {
    const unsigned G = gridDim.x * gridDim.y * gridDim.z;
    unsigned sum, cnt, mine, sp = 0u;
    for (;;) {
        sum = 0u; cnt = 0u; mine = 0u;
#pragma unroll
        for (unsigned j = 0; j < 16; ++j) { const unsigned c = xb_ld(&bar[XB_XCNT(j)]); sum += c; cnt += (c > 0u) ? 1u : 0u; mine = (j == x) ? c : mine; }
        if (sum == G) break;
        __builtin_amdgcn_s_sleep(1);
        if ((++sp & 255u) == 0u) { if (xb_ld(&bar[XB_TMO])) break; if (sp > XB_SPIN_CAP) { atomicAdd(&bar[XB_TMO], 1u); break; } }
    }
    nloc = mine > 0u ? mine : 1u; nx = cnt > 0u ? cnt : 1u;
}
__device__ __forceinline__ void xcd_barrier(const XcdBarrier& b) {
    asm volatile("s_waitcnt vmcnt(0)" ::: "memory");
    __syncthreads();
    if (threadIdx.x == 0) {
        unsigned* bar = b.bar;
        __builtin_amdgcn_s_waitcnt(0);
        unsigned nloc = b.st[0], nx = b.st[1];
        if (nloc == 0u) { xcd_barrier_complete(bar, b.x, nloc, nx); b.st[0] = nloc; b.st[1] = nx; }
        const unsigned old = xb_add(&bar[XB_XSUB(b.x)], 1u);
        const unsigned gen = old / nloc;
        if (old + 1u == (gen + 1u) * nloc) {
            __builtin_amdgcn_fence(__ATOMIC_RELEASE, "agent");
            asm volatile("s_waitcnt vmcnt(0)" ::: "memory");
            const unsigned og = xb_add(&bar[XB_TOP], 1u);
            const unsigned tg = og / nx;
            if (og + 1u == (tg + 1u) * nx) xb_add(&bar[XB_TOPGEN], 1u);
            else XB_SPIN(xb_ld(&bar[XB_TOPGEN]) == tg, bar);
            __builtin_amdgcn_fence(__ATOMIC_ACQUIRE, "agent");
            xb_add(&bar[XB_XGEN(b.x)], 1u);
            asm volatile("s_waitcnt vmcnt(0)" ::: "memory");
        } else {
            XB_SPIN(xb_ld(&bar[XB_XGEN(b.x)]) == gen, bar);
            __builtin_amdgcn_fence(__ATOMIC_ACQUIRE, "agent");
            asm volatile("s_waitcnt vmcnt(0)" ::: "memory");
        }
    }
    __syncthreads();
}

#define CAS __attribute__((address_space(4)))
#define PR_BEGIN(id) do { if (PROBE_SP == (id)) c.prt = __builtin_amdgcn_s_memrealtime(); } while (0)
#define PR_END(id) do { if (PROBE_SP == (id)) c.pracc += __builtin_amdgcn_s_memrealtime() - c.prt; } while (0)
struct Ctx {
    const CAS Params* p;
    float* smf;
    int tid;
    mutable unsigned long long pracc, prt;
    __device__ __forceinline__ const float* in(int i) const { return p->in[i]; }
    __device__ __forceinline__ float* out() const { return p->out; }
    template <class T> __device__ __forceinline__ T* w(size_t off) const { return (T*)(p->ws + off); }
};

__device__ __forceinline__ const float* xsrc(const Ctx& c, int layer, int n) {
    if (layer == 0) { const int b = n / LT, pos = n % LT; return pos < CTX ? c.in(2) + ((size_t)b * CTX + pos) * D : c.in(0) + ((size_t)b * SEQ + (pos - CTX)) * D; }
    return c.w<float>(WS_X) + (size_t)n * D;
}
__device__ __forceinline__ void ngemm8(const bf16* const (&ar)[8], const float* bcol, int ldb, int K, float (&acc)[8]) {
    for (int k0 = 0; k0 < K; k0 += 8) {
        float w[8];
#pragma unroll
        for (int kk = 0; kk < 8; ++kk) w[kk] = bcol[(size_t)(k0 + kk) * ldb];
#pragma unroll
        for (int r = 0; r < 8; ++r) {
            float a[8]; unpack8(*(const uint4*)(ar[r] + k0), a);
#pragma unroll
            for (int kk = 0; kk < 8; ++kk) acc[r] = fmaf(a[kk], w[kk], acc[r]);
        }
    }
}

__device__ __forceinline__ void ph_prep(Ctx& c, int gtid, int gthreads, int bid, int G, float* lds) {
    float* MOD = c.w<float>(WS_MOD);
    const int tid = c.tid;
    PR_BEGIN(120);
    for (int tile = bid; tile < 192; tile += G) {
        const int l = tile / 96, j0 = (tile % 96) * 64;
        __syncthreads();
        for (int idx = tid; idx < 5 * D; idx += NTHR) { const int r = idx >> 10, k = idx & 1023; lds[idx] = silu_f(r < 4 ? c.in(1)[r * D + k] : c.in(3)[k]); }
        __syncthreads();
        const int jj = tid & 63, kq = tid >> 6;
        const float* aw = c.in(4) + (size_t)l * D * 6144 + j0 + jj;
        float acc[5] = {0.f, 0.f, 0.f, 0.f, 0.f};
        for (int k0 = kq * 256; k0 < kq * 256 + 256; k0 += 32) {
            float w[32];
#pragma unroll
            for (int i = 0; i < 32; ++i) w[i] = aw[(size_t)(k0 + i) * 6144];
#pragma unroll
            for (int i = 0; i < 32; ++i)
#pragma unroll
                for (int r = 0; r < 5; ++r) acc[r] = fmaf(lds[r * D + k0 + i], w[i], acc[r]);
        }
#pragma unroll
        for (int r = 0; r < 5; ++r) lds[5 * D + (kq * 64 + jj) * 5 + r] = acc[r];
        __syncthreads();
        for (int idx = tid; idx < 320; idx += NTHR) { const int j2 = idx / 5, r = idx % 5;
            const float s = lds[5 * D + j2 * 5 + r] + lds[5 * D + (64 + j2) * 5 + r] + lds[5 * D + (128 + j2) * 5 + r] + lds[5 * D + (192 + j2) * 5 + r];
            MOD[(l * 5 + r) * 6144 + j0 + j2] = s + c.in(5)[l * 6144 + j0 + j2]; }
    }
    PR_END(120); PR_BEGIN(121);
    asm volatile("" : "+s"(c.p));
    float* S5A = c.w<float>(WS_S5A); float* S5BB = c.w<float>(WS_S5BB);
    for (int it = gtid; it < 2 * 2 * 16 * 64; it += gthreads) {
        const int ldg = it / 64;
        const float lr = c.in(10)[it], li = c.in(11)[it], dt = expf(c.in(12)[ldg]);
        const float mag = expf(lr * dt), are = mag * cosf(li * dt), aim = mag * sinf(li * dt);
        const float den = lr * lr + li * li;
        const float fre = ((are - 1.f) * lr + aim * li) / den, fim = (aim * lr - (are - 1.f) * li) / den;
        S5A[it * 2] = are; S5A[it * 2 + 1] = aim;
        for (int ch = 0; ch < 16; ++ch) {
            const float br = c.in(13)[(size_t)it * 16 + ch], bi = c.in(14)[(size_t)it * 16 + ch];
            S5BB[((size_t)it * 16 + ch) * 2] = fre * br - fim * bi;
            S5BB[((size_t)it * 16 + ch) * 2 + 1] = fre * bi + fim * br;
        }
    }
    asm volatile("" : "+s"(c.p));
    float* S5P = c.w<float>(WS_S5P);
    for (int it = gtid; it < 2 * 2 * 16 * 64 * 33; it += gthreads) {
        const int ldgp = it / 33, k = it % 33;
        const float lr = c.in(10)[ldgp], li = c.in(11)[ldgp], dt = expf(c.in(12)[ldgp / 64]);
        const float e = expf((float)k * lr * dt), ang = (float)k * li * dt;
        S5P[it * 2] = e * cosf(ang); S5P[it * 2 + 1] = e * sinf(ang);
    }
    PR_END(121); PR_BEGIN(122);
    asm volatile("" : "+s"(c.p));
    float* KLAG = c.w<float>(WS_KLAG);
    for (int tile = (G >= 256 ? bid - 192 + (bid < 192 ? G : 0) : bid); tile < 64; tile += G) {
        const int d = tile & 1, g = (tile >> 1) & 15, l = tile >> 5, ldg = (l * 2 + d) * 16 + g;
        float* LA = lds;
        float* LB = lds + 256;
        float* LC = lds + 2304;
        __syncthreads();
        if (tid < 64) {
            const int ldgp = ldg * 64 + tid;
            const float lr = c.in(10)[ldgp], li = c.in(11)[ldgp], dt = expf(c.in(12)[ldg]);
            const float mag = expf(lr * dt), are = mag * cosf(li * dt), aim = mag * sinf(li * dt), den = lr * lr + li * li;
            LA[tid * 4] = are; LA[tid * 4 + 1] = aim; LA[tid * 4 + 2] = ((are - 1.f) * lr + aim * li) / den; LA[tid * 4 + 3] = (aim * lr - (are - 1.f) * li) / den;
        }
        __syncthreads();
        for (int idx = tid; idx < 1024; idx += NTHR) {
            const int p = idx >> 4, cp = idx & 15;
            const float fre = LA[p * 4 + 2], fim = LA[p * 4 + 3];
            const float br = c.in(13)[((size_t)ldg * 64 + p) * 16 + cp], bi = c.in(14)[((size_t)ldg * 64 + p) * 16 + cp];
            LB[idx * 2] = fre * br - fim * bi; LB[idx * 2 + 1] = fre * bi + fim * br;
            const int cc = idx >> 6, p2 = idx & 63;
            LC[idx * 2] = c.in(15)[(size_t)ldg * 1024 + cc * 64 + p2]; LC[idx * 2 + 1] = c.in(16)[(size_t)ldg * 1024 + cc * 64 + p2];
        }
        __syncthreads();
        const int cp = tid >> 4, cc = tid & 15;
        float acc[32];
#pragma unroll
        for (int k = 0; k < 32; ++k) acc[k] = 0.f;
        for (int p = 0; p < 64; ++p) {
            const float are = LA[p * 4], aim = LA[p * 4 + 1];
            const float bbr = LB[(p * 16 + cp) * 2], bbi = LB[(p * 16 + cp) * 2 + 1], cr = LC[(cc * 64 + p) * 2], ci = LC[(cc * 64 + p) * 2 + 1];
            float zr = cr * bbr - ci * bbi, zi = cr * bbi + ci * bbr;
#pragma unroll
            for (int k = 0; k < 32; ++k) { acc[k] += zr; const float tr = zr * are - zi * aim, ti = zr * aim + zi * are; zr = tr; zi = ti; }
        }
#pragma unroll
        for (int k = 0; k < 32; ++k) KLAG[((size_t)((l * 16 + g) * 2 + d) * 32 + k) * 256 + cp * 16 + cc] = acc[k];
    }
    PR_END(122); PR_BEGIN(123);
    asm volatile("" : "+s"(c.p));
    float* RWT = c.w<float>(WS_RWT);
    for (int it = gtid; it < 2 * 36 * 1024; it += gthreads) { const int k = it & 1023, o = (it >> 10) % 36, l = it / (36 * 1024);
        RWT[it] = o < 4 ? c.in(29)[((size_t)l * D + k) * 4 + o] : c.in(31)[((size_t)l * D + k) * 32 + (o - 4)]; }
    asm volatile("" : "+s"(c.p));
    float* WDT = c.w<float>(WS_WDT);
    for (int it = gtid; it < 2 * 8 * 1024; it += gthreads) { const int k = it & 1023, j = (it >> 10) & 7, l = it >> 13; WDT[it] = c.in(8)[((size_t)l * D + k) * DIN + C_DT + j]; }
    asm volatile("" : "+s"(c.p));
    float* ROPE = c.w<float>(WS_ROPE);
    for (int it = gtid; it < 64 * 16; it += gthreads) {
        const int pos = it / 16, f = it % 16;
        const float inv = powf(10000.0f, -(float)f / 16.0f);
        const float ang = (float)pos * inv;
        ROPE[it * 2] = cosf(ang); ROPE[it * 2 + 1] = sinf(ang);
    }
    PR_END(123);
}

__device__ __forceinline__ void dt_project(const LAS float* wdt, const f32x4 (&h)[4], int lane, float* dst) {
    float mine = 0.f;
#pragma unroll 2
    for (int q = 0; q < 8; ++q) {
        float s = 0.f;
#pragma unroll
        for (int i = 0; i < 4; ++i) { const f32x4 w = *(const LAS f32x4*)(wdt + q * 1024 + (lane + 64 * i) * 4); s += h[i][0] * w[0] + h[i][1] * w[1] + h[i][2] * w[2] + h[i][3] * w[3]; }
        s = wave_sum(s);
        if (lane == q) mine = s;
    }
    if (lane < 8) dst[lane] = mine;
}
__device__ __forceinline__ void ph_norm1(const Ctx& c, int layer, int gw, int nwaves, unsigned char* lds) {
    const int lane = c.tid & 63;
    bf16* HA = c.w<bf16>(WS_HA); float* DTR = c.w<float>(WS_DTR);
    const float* MOD = c.w<float>(WS_MOD) + (size_t)layer * 5 * 6144;
    const float* g = c.in(6) + layer * D;
    __syncthreads();
    for (int i = c.tid; i < 2048; i += NTHR) ((f32x4*)lds)[i] = ((const f32x4*)(c.w<float>(WS_WDT) + (size_t)layer * 8 * 1024))[i];
    __syncthreads();
    const LAS float* wdt = (const LAS float*)lds;
    for (int n = gw; n < NT; n += nwaves) {
        const int b = n / LT, pos = n % LT, mr = pos < CTX ? 4 : b;
        const float* x = xsrc(c, layer, n);
        f32x4 v[4]; float ss = 0.f;
#pragma unroll
        for (int i = 0; i < 4; ++i) { v[i] = *(const f32x4*)(x + (lane + 64 * i) * 4); ss += v[i][0] * v[i][0] + v[i][1] * v[i][1] + v[i][2] * v[i][2] + v[i][3] * v[i][3]; }
        const float rstd = rsqrtf(wave_sum(ss) * (1.f / D) + EPS);
#pragma unroll
        for (int i = 0; i < 4; ++i) {
            const int k = (lane + 64 * i) * 4;
            const f32x4 gv = *(const f32x4*)(g + k), sc = *(const f32x4*)(MOD + mr * 6144 + 1024 + k), sh = *(const f32x4*)(MOD + mr * 6144 + k);
            v[i] = v[i] * rstd * gv * (sc + 1.f) + sh;
            *(uint2*)(HA + (size_t)n * D + k) = pack4(v[i]);
        }
        dt_project(wdt, v, lane, DTR + (size_t)n * 8);
    }
}

constexpr int MP_TOK = 32, MP_RST = 528;
__device__ __forceinline__ void ph_minipost(const Ctx& c, int layer, int tile, unsigned char* lds) {
    const int r = tile % 3, tb = tile / 3, tid = c.tid;
    const int n0 = tb * MP_TOK, b = n0 / LT, pos0 = n0 % LT;
    const bf16* XB = c.w<bf16>(WS_XBR) + r * 256;
    unsigned char* raw = lds;
    bf16* trs = (bf16*)(lds + 34 * MP_RST);
    __syncthreads();
    for (int idx = tid; idx < 34 * 32; idx += NTHR) {
        const int row = idx >> 5, ch = idx & 31, pos = pos0 + row - 1;
        const bool ok = !((row == 0 && (pos0 == 0 || pos0 == CTX)) || (row == 33 && (pos0 + MP_TOK == CTX || pos0 + MP_TOK == LT)));
        u32x4 v = (u32x4){0u, 0u, 0u, 0u};
        if (ok) v = *(const u32x4*)(XB + ((size_t)b * LT + pos) * 768 + ch * 8);
        *(u32x4*)(raw + row * MP_RST + ch * 16) = v;
    }
    __syncthreads();
    const float* cw = c.in(22) + (size_t)layer * 3 * 768 + r * 256; const float* cb = c.in(23) + layer * 768 + r * 256;
    const int ch = tid & 31;
    f32x4 w0[2], w1[2], w2[2], bb[2];
#pragma unroll
    for (int q = 0; q < 2; ++q) { w0[q] = *(const f32x4*)(cw + ch * 8 + 4 * q); w1[q] = *(const f32x4*)(cw + 768 + ch * 8 + 4 * q); w2[q] = *(const f32x4*)(cw + 1536 + ch * 8 + 4 * q); bb[q] = *(const f32x4*)(cb + ch * 8 + 4 * q); }
    bf16* XS = c.w<bf16>(WS_XBCS) + r * 256;
#pragma unroll
    for (int i = 0; i < 4; ++i) {
        const int t = (tid >> 5) + 8 * i;
        float xl[8], xc[8], xr[8], y[8];
        unpack8v(*(const u32x4*)(raw + t * MP_RST + ch * 16), xl); unpack8v(*(const u32x4*)(raw + (t + 1) * MP_RST + ch * 16), xc); unpack8v(*(const u32x4*)(raw + (t + 2) * MP_RST + ch * 16), xr);
#pragma unroll
        for (int q = 0; q < 2; ++q)
#pragma unroll
            for (int j = 0; j < 4; ++j) y[4 * q + j] = silu_f(w1[q][j] * xc[4 * q + j] + w0[q][j] * xl[4 * q + j] + w2[q][j] * xr[4 * q + j] + bb[q][j]);
        const bf16x8 yb = pack8(y);
        *(bf16x8*)(XS + ((size_t)n0 + t) * 768 + ch * 8) = yb;
        if (r < 2) {
#pragma unroll
            for (int j = 0; j < 8; ++j) trs[(ch * 8 + j) * 32 + t] = (bf16)yb[j];
        }
    }
    if (r < 2) {
        __syncthreads();
        bf16* TR = (r == 0 ? c.w<bf16>(WS_XT) : c.w<bf16>(WS_BT)) + (size_t)b * 256 * LT + pos0;
        for (int idx = tid; idx < 1024; idx += NTHR) { const int chn = idx >> 2, pc = idx & 3;
            *(u32x4*)(TR + (size_t)chn * LT + pc * 8) = *(const u32x4*)(trs + chn * 32 + pc * 8); }
    }
}

__device__ __forceinline__ void ph_gates(const Ctx& c, int layer, int tile) {
    const int lane = c.tid & 63, n0 = tile * 8 + (c.tid >> 6) * 2, t4 = lane * 4;
    const float dsk = c.in(26)[layer * 4 + (lane >> 4)];
    const f32x4 gn = *(const f32x4*)(c.in(27) + layer * 256 + t4);
    f32x4 ys[2]; uint2 xr[2], zr[2];
#pragma unroll
    for (int u = 0; u < 2; ++u) { const size_t n = (size_t)n0 + u;
        ys[u] = *(const f32x4*)(c.w<float>(WS_YSSD) + n * 256 + t4); xr[u] = *(const uint2*)(c.w<bf16>(WS_XBCS) + n * 768 + t4); zr[u] = *(const uint2*)(c.w<bf16>(WS_Z) + n * 256 + t4); }
#pragma unroll
    for (int u = 0; u < 2; ++u) {
        const f32x4 x = bf4(xr[u]), z = bf4(zr[u]);
        f32x4 y;
#pragma unroll
        for (int j = 0; j < 4; ++j) y[j] = (ys[u][j] + x[j] * dsk) * silu_f(z[j]);
        const float ss = wave_sum(y[0] * y[0] + y[1] * y[1] + y[2] * y[2] + y[3] * y[3]);
        const float rstd = rsqrtf(ss * (1.f / 256.f) + EPS);
        *(uint2*)(c.w<bf16>(WS_MIX) + ((size_t)n0 + u) * D + 512 + t4) = pack4(y * rstd * gn);
    }
}

__device__ __forceinline__ float half_sum(float v) {
#pragma unroll
    for (int o = 1; o < 32; o <<= 1) v += __shfl_xor(v, o);
    return v;
}
__device__ __forceinline__ void ph_norm2(const Ctx& c, int layer, int bid, int G, unsigned char* hbuf, int* lsm) {
    const int lane = c.tid & 63, wid = c.tid >> 6, hl = lane & 31, half = lane >> 5;
    const int per = (NT + G - 1) / G, n0 = bid * per, n1 = (n0 + per < NT) ? n0 + per : NT;
    __syncthreads();
    const float* X = c.w<float>(WS_X); bf16* HA = c.w<bf16>(WS_HA);
    const float* MOD = c.w<float>(WS_MOD) + (size_t)layer * 5 * 6144;
    const float* g = c.in(7) + layer * D;
    int* TE = c.w<int>(WS_TOKE); float* TW = c.w<float>(WS_TOKW);
    float* Lg = (float*)hbuf; float* Lsc = Lg + D; float* Lsh = Lsc + D; float* Lcw = Lsh + D;
    const float* rwt = c.w<float>(WS_RWT) + (size_t)layer * 36 * 1024;
    const int mrA = (n0 % LT) < CTX ? 4 : n0 / LT;
    for (int i = c.tid; i < D / 4; i += NTHR) {
        ((f32x4*)Lg)[i] = ((const f32x4*)g)[i];
        ((f32x4*)Lsc)[i] = ((const f32x4*)(MOD + mrA * 6144 + 4096))[i];
        ((f32x4*)Lsh)[i] = ((const f32x4*)(MOD + mrA * 6144 + 3072))[i];
#pragma unroll
        for (int e = 0; e < 4; ++e) ((f32x4*)(Lcw + e * D))[i] = ((const f32x4*)(rwt + e * 1024))[i];
    }
    __syncthreads();
    for (int nb = n0 + wid * 2; nb < n1; nb += 8) {
        const bool inr = nb + half < n1;
        const int n = inr ? nb + half : n1 - 1;
        const int b = n / LT, pos = n % LT, mr = pos < CTX ? 4 : b;
        const bool act = inr && !(layer == 1 && pos < CTX);
        if (hl == 0 && inr && !act) { lsm[(n - n0) * 2] = -1; lsm[(n - n0) * 2 + 1] = -1; }
        const float* x = X + (size_t)n * D;
        const float* scp = mr == mrA ? Lsc : MOD + mr * 6144 + 4096;
        const float* shp = mr == mrA ? Lsh : MOD + mr * 6144 + 3072;
        float ss = 0.f;
        PR_BEGIN(110);
        f32x4 v[8];
#pragma unroll
        for (int i = 0; i < 8; ++i) { v[i] = *(const f32x4*)(x + (hl + 32 * i) * 4); ss += v[i][0] * v[i][0] + v[i][1] * v[i][1] + v[i][2] * v[i][2] + v[i][3] * v[i][3]; }
        const float rstd = rsqrtf(half_sum(ss) * (1.f / D) + EPS);
        PR_END(110); PR_BEGIN(111);
        float cg[4] = {0.f, 0.f, 0.f, 0.f};
#pragma unroll
        for (int i = 0; i < 8; ++i) {
            const int k = (hl + 32 * i) * 4;
            const f32x4 h = v[i] * rstd * *(const f32x4*)(Lg + k) * (*(const f32x4*)(scp + k) + 1.f) + *(const f32x4*)(shp + k);
            v[i] = h;
            *(uint2*)(HA + (size_t)n * D + k) = pack4(h);
#pragma unroll
            for (int e = 0; e < 4; ++e) { const f32x4 w = *(const f32x4*)(Lcw + e * D + k); cg[e] += h[0] * w[0] + h[1] * w[1] + h[2] * w[2] + h[3] * w[3]; }
        }
        float mx = -1e30f; int gi = 0; float cl[4];
#pragma unroll
        for (int e = 0; e < 4; ++e) { cl[e] = half_sum(cg[e]) + c.in(30)[layer * 4 + e]; if (cl[e] > mx) { mx = cl[e]; gi = e; } }
        PR_END(111); PR_BEGIN(112);
        float fg[8] = {0.f, 0.f, 0.f, 0.f, 0.f, 0.f, 0.f, 0.f};
        const float* fwt = rwt + (4 + gi * 8) * 1024;
#pragma unroll
        for (int ib = 0; ib < 8; ib += 2) {
            f32x4 w[2][8];
#pragma unroll
            for (int i = 0; i < 2; ++i)
#pragma unroll
                for (int e = 0; e < 8; ++e) w[i][e] = *(const f32x4*)(fwt + e * 1024 + (hl + 32 * (ib + i)) * 4);
#pragma unroll
            for (int i = 0; i < 2; ++i)
#pragma unroll
                for (int e = 0; e < 8; ++e) { const f32x4 h = v[ib + i]; fg[e] += h[0] * w[i][e][0] + h[1] * w[i][e][1] + h[2] * w[i][e][2] + h[3] * w[i][e][3]; }
            asm volatile("" ::: "memory");
        }
#pragma unroll
        for (int e = 0; e < 8; ++e) fg[e] = half_sum(fg[e]);
        PR_END(112); PR_BEGIN(113);
        if (hl == 0 && act) {
            float den = 0.f;
#pragma unroll
            for (int e = 0; e < 4; ++e) den += expf(cl[e] - mx);
            const float pg = 1.f / den;
            float f1 = -1e30f, f2 = -1e30f; int i1 = 0, i2 = 0;
#pragma unroll
            for (int e = 0; e < 8; ++e) {
                const float fv = fg[e] + c.in(32)[layer * 32 + gi * 8 + e];
                if (fv > f1) { f2 = f1; i2 = i1; f1 = fv; i1 = e; } else if (fv > f2) { f2 = fv; i2 = e; }
            }
            const float e2 = expf(f2 - f1), w1 = pg / (1.f + e2), w2 = pg * e2 / (1.f + e2);
            const int ex1 = gi * 8 + i1, ex2 = gi * 8 + i2;
            lsm[(n - n0) * 2] = ex1; lsm[(n - n0) * 2 + 1] = ex2;
            TE[n * 2] = ex1; TE[n * 2 + 1] = ex2; TW[n * 2] = w1; TW[n * 2 + 1] = w2;
        }
        PR_END(113);
    }
    PR_BEGIN(114);
    __syncthreads();
    if (c.tid < 32) {
        const int e = c.tid, ne = (n1 > n0 ? n1 - n0 : 0) * 2;
        int cl_ = 0;
        for (int i = 0; i < ne; ++i) cl_ += (lsm[i] == e) ? 1 : 0;
        c.w<int>(WS_BCNT)[bid * 32 + e] = cl_;
    }
    PR_END(114);
}
__device__ __forceinline__ void ph_assign(const Ctx& c, int layer, int bid, int G, int* wk, const int* lsm) {
    const int e = c.tid & 31, part = c.tid >> 5;
    const int per = (NT + G - 1) / G, n0 = bid * per, n1 = (n0 + per < NT) ? n0 + per : NT;
    const int* BC = c.w<int>(WS_BCNT);
    int before = 0, all = 0;
#pragma unroll 16
    for (int blk = part; blk < G; blk += 8) { const int v = BC[blk * 32 + e]; all += v; before += blk < bid ? v : 0; }
    __syncthreads();
    wk[(part * 32 + e) * 2] = before; wk[(part * 32 + e) * 2 + 1] = all;
    __syncthreads();
    if (c.tid < 32) {
        int base = 0, tot = 0;
#pragma unroll
        for (int p = 0; p < 8; ++p) { base += wk[(p * 32 + e) * 2]; tot += wk[(p * 32 + e) * 2 + 1]; }
        if (bid == 0) c.w<unsigned>(WS_CTL)[CW_CNT + (layer * 32 + e) * 64] = (unsigned)tot;
        int* TP = c.w<int>(WS_TOKP); int* LI = c.w<int>(WS_LIST);
        const int ne = (n1 > n0 ? n1 - n0 : 0) * 2;
        int r = 0;
        for (int i = 0; i < ne; ++i) if (lsm[i] == e) { const int n = n0 + (i >> 1); const int ps = base + r; ++r; TP[n * 2 + (i & 1)] = ps; LI[(size_t)e * NT + ps] = n; }
    }
}

__device__ __forceinline__ void moe_offsets(const Ctx& c, int layer, int* sm) {
    __syncthreads();
    if (c.tid == 0) {
        const unsigned* cnt = c.w<unsigned>(WS_CTL) + CW_CNT + layer * 32 * 64;
        int acc = 0;
        for (int e = 0; e < 32; ++e) { const int ce = (int)__hip_atomic_load(cnt + e * 64, __ATOMIC_RELAXED, __HIP_MEMORY_SCOPE_AGENT); sm[e] = acc; sm[33 + e] = ce; acc += (ce + 127) & ~127; }
        sm[32] = acc;
    }
    __syncthreads();
}
__device__ __forceinline__ int slot_expert(const int* sm, int slot) { int e = 0;
#pragma unroll 1
    for (int i = 1; i < 32; ++i) if (slot >= sm[i]) e = i;
    return e; }

__device__ __forceinline__ void ph_combine(const Ctx& c, int layer, int gw, int nwaves, const int* sm, unsigned char* lds) {
    const int lane = c.tid & 63;
    __syncthreads();
    for (int i = c.tid; i < 2048; i += NTHR) ((f32x4*)lds)[i] = ((const f32x4*)(c.w<float>(WS_WDT) + (size_t)8 * 1024))[i];
    __syncthreads();
    const LAS float* wdt = (const LAS float*)lds;
    const int* TE = c.w<int>(WS_TOKE); const int* TP = c.w<int>(WS_TOKP); const float* TW = c.w<float>(WS_TOKW);
    const bf16* OUT = c.w<bf16>(WS_OUT);
    bf16* HA = c.w<bf16>(WS_HA); float* DTR = c.w<float>(WS_DTR);
    const float* MODn = c.w<float>(WS_MOD) + (size_t)1 * 5 * 6144;
    const float* gnext = c.in(6) + D;
    const int ntok = layer == 1 ? NB * SEQ : NT;
    for (int q = gw; q < ntok; q += 2 * nwaves) {
        int nn[2]; bool ok[2];
#pragma unroll
        for (int u = 0; u < 2; ++u) { int qq = q + u * nwaves; ok[u] = qq < ntok; qq = ok[u] ? qq : q; nn[u] = layer == 1 ? (qq / SEQ) * LT + CTX + (qq % SEQ) : qq; }
        int s0[2], s1[2]; float w0[2], w1[2]; int mr[2];
#pragma unroll
        for (int u = 0; u < 2; ++u) { const int n = nn[u]; mr[u] = (n % LT) < CTX ? 4 : n / LT;
            s0[u] = sm[TE[n * 2]] + TP[n * 2]; s1[u] = sm[TE[n * 2 + 1]] + TP[n * 2 + 1]; w0[u] = TW[n * 2]; w1[u] = TW[n * 2 + 1]; }
        f32x4 xv[2][4], gv[2][4]; uint2 oa[2][4], ob[2][4];
#pragma unroll
        for (int u = 0; u < 2; ++u) { const float* X = c.w<float>(WS_X) + (size_t)nn[u] * D; const float* g2 = c.w<float>(WS_MOD) + (size_t)layer * 5 * 6144 + mr[u] * 6144 + 5120;
#pragma unroll
            for (int i = 0; i < 4; ++i) { const int k = (lane + 64 * i) * 4;
                xv[u][i] = *(const f32x4*)(X + k); gv[u][i] = *(const f32x4*)(g2 + k);
                oa[u][i] = *(const uint2*)(OUT + (size_t)s0[u] * D + k); ob[u][i] = *(const uint2*)(OUT + (size_t)s1[u] * D + k); } }
        float ss[2] = {0.f, 0.f};
#pragma unroll
        for (int u = 0; u < 2; ++u)
#pragma unroll
            for (int i = 0; i < 4; ++i) { xv[u][i] = xv[u][i] + gv[u][i] * (bf4(oa[u][i]) * w0[u] + bf4(ob[u][i]) * w1[u]);
                ss[u] += xv[u][i][0] * xv[u][i][0] + xv[u][i][1] * xv[u][i][1] + xv[u][i][2] * xv[u][i][2] + xv[u][i][3] * xv[u][i][3]; }
        float rstd[2];
#pragma unroll
        for (int u = 0; u < 2; ++u) rstd[u] = rsqrtf(wave_sum(ss[u]) * (1.f / D) + EPS);
#pragma unroll
        for (int u = 0; u < 2; ++u) {
            if (!ok[u]) continue;
            const int n = nn[u];
            if (layer == 1) {
                float* o = c.out() + ((size_t)(n / LT) * SEQ + (n % LT - CTX)) * D;
#pragma unroll
                for (int i = 0; i < 4; ++i) { const int k = (lane + 64 * i) * 4; *(f32x4*)(o + k) = xv[u][i] * rstd[u] * *(const f32x4*)(c.in(36) + k); }
            } else {
                float* X = c.w<float>(WS_X) + (size_t)n * D;
                f32x4 hv[4];
#pragma unroll
                for (int i = 0; i < 4; ++i) {
                    const int k = (lane + 64 * i) * 4;
                    *(f32x4*)(X + k) = xv[u][i];
                    hv[i] = xv[u][i] * rstd[u] * *(const f32x4*)(gnext + k) * (*(const f32x4*)(MODn + mr[u] * 6144 + 1024 + k) + 1.f) + *(const f32x4*)(MODn + mr[u] * 6144 + k);
                    *(uint2*)(HA + (size_t)n * D + k) = pack4(hv[i]);
                }
                dt_project(wdt, hv, lane, DTR + (size_t)n * 8);
            }
        }
    }
}

typedef LAS const char* lds_cptr;
constexpr int GEMM_LDS = 35840;
constexpr int GA_KH = 8256, GB_OFF = 16512, GB_ST = 288;
__device__ __forceinline__ s16x4 lds_tr(lds_cptr p) { return __builtin_bit_cast(s16x4, __builtin_amdgcn_ds_read_tr16_b64_v4i16((LAS s16x4*)p)); }

template <bool B_F32, int DEEP = 2  , class ARow>
__device__ __forceinline__ void gemm_tile(const int tid, unsigned char* lds, const bf16* Abase, ARow arow  , const void* Bbase, unsigned boff  , int ldb, bool bval, int K, f32x4 (&acc)[4][4]) {
    const int lane = tid & 63, wid = tid >> 6, wr = wid >> 1, wc = wid & 1, fr = lane & 15, fq = lane >> 4;
#pragma unroll
    for (int m = 0; m < 4; ++m)
#pragma unroll
        for (int n = 0; n < 4; ++n) acc[m][n] = (f32x4){0.f, 0.f, 0.f, 0.f};
    unsigned ao[4];
#pragma unroll
    for (int i = 0; i < 4; ++i) ao[i] = arow((tid >> 3) + 32 * i) + (tid & 7) * 8;
    const int bk = tid >> 4, bnc = tid & 15;
    constexpr int NRB = B_F32 ? 8 : 4;
    u32x4 ra0[4], ra1[4]; u32x4 rb0[NRB], rb1[NRB];
    auto gloadA = [&](int kt, u32x4 (&ra)[4]) __attribute__((always_inline)) {
#pragma unroll
        for (int i = 0; i < 4; ++i) ra[i] = *(const u32x4*)(Abase + (ao[i] + kt * 64));
    };
    auto gloadB = [&](int kt, u32x4 (&rb)[NRB]) __attribute__((always_inline)) {
        if (B_F32) {
            const float* bp = (const float*)Bbase + (boff + (unsigned)((kt * 64 + bk) * ldb));
#pragma unroll
            for (int i = 0; i < 4; ++i) {
                if (bval) { rb[2 * i] = *(const u32x4*)(bp + (unsigned)(16 * i * ldb)); rb[2 * i + 1] = *(const u32x4*)(bp + (unsigned)(16 * i * ldb) + 4); }
                else { rb[2 * i] = (u32x4){0u, 0u, 0u, 0u}; rb[2 * i + 1] = rb[2 * i]; }
            }
        } else {
            const bf16* bp = (const bf16*)Bbase + (boff + (unsigned)((kt * 64 + bk) * ldb));
#pragma unroll
            for (int i = 0; i < 4; ++i) rb[i] = bval ? *(const u32x4*)(bp + (unsigned)(16 * i * ldb)) : (u32x4){0u, 0u, 0u, 0u};
        }
    };
    auto lstore = [&](const u32x4 (&ra)[4], const u32x4 (&rb)[NRB]) __attribute__((always_inline)) {
#pragma unroll
        for (int i = 0; i < 4; ++i) { const int row = (tid >> 3) + 32 * i, kc = tid & 7;
            const u32x4 v = (kc & 1) ? (u32x4){ra[i][2], ra[i][3], ra[i][0], ra[i][1]} : ra[i];
            *(u32x4*)(lds + (kc >> 2) * GA_KH + row * 64 + (kc & 3) * 16) = v; }
#pragma unroll
        for (int i = 0; i < 4; ++i) { const int k = bk + 16 * i;
            u32x4 v;
            if (B_F32) { const f32x4 x = __builtin_bit_cast(f32x4, rb[2 * i]), y = __builtin_bit_cast(f32x4, rb[2 * i + 1]);
                v[0] = pk2bf(x[0], x[1]); v[1] = pk2bf(x[2], x[3]); v[2] = pk2bf(y[0], y[1]); v[3] = pk2bf(y[2], y[3]); }
            else v = rb[i];
            *(u32x4*)(lds + GB_OFF + k * GB_ST + bnc * 16) = v; }
    };
    const lds_cptr la = (lds_cptr)lds + (wr * 64 + fr) * 64 + fq * 16;
    const lds_cptr lb = (lds_cptr)lds + GB_OFF + (8 * fq + (fr >> 2) + (fq & 1) * 4) * GB_ST + wc * 128 + (fr & 3) * 8;
    const int bsw = (fq & 1) ? -4 * GB_ST : 4 * GB_ST;
    auto compute = [&]() __attribute__((always_inline)) {
#pragma unroll
        for (int kh = 0; kh < 2; ++kh) {
            bf16x8 af[4], bfr[4];
#pragma unroll
            for (int m = 0; m < 4; ++m) af[m] = *(const LAS bf16x8*)(la + kh * GA_KH + m * 1024);
#pragma unroll
            for (int n = 0; n < 4; ++n) {
                const s16x4 r0 = lds_tr(lb + kh * 32 * GB_ST + n * 32), r1 = lds_tr(lb + kh * 32 * GB_ST + n * 32 + bsw);
                bfr[n] = (bf16x8){r0[0], r0[1], r0[2], r0[3], r1[0], r1[1], r1[2], r1[3]};
            }
#pragma unroll
            for (int m = 0; m < 4; ++m)
#pragma unroll
                for (int n = 0; n < 4; ++n) acc[m][n] = __builtin_amdgcn_mfma_f32_16x16x32_bf16(bfr[n], af[m], acc[m][n], 0, 0, 0);
        }
    };
    const int nk = K / 64;
    if (DEEP == 0) {
        gloadA(0, ra0); gloadB(0, rb0);
        for (int kt = 0; kt < nk; ++kt) {
            __syncthreads();
            lstore(ra0, rb0);
            __syncthreads();
            if (kt + 1 < nk) { gloadA(kt + 1, ra0); gloadB(kt + 1, rb0); }
            compute();
        }
        return;
    }
    if (DEEP == 1) {
        gloadA(0, ra0); gloadB(0, rb0); gloadA(1, ra1);
        for (int kt = 0; kt < nk; kt += 2) {
            __syncthreads();
            lstore(ra0, rb0);
            __syncthreads();
            gloadB(kt + 1, rb0);
            if (kt + 2 < nk) gloadA(kt + 2, ra0);
            compute();
            __syncthreads();
            lstore(ra1, rb0);
            __syncthreads();
            if (kt + 2 < nk) gloadB(kt + 2, rb0);
            if (kt + 3 < nk) gloadA(kt + 3, ra1);
            compute();
        }
        return;
    }
    gloadB(0, rb0); gloadA(0, ra0); gloadB(1, rb1);
    for (int kt = 0; kt < nk; kt += 2) {
        __syncthreads();
        lstore(ra0, rb0);
        __syncthreads();
        gloadA(kt + 1, ra0);
        if (kt + 2 < nk) gloadB(kt + 2, rb0);
        compute();
        __syncthreads();
        lstore(ra0, rb1);
        __syncthreads();
        if (kt + 2 < nk) gloadA(kt + 2, ra0);
        if (kt + 3 < nk) gloadB(kt + 3, rb1);
        compute();
    }
}


__device__ __forceinline__ void cvt8(const float* s, bf16* d) {
    const f32x4 a = *(const f32x4*)s, b = *(const f32x4*)(s + 4);
    u32x4 o; o[0] = pk2bf(a[0], a[1]); o[1] = pk2bf(a[2], a[3]); o[2] = pk2bf(b[0], b[1]); o[3] = pk2bf(b[2], b[3]);
    *(u32x4*)d = o;
}
__device__ __forceinline__ void cvt_small(Ctx& c, int gtid, int gthreads) {
    asm volatile("" : "+s"(c.p));

    constexpr int N_IN = 2 * D * (DINV / 8), N_OUT = 2 * D * (D / 8), N_GLU = 2 * 256 * 32;
    for (int it = gtid; it < N_IN + N_OUT + N_GLU; it += gthreads) {
        if (it < N_IN) { const int ch = it % (DINV / 8), lk = it / (DINV / 8), vc = ch * 8, ac = vc < C_DT ? vc : vc + 8;
            cvt8(c.in(8) + (size_t)lk * DIN + ac, c.w<bf16>(WS_BIN) + (size_t)lk * DINV + vc); }
        else if (it < N_IN + N_OUT) { const int j = it - N_IN; cvt8(c.in(9) + (size_t)j * 8, c.w<bf16>(WS_BOUT) + (size_t)j * 8); }
        else { const int j = it - N_IN - N_OUT; cvt8(c.in(18) + (size_t)j * 8, c.w<bf16>(WS_BGLU) + (size_t)j * 8); }
    }
}
constexpr int CVT_MOE_TILES = 1536;
__device__ __forceinline__ void cvt_moe(const Ctx& c, int layer, int tile) {
#pragma unroll 1
    for (int h = 0; h < 2; ++h) {
        const float* sp[8]; bf16* dp[8];
#pragma unroll
        for (int i = 0; i < 8; ++i) {
            const int it = tile * 4096 + (h * 8 + i) * 256 + c.tid;
            if (it < 32 * 1024 * 128) {
                const int ch = it & 127, ek = it >> 7;
                const int blk = ch >> 3, w = (ch & 7) * 8;
                sp[i] = (w < 32 ? c.in(33) : c.in(34)) + ((size_t)layer * NEXP * D + ek) * DE + blk * 32 + (w & 31);
                dp[i] = c.w<bf16>(WS_BGU) + (size_t)ek * 1024 + ch * 8;
            } else {
                const int j = it - 32 * 1024 * 128;
                sp[i] = c.in(35) + (size_t)layer * NEXP * DE * D + (size_t)j * 8; dp[i] = c.w<bf16>(WS_BDN) + (size_t)j * 8;
            }
        }
        f32x4 va[8], vb[8];
#pragma unroll
        for (int i = 0; i < 8; ++i) { va[i] = *(const f32x4*)sp[i]; vb[i] = *(const f32x4*)(sp[i] + 4); }
#pragma unroll
        for (int i = 0; i < 8; ++i) { u32x4 o; o[0] = pk2bf(va[i][0], va[i][1]); o[1] = pk2bf(va[i][2], va[i][3]); o[2] = pk2bf(vb[i][0], vb[i][1]); o[3] = pk2bf(vb[i][2], vb[i][3]); *(u32x4*)dp[i] = o; }
    }
}

__device__ __forceinline__ void ph_inproj_mfma(const Ctx& c, int layer, int tile, unsigned char* lds) {
    const int mt = tile / 18, nt = tile % 18;
    const bf16* HA = c.w<bf16>(WS_HA) + (size_t)mt * 128 * D;
    f32x4 acc[4][4];
    const int vc = nt * 128 + (c.tid & 15) * 8;
    gemm_tile<false, 1>(c.tid, lds, HA, [&](int r) __attribute__((always_inline)) { return (unsigned)(r * D); }, c.w<bf16>(WS_BIN) + (size_t)layer * D * DINV, (unsigned)vc, DINV, true, D, acc);
    const int lane = c.tid & 63, wid = c.tid >> 6, wr = wid >> 1, wc = wid & 1, fr = lane & 15, fq = lane >> 4;
    const int n0 = mt * 128, b = n0 / LT, pos0 = n0 % LT;
    if (nt < 2) {
        bf16* UH = c.w<bf16>(WS_UH);
#pragma unroll
        for (int m = 0; m < 4; ++m) {
            const int pos = pos0 + wr * 64 + m * 16 + fr, J = b * 136 + (pos >> 5), tt = pos & 31;
#pragma unroll
            for (int n = 0; n < 4; ++n) { const int col = nt * 128 + wc * 64 + n * 16 + fq * 4;
                *(uint2*)(UH + ((size_t)(col >> 4) * NCH5 + J) * 768 + tt * 16 + (col & 15)) = pack4(acc[m][n]); }
        }
    } else if (nt < 6 || nt >= 14) {
        const int kind = nt >= 14 ? 1 : 0, sub = nt - (kind ? 14 : 2);
        if (sub == 3) {
            bf16* Vt = c.w<bf16>(kind ? WS_WV : WS_GV) + ((size_t)b * 2 + wc) * 64 * LT;
#pragma unroll
            for (int m = 0; m < 4; ++m) { const int pos = pos0 + wr * 64 + m * 16 + fr;
#pragma unroll
                for (int n = 0; n < 4; ++n)
#pragma unroll
                    for (int jj = 0; jj < 4; ++jj) Vt[(size_t)(n * 16 + fq * 4 + jj) * LT + pos] = f2bf(acc[m][n][jj]); }
        } else {
            const bool isq = sub < 2; const int head = isq ? sub * 2 + wc : wc;
            bf16* dst = isq ? c.w<bf16>(kind ? WS_WQ : WS_GQ) + ((size_t)b * 4 + head) * LT * 64 : c.w<bf16>(kind ? WS_WK : WS_GK) + ((size_t)b * 2 + head) * LT * 64;
            const float* gain = (isq ? c.in(20) : c.in(21)) + layer * 64;
            const float qs = isq ? 0.18033688011112042f : 1.f;
            const float* ROPE = c.w<float>(WS_ROPE);
#pragma unroll
            for (int m = 0; m < 4; ++m) {
                const int pos = pos0 + wr * 64 + m * 16 + fr;
                f32x4 v[4];
#pragma unroll
                for (int n = 0; n < 4; ++n) v[n] = acc[m][n];
                if (kind == 0) {
                    float ss = 0.f;
#pragma unroll
                    for (int n = 0; n < 4; ++n) ss += v[n][0] * v[n][0] + v[n][1] * v[n][1] + v[n][2] * v[n][2] + v[n][3] * v[n][3];
                    ss += __shfl_xor(ss, 16); ss += __shfl_xor(ss, 32);
                    const float rstd = rsqrtf(ss * (1.f / 64.f) + EPS);
#pragma unroll
                    for (int n = 0; n < 4; ++n) v[n] = v[n] * rstd * *(const f32x4*)(gain + n * 16 + fq * 4);
                }
                if (pos >= CTX) {
                    const int l = pos - CTX;
#pragma unroll
                    for (int a = 0; a < 2; ++a) { const int rp = a == 0 ? (l >> 6) : (l & 63);
#pragma unroll
                        for (int jj = 0; jj < 4; ++jj) { const f32x2 cs = *(const f32x2*)(ROPE + (rp * 16 + fq * 4 + jj) * 2);
                            const float x0 = v[2 * a][jj], x1 = v[2 * a + 1][jj];
                            v[2 * a][jj] = x0 * cs[0] - x1 * cs[1]; v[2 * a + 1][jj] = x1 * cs[0] + x0 * cs[1]; } }
                }
#pragma unroll
                for (int n = 0; n < 4; ++n) *(uint2*)(dst + (size_t)pos * 64 + n * 16 + fq * 4) = pack4(v[n] * qs);
            }
        }
    } else {
        bf16* dst; int ld, col0;
        if (nt < 8) { dst = c.w<bf16>(WS_Z); ld = 256; col0 = (nt - 6) * 128; } else { dst = c.w<bf16>(WS_XBR); ld = 768; col0 = (nt - 8) * 128; }
#pragma unroll
        for (int m = 0; m < 4; ++m) { const size_t row = (size_t)n0 + wr * 64 + m * 16 + fr;
#pragma unroll
            for (int n = 0; n < 4; ++n) *(uint2*)(dst + row * ld + col0 + wc * 64 + n * 16 + fq * 4) = pack4(acc[m][n]); }
    }
}

#define EPI_COORDS const int lane = c.tid & 63, wid = c.tid >> 6, wr = wid >> 1, wc = wid & 1, fr = lane & 15, fq = lane >> 4
__device__ __forceinline__ void ph_glu_mfma(const Ctx& c, int layer, int tile, unsigned char* lds) {
    const int mt = tile >> 1, nt = tile & 1;
    const bf16* G5 = c.w<bf16>(WS_G5) + (size_t)mt * 128 * 256;
    f32x4 acc[4][4];
    const int bc = nt * 128 + (c.tid & 15) * 8;
    gemm_tile<false>(c.tid, lds, G5, [&](int r) __attribute__((always_inline)) { return (unsigned)(r * 256); }, c.w<bf16>(WS_BGLU) + (size_t)layer * 256 * 256, (unsigned)bc, 256, true, 256, acc);
    EPI_COORDS;
    bf16* MIX = c.w<bf16>(WS_MIX);
#pragma unroll
    for (int m = 0; m < 4; ++m)
#pragma unroll
        for (int n = 0; n < 4; ++n) {
            const int rl = wr * 64 + m * 16 + fr, col = nt * 128 + wc * 64 + n * 16 + fq * 4;
            const f32x4 bb = *(const f32x4*)(c.in(19) + layer * 256 + col);
            const uint2 gv = *(const uint2*)(G5 + (size_t)rl * 256 + col);
            const float g0 = __uint_as_float(gv.x << 16), g1 = __uint_as_float(gv.x & 0xffff0000u), g2 = __uint_as_float(gv.y << 16), g3 = __uint_as_float(gv.y & 0xffff0000u);
            uint2 o;
            o.x = pk2bf(g0 * sigmoid_f(acc[m][n][0] + bb[0]), g1 * sigmoid_f(acc[m][n][1] + bb[1]));
            o.y = pk2bf(g2 * sigmoid_f(acc[m][n][2] + bb[2]), g3 * sigmoid_f(acc[m][n][3] + bb[3]));
            *(uint2*)(MIX + (size_t)(mt * 128 + rl) * D + col) = o;
        }
}
__device__ __forceinline__ void ph_outproj_mfma(const Ctx& c, int layer, int tile, unsigned char* lds) {
    int mt = tile >> 3; const int nt = tile & 7;
    if (layer == 1) { if (mt >= 128) return; mt = (mt >> 5) * 34 + 2 + (mt & 31); }
    const bf16* MIX = c.w<bf16>(WS_MIX) + (size_t)mt * 128 * D;
    f32x4 acc[4][4];
    const int bc = nt * 128 + (c.tid & 15) * 8;
    gemm_tile<false, 1>(c.tid, lds, MIX, [&](int r) __attribute__((always_inline)) { return (unsigned)(r * D); }, c.w<bf16>(WS_BOUT) + (size_t)layer * D * D, (unsigned)bc, D, true, D, acc);
    EPI_COORDS;
    const float* MOD = c.w<float>(WS_MOD) + (size_t)layer * 5 * 6144;
    float* X = c.w<float>(WS_X);
#pragma unroll
    for (int m = 0; m < 4; ++m) {
        const int row = mt * 128 + wr * 64 + m * 16 + fr, b = row / LT, pos = row % LT, mr = pos < CTX ? 4 : b;
        const float* xs = xsrc(c, layer, row);
#pragma unroll
        for (int n = 0; n < 4; ++n) {
            const int col = nt * 128 + wc * 64 + n * 16 + fq * 4;
            const f32x4 g1 = *(const f32x4*)(MOD + mr * 6144 + 2048 + col);
            *(f32x4*)(X + (size_t)row * D + col) = *(const f32x4*)(xs + col) + g1 * acc[m][n];
        }
    }
}
__device__ __forceinline__ void ph_moe1_mfma(const Ctx& c, int layer, int tile, const int* sm, unsigned char* lds) {
    const int st = tile >> 3, nt = tile & 7;
    const int s0 = st * 128;
    if (s0 >= sm[32]) return;
    const int e = slot_expert(sm, s0), base = s0 - sm[e], ce = sm[33 + e];
    if (base >= ce) return;
    const bf16* HA = c.w<bf16>(WS_HA); const int* LI = c.w<int>(WS_LIST) + (size_t)e * NT;
    f32x4 acc[4][4];
    gemm_tile<false>(c.tid, lds, HA, [&](int r) __attribute__((always_inline)) { const int tok = LI[(base + r < ce) ? (base + r) : base]; return (unsigned)(tok * D); }, c.w<bf16>(WS_BGU) + (size_t)e * D * 1024, (unsigned)(nt * 128 + (c.tid & 15) * 8), 1024, true, D, acc);
    EPI_COORDS;
    bf16* ACT = c.w<bf16>(WS_ACT);
#pragma unroll
    for (int m = 0; m < 4; ++m) {
        const int rl = wr * 64 + m * 16 + fr;
#pragma unroll
        for (int n = 0; n < 2; ++n) {
            const int col = nt * 64 + wc * 32 + n * 16 + fq * 4;
            const f32x4 g = acc[m][n], u = acc[m][n + 2];
            uint2 o; o.x = pk2bf(silu_f(g[0]) * u[0], silu_f(g[1]) * u[1]); o.y = pk2bf(silu_f(g[2]) * u[2], silu_f(g[3]) * u[3]);
            *(uint2*)(ACT + (size_t)(s0 + rl) * DE + col) = o;
        }
    }
}
__device__ __forceinline__ void ph_moe2_mfma(const Ctx& c, int layer, int tile, const int* sm, unsigned char* lds) {
    const int st = tile >> 3, nt = tile & 7;
    const int s0 = st * 128;
    if (s0 >= sm[32]) return;
    const int e = slot_expert(sm, s0), base = s0 - sm[e], ce = sm[33 + e];
    if (base >= ce) return;
    const bf16* ACT = c.w<bf16>(WS_ACT) + (size_t)s0 * DE;
    f32x4 acc[4][4];
    const int bc = nt * 128 + (c.tid & 15) * 8;
    gemm_tile<false>(c.tid, lds, ACT, [&](int r) __attribute__((always_inline)) { return (unsigned)(r * DE); }, c.w<bf16>(WS_BDN) + (size_t)e * DE * D, (unsigned)bc, D, true, DE, acc);
    EPI_COORDS;
    bf16* OUT = c.w<bf16>(WS_OUT);
#pragma unroll
    for (int m = 0; m < 4; ++m)
#pragma unroll
        for (int n = 0; n < 4; ++n) {
            const int rl = wr * 64 + m * 16 + fr, col = nt * 128 + wc * 64 + n * 16 + fq * 4;
            uint2 o; o.x = pk2bf(acc[m][n][0], acc[m][n][1]); o.y = pk2bf(acc[m][n][2], acc[m][n][3]);
            *(uint2*)(OUT + (size_t)(s0 + rl) * D + col) = o;
        }
}


typedef float f32x16 __attribute__((ext_vector_type(16)));
constexpr int AT_KST = 144, AT_VST = 136;
constexpr int AT_KOFF = 0, AT_VOFF = 64 * AT_KST, AT_BUF = AT_VOFF + 64 * AT_VST;
constexpr int AT_SOFF = GEMM_LDS + 512;
static_assert(2 * AT_BUF <= GEMM_LDS, "attention double buffer must fit the GEMM LDS region");
constexpr float AT_THR = 5.0f;
__device__ __forceinline__ float vmax(float a, float b) { return __builtin_fmaxf(a, b); }
__device__ __forceinline__ float vmax3(float a, float b, float c) { return __builtin_fmaxf(__builtin_fmaxf(a, b), c); }
__device__ __forceinline__ float xhalf(float v) { const auto r = __builtin_amdgcn_permlane32_swap(__float_as_uint(v), __float_as_uint(v), false, false); return __uint_as_float((threadIdx.x & 32) ? r[0] : r[1]); }
__device__ __forceinline__ int crow(int r, int hi) { return (r & 3) + 8 * (r >> 2) + 4 * hi; }

__device__ __forceinline__ void attn_tile(const Ctx& c, int layer, int idx, unsigned char* lds) {
    const int tid = c.tid, lane = tid & 63, wid = tid >> 6, r32 = lane & 31, hi = lane >> 5;
    int kind, b, h, qt;
    if (idx < 1024) { kind = idx >> 9; const int r = idx & 511; b = r >> 7; h = (r >> 5) & 3; qt = 2 + (r & 31); }
    else { const int r = idx - 1024; kind = r >> 5; b = (r >> 3) & 3; h = (r >> 1) & 3; qt = r & 1; }
    const int kvh = h >> 1;
    const bf16* Q = c.w<bf16>(kind ? WS_WQ : WS_GQ) + ((size_t)b * 4 + h) * LT * 64;
    const bf16* K = c.w<bf16>(kind ? WS_WK : WS_GK) + ((size_t)b * 2 + kvh) * LT * 64;
    const bf16* Vt = c.w<bf16>(kind ? WS_WV : WS_GV) + ((size_t)b * 2 + kvh) * 64 * LT;
    const int q0 = qt * 128;
    const int qpos = q0 + wid * 32 + r32;
    int b0 = CTX, b1 = CTX;
    if (qt >= 2) { if (kind == 0) { b0 = CTX; b1 = LT; } else { b0 = q0 - 128 < CTX ? CTX : q0 - 128; b1 = q0 + 256 > LT ? LT : q0 + 256; } }
    const int nA = CTX / 64, ntile = nA + (b1 - b0) / 64;
    bf16x8 qf[4];
#pragma unroll
    for (int d0 = 0; d0 < 4; ++d0) qf[d0] = *(const bf16x8*)(Q + (size_t)qpos * 64 + d0 * 16 + hi * 8);
    f32x16 o0, o1;
#pragma unroll
    for (int r = 0; r < 16; ++r) { o0[r] = 0.f; o1[r] = 0.f; }
    float m = -1e30f, l = 0.f;
    if (kind == 1) { m = c.in(28)[layer * 4 + h] * 1.4426950408889634f; l = (hi == 0) ? 1.f : 0.f; }
    float* wsf = (float*)(lds + AT_SOFF) + wid * 32;
    u32x4 rk0[2], rv0[2];
    auto gload = [&](int ti, u32x4 (&rk)[2], u32x4 (&rv)[2]) __attribute__((always_inline)) {
        const int kb = ti < nA ? ti * 64 : b0 + (ti - nA) * 64;
#pragma unroll
        for (int i = 0; i < 2; ++i) { const int cc = tid + 256 * i;
            rk[i] = *(const u32x4*)(K + (size_t)(kb + (cc >> 3)) * 64 + (cc & 7) * 8);
            rv[i] = *(const u32x4*)(Vt + (size_t)(cc >> 3) * LT + kb + (cc & 7) * 8); }
    };
    auto lstore = [&](int buf, const u32x4 (&rk)[2], const u32x4 (&rv)[2]) __attribute__((always_inline)) {
#pragma unroll
        for (int i = 0; i < 2; ++i) { const int cc = tid + 256 * i;
            *(u32x4*)(lds + buf * AT_BUF + AT_KOFF + (cc >> 3) * AT_KST + (cc & 7) * 16) = rk[i];
            unsigned char* vp = lds + buf * AT_BUF + AT_VOFF + (cc >> 3) * AT_VST + (cc & 7) * 16;
            *(uint2*)vp = make_uint2(rv[i][0], rv[i][1]); *(uint2*)(vp + 8) = make_uint2(rv[i][2], rv[i][3]); }
    };
    const lds_cptr lk0 = (lds_cptr)lds + AT_KOFF + r32 * AT_KST + hi * 16;
    const lds_cptr lv0 = (lds_cptr)lds + AT_VOFF + r32 * AT_VST + hi * 8;
    auto compute = [&](int ti) __attribute__((always_inline)) {
        const int kb = ti < nA ? ti * 64 : b0 + (ti - nA) * 64;
        const lds_cptr lk = lk0 + (ti & 1) * AT_BUF, lv = lv0 + (ti & 1) * AT_BUF;
        f32x16 p0, p1;
#pragma unroll
        for (int r = 0; r < 16; ++r) { p0[r] = 0.f; p1[r] = 0.f; }
#pragma unroll
        for (int d0 = 0; d0 < 4; ++d0) {
            const bf16x8 k0 = *(const LAS bf16x8*)(lk + d0 * 32), k1 = *(const LAS bf16x8*)(lk + 32 * AT_KST + d0 * 32);
            p0 = __builtin_amdgcn_mfma_f32_32x32x16_bf16(k0, qf[d0], p0, 0, 0, 0);
            p1 = __builtin_amdgcn_mfma_f32_32x32x16_bf16(k1, qf[d0], p1, 0, 0, 0);
        }
        if (kind == 1 && ti >= nA) {
#pragma unroll
            for (int r = 0; r < 16; ++r) {
                const int d0_ = kb + crow(r, hi) - qpos, d1_ = d0_ + 32;
                if (d0_ > 128 || d0_ < -128) p0[r] = -INFINITY;
                if (d1_ > 128 || d1_ < -128) p1[r] = -INFINITY;
            }
        }
        s16x4 vlo[4], vhi[4];
#pragma unroll
        for (int s = 0; s < 2; ++s)
#pragma unroll
            for (int d0 = 0; d0 < 2; ++d0) { const lds_cptr vp = lv + d0 * 32 * AT_VST + (16 * s) * 2;
                vlo[s * 2 + d0] = *(const LAS s16x4*)vp; vhi[s * 2 + d0] = *(const LAS s16x4*)(vp + 16); }
        float ma[8];
#pragma unroll
        for (int r = 0; r < 8; ++r) ma[r] = vmax3(p0[2 * r], p0[2 * r + 1], vmax(p1[2 * r], p1[2 * r + 1]));
        float rm = vmax(vmax3(ma[0], ma[1], ma[2]), vmax3(ma[3], ma[4], vmax3(ma[5], ma[6], ma[7])));
        rm = vmax(rm, xhalf(rm));
        if (__any(rm > m + AT_THR)) {
            const float mn = fmaxf(m, rm), f = __builtin_amdgcn_exp2f(m - mn);
            m = mn; l *= f;
            if (hi == 0) wsf[r32] = f;
#pragma unroll
            for (int g = 0; g < 4; ++g) { const f32x4 fv = *(const f32x4*)(wsf + 8 * g + 4 * hi);
#pragma unroll
                for (int j = 0; j < 4; ++j) { o0[4 * g + j] *= fv[j]; o1[4 * g + j] *= fv[j]; } }
        }
        p0 = p0 - m; p1 = p1 - m;
#pragma unroll
        for (int r = 0; r < 16; ++r) { p0[r] = __builtin_amdgcn_exp2f(p0[r]); p1[r] = __builtin_amdgcn_exp2f(p1[r]); }
        { const f32x16 sv = p0 + p1;
          const f32x4 s4 = (f32x4){sv[0], sv[1], sv[2], sv[3]} + (f32x4){sv[4], sv[5], sv[6], sv[7]} + (f32x4){sv[8], sv[9], sv[10], sv[11]} + (f32x4){sv[12], sv[13], sv[14], sv[15]};
          l += (s4[0] + s4[1]) + (s4[2] + s4[3]); }
#pragma unroll
        for (int t = 0; t < 2; ++t)
#pragma unroll
            for (int s = 0; s < 2; ++s) {
                float t8[8];
#pragma unroll
                for (int j = 0; j < 8; ++j) t8[j] = t == 0 ? p0[8 * s + j] : p1[8 * s + j];
                const bf16x8 pa = pack8(t8);
#pragma unroll
                for (int d0 = 0; d0 < 2; ++d0) {
                    const lds_cptr vp = lv + d0 * 32 * AT_VST + (32 * t + 16 * s) * 2;
                    const s16x4 lo = t == 0 ? vlo[s * 2 + d0] : *(const LAS s16x4*)vp, hv = t == 0 ? vhi[s * 2 + d0] : *(const LAS s16x4*)(vp + 16);
                    const bf16x8 vf = (bf16x8){lo[0], lo[1], lo[2], lo[3], hv[0], hv[1], hv[2], hv[3]};
                    if (d0 == 0) o0 = __builtin_amdgcn_mfma_f32_32x32x16_bf16(pa, vf, o0, 0, 0, 0);
                    else o1 = __builtin_amdgcn_mfma_f32_32x32x16_bf16(pa, vf, o1, 0, 0, 0);
                }
            }
    };
    gload(0, rk0, rv0);
    __syncthreads();
    lstore(0, rk0, rv0);
    gload(1, rk0, rv0);
    __syncthreads();
    for (int ti = 0; ti < ntile; ti += 2) {
        lstore(1, rk0, rv0);
        if (ti + 2 < ntile) gload(ti + 2, rk0, rv0);
        compute(ti);
        __syncthreads();
        if (ti + 2 < ntile) lstore(0, rk0, rv0);
        if (ti + 3 < ntile) gload(ti + 3, rk0, rv0);
        compute(ti + 1);
        __syncthreads();
    }
    l += __shfl_xor(l, 32);
    if (hi == 0) wsf[r32] = 1.f / l;
    bf16* MIX = c.w<bf16>(WS_MIX) + ((size_t)b * LT + q0 + wid * 32) * D + (kind ? 768 : 256) + h * 64 + r32;
#pragma unroll
    for (int g = 0; g < 4; ++g) { const f32x4 fv = *(const f32x4*)(wsf + 8 * g + 4 * hi);
#pragma unroll
        for (int j = 0; j < 4; ++j) { const int r = 4 * g + j; bf16* mp = MIX + (size_t)crow(r, hi) * D;
            mp[0] = f2bf(o0[r] * fv[j]); mp[32] = f2bf(o1[r] * fv[j]); } }
}


__device__ __forceinline__ void ph_prepB(const Ctx& c, int tile) {
    const float* KLAG = c.w<float>(WS_KLAG); const float* S5P = c.w<float>(WS_S5P); const float* S5BB = c.w<float>(WS_S5BB);
    bf16* WY = c.w<bf16>(WS_WY); bf16* WSm = c.w<bf16>(WS_WS);
    if (tile < 3072) {
        const int it = tile * NTHR + c.tid;
        const int t = it & 31, kr = (it >> 5) % 768, lg = it / (768 * 32), l = lg >> 4, g = lg & 15;
        float v[16];
        if (kr < 512) {
            const int s = kr >> 4, cp = kr & 15;
#pragma unroll
            for (int i = 0; i < 16; ++i) v[i] = 0.f;
            if (s <= t) { const f32x4* kp = (const f32x4*)(KLAG + ((size_t)(lg * 2 + 0) * 32 + (t - s)) * 256 + cp * 16);
#pragma unroll
                for (int q = 0; q < 4; ++q) { const f32x4 x = kp[q]; v[4 * q] += x[0]; v[4 * q + 1] += x[1]; v[4 * q + 2] += x[2]; v[4 * q + 3] += x[3]; } }
            if (s >= t) { const f32x4* kp = (const f32x4*)(KLAG + ((size_t)(lg * 2 + 1) * 32 + (s - t)) * 256 + cp * 16);
#pragma unroll
                for (int q = 0; q < 4; ++q) { const f32x4 x = kp[q]; v[4 * q] += x[0]; v[4 * q + 1] += x[1]; v[4 * q + 2] += x[2]; v[4 * q + 3] += x[3]; } }
            if (s == t) { const float dsk = c.in(17)[l * 256 + g * 16 + cp];
#pragma unroll
                for (int i = 0; i < 16; ++i) if (i == cp) v[i] += dsk; }
        } else {
            const int q = kr - 512, d = q >> 7, p = (q >> 1) & 63, ri = q & 1, e = d == 0 ? t + 1 : 32 - t;
            const int ldg = (l * 2 + d) * 16 + g;
            const float pr = S5P[((size_t)(ldg * 64 + p) * 33 + e) * 2], pi = S5P[((size_t)(ldg * 64 + p) * 33 + e) * 2 + 1];
#pragma unroll
            for (int i = 0; i < 16; ++i) {
                const float cr = c.in(15)[(size_t)ldg * 1024 + i * 64 + p], ci = c.in(16)[(size_t)ldg * 1024 + i * 64 + p];
                v[i] = ri == 0 ? (cr * pr - ci * pi) : -(cr * pi + ci * pr);
            }
        }
        u32x4 o0, o1;
        o0[0] = pk2bf(v[0], v[1]); o0[1] = pk2bf(v[2], v[3]); o0[2] = pk2bf(v[4], v[5]); o0[3] = pk2bf(v[6], v[7]);
        o1[0] = pk2bf(v[8], v[9]); o1[1] = pk2bf(v[10], v[11]); o1[2] = pk2bf(v[12], v[13]); o1[3] = pk2bf(v[14], v[15]);
        u32x4* op = (u32x4*)(WY + ((size_t)lg * 768 + kr) * 512 + t * 16);
        op[0] = o0; op[1] = o1;
    }
    else {
        const int it = (tile - 3072) * NTHR + c.tid;
        const int ncq = it & 31, kr = (it >> 5) & 511, lg = it >> 14, l = lg >> 4, g = lg & 15;
        const int s = kr >> 4, cp = kr & 15, d = ncq >> 4, p0 = (ncq & 15) * 4, e = d == 0 ? 31 - s : s;
        const int ldg = (l * 2 + d) * 16 + g;
        float v[8];
#pragma unroll
        for (int i = 0; i < 4; ++i) {
            const int p = p0 + i;
            const float pr = S5P[((size_t)(ldg * 64 + p) * 33 + e) * 2], pi = S5P[((size_t)(ldg * 64 + p) * 33 + e) * 2 + 1];
            const float br = S5BB[((size_t)(ldg * 64 + p) * 16 + cp) * 2], bi = S5BB[((size_t)(ldg * 64 + p) * 16 + cp) * 2 + 1];
            v[2 * i] = pr * br - pi * bi; v[2 * i + 1] = pr * bi + pi * br;
        }
        u32x4 o; o[0] = pk2bf(v[0], v[1]); o[1] = pk2bf(v[2], v[3]); o[2] = pk2bf(v[4], v[5]); o[3] = pk2bf(v[6], v[7]);
        *(u32x4*)(WSm + ((size_t)lg * 512 + kr) * 256 + ncq * 8) = o;
    }
}
__device__ __forceinline__ void s5_gemm_s(const Ctx& c, int layer, int tile, unsigned char* lds) {
    const int nt = tile & 1, mt = (tile >> 1) % 5, g = tile / 10;
    const bf16* UH = c.w<bf16>(WS_UH) + (size_t)g * NCH5 * 768;
    f32x4 acc[4][4];
    const int bc = nt * 128 + (c.tid & 15) * 8;
    gemm_tile<false, 0>(c.tid, lds, UH, [&](int r) __attribute__((always_inline)) { int row = mt * 128 + r; row = row < NCH5 ? row : NCH5 - 1; return (unsigned)(row * 768); },
                     c.w<bf16>(WS_WS) + (size_t)(layer * 16 + g) * 512 * 256, (unsigned)bc, 256, true, 512, acc);
    EPI_COORDS;
    float* SALL = c.w<float>(WS_SALL) + (size_t)g * NCH5 * 256;
#pragma unroll
    for (int m = 0; m < 4; ++m)
#pragma unroll
        for (int n = 0; n < 4; ++n) {
            const int row = mt * 128 + wr * 64 + m * 16 + fr, col = nt * 128 + wc * 64 + n * 16 + fq * 4;
            if (row < NCH5) *(f32x4*)(SALL + (size_t)row * 256 + col) = acc[m][n];
        }
}
__device__ __forceinline__ void s5_recur(const Ctx& c, int layer, int gtid, int gthreads) {
    const float* S5P = c.w<float>(WS_S5P);
    for (int it = gtid; it < 4 * 16 * 2 * 64; it += gthreads) {
        const int p = it & 63, d = (it >> 6) & 1, g = (it >> 7) & 15, b = it >> 11;
        const int ldg = (layer * 2 + d) * 16 + g;
        const float ar = S5P[((size_t)(ldg * 64 + p) * 33 + 32) * 2], ai = S5P[((size_t)(ldg * 64 + p) * 33 + 32) * 2 + 1];
        const float* S = c.w<float>(WS_SALL) + ((size_t)g * NCH5 + b * 136) * 256 + d * 128 + p * 2;
        bf16* H = c.w<bf16>(WS_UH) + ((size_t)g * NCH5 + b * 136) * 768 + 512 + d * 128 + p * 2;
        float hr = 0.f, hi = 0.f;
#pragma unroll 1
        for (int s0 = 0; s0 < 136; s0 += 34) {
            f32x2 sv[34]; int jj[34];
#pragma unroll
            for (int i = 0; i < 34; ++i) { const int s = s0 + i; jj[i] = d == 0 ? s : (s < 8 ? 7 - s : 143 - s); sv[i] = *(const f32x2*)(S + (size_t)jj[i] * 256); }
#pragma unroll
            for (int i = 0; i < 34; ++i) {
                *(unsigned*)(H + (size_t)jj[i] * 768) = pk2bf(hr, hi);
                const float nr = ar * hr - ai * hi + sv[i][0], ni = ar * hi + ai * hr + sv[i][1]; hr = nr; hi = ni;
            }
        }
    }
}
__device__ __forceinline__ void s5_gemm_y(const Ctx& c, int layer, int tile, unsigned char* lds) {
    const int nt = tile & 3, mt = (tile >> 2) % 5, g = tile / 20;
    const bf16* UH = c.w<bf16>(WS_UH) + (size_t)g * NCH5 * 768;
    f32x4 acc[4][4];
    const int bc = nt * 128 + (c.tid & 15) * 8;
    gemm_tile<false, 0>(c.tid, lds, UH, [&](int r) __attribute__((always_inline)) { int row = mt * 128 + r; row = row < NCH5 ? row : NCH5 - 1; return (unsigned)(row * 768); },
                     c.w<bf16>(WS_WY) + (size_t)(layer * 16 + g) * 768 * 512, (unsigned)bc, 512, true, 768, acc);
    EPI_COORDS;
    bf16* G5 = c.w<bf16>(WS_G5);
#pragma unroll
    for (int m = 0; m < 4; ++m) {
        const int row = mt * 128 + wr * 64 + m * 16 + fr;
        if (row < NCH5) {
            const int b = row / 136, jj = row % 136;
#pragma unroll
            for (int n = 0; n < 4; ++n) {
                const int col = nt * 128 + wc * 64 + n * 16 + fq * 4, t = col >> 4, cc = col & 15;
                const size_t tok = (size_t)b * LT + jj * 32 + t;
                uint2 o; o.x = pk2bf(gelu_tanh(acc[m][n][0]), gelu_tanh(acc[m][n][1])); o.y = pk2bf(gelu_tanh(acc[m][n][2]), gelu_tanh(acc[m][n][3]));
                *(uint2*)(G5 + tok * 256 + g * 16 + cc) = o;
            }
        }
    }
}


__device__ __forceinline__ void ssd_vectors(const Ctx& c, int layer, int b, int j, int h, float* vec) {
    const int tid = c.tid, lane = tid & 63;
    __syncthreads();
    float dtf = 0.f, dtr = 0.f, af = 0.f, ar = 0.f;
    if (tid < 128) {
        const float* DTR = c.w<float>(WS_DTR) + ((size_t)b * LT + j * 128 + tid) * 8;
        dtf = softplus_f(DTR[h] + c.in(24)[(layer * 2 + 0) * 4 + h]);
        dtr = softplus_f(DTR[4 + h] + c.in(24)[(layer * 2 + 1) * 4 + h]);
        af = -dtf * expf(c.in(25)[(layer * 2 + 0) * 4 + h]); ar = -dtr * expf(c.in(25)[(layer * 2 + 1) * 4 + h]);
    }
    float sf = af, sr = ar;
#pragma unroll
    for (int o = 1; o < 64; o <<= 1) { const float tf = __shfl_up(sf, o), tr = __shfl_up(sr, o); if (lane >= o) { sf += tf; sr += tr; } }
    if (tid == 63) { vec[1026] = sf; vec[1027] = sr; }
    __syncthreads();
    if (tid >= 64 && tid < 128) { sf += vec[1026]; sr += vec[1027]; }
    if (tid == 127) { vec[1024] = sf; vec[1025] = sr; }
    __syncthreads();
    if (tid < 128) {
        const float totf = vec[1024], totr = vec[1025], cer = sr - ar;
        vec[tid] = dtf; vec[128 + tid] = dtr; vec[256 + tid] = sf; vec[384 + tid] = cer;
        vec[512 + tid] = dtf * __expf(totf - sf); vec[640 + tid] = dtr * __expf(cer);
        vec[768 + tid] = __expf(sf); vec[896 + tid] = __expf(totr - cer);
    }
    __syncthreads();
}
__device__ __forceinline__ void ssd_s1(const Ctx& c, int layer, int tile, unsigned char* lds) {
    const int h = tile & 3, j = (tile >> 2) % NCH, b = tile / (4 * NCH);
    float* vec = (float*)lds;
    ssd_vectors(c, layer, b, j, h, vec);
    const int tid = c.tid, lane = tid & 63, wid = tid >> 6, fr = lane & 15, fq = lane >> 4, grp = h >> 1;
    const bf16* XT = c.w<bf16>(WS_XT) + ((size_t)b * 256 + h * 64 + wid * 16 + fr) * LT + j * 128;
    const bf16* BT = c.w<bf16>(WS_BT) + ((size_t)b * 256 + grp * 128 + fr) * LT + j * 128;
    f32x4 acc[2][8];
#pragma unroll
    for (int d = 0; d < 2; ++d)
#pragma unroll
        for (int ns = 0; ns < 8; ++ns) acc[d][ns] = (f32x4){0.f, 0.f, 0.f, 0.f};
    u32x4 xraw[4];
#pragma unroll
    for (int kk = 0; kk < 4; ++kk) xraw[kk] = *(const u32x4*)(XT + 32 * kk + 8 * fq);
#pragma unroll
    for (int kk = 0; kk < 4; ++kk) {
        bf16x8 bfr[8];
#pragma unroll
        for (int ns = 0; ns < 8; ++ns) bfr[ns] = *(const bf16x8*)(BT + (size_t)ns * 16 * LT + 32 * kk + 8 * fq);
        float xv[8], xa[8], xb[8];
        unpack8v(xraw[kk], xv);
        const f32x4 w0 = *(const f32x4*)(vec + 512 + 32 * kk + 8 * fq), w1 = *(const f32x4*)(vec + 512 + 32 * kk + 8 * fq + 4);
        const f32x4 r0 = *(const f32x4*)(vec + 640 + 32 * kk + 8 * fq), r1 = *(const f32x4*)(vec + 640 + 32 * kk + 8 * fq + 4);
#pragma unroll
        for (int i = 0; i < 4; ++i) { xa[i] = xv[i] * w0[i]; xa[4 + i] = xv[4 + i] * w1[i]; xb[i] = xv[i] * r0[i]; xb[4 + i] = xv[4 + i] * r1[i]; }
        const bf16x8 xf = pack8(xa), xr = pack8(xb);
#pragma unroll
        for (int ns = 0; ns < 8; ++ns) {
            acc[0][ns] = __builtin_amdgcn_mfma_f32_16x16x32_bf16(bfr[ns], xf, acc[0][ns], 0, 0, 0);
            acc[1][ns] = __builtin_amdgcn_mfma_f32_16x16x32_bf16(bfr[ns], xr, acc[1][ns], 0, 0, 0);
        }
    }
    const size_t sidx = (size_t)((b * NCH + j) * 4 + h) * 2;
    float* ST = c.w<float>(WS_ST);
#pragma unroll
    for (int d = 0; d < 2; ++d)
#pragma unroll
        for (int ns = 0; ns < 8; ++ns) *(f32x4*)(ST + ((sidx + d) * 64 + wid * 16 + fr) * 128 + ns * 16 + 4 * fq) = acc[d][ns];
    if (tid == 0) { float* TOT = c.w<float>(WS_TOT); TOT[sidx] = __expf(vec[1024]); TOT[sidx + 1] = __expf(vec[1025]); }
}
__device__ __forceinline__ void ssd_recur(const Ctx& c, int gtid, int gthreads) {
    const float* ST = c.w<float>(WS_ST); bf16* HIN = c.w<bf16>(WS_HIN); const float* TOT = c.w<float>(WS_TOT);
    for (int it = gtid; it < 4 * 4 * 2 * 64 * 32; it += gthreads) {
        const int n4 = it & 31, p = (it >> 5) & 63, d = (it >> 11) & 1, h = (it >> 12) & 3, b = it >> 14;
        f32x4 H = (f32x4){0.f, 0.f, 0.f, 0.f};
#pragma unroll 1
        for (int s0 = 0; s0 < NCH; s0 += 17) {
            f32x4 sv[17]; float tv[17];
#pragma unroll
            for (int i = 0; i < 17; ++i) { const int s = s0 + i, jj = d == 0 ? s : (s < 2 ? 1 - s : 35 - s);
                const size_t idx = (size_t)((b * NCH + jj) * 4 + h) * 2 + d;
                sv[i] = *(const f32x4*)(ST + (idx * 64 + p) * 128 + n4 * 4); tv[i] = TOT[idx]; }
#pragma unroll
            for (int i = 0; i < 17; ++i) { const int s = s0 + i, jj = d == 0 ? s : (s < 2 ? 1 - s : 35 - s);
                const size_t idx = (size_t)((b * NCH + jj) * 4 + h) * 2 + d;
                uint2 o; o.x = pk2bf(H[0], H[1]); o.y = pk2bf(H[2], H[3]);
                *(uint2*)(HIN + (idx * 64 + p) * 128 + n4 * 4) = o;
                H = H * tv[i] + sv[i]; }
        }
    }
}
__device__ __forceinline__ void ssd_s3(const Ctx& c, int layer, int tile, unsigned char* lds) {
    const int half = tile & 1, h = (tile >> 1) & 3, j = (tile >> 3) % NCH, b = tile / (8 * NCH);
    float* vec = (float*)lds;
    const int tid = c.tid, lane = tid & 63, wid = tid >> 6, fr = lane & 15, fq = lane >> 4, grp = h >> 1;
    const size_t tok0 = (size_t)b * LT + j * 128;
    const bf16* XS = c.w<bf16>(WS_XBCS) + tok0 * 768;
    const int l = 64 * half + 16 * wid + fr;
    bf16x8 cf[4];
#pragma unroll
    for (int k = 0; k < 4; ++k) cf[k] = *(const bf16x8*)(XS + (size_t)l * 768 + 512 + grp * 128 + 32 * k + 8 * fq);
    const bf16* XT = c.w<bf16>(WS_XT) + ((size_t)b * 256 + h * 64 + fr) * LT + j * 128;
    s16x4 xlo[4][4], xhi[4][4];
#pragma unroll
    for (int kk = 0; kk < 4; ++kk)
#pragma unroll
        for (int pt = 0; pt < 4; ++pt) { const bf16* xp = XT + (size_t)pt * 16 * LT + 32 * kk + 4 * fq; xlo[kk][pt] = *(const s16x4*)xp; xhi[kk][pt] = *(const s16x4*)(xp + 16); }
    bf16x8 bfr[2][2][4];
    auto loadB = [&](int sp, bf16x8 (&dst)[2][4]) __attribute__((always_inline)) {
#pragma unroll
        for (int s2 = 0; s2 < 2; ++s2)
#pragma unroll
            for (int k = 0; k < 4; ++k) dst[s2][k] = *(const bf16x8*)(XS + (size_t)(16 * (sp + s2) + fr) * 768 + 256 + grp * 128 + 32 * k + 8 * fq);
    };
    loadB(0, bfr[0]);
    asm volatile("" ::: "memory");
    ssd_vectors(c, layer, b, j, h, vec);
    f32x4 G[8];
#pragma unroll
    for (int sp = 0; sp < 8; sp += 2) {
        if (sp + 2 < 8) { loadB(sp + 2, bfr[((sp >> 1) + 1) & 1]); asm volatile("" ::: "memory"); }
#pragma unroll
        for (int s2 = 0; s2 < 2; ++s2) {
            G[sp + s2] = (f32x4){0.f, 0.f, 0.f, 0.f};
#pragma unroll
            for (int k = 0; k < 4; ++k) G[sp + s2] = __builtin_amdgcn_mfma_f32_16x16x32_bf16(bfr[(sp >> 1) & 1][s2][k], cf[k], G[sp + s2], 0, 0, 0);
        }
    }
    const bf16* HIN = c.w<bf16>(WS_HIN) + (size_t)((b * NCH + j) * 4 + h) * 2 * 8192;
    bf16x8 hfr[4][4];
    auto loadH = [&](int d) __attribute__((always_inline)) {
#pragma unroll
        for (int k = 0; k < 4; ++k)
#pragma unroll
            for (int pt = 0; pt < 4; ++pt) hfr[k][pt] = *(const bf16x8*)(HIN + ((size_t)d * 64 + 16 * pt + fr) * 128 + 32 * k + 8 * fq);
    };
    loadH(0);
    asm volatile("" ::: "memory");
    {
        const float csf_l = vec[256 + l], cer_l = vec[384 + l];
#pragma unroll
        for (int st = 0; st < 8; ++st) {
            const int sb = 16 * st + 4 * fq;
            const f32x4 dtf_s = *(const f32x4*)(vec + sb), dtr_s = *(const f32x4*)(vec + 128 + sb), csf_s = *(const f32x4*)(vec + 256 + sb), cer_s = *(const f32x4*)(vec + 384 + sb);
#pragma unroll
            for (int jj = 0; jj < 4; ++jj) {
                const int s = sb + jj;
                float w = 0.f;
                if (s <= l) w += dtf_s[jj] * __expf(csf_l - csf_s[jj]);
                if (s >= l) w += dtr_s[jj] * __expf(cer_s[jj] - cer_l);
                G[st][jj] *= w;
            }
        }
    }
    f32x4 y[4];
#pragma unroll
    for (int pt = 0; pt < 4; ++pt) y[pt] = (f32x4){0.f, 0.f, 0.f, 0.f};
#pragma unroll
    for (int kk = 0; kk < 4; ++kk) {
        float t8[8];
#pragma unroll
        for (int i = 0; i < 4; ++i) { t8[i] = G[2 * kk][i]; t8[4 + i] = G[2 * kk + 1][i]; }
        const bf16x8 pf = pack8(t8);
#pragma unroll
        for (int pt = 0; pt < 4; ++pt) {
            const bf16x8 xf = (bf16x8){xlo[kk][pt][0], xlo[kk][pt][1], xlo[kk][pt][2], xlo[kk][pt][3], xhi[kk][pt][0], xhi[kk][pt][1], xhi[kk][pt][2], xhi[kk][pt][3]};
            y[pt] = __builtin_amdgcn_mfma_f32_16x16x32_bf16(xf, pf, y[pt], 0, 0, 0);
        }
    }
#pragma unroll
    for (int d = 0; d < 2; ++d) {
        const float e = vec[(d == 0 ? 768 : 896) + l];
        bf16x8 cs[4];
#pragma unroll
        for (int k = 0; k < 4; ++k) {
            float t8[8]; unpack8v(__builtin_bit_cast(u32x4, cf[k]), t8);
#pragma unroll
            for (int i = 0; i < 8; ++i) t8[i] *= e;
            cs[k] = pack8(t8);
        }
#pragma unroll
        for (int k = 0; k < 4; ++k)
#pragma unroll
            for (int pt = 0; pt < 4; ++pt) y[pt] = __builtin_amdgcn_mfma_f32_16x16x32_bf16(hfr[k][pt], cs[k], y[pt], 0, 0, 0);
        if (d == 0) loadH(1);
    }
    float* Y = c.w<float>(WS_YSSD) + tok0 * 256;
#pragma unroll
    for (int pt = 0; pt < 4; ++pt) *(f32x4*)(Y + (size_t)l * 256 + h * 64 + 16 * pt + 4 * fq) = y[pt];
}

__device__ __forceinline__ void ph_mix1(Ctx& c, int layer, int bid, int G, unsigned char* lds, const volatile unsigned* rolew) {
    const unsigned* ctl = c.w<unsigned>(WS_CTL);
    int role = __builtin_amdgcn_readfirstlane((int)rolew[0]), idx = __builtin_amdgcn_readfirstlane((int)rolew[1]);
    int nheavy = __builtin_amdgcn_readfirstlane((int)__hip_atomic_load(ctl + CW_NROLE, __ATOMIC_RELAXED, __HIP_MEMORY_SCOPE_AGENT)), nlight = __builtin_amdgcn_readfirstlane((int)__hip_atomic_load(ctl + CW_NROLE + 64, __ATOMIC_RELAXED, __HIP_MEMORY_SCOPE_AGENT));
    if (nheavy < 1 || nlight < 1 || nheavy + nlight != G) {
        nheavy = G / 2; nlight = G - nheavy; role = bid < nheavy ? 0 : 1; idx = role ? bid - nheavy : bid;
    }
    if (role == 0) {
        for (int t = idx; t < 512; t += nheavy) { asm volatile("" : "+v"(c.tid)); asm volatile("" : "+s"(c.p)); PR_BEGIN(130); attn_tile(c, layer, t, lds); PR_END(130); }
        return;
    }
    for (int t = idx; t < 1280 + CVT_MOE_TILES; t += nlight) {
        asm volatile("" : "+v"(c.tid)); asm volatile("" : "+s"(c.p));
        if (t < 544) { PR_BEGIN(132); ssd_s1(c, layer, t, lds); PR_END(132); }
        else if (t < 1120) { PR_BEGIN(134); attn_tile(c, layer, t - 544 + 512, lds); PR_END(134); }
        else if (t < 1280) s5_gemm_s(c, layer, t - 1120, lds);
        else { PR_BEGIN(131); cvt_moe(c, layer, t - 1280); PR_END(131); }
    }
}

constexpr int PH_PER_LAYER = 12, N_PHASES = 2 + 2 * PH_PER_LAYER;

__global__ void __launch_bounds__(NTHR, 2) mk_fwd(Params prm) {
    __shared__ __attribute__((aligned(16))) unsigned char smem_raw[GEMM_LDS + 512 + 1536];
    float* smem = (float*)(smem_raw + GEMM_LDS);
    Ctx c; c.p = (const CAS Params*)__builtin_amdgcn_kernarg_segment_ptr(); c.smf = smem; c.tid = threadIdx.x;
    const int G = gridDim.x, bid = blockIdx.x;
    const int gthreads = G * NTHR, nwaves = gthreads >> 6;
#define gtid (bid * NTHR + c.tid)
#define gw ((bid * NTHR + c.tid) >> 6)
    int* smi = (int*)(smem + 16);
#if MK_SINGLE
    volatile unsigned* bst = (volatile unsigned*)(smem + 120);
    if (c.tid == 0) { bst[0] = 0u; bst[1] = 0u; }
    __syncthreads();
    XcdBarrier bar = xcd_barrier_post(c.w<unsigned>(WS_CTL) + CW_BAR, bst);
    if (c.tid == 0) {
        unsigned* ctl = c.w<unsigned>(WS_CTL);
        const unsigned key = (xb_xcc_id() << 8) | ((unsigned)__builtin_amdgcn_s_getreg((7 << 11) | (8 << 6) | 4) & 0xFFu);
        const unsigned prev = xb_add(&ctl[CW_CUKEY + key], 1u);
        const unsigned role = prev & 1u;
        const unsigned idx = xb_add(&ctl[CW_NROLE + 64 * role], 1u);
        ((volatile unsigned*)smem)[100] = role; ((volatile unsigned*)smem)[101] = idx;
    }
#endif
    unsigned long long pr_t0 = 0ull; c.pracc = 0ull; c.prt = 0ull;
#define pr_acc c.pracc
#if MK_SINGLE
    if (PROBE_SP == 102) { pr_t0 = __builtin_amdgcn_s_memrealtime(); xcd_barrier(bar); pr_acc += __builtin_amdgcn_s_memrealtime() - pr_t0; }
#endif
    for (int ph = prm.ph_lo; ph < prm.ph_hi; ++ph) {
        if (PROBE_SP >= 0) pr_t0 = __builtin_amdgcn_s_memrealtime();
        asm volatile("" : "+s"(c.p));
        { int t_ = threadIdx.x; asm volatile("" : "+v"(t_)); c.tid = t_; }
        if (ph == 0) { ph_prep(c, gtid, gthreads, bid, G, (float*)smem_raw); PR_BEGIN(124); cvt_small(c, gtid, gthreads); PR_END(124); }
        else if (ph == 1) ph_norm1(c, 0, gw, nwaves, smem_raw);
        else {
            const int layer = (ph - 2) / PH_PER_LAYER, sp = (ph - 2) % PH_PER_LAYER;
            switch (sp) {
            case 0: for (int t = bid; t < 136 * 18 + (layer == 0 ? 5120 : 0); t += G) { asm volatile("" : "+v"(c.tid)); if (t < 136 * 18) ph_inproj_mfma(c, layer, t, smem_raw); else ph_prepB(c, t - 136 * 18); } break;
            case 1: for (int t = bid; t < (NT / 32) * 3; t += G) ph_minipost(c, layer, t, smem_raw); break;
            case 2: ph_mix1(c, layer, bid, G, smem_raw, (const volatile unsigned*)smem + 100); break;
            case 3: s5_recur(c, layer, gtid, gthreads); ssd_recur(c, gtid, gthreads); break;
            case 4: for (int t = bid; t < 1088 + 320; t += G) { asm volatile("" : "+v"(c.tid)); asm volatile("" : "+s"(c.p)); if (t < 1088) ssd_s3(c, layer, t, smem_raw); else s5_gemm_y(c, layer, t - 1088, smem_raw); } break;
            case 5: for (int t = bid; t < 136 * 2 + NT / 8; t += G) { asm volatile("" : "+v"(c.tid)); if (t < 136 * 2) ph_glu_mfma(c, layer, t, smem_raw); else ph_gates(c, layer, t - 136 * 2); } break;
            case 6: for (int t = bid; t < 136 * 8; t += G) ph_outproj_mfma(c, layer, t, smem_raw); break;
            case 7: ph_norm2(c, layer, bid, G, smem_raw, (int*)(smem_raw + GEMM_LDS + 512)); break;
            case 8: ph_assign(c, layer, bid, G, (int*)smem_raw, (const int*)(smem_raw + GEMM_LDS + 512)); break;
            case 9: moe_offsets(c, layer, smi); for (int t = bid; t < (NSLOT / 128) * 8; t += G) ph_moe1_mfma(c, layer, t, smi, smem_raw); break;
            case 10: moe_offsets(c, layer, smi); for (int t = bid; t < (NSLOT / 128) * 8; t += G) ph_moe2_mfma(c, layer, t, smi, smem_raw); break;
            case 11: moe_offsets(c, layer, smi); ph_combine(c, layer, gw, nwaves, smi, smem_raw); break;
            }
        }
#if MK_SINGLE
        if (ph + 1 < prm.ph_hi) xcd_barrier(bar);
#endif
        if (PROBE_SP >= 0 && ((PROBE_SP < 100 && ph >= 2 && (ph - 2) % PH_PER_LAYER == PROBE_SP) || (PROBE_SP == 100 && ph == 0) || (PROBE_SP == 101 && ph == 1))) pr_acc += __builtin_amdgcn_s_memrealtime() - pr_t0;
    }
#if MK_SINGLE
    if (PROBE_SP == 200) { for (int i = 0; i < 16; ++i) xcd_barrier(bar); }
#endif
    if (PROBE_SP >= 0 && PROBE_SP < 200 && bid == 0 && c.tid == 0) { const unsigned long long t1 = __builtin_amdgcn_s_memrealtime(); while (__builtin_amdgcn_s_memrealtime() - t1 < 8ull * pr_acc) __builtin_amdgcn_s_sleep(8); }
}
}

extern "C" void kernel_launch(void* const* d_in, const int* in_sizes, int n_in, void* d_out, int out_size, void* d_ws, size_t ws_size, hipStream_t stream) {
    static int grid = 0;
    if (grid == 0) {
        if (n_in != 37 || ws_size < WS_END) { fprintf(stderr, "kernel_launch: need 37 inputs and %zu bytes of workspace; got %d, %zu\n", (size_t)WS_END, n_in, ws_size); grid = -1; return; }
        int dev = 0, cus = 0, per_cu = 0;
        hipGetDevice(&dev); hipDeviceGetAttribute(&cus, hipDeviceAttributeMultiprocessorCount, dev);
        if (hipOccupancyMaxActiveBlocksPerMultiprocessor(&per_cu, (const void*)mk_fwd, NTHR, 0) != hipSuccess || per_cu < 1) per_cu = 1;
        if (per_cu > 4) per_cu = 4;
        grid = cus * per_cu;
    }
    if (grid < 0) return;
    hipMemsetAsync((char*)d_ws + WS_CTL, 0, CTL_BYTES, stream);
    Params p{};
    for (int i = 0; i < 37; ++i) p.in[i] = (const float*)d_in[i];
    p.out = (float*)d_out; p.ws = (unsigned char*)d_ws;
#if MK_SINGLE
    p.ph_lo = 0; p.ph_hi = N_PHASES;
    void* args[] = {&p};
    hipError_t e = hipLaunchCooperativeKernel((const void*)mk_fwd, dim3(grid), dim3(NTHR), args, 0, stream);
    if (e != hipSuccess) fprintf(stderr, "cooperative launch failed: %s (grid %d)\n", hipGetErrorString(e), grid);
#else
    for (int ph = 0; ph < N_PHASES; ++ph) {
        p.ph_lo = ph; p.ph_hi = ph + 1;
        hipLaunchKernelGGL(mk_fwd, dim3(grid), dim3(NTHR), 0, stream, p);
    }
#endif
}
```

```cpp
#include <hip/hip_runtime.h>
#include <cstdio>
#include <cstdint>

#ifndef PROBE_SP
#define PROBE_SP -1
#endif
#ifndef MK_SINGLE
#define MK_SINGLE 1
#endif

namespace {
typedef unsigned short bf16;
#define LAS __attribute__((address_space(3)))

constexpr int D = 1024, NB = 4, SEQ = 4096, CTX = 256, LT = SEQ + CTX, NT = NB * LT;
constexpr int DIN = 2312;
constexpr int C_U = 0, C_GQ = 256, C_GK = 512, C_GV = 640, C_Z = 768, C_XBC = 1024, C_DT = 1792, C_WQ = 1800, C_WK = 2056, C_WV = 2184;
constexpr int NEXP = 32, DE = 512;
constexpr int NSLOT = 2 * NT + NEXP * 128;
constexpr float EPS = 1e-6f;
constexpr int NTHR = 256;

constexpr size_t al(size_t x) { return (x + 255) & ~(size_t)255; }
constexpr size_t WS_CTL = 0, CTL_BYTES = 1u << 20;
constexpr size_t WS_MOD = WS_CTL + CTL_BYTES;
constexpr size_t WS_S5A = al(WS_MOD + 2 * 5 * 6144 * 4);
constexpr size_t WS_S5BB = al(WS_S5A + 2 * 2 * 16 * 64 * 2 * 4);
constexpr size_t WS_ROPE = al(WS_S5BB + 2 * 2 * 16 * 64 * 16 * 2 * 4);
constexpr size_t WS_X = al(WS_ROPE + 64 * 16 * 2 * 4);
constexpr size_t WS_HA = al(WS_X + (size_t)NT * D * 4);
constexpr size_t WS_Z = al(WS_HA + (size_t)NT * D * 2);
constexpr size_t WS_XBR = al(WS_Z + (size_t)NT * 256 * 2);
constexpr size_t WS_GQ = al(WS_XBR + (size_t)NT * 768 * 2);
constexpr size_t WS_GK = al(WS_GQ + (size_t)NT * 256 * 2);
constexpr size_t WS_GV = al(WS_GK + (size_t)NT * 128 * 2);
constexpr size_t WS_WQ = al(WS_GV + (size_t)NT * 128 * 2);
constexpr size_t WS_WK = al(WS_WQ + (size_t)NT * 256 * 2);
constexpr size_t WS_WV = al(WS_WK + (size_t)NT * 128 * 2);
constexpr size_t WS_XBCS = al(WS_WV + (size_t)NT * 128 * 2);
constexpr size_t WS_YSSD = al(WS_XBCS + (size_t)NT * 768 * 2);
constexpr size_t WS_G5 = al(WS_YSSD + (size_t)NT * 256 * 4);
constexpr size_t WS_MIX = al(WS_G5 + (size_t)NT * 256 * 2);
constexpr size_t WS_OUT = WS_Z;
constexpr size_t WS_ACT = al(WS_OUT + (size_t)NSLOT * D * 2);
static_assert(WS_ACT + (size_t)NSLOT * DE * 2 <= WS_MIX, "MoE-stage alias must end before MIX");
constexpr size_t WS_TOKE = al(WS_MIX + (size_t)NT * D * 2);
constexpr size_t WS_TOKP = al(WS_TOKE + (size_t)NT * 2 * 4);
constexpr size_t WS_TOKW = al(WS_TOKP + (size_t)NT * 2 * 4);
constexpr size_t WS_LIST = al(WS_TOKW + (size_t)NT * 2 * 4);
constexpr size_t WS_DTR = al(WS_LIST + (size_t)NEXP * NT * 4);
constexpr int NCH5 = NT / 32;
constexpr size_t WS_S5P = al(WS_DTR + (size_t)NT * 8 * 4);
constexpr size_t WS_KLAG = al(WS_S5P + (size_t)2 * 2 * 16 * 64 * 33 * 2 * 4);
constexpr size_t WS_WY = al(WS_KLAG + (size_t)2 * 16 * 2 * 32 * 256 * 4);
constexpr size_t WS_WS = al(WS_WY + (size_t)2 * 16 * 768 * 512 * 2);
constexpr size_t WS_UH = al(WS_WS + (size_t)2 * 16 * 512 * 256 * 2);
constexpr size_t WS_SALL = al(WS_UH + (size_t)16 * NCH5 * 768 * 2);
constexpr int NCH = LT / 128;
constexpr size_t WS_XT = al(WS_SALL + (size_t)16 * NCH5 * 256 * 4);
constexpr size_t WS_BT = al(WS_XT + (size_t)NB * 256 * LT * 2);
constexpr size_t WS_ST = al(WS_BT + (size_t)NB * 256 * LT * 2);
constexpr size_t WS_HIN = al(WS_ST + (size_t)NB * NCH * 8 * 8192 * 4);
constexpr size_t WS_TOT = al(WS_HIN + (size_t)NB * NCH * 8 * 8192 * 2);
constexpr size_t WS_BCNT = al(WS_TOT + (size_t)NB * NCH * 8 * 4);
constexpr size_t WS_WDT = al(WS_BCNT + 1024 * 32 * 4);
constexpr size_t WS_RWT = al(WS_WDT + 2 * 8 * 1024 * 4);
constexpr int DINV = 2304;
constexpr size_t WS_BIN = al(WS_RWT + 2 * 36 * 1024 * 4);
constexpr size_t WS_BOUT = al(WS_BIN + (size_t)2 * D * DINV * 2);
constexpr size_t WS_BGLU = al(WS_BOUT + (size_t)2 * D * D * 2);
constexpr size_t WS_BGU = al(WS_BGLU + (size_t)2 * 256 * 256 * 2);
constexpr size_t WS_BDN = al(WS_BGU + (size_t)NEXP * D * 1024 * 2);
constexpr size_t WS_END = al(WS_BDN + (size_t)NEXP * DE * D * 2);
constexpr int CW_CNT = 8192;
constexpr int CW_BAR = 4096;
constexpr int CW_NROLE = 64;
constexpr int CW_CUKEY = 32768;

struct Params {
    const float* in[37];
    float* out;
    unsigned char* ws;
    int ph_lo, ph_hi;
};

typedef short bf16x8 __attribute__((ext_vector_type(8)));
typedef short s16x4 __attribute__((ext_vector_type(4)));
typedef float f32x4 __attribute__((ext_vector_type(4)));
typedef unsigned u32x4 __attribute__((ext_vector_type(4)));
__device__ __forceinline__ float bf2f(bf16 v) { return __uint_as_float(((unsigned)v) << 16); }
typedef float f32x2 __attribute__((ext_vector_type(2)));
typedef __bf16 bf16x2_t __attribute__((ext_vector_type(2)));
__device__ __forceinline__ bf16 f2bf(float f) { return __builtin_bit_cast(bf16, (__bf16)f); }
__device__ __forceinline__ float silu_f(float x) { return x / (1.f + __expf(-x)); }
__device__ __forceinline__ float sigmoid_f(float x) { return 1.f / (1.f + __expf(-x)); }
__device__ __forceinline__ float gelu_tanh(float x) { const float u = 0.7978845608028654f * (x + 0.044715f * x * x * x); return 0.5f * x * (1.f + tanhf(u)); }
__device__ __forceinline__ float softplus_f(float x) { return fmaxf(x, 0.f) + log1pf(__expf(-fabsf(x))); }
__device__ __forceinline__ float wave_sum(float v) {
#pragma unroll
    for (int o = 1; o < 64; o <<= 1) v += __shfl_xor(v, o);
    return v;
}
__device__ __forceinline__ float block_sum(float v, float* red) {
    v = wave_sum(v);
    __syncthreads();
    if ((threadIdx.x & 63) == 0) red[threadIdx.x >> 6] = v;
    __syncthreads();
    return red[0] + red[1] + red[2] + red[3];
}
__device__ __forceinline__ unsigned pk2bf(float lo, float hi) { const f32x2 v = {lo, hi}; return __builtin_bit_cast(unsigned, __builtin_convertvector(v, bf16x2_t)); }
__device__ __forceinline__ void unpack8v(const u32x4 v, float (&f)[8]) {
    f[0] = __uint_as_float(v[0] << 16); f[1] = __uint_as_float(v[0] & 0xffff0000u);
    f[2] = __uint_as_float(v[1] << 16); f[3] = __uint_as_float(v[1] & 0xffff0000u);
    f[4] = __uint_as_float(v[2] << 16); f[5] = __uint_as_float(v[2] & 0xffff0000u);
    f[6] = __uint_as_float(v[3] << 16); f[7] = __uint_as_float(v[3] & 0xffff0000u);
}
__device__ __forceinline__ bf16x8 pack8(const float (&f)[8]) {
    u32x4 v; v[0] = pk2bf(f[0], f[1]); v[1] = pk2bf(f[2], f[3]); v[2] = pk2bf(f[4], f[5]); v[3] = pk2bf(f[6], f[7]);
    return __builtin_bit_cast(bf16x8, v);
}
__device__ __forceinline__ f32x4 bf4(const uint2 u) { return (f32x4){__uint_as_float(u.x << 16), __uint_as_float(u.x & 0xffff0000u), __uint_as_float(u.y << 16), __uint_as_float(u.y & 0xffff0000u)}; }
__device__ __forceinline__ uint2 pack4(const f32x4 v) { uint2 o; o.x = pk2bf(v[0], v[1]); o.y = pk2bf(v[2], v[3]); return o; }
__device__ __forceinline__ void unpack8(const uint4 v, float (&f)[8]) {
    f[0] = __uint_as_float(v.x << 16); f[1] = __uint_as_float(v.x & 0xffff0000u);
    f[2] = __uint_as_float(v.y << 16); f[3] = __uint_as_float(v.y & 0xffff0000u);
    f[4] = __uint_as_float(v.z << 16); f[5] = __uint_as_float(v.z & 0xffff0000u);
    f[6] = __uint_as_float(v.w << 16); f[7] = __uint_as_float(v.w & 0xffff0000u);
}

#define XB_TMO      128
#define XB_XCNT(j)  (256  + 64 * (j))
#define XB_XSUB(j)  (1280 + 64 * (j))
#define XB_XGEN(j)  (2304 + 64 * (j))
#define XB_TOP      3328
#define XB_TOPGEN   3392
#define XCD_BAR_WORDS 3456
#define XB_SPIN_CAP (1u << 22)
__device__ __forceinline__ unsigned xb_ld(unsigned* p)              { return __hip_atomic_load(p, __ATOMIC_RELAXED, __HIP_MEMORY_SCOPE_AGENT); }
__device__ __forceinline__ unsigned xb_add(unsigned* p, unsigned v) { return __hip_atomic_fetch_add(p, v, __ATOMIC_RELAXED, __HIP_MEMORY_SCOPE_AGENT); }
__device__ __forceinline__ unsigned xb_xcc_id() { return (unsigned)__builtin_amdgcn_s_getreg((3 << 11) | 20) & 0xFu; }
#define XB_SPIN(cond, bar) do { unsigned _sp = 0; while (cond) { __builtin_amdgcn_s_sleep(1); \
    if ((++_sp & 255u) == 0u) { if (xb_ld(&(bar)[XB_TMO])) break; if (_sp > XB_SPIN_CAP) { atomicAdd(&(bar)[XB_TMO], 1u); break; } } } } while (0)
struct XcdBarrier { unsigned* bar; unsigned x; volatile unsigned* st; };
__device__ __forceinline__ XcdBarrier xcd_barrier_post(unsigned* bar, volatile unsigned* st) {
    XcdBarrier b; b.bar = bar; b.x = xb_xcc_id(); b.st = st;
    if (threadIdx.x == 0) (void)xb_add(&bar[XB_XCNT(b.x)], 1u);
    return b;
}
__device__ __forceinline__ void xcd_barrier_complete(unsigned* bar, unsigned x, unsigned& nloc, unsigned& nx) {
    const unsigned G = gridDim.x * gridDim.y * gridDim.z;
    unsigned sum, cnt, mine, sp = 0u;
    for (;;) {
        sum = 0u; cnt = 0u; mine = 0u;
#pragma unroll
        for (unsigned j = 0; j < 16; ++j) { const unsigned c = xb_ld(&bar[XB_XCNT(j)]); sum += c; cnt += (c > 0u) ? 1u : 0u; mine = (j == x) ? c : mine; }
        if (sum == G) break;
        __builtin_amdgcn_s_sleep(1);
        if ((++sp & 255u) == 0u) { if (xb_ld(&bar[XB_TMO])) break; if (sp > XB_SPIN_CAP) { atomicAdd(&bar[XB_TMO], 1u); break; } }
    }
    nloc = mine > 0u ? mine : 1u; nx = cnt > 0u ? cnt : 1u;
}
__device__ __forceinline__ void xcd_barrier(const XcdBarrier& b) {
    asm volatile("s_waitcnt vmcnt(0)" ::: "memory");
    __syncthreads();
    if (threadIdx.x == 0) {
        unsigned* bar = b.bar;
        __builtin_amdgcn_s_waitcnt(0);
        unsigned nloc = b.st[0], nx = b.st[1];
        if (nloc == 0u) { xcd_barrier_complete(bar, b.x, nloc, nx); b.st[0] = nloc; b.st[1] = nx; }
        const unsigned old = xb_add(&bar[XB_XSUB(b.x)], 1u);
        const unsigned gen = old / nloc;
        if (old + 1u == (gen + 1u) * nloc) {
            __builtin_amdgcn_fence(__ATOMIC_RELEASE, "agent");
            asm volatile("s_waitcnt vmcnt(0)" ::: "memory");
            const unsigned og = xb_add(&bar[XB_TOP], 1u);
            const unsigned tg = og / nx;
            if (og + 1u == (tg + 1u) * nx) xb_add(&bar[XB_TOPGEN], 1u);
            else XB_SPIN(xb_ld(&bar[XB_TOPGEN]) == tg, bar);
            __builtin_amdgcn_fence(__ATOMIC_ACQUIRE, "agent");
            xb_add(&bar[XB_XGEN(b.x)], 1u);
            asm volatile("s_waitcnt vmcnt(0)" ::: "memory");
        } else {
            XB_SPIN(xb_ld(&bar[XB_XGEN(b.x)]) == gen, bar);
            __builtin_amdgcn_fence(__ATOMIC_ACQUIRE, "agent");
            asm volatile("s_waitcnt vmcnt(0)" ::: "memory");
        }
    }
    __syncthreads();
}

#define CAS __attribute__((address_space(4)))
#define PR_BEGIN(id) do { if (PROBE_SP == (id)) c.prt = __builtin_amdgcn_s_memrealtime(); } while (0)
#define PR_END(id) do { if (PROBE_SP == (id)) c.pracc += __builtin_amdgcn_s_memrealtime() - c.prt; } while (0)
struct Ctx {
    const CAS Params* p;
    float* smf;
    int tid;
    mutable unsigned long long pracc, prt;
    __device__ __forceinline__ const float* in(int i) const { return p->in[i]; }
    __device__ __forceinline__ float* out() const { return p->out; }
    template <class T> __device__ __forceinline__ T* w(size_t off) const { return (T*)(p->ws + off); }
};

__device__ __forceinline__ const float* xsrc(const Ctx& c, int layer, int n) {
    if (layer == 0) { const int b = n / LT, pos = n % LT; return pos < CTX ? c.in(2) + ((size_t)b * CTX + pos) * D : c.in(0) + ((size_t)b * SEQ + (pos - CTX)) * D; }
    return c.w<float>(WS_X) + (size_t)n * D;
}
__device__ __forceinline__ void ngemm8(const bf16* const (&ar)[8], const float* bcol, int ldb, int K, float (&acc)[8]) {
    for (int k0 = 0; k0 < K; k0 += 8) {
        float w[8];
#pragma unroll
        for (int kk = 0; kk < 8; ++kk) w[kk] = bcol[(size_t)(k0 + kk) * ldb];
#pragma unroll
        for (int r = 0; r < 8; ++r) {
            float a[8]; unpack8(*(const uint4*)(ar[r] + k0), a);
#pragma unroll
            for (int kk = 0; kk < 8; ++kk) acc[r] = fmaf(a[kk], w[kk], acc[r]);
        }
    }
}

__device__ __forceinline__ void ph_prep(Ctx& c, int gtid, int gthreads, int bid, int G, float* lds) {
    float* MOD = c.w<float>(WS_MOD);
    const int tid = c.tid;
    PR_BEGIN(120);
    for (int tile = bid; tile < 192; tile += G) {
        const int l = tile / 96, j0 = (tile % 96) * 64;
        __syncthreads();
        for (int idx = tid; idx < 5 * D; idx += NTHR) { const int r = idx >> 10, k = idx & 1023; lds[idx] = silu_f(r < 4 ? c.in(1)[r * D + k] : c.in(3)[k]); }
        __syncthreads();
        const int jj = tid & 63, kq = tid >> 6;
        const float* aw = c.in(4) + (size_t)l * D * 6144 + j0 + jj;
        float acc[5] = {0.f, 0.f, 0.f, 0.f, 0.f};
        for (int k0 = kq * 256; k0 < kq * 256 + 256; k0 += 32) {
            float w[32];
#pragma unroll
            for (int i = 0; i < 32; ++i) w[i] = aw[(size_t)(k0 + i) * 6144];
#pragma unroll
            for (int i = 0; i < 32; ++i)
#pragma unroll
                for (int r = 0; r < 5; ++r) acc[r] = fmaf(lds[r * D + k0 + i], w[i], acc[r]);
        }
#pragma unroll
        for (int r = 0; r < 5; ++r) lds[5 * D + (kq * 64 + jj) * 5 + r] = acc[r];
        __syncthreads();
        for (int idx = tid; idx < 320; idx += NTHR) { const int j2 = idx / 5, r = idx % 5;
            const float s = lds[5 * D + j2 * 5 + r] + lds[5 * D + (64 + j2) * 5 + r] + lds[5 * D + (128 + j2) * 5 + r] + lds[5 * D + (192 + j2) * 5 + r];
            MOD[(l * 5 + r) * 6144 + j0 + j2] = s + c.in(5)[l * 6144 + j0 + j2]; }
    }
    PR_END(120); PR_BEGIN(121);
    asm volatile("" : "+s"(c.p));
    float* S5A = c.w<float>(WS_S5A); float* S5BB = c.w<float>(WS_S5BB);
    for (int it = gtid; it < 2 * 2 * 16 * 64; it += gthreads) {
        const int ldg = it / 64;
        const float lr = c.in(10)[it], li = c.in(11)[it], dt = expf(c.in(12)[ldg]);
        const float mag = expf(lr * dt), are = mag * cosf(li * dt), aim = mag * sinf(li * dt);
        const float den = lr * lr + li * li;
        const float fre = ((are - 1.f) * lr + aim * li) / den, fim = (aim * lr - (are - 1.f) * li) / den;
        S5A[it * 2] = are; S5A[it * 2 + 1] = aim;
        for (int ch = 0; ch < 16; ++ch) {
            const float br = c.in(13)[(size_t)it * 16 + ch], bi = c.in(14)[(size_t)it * 16 + ch];
            S5BB[((size_t)it * 16 + ch) * 2] = fre * br - fim * bi;
            S5BB[((size_t)it * 16 + ch) * 2 + 1] = fre * bi + fim * br;
        }
    }
    asm volatile("" : "+s"(c.p));
    float* S5P = c.w<float>(WS_S5P);
    for (int it = gtid; it < 2 * 2 * 16 * 64 * 33; it += gthreads) {
        const int ldgp = it / 33, k = it % 33;
        const float lr = c.in(10)[ldgp], li = c.in(11)[ldgp], dt = expf(c.in(12)[ldgp / 64]);
        const float e = expf((float)k * lr * dt), ang = (float)k * li * dt;
        S5P[it * 2] = e * cosf(ang); S5P[it * 2 + 1] = e * sinf(ang);
    }
    PR_END(121); PR_BEGIN(122);
    asm volatile("" : "+s"(c.p));
    float* KLAG = c.w<float>(WS_KLAG);
    for (int tile = (G >= 256 ? bid - 192 + (bid < 192 ? G : 0) : bid); tile < 64; tile += G) {
        const int d = tile & 1, g = (tile >> 1) & 15, l = tile >> 5, ldg = (l * 2 + d) * 16 + g;
        float* LA = lds;
        float* LB = lds + 256;
        float* LC = lds + 2304;
        __syncthreads();
        if (tid < 64) {
            const int ldgp = ldg * 64 + tid;
            const float lr = c.in(10)[ldgp], li = c.in(11)[ldgp], dt = expf(c.in(12)[ldg]);
            const float mag = expf(lr * dt), are = mag * cosf(li * dt), aim = mag * sinf(li * dt), den = lr * lr + li * li;
            LA[tid * 4] = are; LA[tid * 4 + 1] = aim; LA[tid * 4 + 2] = ((are - 1.f) * lr + aim * li) / den; LA[tid * 4 + 3] = (aim * lr - (are - 1.f) * li) / den;
        }
        __syncthreads();
        for (int idx = tid; idx < 1024; idx += NTHR) {
            const int p = idx >> 4, cp = idx & 15;
            const float fre = LA[p * 4 + 2], fim = LA[p * 4 + 3];
            const float br = c.in(13)[((size_t)ldg * 64 + p) * 16 + cp], bi = c.in(14)[((size_t)ldg * 64 + p) * 16 + cp];
            LB[idx * 2] = fre * br - fim * bi; LB[idx * 2 + 1] = fre * bi + fim * br;
            const int cc = idx >> 6, p2 = idx & 63;
            LC[idx * 2] = c.in(15)[(size_t)ldg * 1024 + cc * 64 + p2]; LC[idx * 2 + 1] = c.in(16)[(size_t)ldg * 1024 + cc * 64 + p2];
        }
        __syncthreads();
        const int cp = tid >> 4, cc = tid & 15;
        float acc[32];
#pragma unroll
        for (int k = 0; k < 32; ++k) acc[k] = 0.f;
        for (int p = 0; p < 64; ++p) {
            const float are = LA[p * 4], aim = LA[p * 4 + 1];
            const float bbr = LB[(p * 16 + cp) * 2], bbi = LB[(p * 16 + cp) * 2 + 1], cr = LC[(cc * 64 + p) * 2], ci = LC[(cc * 64 + p) * 2 + 1];
            float zr = cr * bbr - ci * bbi, zi = cr * bbi + ci * bbr;
#pragma unroll
            for (int k = 0; k < 32; ++k) { acc[k] += zr; const float tr = zr * are - zi * aim, ti = zr * aim + zi * are; zr = tr; zi = ti; }
        }
#pragma unroll
        for (int k = 0; k < 32; ++k) KLAG[((size_t)((l * 16 + g) * 2 + d) * 32 + k) * 256 + cp * 16 + cc] = acc[k];
    }
    PR_END(122); PR_BEGIN(123);
    asm volatile("" : "+s"(c.p));
    float* RWT = c.w<float>(WS_RWT);
    for (int it = gtid; it < 2 * 36 * 1024; it += gthreads) { const int k = it & 1023, o = (it >> 10) % 36, l = it / (36 * 1024);
        RWT[it] = o < 4 ? c.in(29)[((size_t)l * D + k) * 4 + o] : c.in(31)[((size_t)l * D + k) * 32 + (o - 4)]; }
    asm volatile("" : "+s"(c.p));
    float* WDT = c.w<float>(WS_WDT);
    for (int it = gtid; it < 2 * 8 * 1024; it += gthreads) { const int k = it & 1023, j = (it >> 10) & 7, l = it >> 13; WDT[it] = c.in(8)[((size_t)l * D + k) * DIN + C_DT + j]; }
    asm volatile("" : "+s"(c.p));
    float* ROPE = c.w<float>(WS_ROPE);
    for (int it = gtid; it < 64 * 16; it += gthreads) {
        const int pos = it / 16, f = it % 16;
        const float inv = powf(10000.0f, -(float)f / 16.0f);
        const float ang = (float)pos * inv;
        ROPE[it * 2] = cosf(ang); ROPE[it * 2 + 1] = sinf(ang);
    }
    PR_END(123);
}

__device__ __forceinline__ void dt_project(const LAS float* wdt, const f32x4 (&h)[4], int lane, float* dst) {
    float mine = 0.f;
#pragma unroll 2
    for (int q = 0; q < 8; ++q) {
        float s = 0.f;
#pragma unroll
        for (int i = 0; i < 4; ++i) { const f32x4 w = *(const LAS f32x4*)(wdt + q * 1024 + (lane + 64 * i) * 4); s += h[i][0] * w[0] + h[i][1] * w[1] + h[i][2] * w[2] + h[i][3] * w[3]; }
        s = wave_sum(s);
        if (lane == q) mine = s;
    }
    if (lane < 8) dst[lane] = mine;
}
__device__ __forceinline__ void ph_norm1(const Ctx& c, int layer, int gw, int nwaves, unsigned char* lds) {
    const int lane = c.tid & 63;
    bf16* HA = c.w<bf16>(WS_HA); float* DTR = c.w<float>(WS_DTR);
    const float* MOD = c.w<float>(WS_MOD) + (size_t)layer * 5 * 6144;
    const float* g = c.in(6) + layer * D;
    __syncthreads();
    for (int i = c.tid; i < 2048; i += NTHR) ((f32x4*)lds)[i] = ((const f32x4*)(c.w<float>(WS_WDT) + (size_t)layer * 8 * 1024))[i];
    __syncthreads();
    const LAS float* wdt = (const LAS float*)lds;
    for (int n = gw; n < NT; n += nwaves) {
        const int b = n / LT, pos = n % LT, mr = pos < CTX ? 4 : b;
        const float* x = xsrc(c, layer, n);
        f32x4 v[4]; float ss = 0.f;
#pragma unroll
        for (int i = 0; i < 4; ++i) { v[i] = *(const f32x4*)(x + (lane + 64 * i) * 4); ss += v[i][0] * v[i][0] + v[i][1] * v[i][1] + v[i][2] * v[i][2] + v[i][3] * v[i][3]; }
        const float rstd = rsqrtf(wave_sum(ss) * (1.f / D) + EPS);
#pragma unroll
        for (int i = 0; i < 4; ++i) {
            const int k = (lane + 64 * i) * 4;
            const f32x4 gv = *(const f32x4*)(g + k), sc = *(const f32x4*)(MOD + mr * 6144 + 1024 + k), sh = *(const f32x4*)(MOD + mr * 6144 + k);
            v[i] = v[i] * rstd * gv * (sc + 1.f) + sh;
            *(uint2*)(HA + (size_t)n * D + k) = pack4(v[i]);
        }
        dt_project(wdt, v, lane, DTR + (size_t)n * 8);
    }
}

constexpr int MP_TOK = 32, MP_RST = 528;
__device__ __forceinline__ void ph_minipost(const Ctx& c, int layer, int tile, unsigned char* lds) {
    const int r = tile % 3, tb = tile / 3, tid = c.tid;
    const int n0 = tb * MP_TOK, b = n0 / LT, pos0 = n0 % LT;
    const bf16* XB = c.w<bf16>(WS_XBR) + r * 256;
    unsigned char* raw = lds;
    bf16* trs = (bf16*)(lds + 34 * MP_RST);
    __syncthreads();
    for (int idx = tid; idx < 34 * 32; idx += NTHR) {
        const int row = idx >> 5, ch = idx & 31, pos = pos0 + row - 1;
        const bool ok = !((row == 0 && (pos0 == 0 || pos0 == CTX)) || (row == 33 && (pos0 + MP_TOK == CTX || pos0 + MP_TOK == LT)));
        u32x4 v = (u32x4){0u, 0u, 0u, 0u};
        if (ok) v = *(const u32x4*)(XB + ((size_t)b * LT + pos) * 768 + ch * 8);
        *(u32x4*)(raw + row * MP_RST + ch * 16) = v;
    }
    __syncthreads();
    const float* cw = c.in(22) + (size_t)layer * 3 * 768 + r * 256; const float* cb = c.in(23) + layer * 768 + r * 256;
    const int ch = tid & 31;
    f32x4 w0[2], w1[2], w2[2], bb[2];
#pragma unroll
    for (int q = 0; q < 2; ++q) { w0[q] = *(const f32x4*)(cw + ch * 8 + 4 * q); w1[q] = *(const f32x4*)(cw + 768 + ch * 8 + 4 * q); w2[q] = *(const f32x4*)(cw + 1536 + ch * 8 + 4 * q); bb[q] = *(const f32x4*)(cb + ch * 8 + 4 * q); }
    bf16* XS = c.w<bf16>(WS_XBCS) + r * 256;
#pragma unroll
    for (int i = 0; i < 4; ++i) {
        const int t = (tid >> 5) + 8 * i;
        float xl[8], xc[8], xr[8], y[8];
        unpack8v(*(const u32x4*)(raw + t * MP_RST + ch * 16), xl); unpack8v(*(const u32x4*)(raw + (t + 1) * MP_RST + ch * 16), xc); unpack8v(*(const u32x4*)(raw + (t + 2) * MP_RST + ch * 16), xr);
#pragma unroll
        for (int q = 0; q < 2; ++q)
#pragma unroll
            for (int j = 0; j < 4; ++j) y[4 * q + j] = silu_f(w1[q][j] * xc[4 * q + j] + w0[q][j] * xl[4 * q + j] + w2[q][j] * xr[4 * q + j] + bb[q][j]);
        const bf16x8 yb = pack8(y);
        *(bf16x8*)(XS + ((size_t)n0 + t) * 768 + ch * 8) = yb;
        if (r < 2) {
#pragma unroll
            for (int j = 0; j < 8; ++j) trs[(ch * 8 + j) * 32 + t] = (bf16)yb[j];
        }
    }
    if (r < 2) {
        __syncthreads();
        bf16* TR = (r == 0 ? c.w<bf16>(WS_XT) : c.w<bf16>(WS_BT)) + (size_t)b * 256 * LT + pos0;
        for (int idx = tid; idx < 1024; idx += NTHR) { const int chn = idx >> 2, pc = idx & 3;
            *(u32x4*)(TR + (size_t)chn * LT + pc * 8) = *(const u32x4*)(trs + chn * 32 + pc * 8); }
    }
}

__device__ __forceinline__ void ph_gates(const Ctx& c, int layer, int tile) {
    const int lane = c.tid & 63, n0 = tile * 8 + (c.tid >> 6) * 2, t4 = lane * 4;
    const float dsk = c.in(26)[layer * 4 + (lane >> 4)];
    const f32x4 gn = *(const f32x4*)(c.in(27) + layer * 256 + t4);
    f32x4 ys[2]; uint2 xr[2], zr[2];
#pragma unroll
    for (int u = 0; u < 2; ++u) { const size_t n = (size_t)n0 + u;
        ys[u] = *(const f32x4*)(c.w<float>(WS_YSSD) + n * 256 + t4); xr[u] = *(const uint2*)(c.w<bf16>(WS_XBCS) + n * 768 + t4); zr[u] = *(const uint2*)(c.w<bf16>(WS_Z) + n * 256 + t4); }
#pragma unroll
    for (int u = 0; u < 2; ++u) {
        const f32x4 x = bf4(xr[u]), z = bf4(zr[u]);
        f32x4 y;
#pragma unroll
        for (int j = 0; j < 4; ++j) y[j] = (ys[u][j] + x[j] * dsk) * silu_f(z[j]);
        const float ss = wave_sum(y[0] * y[0] + y[1] * y[1] + y[2] * y[2] + y[3] * y[3]);
        const float rstd = rsqrtf(ss * (1.f / 256.f) + EPS);
        *(uint2*)(c.w<bf16>(WS_MIX) + ((size_t)n0 + u) * D + 512 + t4) = pack4(y * rstd * gn);
    }
}

__device__ __forceinline__ float half_sum(float v) {
#pragma unroll
    for (int o = 1; o < 32; o <<= 1) v += __shfl_xor(v, o);
    return v;
}
__device__ __forceinline__ void ph_norm2(const Ctx& c, int layer, int bid, int G, unsigned char* hbuf, int* lsm) {
    const int lane = c.tid & 63, wid = c.tid >> 6, hl = lane & 31, half = lane >> 5;
    const int per = (NT + G - 1) / G, n0 = bid * per, n1 = (n0 + per < NT) ? n0 + per : NT;
    __syncthreads();
    const float* X = c.w<float>(WS_X); bf16* HA = c.w<bf16>(WS_HA);
    const float* MOD = c.w<float>(WS_MOD) + (size_t)layer * 5 * 6144;
    const float* g = c.in(7) + layer * D;
    int* TE = c.w<int>(WS_TOKE); float* TW = c.w<float>(WS_TOKW);
    float* Lg = (float*)hbuf; float* Lsc = Lg + D; float* Lsh = Lsc + D; float* Lcw = Lsh + D;
    const float* rwt = c.w<float>(WS_RWT) + (size_t)layer * 36 * 1024;
    const int mrA = (n0 % LT) < CTX ? 4 : n0 / LT;
    for (int i = c.tid; i < D / 4; i += NTHR) {
        ((f32x4*)Lg)[i] = ((const f32x4*)g)[i];
        ((f32x4*)Lsc)[i] = ((const f32x4*)(MOD + mrA * 6144 + 4096))[i];
        ((f32x4*)Lsh)[i] = ((const f32x4*)(MOD + mrA * 6144 + 3072))[i];
#pragma unroll
        for (int e = 0; e < 4; ++e) ((f32x4*)(Lcw + e * D))[i] = ((const f32x4*)(rwt + e * 1024))[i];
    }
    __syncthreads();
    for (int nb = n0 + wid * 2; nb < n1; nb += 8) {
        const bool inr = nb + half < n1;
        const int n = inr ? nb + half : n1 - 1;
        const int b = n / LT, pos = n % LT, mr = pos < CTX ? 4 : b;
        const bool act = inr && !(layer == 1 && pos < CTX);
        if (hl == 0 && inr && !act) { lsm[(n - n0) * 2] = -1; lsm[(n - n0) * 2 + 1] = -1; }
        const float* x = X + (size_t)n * D;
        const float* scp = mr == mrA ? Lsc : MOD + mr * 6144 + 4096;
        const float* shp = mr == mrA ? Lsh : MOD + mr * 6144 + 3072;
        float ss = 0.f;
        PR_BEGIN(110);
        f32x4 v[8];
#pragma unroll
        for (int i = 0; i < 8; ++i) { v[i] = *(const f32x4*)(x + (hl + 32 * i) * 4); ss += v[i][0] * v[i][0] + v[i][1] * v[i][1] + v[i][2] * v[i][2] + v[i][3] * v[i][3]; }
        const float rstd = rsqrtf(half_sum(ss) * (1.f / D) + EPS);
        PR_END(110); PR_BEGIN(111);
        float cg[4] = {0.f, 0.f, 0.f, 0.f};
#pragma unroll
        for (int i = 0; i < 8; ++i) {
            const int k = (hl + 32 * i) * 4;
            const f32x4 h = v[i] * rstd * *(const f32x4*)(Lg + k) * (*(const f32x4*)(scp + k) + 1.f) + *(const f32x4*)(shp + k);
            v[i] = h;
            *(uint2*)(HA + (size_t)n * D + k) = pack4(h);
#pragma unroll
            for (int e = 0; e < 4; ++e) { const f32x4 w = *(const f32x4*)(Lcw + e * D + k); cg[e] += h[0] * w[0] + h[1] * w[1] + h[2] * w[2] + h[3] * w[3]; }
        }
        float mx = -1e30f; int gi = 0; float cl[4];
#pragma unroll
        for (int e = 0; e < 4; ++e) { cl[e] = half_sum(cg[e]) + c.in(30)[layer * 4 + e]; if (cl[e] > mx) { mx = cl[e]; gi = e; } }
        PR_END(111); PR_BEGIN(112);
        float fg[8] = {0.f, 0.f, 0.f, 0.f, 0.f, 0.f, 0.f, 0.f};
        const float* fwt = rwt + (4 + gi * 8) * 1024;
#pragma unroll
        for (int ib = 0; ib < 8; ib += 2) {
            f32x4 w[2][8];
#pragma unroll
            for (int i = 0; i < 2; ++i)
#pragma unroll
                for (int e = 0; e < 8; ++e) w[i][e] = *(const f32x4*)(fwt + e * 1024 + (hl + 32 * (ib + i)) * 4);
#pragma unroll
            for (int i = 0; i < 2; ++i)
#pragma unroll
                for (int e = 0; e < 8; ++e) { const f32x4 h = v[ib + i]; fg[e] += h[0] * w[i][e][0] + h[1] * w[i][e][1] + h[2] * w[i][e][2] + h[3] * w[i][e][3]; }
            asm volatile("" ::: "memory");
        }
#pragma unroll
        for (int e = 0; e < 8; ++e) fg[e] = half_sum(fg[e]);
        PR_END(112); PR_BEGIN(113);
        if (hl == 0 && act) {
            float den = 0.f;
#pragma unroll
            for (int e = 0; e < 4; ++e) den += expf(cl[e] - mx);
            const float pg = 1.f / den;
            float f1 = -1e30f, f2 = -1e30f; int i1 = 0, i2 = 0;
#pragma unroll
            for (int e = 0; e < 8; ++e) {
                const float fv = fg[e] + c.in(32)[layer * 32 + gi * 8 + e];
                if (fv > f1) { f2 = f1; i2 = i1; f1 = fv; i1 = e; } else if (fv > f2) { f2 = fv; i2 = e; }
            }
            const float e2 = expf(f2 - f1), w1 = pg / (1.f + e2), w2 = pg * e2 / (1.f + e2);
            const int ex1 = gi * 8 + i1, ex2 = gi * 8 + i2;
            lsm[(n - n0) * 2] = ex1; lsm[(n - n0) * 2 + 1] = ex2;
            TE[n * 2] = ex1; TE[n * 2 + 1] = ex2; TW[n * 2] = w1; TW[n * 2 + 1] = w2;
        }
        PR_END(113);
    }
    PR_BEGIN(114);
    __syncthreads();
    if (c.tid < 32) {
        const int e = c.tid, ne = (n1 > n0 ? n1 - n0 : 0) * 2;
        int cl_ = 0;
        for (int i = 0; i < ne; ++i) cl_ += (lsm[i] == e) ? 1 : 0;
        c.w<int>(WS_BCNT)[bid * 32 + e] = cl_;
    }
    PR_END(114);
}
__device__ __forceinline__ void ph_assign(const Ctx& c, int layer, int bid, int G, int* wk, const int* lsm) {
    const int e = c.tid & 31, part = c.tid >> 5;
    const int per = (NT + G - 1) / G, n0 = bid * per, n1 = (n0 + per < NT) ? n0 + per : NT;
    const int* BC = c.w<int>(WS_BCNT);
    int before = 0, all = 0;
#pragma unroll 16
    for (int blk = part; blk < G; blk += 8) { const int v = BC[blk * 32 + e]; all += v; before += blk < bid ? v : 0; }
    __syncthreads();
    wk[(part * 32 + e) * 2] = before; wk[(part * 32 + e) * 2 + 1] = all;
    __syncthreads();
    if (c.tid < 32) {
        int base = 0, tot = 0;
#pragma unroll
        for (int p = 0; p < 8; ++p) { base += wk[(p * 32 + e) * 2]; tot += wk[(p * 32 + e) * 2 + 1]; }
        if (bid == 0) c.w<unsigned>(WS_CTL)[CW_CNT + (layer * 32 + e) * 64] = (unsigned)tot;
        int* TP = c.w<int>(WS_TOKP); int* LI = c.w<int>(WS_LIST);
        const int ne = (n1 > n0 ? n1 - n0 : 0) * 2;
        int r = 0;
        for (int i = 0; i < ne; ++i) if (lsm[i] == e) { const int n = n0 + (i >> 1); const int ps = base + r; ++r; TP[n * 2 + (i & 1)] = ps; LI[(size_t)e * NT + ps] = n; }
    }
}

__device__ __forceinline__ void moe_offsets(const Ctx& c, int layer, int* sm) {
    __syncthreads();
    if (c.tid == 0) {
        const unsigned* cnt = c.w<unsigned>(WS_CTL) + CW_CNT + layer * 32 * 64;
        int acc = 0;
        for (int e = 0; e < 32; ++e) { const int ce = (int)__hip_atomic_load(cnt + e * 64, __ATOMIC_RELAXED, __HIP_MEMORY_SCOPE_AGENT); sm[e] = acc; sm[33 + e] = ce; acc += (ce + 127) & ~127; }
        sm[32] = acc;
    }
    __syncthreads();
}
__device__ __forceinline__ int slot_expert(const int* sm, int slot) { int e = 0;
#pragma unroll 1
    for (int i = 1; i < 32; ++i) if (slot >= sm[i]) e = i;
    return e; }

__device__ __forceinline__ void ph_combine(const Ctx& c, int layer, int gw, int nwaves, const int* sm, unsigned char* lds) {
    const int lane = c.tid & 63;
    __syncthreads();
    for (int i = c.tid; i < 2048; i += NTHR) ((f32x4*)lds)[i] = ((const f32x4*)(c.w<float>(WS_WDT) + (size_t)8 * 1024))[i];
    __syncthreads();
    const LAS float* wdt = (const LAS float*)lds;
    const int* TE = c.w<int>(WS_TOKE); const int* TP = c.w<int>(WS_TOKP); const float* TW = c.w<float>(WS_TOKW);
    const bf16* OUT = c.w<bf16>(WS_OUT);
    bf16* HA = c.w<bf16>(WS_HA); float* DTR = c.w<float>(WS_DTR);
    const float* MODn = c.w<float>(WS_MOD) + (size_t)1 * 5 * 6144;
    const float* gnext = c.in(6) + D;
    const int ntok = layer == 1 ? NB * SEQ : NT;
    for (int q = gw; q < ntok; q += 2 * nwaves) {
        int nn[2]; bool ok[2];
#pragma unroll
        for (int u = 0; u < 2; ++u) { int qq = q + u * nwaves; ok[u] = qq < ntok; qq = ok[u] ? qq : q; nn[u] = layer == 1 ? (qq / SEQ) * LT + CTX + (qq % SEQ) : qq; }
        int s0[2], s1[2]; float w0[2], w1[2]; int mr[2];
#pragma unroll
        for (int u = 0; u < 2; ++u) { const int n = nn[u]; mr[u] = (n % LT) < CTX ? 4 : n / LT;
            s0[u] = sm[TE[n * 2]] + TP[n * 2]; s1[u] = sm[TE[n * 2 + 1]] + TP[n * 2 + 1]; w0[u] = TW[n * 2]; w1[u] = TW[n * 2 + 1]; }
        f32x4 xv[2][4], gv[2][4]; uint2 oa[2][4], ob[2][4];
#pragma unroll
        for (int u = 0; u < 2; ++u) { const float* X = c.w<float>(WS_X) + (size_t)nn[u] * D; const float* g2 = c.w<float>(WS_MOD) + (size_t)layer * 5 * 6144 + mr[u] * 6144 + 5120;
#pragma unroll
            for (int i = 0; i < 4; ++i) { const int k = (lane + 64 * i) * 4;
                xv[u][i] = *(const f32x4*)(X + k); gv[u][i] = *(const f32x4*)(g2 + k);
                oa[u][i] = *(const uint2*)(OUT + (size_t)s0[u] * D + k); ob[u][i] = *(const uint2*)(OUT + (size_t)s1[u] * D + k); } }
        float ss[2] = {0.f, 0.f};
#pragma unroll
        for (int u = 0; u < 2; ++u)
#pragma unroll
            for (int i = 0; i < 4; ++i) { xv[u][i] = xv[u][i] + gv[u][i] * (bf4(oa[u][i]) * w0[u] + bf4(ob[u][i]) * w1[u]);
                ss[u] += xv[u][i][0] * xv[u][i][0] + xv[u][i][1] * xv[u][i][1] + xv[u][i][2] * xv[u][i][2] + xv[u][i][3] * xv[u][i][3]; }
        float rstd[2];
#pragma unroll
        for (int u = 0; u < 2; ++u) rstd[u] = rsqrtf(wave_sum(ss[u]) * (1.f / D) + EPS);
#pragma unroll
        for (int u = 0; u < 2; ++u) {
            if (!ok[u]) continue;
            const int n = nn[u];
            if (layer == 1) {
                float* o = c.out() + ((size_t)(n / LT) * SEQ + (n % LT - CTX)) * D;
#pragma unroll
                for (int i = 0; i < 4; ++i) { const int k = (lane + 64 * i) * 4; *(f32x4*)(o + k) = xv[u][i] * rstd[u] * *(const f32x4*)(c.in(36) + k); }
            } else {
                float* X = c.w<float>(WS_X) + (size_t)n * D;
                f32x4 hv[4];
#pragma unroll
                for (int i = 0; i < 4; ++i) {
                    const int k = (lane + 64 * i) * 4;
                    *(f32x4*)(X + k) = xv[u][i];
                    hv[i] = xv[u][i] * rstd[u] * *(const f32x4*)(gnext + k) * (*(const f32x4*)(MODn + mr[u] * 6144 + 1024 + k) + 1.f) + *(const f32x4*)(MODn + mr[u] * 6144 + k);
                    *(uint2*)(HA + (size_t)n * D + k) = pack4(hv[i]);
                }
                dt_project(wdt, hv, lane, DTR + (size_t)n * 8);
            }
        }
    }
}

typedef LAS const char* lds_cptr;
constexpr int GEMM_LDS = 35840;
constexpr int GA_KH = 8256, GB_OFF = 16512, GB_ST = 288;
__device__ __forceinline__ s16x4 lds_tr(lds_cptr p) { return __builtin_bit_cast(s16x4, __builtin_amdgcn_ds_read_tr16_b64_v4i16((LAS s16x4*)p)); }

template <bool B_F32, int DEEP = 2  , class ARow>
__device__ __forceinline__ void gemm_tile(const int tid, unsigned char* lds, const bf16* Abase, ARow arow  , const void* Bbase, unsigned boff  , int ldb, bool bval, int K, f32x4 (&acc)[4][4]) {
    const int lane = tid & 63, wid = tid >> 6, wr = wid >> 1, wc = wid & 1, fr = lane & 15, fq = lane >> 4;
#pragma unroll
    for (int m = 0; m < 4; ++m)
#pragma unroll
        for (int n = 0; n < 4; ++n) acc[m][n] = (f32x4){0.f, 0.f, 0.f, 0.f};
    unsigned ao[4];
#pragma unroll
    for (int i = 0; i < 4; ++i) ao[i] = arow((tid >> 3) + 32 * i) + (tid & 7) * 8;
    const int bk = tid >> 4, bnc = tid & 15;
    constexpr int NRB = B_F32 ? 8 : 4;
    u32x4 ra0[4], ra1[4]; u32x4 rb0[NRB], rb1[NRB];
    auto gloadA = [&](int kt, u32x4 (&ra)[4]) __attribute__((always_inline)) {
#pragma unroll
        for (int i = 0; i < 4; ++i) ra[i] = *(const u32x4*)(Abase + (ao[i] + kt * 64));
    };
    auto gloadB = [&](int kt, u32x4 (&rb)[NRB]) __attribute__((always_inline)) {
        if (B_F32) {
            const float* bp = (const float*)Bbase + (boff + (unsigned)((kt * 64 + bk) * ldb));
#pragma unroll
            for (int i = 0; i < 4; ++i) {
                if (bval) { rb[2 * i] = *(const u32x4*)(bp + (unsigned)(16 * i * ldb)); rb[2 * i + 1] = *(const u32x4*)(bp + (unsigned)(16 * i * ldb) + 4); }
                else { rb[2 * i] = (u32x4){0u, 0u, 0u, 0u}; rb[2 * i + 1] = rb[2 * i]; }
            }
        } else {
            const bf16* bp = (const bf16*)Bbase + (boff + (unsigned)((kt * 64 + bk) * ldb));
#pragma unroll
            for (int i = 0; i < 4; ++i) rb[i] = bval ? *(const u32x4*)(bp + (unsigned)(16 * i * ldb)) : (u32x4){0u, 0u, 0u, 0u};
        }
    };
    auto lstore = [&](const u32x4 (&ra)[4], const u32x4 (&rb)[NRB]) __attribute__((always_inline)) {
#pragma unroll
        for (int i = 0; i < 4; ++i) { const int row = (tid >> 3) + 32 * i, kc = tid & 7;
            const u32x4 v = (kc & 1) ? (u32x4){ra[i][2], ra[i][3], ra[i][0], ra[i][1]} : ra[i];
            *(u32x4*)(lds + (kc >> 2) * GA_KH + row * 64 + (kc & 3) * 16) = v; }
#pragma unroll
        for (int i = 0; i < 4; ++i) { const int k = bk + 16 * i;
            u32x4 v;
            if (B_F32) { const f32x4 x = __builtin_bit_cast(f32x4, rb[2 * i]), y = __builtin_bit_cast(f32x4, rb[2 * i + 1]);
                v[0] = pk2bf(x[0], x[1]); v[1] = pk2bf(x[2], x[3]); v[2] = pk2bf(y[0], y[1]); v[3] = pk2bf(y[2], y[3]); }
            else v = rb[i];
            *(u32x4*)(lds + GB_OFF + k * GB_ST + bnc * 16) = v; }
    };
    const lds_cptr la = (lds_cptr)lds + (wr * 64 + fr) * 64 + fq * 16;
    const lds_cptr lb = (lds_cptr)lds + GB_OFF + (8 * fq + (fr >> 2) + (fq & 1) * 4) * GB_ST + wc * 128 + (fr & 3) * 8;
    const int bsw = (fq & 1) ? -4 * GB_ST : 4 * GB_ST;
    auto compute = [&]() __attribute__((always_inline)) {
#pragma unroll
        for (int kh = 0; kh < 2; ++kh) {
            bf16x8 af[4], bfr[4];
#pragma unroll
            for (int m = 0; m < 4; ++m) af[m] = *(const LAS bf16x8*)(la + kh * GA_KH + m * 1024);
#pragma unroll
            for (int n = 0; n < 4; ++n) {
                const s16x4 r0 = lds_tr(lb + kh * 32 * GB_ST + n * 32), r1 = lds_tr(lb + kh * 32 * GB_ST + n * 32 + bsw);
                bfr[n] = (bf16x8){r0[0], r0[1], r0[2], r0[3], r1[0], r1[1], r1[2], r1[3]};
            }
#pragma unroll
            for (int m = 0; m < 4; ++m)
#pragma unroll
                for (int n = 0; n < 4; ++n) acc[m][n] = __builtin_amdgcn_mfma_f32_16x16x32_bf16(bfr[n], af[m], acc[m][n], 0, 0, 0);
        }
    };
    const int nk = K / 64;
    if (DEEP == 0) {
        gloadA(0, ra0); gloadB(0, rb0);
        for (int kt = 0; kt < nk; ++kt) {
            __syncthreads();
            lstore(ra0, rb0);
            __syncthreads();
            if (kt + 1 < nk) { gloadA(kt + 1, ra0); gloadB(kt + 1, rb0); }
            compute();
        }
        return;
    }
    if (DEEP == 1) {
        gloadA(0, ra0); gloadB(0, rb0); gloadA(1, ra1);
        for (int kt = 0; kt < nk; kt += 2) {
            __syncthreads();
            lstore(ra0, rb0);
            __syncthreads();
            gloadB(kt + 1, rb0);
            if (kt + 2 < nk) gloadA(kt + 2, ra0);
            compute();
            __syncthreads();
            lstore(ra1, rb0);
            __syncthreads();
            if (kt + 2 < nk) gloadB(kt + 2, rb0);
            if (kt + 3 < nk) gloadA(kt + 3, ra1);
            compute();
        }
        return;
    }
    gloadB(0, rb0); gloadA(0, ra0); gloadB(1, rb1);
    for (int kt = 0; kt < nk; kt += 2) {
        __syncthreads();
        lstore(ra0, rb0);
        __syncthreads();
        gloadA(kt + 1, ra0);
        if (kt + 2 < nk) gloadB(kt + 2, rb0);
        compute();
        __syncthreads();
        lstore(ra0, rb1);
        __syncthreads();
        if (kt + 2 < nk) gloadA(kt + 2, ra0);
        if (kt + 3 < nk) gloadB(kt + 3, rb1);
        compute();
    }
}


__device__ __forceinline__ void cvt8(const float* s, bf16* d) {
    const f32x4 a = *(const f32x4*)s, b = *(const f32x4*)(s + 4);
    u32x4 o; o[0] = pk2bf(a[0], a[1]); o[1] = pk2bf(a[2], a[3]); o[2] = pk2bf(b[0], b[1]); o[3] = pk2bf(b[2], b[3]);
    *(u32x4*)d = o;
}
__device__ __forceinline__ void cvt_small(Ctx& c, int gtid, int gthreads) {
    asm volatile("" : "+s"(c.p));

    constexpr int N_IN = 2 * D * (DINV / 8), N_OUT = 2 * D * (D / 8), N_GLU = 2 * 256 * 32;
    for (int it = gtid; it < N_IN + N_OUT + N_GLU; it += gthreads) {
        if (it < N_IN) { const int ch = it % (DINV / 8), lk = it / (DINV / 8), vc = ch * 8, ac = vc < C_DT ? vc : vc + 8;
            cvt8(c.in(8) + (size_t)lk * DIN + ac, c.w<bf16>(WS_BIN) + (size_t)lk * DINV + vc); }
        else if (it < N_IN + N_OUT) { const int j = it - N_IN; cvt8(c.in(9) + (size_t)j * 8, c.w<bf16>(WS_BOUT) + (size_t)j * 8); }
        else { const int j = it - N_IN - N_OUT; cvt8(c.in(18) + (size_t)j * 8, c.w<bf16>(WS_BGLU) + (size_t)j * 8); }
    }
}
constexpr int CVT_MOE_TILES = 1536;
__device__ __forceinline__ void cvt_moe(const Ctx& c, int layer, int tile) {
#pragma unroll 1
    for (int h = 0; h < 2; ++h) {
        const float* sp[8]; bf16* dp[8];
#pragma unroll
        for (int i = 0; i < 8; ++i) {
            const int it = tile * 4096 + (h * 8 + i) * 256 + c.tid;
            if (it < 32 * 1024 * 128) {
                const int ch = it & 127, ek = it >> 7;
                const int blk = ch >> 3, w = (ch & 7) * 8;
                sp[i] = (w < 32 ? c.in(33) : c.in(34)) + ((size_t)layer * NEXP * D + ek) * DE + blk * 32 + (w & 31);
                dp[i] = c.w<bf16>(WS_BGU) + (size_t)ek * 1024 + ch * 8;
            } else {
                const int j = it - 32 * 1024 * 128;
                sp[i] = c.in(35) + (size_t)layer * NEXP * DE * D + (size_t)j * 8; dp[i] = c.w<bf16>(WS_BDN) + (size_t)j * 8;
            }
        }
        f32x4 va[8], vb[8];
#pragma unroll
        for (int i = 0; i < 8; ++i) { va[i] = *(const f32x4*)sp[i]; vb[i] = *(const f32x4*)(sp[i] + 4); }
#pragma unroll
        for (int i = 0; i < 8; ++i) { u32x4 o; o[0] = pk2bf(va[i][0], va[i][1]); o[1] = pk2bf(va[i][2], va[i][3]); o[2] = pk2bf(vb[i][0], vb[i][1]); o[3] = pk2bf(vb[i][2], vb[i][3]); *(u32x4*)dp[i] = o; }
    }
}

__device__ __forceinline__ void ph_inproj_mfma(const Ctx& c, int layer, int tile, unsigned char* lds) {
    const int mt = tile / 18, nt = tile % 18;
    const bf16* HA = c.w<bf16>(WS_HA) + (size_t)mt * 128 * D;
    f32x4 acc[4][4];
    const int vc = nt * 128 + (c.tid & 15) * 8;
    gemm_tile<false, 1>(c.tid, lds, HA, [&](int r) __attribute__((always_inline)) { return (unsigned)(r * D); }, c.w<bf16>(WS_BIN) + (size_t)layer * D * DINV, (unsigned)vc, DINV, true, D, acc);
    const int lane = c.tid & 63, wid = c.tid >> 6, wr = wid >> 1, wc = wid & 1, fr = lane & 15, fq = lane >> 4;
    const int n0 = mt * 128, b = n0 / LT, pos0 = n0 % LT;
    if (nt < 2) {
        bf16* UH = c.w<bf16>(WS_UH);
#pragma unroll
        for (int m = 0; m < 4; ++m) {
            const int pos = pos0 + wr * 64 + m * 16 + fr, J = b * 136 + (pos >> 5), tt = pos & 31;
#pragma unroll
            for (int n = 0; n < 4; ++n) { const int col = nt * 128 + wc * 64 + n * 16 + fq * 4;
                *(uint2*)(UH + ((size_t)(col >> 4) * NCH5 + J) * 768 + tt * 16 + (col & 15)) = pack4(acc[m][n]); }
        }
    } else if (nt < 6 || nt >= 14) {
        const int kind = nt >= 14 ? 1 : 0, sub = nt - (kind ? 14 : 2);
        if (sub == 3) {
            bf16* Vt = c.w<bf16>(kind ? WS_WV : WS_GV) + ((size_t)b * 2 + wc) * 64 * LT;
#pragma unroll
            for (int m = 0; m < 4; ++m) { const int pos = pos0 + wr * 64 + m * 16 + fr;
#pragma unroll
                for (int n = 0; n < 4; ++n)
#pragma unroll
                    for (int jj = 0; jj < 4; ++jj) Vt[(size_t)(n * 16 + fq * 4 + jj) * LT + pos] = f2bf(acc[m][n][jj]); }
        } else {
            const bool isq = sub < 2; const int head = isq ? sub * 2 + wc : wc;
            bf16* dst = isq ? c.w<bf16>(kind ? WS_WQ : WS_GQ) + ((size_t)b * 4 + head) * LT * 64 : c.w<bf16>(kind ? WS_WK : WS_GK) + ((size_t)b * 2 + head) * LT * 64;
            const float* gain = (isq ? c.in(20) : c.in(21)) + layer * 64;
            const float qs = isq ? 0.18033688011112042f : 1.f;
            const float* ROPE = c.w<float>(WS_ROPE);
#pragma unroll
            for (int m = 0; m < 4; ++m) {
                const int pos = pos0 + wr * 64 + m * 16 + fr;
                f32x4 v[4];
#pragma unroll
                for (int n = 0; n < 4; ++n) v[n] = acc[m][n];
                if (kind == 0) {
                    float ss = 0.f;
#pragma unroll
                    for (int n = 0; n < 4; ++n) ss += v[n][0] * v[n][0] + v[n][1] * v[n][1] + v[n][2] * v[n][2] + v[n][3] * v[n][3];
                    ss += __shfl_xor(ss, 16); ss += __shfl_xor(ss, 32);
                    const float rstd = rsqrtf(ss * (1.f / 64.f) + EPS);
#pragma unroll
                    for (int n = 0; n < 4; ++n) v[n] = v[n] * rstd * *(const f32x4*)(gain + n * 16 + fq * 4);
                }
                if (pos >= CTX) {
                    const int l = pos - CTX;
#pragma unroll
                    for (int a = 0; a < 2; ++a) { const int rp = a == 0 ? (l >> 6) : (l & 63);
#pragma unroll
                        for (int jj = 0; jj < 4; ++jj) { const f32x2 cs = *(const f32x2*)(ROPE + (rp * 16 + fq * 4 + jj) * 2);
                            const float x0 = v[2 * a][jj], x1 = v[2 * a + 1][jj];
                            v[2 * a][jj] = x0 * cs[0] - x1 * cs[1]; v[2 * a + 1][jj] = x1 * cs[0] + x0 * cs[1]; } }
                }
#pragma unroll
                for (int n = 0; n < 4; ++n) *(uint2*)(dst + (size_t)pos * 64 + n * 16 + fq * 4) = pack4(v[n] * qs);
            }
        }
    } else {
        bf16* dst; int ld, col0;
        if (nt < 8) { dst = c.w<bf16>(WS_Z); ld = 256; col0 = (nt - 6) * 128; } else { dst = c.w<bf16>(WS_XBR); ld = 768; col0 = (nt - 8) * 128; }
#pragma unroll
        for (int m = 0; m < 4; ++m) { const size_t row = (size_t)n0 + wr * 64 + m * 16 + fr;
#pragma unroll
            for (int n = 0; n < 4; ++n) *(uint2*)(dst + row * ld + col0 + wc * 64 + n * 16 + fq * 4) = pack4(acc[m][n]); }
    }
}

#define EPI_COORDS const int lane = c.tid & 63, wid = c.tid >> 6, wr = wid >> 1, wc = wid & 1, fr = lane & 15, fq = lane >> 4
__device__ __forceinline__ void ph_glu_mfma(const Ctx& c, int layer, int tile, unsigned char* lds) {
    const int mt = tile >> 1, nt = tile & 1;
    const bf16* G5 = c.w<bf16>(WS_G5) + (size_t)mt * 128 * 256;
    f32x4 acc[4][4];
    const int bc = nt * 128 + (c.tid & 15) * 8;
    gemm_tile<false>(c.tid, lds, G5, [&](int r) __attribute__((always_inline)) { return (unsigned)(r * 256); }, c.w<bf16>(WS_BGLU) + (size_t)layer * 256 * 256, (unsigned)bc, 256, true, 256, acc);
    EPI_COORDS;
    bf16* MIX = c.w<bf16>(WS_MIX);
#pragma unroll
    for (int m = 0; m < 4; ++m)
#pragma unroll
        for (int n = 0; n < 4; ++n) {
            const int rl = wr * 64 + m * 16 + fr, col = nt * 128 + wc * 64 + n * 16 + fq * 4;
            const f32x4 bb = *(const f32x4*)(c.in(19) + layer * 256 + col);
            const uint2 gv = *(const uint2*)(G5 + (size_t)rl * 256 + col);
            const float g0 = __uint_as_float(gv.x << 16), g1 = __uint_as_float(gv.x & 0xffff0000u), g2 = __uint_as_float(gv.y << 16), g3 = __uint_as_float(gv.y & 0xffff0000u);
            uint2 o;
            o.x = pk2bf(g0 * sigmoid_f(acc[m][n][0] + bb[0]), g1 * sigmoid_f(acc[m][n][1] + bb[1]));
            o.y = pk2bf(g2 * sigmoid_f(acc[m][n][2] + bb[2]), g3 * sigmoid_f(acc[m][n][3] + bb[3]));
            *(uint2*)(MIX + (size_t)(mt * 128 + rl) * D + col) = o;
        }
}
__device__ __forceinline__ void ph_outproj_mfma(const Ctx& c, int layer, int tile, unsigned char* lds) {
    int mt = tile >> 3; const int nt = tile & 7;
    if (layer == 1) { if (mt >= 128) return; mt = (mt >> 5) * 34 + 2 + (mt & 31); }
    const bf16* MIX = c.w<bf16>(WS_MIX) + (size_t)mt * 128 * D;
    f32x4 acc[4][4];
    const int bc = nt * 128 + (c.tid & 15) * 8;
    gemm_tile<false, 1>(c.tid, lds, MIX, [&](int r) __attribute__((always_inline)) { return (unsigned)(r * D); }, c.w<bf16>(WS_BOUT) + (size_t)layer * D * D, (unsigned)bc, D, true, D, acc);
    EPI_COORDS;
    const float* MOD = c.w<float>(WS_MOD) + (size_t)layer * 5 * 6144;
    float* X = c.w<float>(WS_X);
#pragma unroll
    for (int m = 0; m < 4; ++m) {
        const int row = mt * 128 + wr * 64 + m * 16 + fr, b = row / LT, pos = row % LT, mr = pos < CTX ? 4 : b;
        const float* xs = xsrc(c, layer, row);
#pragma unroll
        for (int n = 0; n < 4; ++n) {
            const int col = nt * 128 + wc * 64 + n * 16 + fq * 4;
            const f32x4 g1 = *(const f32x4*)(MOD + mr * 6144 + 2048 + col);
            *(f32x4*)(X + (size_t)row * D + col) = *(const f32x4*)(xs + col) + g1 * acc[m][n];
        }
    }
}
__device__ __forceinline__ void ph_moe1_mfma(const Ctx& c, int layer, int tile, const int* sm, unsigned char* lds) {
    const int st = tile >> 3, nt = tile & 7;
    const int s0 = st * 128;
    if (s0 >= sm[32]) return;
    const int e = slot_expert(sm, s0), base = s0 - sm[e], ce = sm[33 + e];
    if (base >= ce) return;
    const bf16* HA = c.w<bf16>(WS_HA); const int* LI = c.w<int>(WS_LIST) + (size_t)e * NT;
    f32x4 acc[4][4];
    gemm_tile<false>(c.tid, lds, HA, [&](int r) __attribute__((always_inline)) { const int tok = LI[(base + r < ce) ? (base + r) : base]; return (unsigned)(tok * D); }, c.w<bf16>(WS_BGU) + (size_t)e * D * 1024, (unsigned)(nt * 128 + (c.tid & 15) * 8), 1024, true, D, acc);
    EPI_COORDS;
    bf16* ACT = c.w<bf16>(WS_ACT);
#pragma unroll
    for (int m = 0; m < 4; ++m) {
        const int rl = wr * 64 + m * 16 + fr;
#pragma unroll
        for (int n = 0; n < 2; ++n) {
            const int col = nt * 64 + wc * 32 + n * 16 + fq * 4;
            const f32x4 g = acc[m][n], u = acc[m][n + 2];
            uint2 o; o.x = pk2bf(silu_f(g[0]) * u[0], silu_f(g[1]) * u[1]); o.y = pk2bf(silu_f(g[2]) * u[2], silu_f(g[3]) * u[3]);
            *(uint2*)(ACT + (size_t)(s0 + rl) * DE + col) = o;
        }
    }
}
__device__ __forceinline__ void ph_moe2_mfma(const Ctx& c, int layer, int tile, const int* sm, unsigned char* lds) {
    const int st = tile >> 3, nt = tile & 7;
    const int s0 = st * 128;
    if (s0 >= sm[32]) return;
    const int e = slot_expert(sm, s0), base = s0 - sm[e], ce = sm[33 + e];
    if (base >= ce) return;
    const bf16* ACT = c.w<bf16>(WS_ACT) + (size_t)s0 * DE;
    f32x4 acc[4][4];
    const int bc = nt * 128 + (c.tid & 15) * 8;
    gemm_tile<false>(c.tid, lds, ACT, [&](int r) __attribute__((always_inline)) { return (unsigned)(r * DE); }, c.w<bf16>(WS_BDN) + (size_t)e * DE * D, (unsigned)bc, D, true, DE, acc);
    EPI_COORDS;
    bf16* OUT = c.w<bf16>(WS_OUT);
#pragma unroll
    for (int m = 0; m < 4; ++m)
#pragma unroll
        for (int n = 0; n < 4; ++n) {
            const int rl = wr * 64 + m * 16 + fr, col = nt * 128 + wc * 64 + n * 16 + fq * 4;
            uint2 o; o.x = pk2bf(acc[m][n][0], acc[m][n][1]); o.y = pk2bf(acc[m][n][2], acc[m][n][3]);
            *(uint2*)(OUT + (size_t)(s0 + rl) * D + col) = o;
        }
}


typedef float f32x16 __attribute__((ext_vector_type(16)));
constexpr int AT_KST = 144, AT_VST = 136;
constexpr int AT_KOFF = 0, AT_VOFF = 64 * AT_KST, AT_BUF = AT_VOFF + 64 * AT_VST;
constexpr int AT_SOFF = GEMM_LDS + 512;
static_assert(2 * AT_BUF <= GEMM_LDS, "attention double buffer must fit the GEMM LDS region");
constexpr float AT_THR = 5.0f;
__device__ __forceinline__ float vmax(float a, float b) { return __builtin_fmaxf(a, b); }
__device__ __forceinline__ float vmax3(float a, float b, float c) { return __builtin_fmaxf(__builtin_fmaxf(a, b), c); }
__device__ __forceinline__ float xhalf(float v) { const auto r = __builtin_amdgcn_permlane32_swap(__float_as_uint(v), __float_as_uint(v), false, false); return __uint_as_float((threadIdx.x & 32) ? r[0] : r[1]); }
__device__ __forceinline__ int crow(int r, int hi) { return (r & 3) + 8 * (r >> 2) + 4 * hi; }

__device__ __forceinline__ void attn_tile(const Ctx& c, int layer, int idx, unsigned char* lds) {
    const int tid = c.tid, lane = tid & 63, wid = tid >> 6, r32 = lane & 31, hi = lane >> 5;
    int kind, b, h, qt;
    if (idx < 1024) { kind = idx >> 9; const int r = idx & 511; b = r >> 7; h = (r >> 5) & 3; qt = 2 + (r & 31); }
    else { const int r = idx - 1024; kind = r >> 5; b = (r >> 3) & 3; h = (r >> 1) & 3; qt = r & 1; }
    const int kvh = h >> 1;
    const bf16* Q = c.w<bf16>(kind ? WS_WQ : WS_GQ) + ((size_t)b * 4 + h) * LT * 64;
    const bf16* K = c.w<bf16>(kind ? WS_WK : WS_GK) + ((size_t)b * 2 + kvh) * LT * 64;
    const bf16* Vt = c.w<bf16>(kind ? WS_WV : WS_GV) + ((size_t)b * 2 + kvh) * 64 * LT;
    const int q0 = qt * 128;
    const int qpos = q0 + wid * 32 + r32;
    int b0 = CTX, b1 = CTX;
    if (qt >= 2) { if (kind == 0) { b0 = CTX; b1 = LT; } else { b0 = q0 - 128 < CTX ? CTX : q0 - 128; b1 = q0 + 256 > LT ? LT : q0 + 256; } }
    const int nA = CTX / 64, ntile = nA + (b1 - b0) / 64;
    bf16x8 qf[4];
#pragma unroll
    for (int d0 = 0; d0 < 4; ++d0) qf[d0] = *(const bf16x8*)(Q + (size_t)qpos * 64 + d0 * 16 + hi * 8);
    f32x16 o0, o1;
#pragma unroll
    for (int r = 0; r < 16; ++r) { o0[r] = 0.f; o1[r] = 0.f; }
    float m = -1e30f, l = 0.f;
    if (kind == 1) { m = c.in(28)[layer * 4 + h] * 1.4426950408889634f; l = (hi == 0) ? 1.f : 0.f; }
    bool fixedref = false;
    if (kind == 0) {
        float gm = fmaxf(fabsf(c.in(20)[layer * 64 + lane]), 0.f), km = fabsf(c.in(21)[layer * 64 + lane]);
#pragma unroll
        for (int o = 1; o < 64; o <<= 1) { gm = fmaxf(gm, __shfl_xor(gm, o)); km = fmaxf(km, __shfl_xor(km, o)); }
        fixedref = __builtin_amdgcn_readfirstlane((int)(gm * km * 8.f * 1.4426950408889634f < 40.f)) != 0;
        if (fixedref) m = 0.f;
    }
    float* wsf = (float*)(lds + AT_SOFF) + wid * 32;
    u32x4 rk0[2], rv0[2];
    auto gload = [&](int ti, u32x4 (&rk)[2], u32x4 (&rv)[2]) __attribute__((always_inline)) {
        const int kb = ti < nA ? ti * 64 : b0 + (ti - nA) * 64;
#pragma unroll
        for (int i = 0; i < 2; ++i) { const int cc = tid + 256 * i;
            rk[i] = *(const u32x4*)(K + (size_t)(kb + (cc >> 3)) * 64 + (cc & 7) * 8);
            rv[i] = *(const u32x4*)(Vt + (size_t)(cc >> 3) * LT + kb + (cc & 7) * 8); }
    };
    auto lstore = [&](int buf, const u32x4 (&rk)[2], const u32x4 (&rv)[2]) __attribute__((always_inline)) {
#pragma unroll
        for (int i = 0; i < 2; ++i) { const int cc = tid + 256 * i;
            *(u32x4*)(lds + buf * AT_BUF + AT_KOFF + (cc >> 3) * AT_KST + (cc & 7) * 16) = rk[i];
            unsigned char* vp = lds + buf * AT_BUF + AT_VOFF + (cc >> 3) * AT_VST + (cc & 7) * 16;
            *(uint2*)vp = make_uint2(rv[i][0], rv[i][1]); *(uint2*)(vp + 8) = make_uint2(rv[i][2], rv[i][3]); }
    };
    const lds_cptr lk0 = (lds_cptr)lds + AT_KOFF + r32 * AT_KST + hi * 16;
    const lds_cptr lv0 = (lds_cptr)lds + AT_VOFF + r32 * AT_VST + hi * 8;
    auto compute = [&](int ti) __attribute__((always_inline)) {
        const int kb = ti < nA ? ti * 64 : b0 + (ti - nA) * 64;
        const lds_cptr lk = lk0 + (ti & 1) * AT_BUF, lv = lv0 + (ti & 1) * AT_BUF;
        f32x16 p0, p1;
#pragma unroll
        for (int r = 0; r < 16; ++r) { p0[r] = 0.f; p1[r] = 0.f; }
#pragma unroll
        for (int d0 = 0; d0 < 4; ++d0) {
            const bf16x8 k0 = *(const LAS bf16x8*)(lk + d0 * 32), k1 = *(const LAS bf16x8*)(lk + 32 * AT_KST + d0 * 32);
            p0 = __builtin_amdgcn_mfma_f32_32x32x16_bf16(k0, qf[d0], p0, 0, 0, 0);
            p1 = __builtin_amdgcn_mfma_f32_32x32x16_bf16(k1, qf[d0], p1, 0, 0, 0);
        }
        if (kind == 1 && ti >= nA) {
#pragma unroll
            for (int r = 0; r < 16; ++r) {
                const int d0_ = kb + crow(r, hi) - qpos, d1_ = d0_ + 32;
                if (d0_ > 128 || d0_ < -128) p0[r] = -INFINITY;
                if (d1_ > 128 || d1_ < -128) p1[r] = -INFINITY;
            }
        }
        s16x4 vlo[4], vhi[4];
#pragma unroll
        for (int s = 0; s < 2; ++s)
#pragma unroll
            for (int d0 = 0; d0 < 2; ++d0) { const lds_cptr vp = lv + d0 * 32 * AT_VST + (16 * s) * 2;
                vlo[s * 2 + d0] = *(const LAS s16x4*)vp; vhi[s * 2 + d0] = *(const LAS s16x4*)(vp + 16); }
        if (!fixedref) {
        float ma[8];
#pragma unroll
        for (int r = 0; r < 8; ++r) ma[r] = vmax3(p0[2 * r], p0[2 * r + 1], vmax(p1[2 * r], p1[2 * r + 1]));
        float rm = vmax(vmax3(ma[0], ma[1], ma[2]), vmax3(ma[3], ma[4], vmax3(ma[5], ma[6], ma[7])));
        rm = vmax(rm, xhalf(rm));
        if (__any(rm > m + AT_THR)) {
            const float mn = fmaxf(m, rm), f = __builtin_amdgcn_exp2f(m - mn);
            m = mn; l *= f;
            if (hi == 0) wsf[r32] = f;
#pragma unroll
            for (int g = 0; g < 4; ++g) { const f32x4 fv = *(const f32x4*)(wsf + 8 * g + 4 * hi);
#pragma unroll
                for (int j = 0; j < 4; ++j) { o0[4 * g + j] *= fv[j]; o1[4 * g + j] *= fv[j]; } }
        }
        p0 = p0 - m; p1 = p1 - m;
        }
#pragma unroll
        for (int r = 0; r < 16; ++r) { p0[r] = __builtin_amdgcn_exp2f(p0[r]); p1[r] = __builtin_amdgcn_exp2f(p1[r]); }
        { const f32x16 sv = p0 + p1;
          const f32x4 s4 = (f32x4){sv[0], sv[1], sv[2], sv[3]} + (f32x4){sv[4], sv[5], sv[6], sv[7]} + (f32x4){sv[8], sv[9], sv[10], sv[11]} + (f32x4){sv[12], sv[13], sv[14], sv[15]};
          l += (s4[0] + s4[1]) + (s4[2] + s4[3]); }
#pragma unroll
        for (int t = 0; t < 2; ++t)
#pragma unroll
            for (int s = 0; s < 2; ++s) {
                float t8[8];
#pragma unroll
                for (int j = 0; j < 8; ++j) t8[j] = t == 0 ? p0[8 * s + j] : p1[8 * s + j];
                const bf16x8 pa = pack8(t8);
#pragma unroll
                for (int d0 = 0; d0 < 2; ++d0) {
                    const lds_cptr vp = lv + d0 * 32 * AT_VST + (32 * t + 16 * s) * 2;
                    const s16x4 lo = t == 0 ? vlo[s * 2 + d0] : *(const LAS s16x4*)vp, hv = t == 0 ? vhi[s * 2 + d0] : *(const LAS s16x4*)(vp + 16);
                    const bf16x8 vf = (bf16x8){lo[0], lo[1], lo[2], lo[3], hv[0], hv[1], hv[2], hv[3]};
                    if (d0 == 0) o0 = __builtin_amdgcn_mfma_f32_32x32x16_bf16(pa, vf, o0, 0, 0, 0);
                    else o1 = __builtin_amdgcn_mfma_f32_32x32x16_bf16(pa, vf, o1, 0, 0, 0);
                }
            }
    };
    gload(0, rk0, rv0);
    __syncthreads();
    lstore(0, rk0, rv0);
    gload(1, rk0, rv0);
    __syncthreads();
    for (int ti = 0; ti < ntile; ti += 2) {
        lstore(1, rk0, rv0);
        if (ti + 2 < ntile) gload(ti + 2, rk0, rv0);
        compute(ti);
        __syncthreads();
        if (ti + 2 < ntile) lstore(0, rk0, rv0);
        if (ti + 3 < ntile) gload(ti + 3, rk0, rv0);
        compute(ti + 1);
        __syncthreads();
    }
    l += __shfl_xor(l, 32);
    if (hi == 0) wsf[r32] = 1.f / l;
    bf16* MIX = c.w<bf16>(WS_MIX) + ((size_t)b * LT + q0 + wid * 32) * D + (kind ? 768 : 256) + h * 64 + r32;
#pragma unroll
    for (int g = 0; g < 4; ++g) { const f32x4 fv = *(const f32x4*)(wsf + 8 * g + 4 * hi);
#pragma unroll
        for (int j = 0; j < 4; ++j) { const int r = 4 * g + j; bf16* mp = MIX + (size_t)crow(r, hi) * D;
            mp[0] = f2bf(o0[r] * fv[j]); mp[32] = f2bf(o1[r] * fv[j]); } }
}


__device__ __forceinline__ void ph_prepB(const Ctx& c, int tile) {
    const float* KLAG = c.w<float>(WS_KLAG); const float* S5P = c.w<float>(WS_S5P); const float* S5BB = c.w<float>(WS_S5BB);
    bf16* WY = c.w<bf16>(WS_WY); bf16* WSm = c.w<bf16>(WS_WS);
    if (tile < 3072) {
        const int it = tile * NTHR + c.tid;
        const int t = it & 31, kr = (it >> 5) % 768, lg = it / (768 * 32), l = lg >> 4, g = lg & 15;
        float v[16];
        if (kr < 512) {
            const int s = kr >> 4, cp = kr & 15;
#pragma unroll
            for (int i = 0; i < 16; ++i) v[i] = 0.f;
            if (s <= t) { const f32x4* kp = (const f32x4*)(KLAG + ((size_t)(lg * 2 + 0) * 32 + (t - s)) * 256 + cp * 16);
#pragma unroll
                for (int q = 0; q < 4; ++q) { const f32x4 x = kp[q]; v[4 * q] += x[0]; v[4 * q + 1] += x[1]; v[4 * q + 2] += x[2]; v[4 * q + 3] += x[3]; } }
            if (s >= t) { const f32x4* kp = (const f32x4*)(KLAG + ((size_t)(lg * 2 + 1) * 32 + (s - t)) * 256 + cp * 16);
#pragma unroll
                for (int q = 0; q < 4; ++q) { const f32x4 x = kp[q]; v[4 * q] += x[0]; v[4 * q + 1] += x[1]; v[4 * q + 2] += x[2]; v[4 * q + 3] += x[3]; } }
            if (s == t) { const float dsk = c.in(17)[l * 256 + g * 16 + cp];
#pragma unroll
                for (int i = 0; i < 16; ++i) if (i == cp) v[i] += dsk; }
        } else {
            const int q = kr - 512, d = q >> 7, p = (q >> 1) & 63, ri = q & 1, e = d == 0 ? t + 1 : 32 - t;
            const int ldg = (l * 2 + d) * 16 + g;
            const float pr = S5P[((size_t)(ldg * 64 + p) * 33 + e) * 2], pi = S5P[((size_t)(ldg * 64 + p) * 33 + e) * 2 + 1];
#pragma unroll
            for (int i = 0; i < 16; ++i) {
                const float cr = c.in(15)[(size_t)ldg * 1024 + i * 64 + p], ci = c.in(16)[(size_t)ldg * 1024 + i * 64 + p];
                v[i] = ri == 0 ? (cr * pr - ci * pi) : -(cr * pi + ci * pr);
            }
        }
        u32x4 o0, o1;
        o0[0] = pk2bf(v[0], v[1]); o0[1] = pk2bf(v[2], v[3]); o0[2] = pk2bf(v[4], v[5]); o0[3] = pk2bf(v[6], v[7]);
        o1[0] = pk2bf(v[8], v[9]); o1[1] = pk2bf(v[10], v[11]); o1[2] = pk2bf(v[12], v[13]); o1[3] = pk2bf(v[14], v[15]);
        u32x4* op = (u32x4*)(WY + ((size_t)lg * 768 + kr) * 512 + t * 16);
        op[0] = o0; op[1] = o1;
    }
    else {
        const int it = (tile - 3072) * NTHR + c.tid;
        const int ncq = it & 31, kr = (it >> 5) & 511, lg = it >> 14, l = lg >> 4, g = lg & 15;
        const int s = kr >> 4, cp = kr & 15, d = ncq >> 4, p0 = (ncq & 15) * 4, e = d == 0 ? 31 - s : s;
        const int ldg = (l * 2 + d) * 16 + g;
        float v[8];
#pragma unroll
        for (int i = 0; i < 4; ++i) {
            const int p = p0 + i;
            const float pr = S5P[((size_t)(ldg * 64 + p) * 33 + e) * 2], pi = S5P[((size_t)(ldg * 64 + p) * 33 + e) * 2 + 1];
            const float br = S5BB[((size_t)(ldg * 64 + p) * 16 + cp) * 2], bi = S5BB[((size_t)(ldg * 64 + p) * 16 + cp) * 2 + 1];
            v[2 * i] = pr * br - pi * bi; v[2 * i + 1] = pr * bi + pi * br;
        }
        u32x4 o; o[0] = pk2bf(v[0], v[1]); o[1] = pk2bf(v[2], v[3]); o[2] = pk2bf(v[4], v[5]); o[3] = pk2bf(v[6], v[7]);
        *(u32x4*)(WSm + ((size_t)lg * 512 + kr) * 256 + ncq * 8) = o;
    }
}
__device__ __forceinline__ void s5_gemm_s(const Ctx& c, int layer, int tile, unsigned char* lds) {
    const int nt = tile & 1, mt = (tile >> 1) % 5, g = tile / 10;
    const bf16* UH = c.w<bf16>(WS_UH) + (size_t)g * NCH5 * 768;
    f32x4 acc[4][4];
    const int bc = nt * 128 + (c.tid & 15) * 8;
    gemm_tile<false, 0>(c.tid, lds, UH, [&](int r) __attribute__((always_inline)) { int row = mt * 128 + r; row = row < NCH5 ? row : NCH5 - 1; return (unsigned)(row * 768); },
                     c.w<bf16>(WS_WS) + (size_t)(layer * 16 + g) * 512 * 256, (unsigned)bc, 256, true, 512, acc);
    EPI_COORDS;
    float* SALL = c.w<float>(WS_SALL) + (size_t)g * NCH5 * 256;
#pragma unroll
    for (int m = 0; m < 4; ++m)
#pragma unroll
        for (int n = 0; n < 4; ++n) {
            const int row = mt * 128 + wr * 64 + m * 16 + fr, col = nt * 128 + wc * 64 + n * 16 + fq * 4;
            if (row < NCH5) *(f32x4*)(SALL + (size_t)row * 256 + col) = acc[m][n];
        }
}
__device__ __forceinline__ void s5_recur(const Ctx& c, int layer, int gtid, int gthreads) {
    const float* S5P = c.w<float>(WS_S5P);
    for (int it = gtid; it < 4 * 16 * 2 * 64; it += gthreads) {
        const int p = it & 63, d = (it >> 6) & 1, g = (it >> 7) & 15, b = it >> 11;
        const int ldg = (layer * 2 + d) * 16 + g;
        const float ar = S5P[((size_t)(ldg * 64 + p) * 33 + 32) * 2], ai = S5P[((size_t)(ldg * 64 + p) * 33 + 32) * 2 + 1];
        const float* S = c.w<float>(WS_SALL) + ((size_t)g * NCH5 + b * 136) * 256 + d * 128 + p * 2;
        bf16* H = c.w<bf16>(WS_UH) + ((size_t)g * NCH5 + b * 136) * 768 + 512 + d * 128 + p * 2;
        float hr = 0.f, hi = 0.f;
#pragma unroll 1
        for (int s0 = 0; s0 < 136; s0 += 34) {
            f32x2 sv[34]; int jj[34];
#pragma unroll
            for (int i = 0; i < 34; ++i) { const int s = s0 + i; jj[i] = d == 0 ? s : (s < 8 ? 7 - s : 143 - s); sv[i] = *(const f32x2*)(S + (size_t)jj[i] * 256); }
#pragma unroll
            for (int i = 0; i < 34; ++i) {
                *(unsigned*)(H + (size_t)jj[i] * 768) = pk2bf(hr, hi);
                const float nr = ar * hr - ai * hi + sv[i][0], ni = ar * hi + ai * hr + sv[i][1]; hr = nr; hi = ni;
            }
        }
    }
}
__device__ __forceinline__ void s5_gemm_y(const Ctx& c, int layer, int tile, unsigned char* lds) {
    const int nt = tile & 3, mt = (tile >> 2) % 5, g = tile / 20;
    const bf16* UH = c.w<bf16>(WS_UH) + (size_t)g * NCH5 * 768;
    f32x4 acc[4][4];
    const int bc = nt * 128 + (c.tid & 15) * 8;
    gemm_tile<false, 0>(c.tid, lds, UH, [&](int r) __attribute__((always_inline)) { int row = mt * 128 + r; row = row < NCH5 ? row : NCH5 - 1; return (unsigned)(row * 768); },
                     c.w<bf16>(WS_WY) + (size_t)(layer * 16 + g) * 768 * 512, (unsigned)bc, 512, true, 768, acc);
    EPI_COORDS;
    bf16* G5 = c.w<bf16>(WS_G5);
#pragma unroll
    for (int m = 0; m < 4; ++m) {
        const int row = mt * 128 + wr * 64 + m * 16 + fr;
        if (row < NCH5) {
            const int b = row / 136, jj = row % 136;
#pragma unroll
            for (int n = 0; n < 4; ++n) {
                const int col = nt * 128 + wc * 64 + n * 16 + fq * 4, t = col >> 4, cc = col & 15;
                const size_t tok = (size_t)b * LT + jj * 32 + t;
                uint2 o; o.x = pk2bf(gelu_tanh(acc[m][n][0]), gelu_tanh(acc[m][n][1])); o.y = pk2bf(gelu_tanh(acc[m][n][2]), gelu_tanh(acc[m][n][3]));
                *(uint2*)(G5 + tok * 256 + g * 16 + cc) = o;
            }
        }
    }
}


__device__ __forceinline__ void ssd_vectors(const Ctx& c, int layer, int b, int j, int h, float* vec) {
    const int tid = c.tid, lane = tid & 63;
    __syncthreads();
    float dtf = 0.f, dtr = 0.f, af = 0.f, ar = 0.f;
    if (tid < 128) {
        const float* DTR = c.w<float>(WS_DTR) + ((size_t)b * LT + j * 128 + tid) * 8;
        dtf = softplus_f(DTR[h] + c.in(24)[(layer * 2 + 0) * 4 + h]);
        dtr = softplus_f(DTR[4 + h] + c.in(24)[(layer * 2 + 1) * 4 + h]);
        af = -dtf * expf(c.in(25)[(layer * 2 + 0) * 4 + h]); ar = -dtr * expf(c.in(25)[(layer * 2 + 1) * 4 + h]);
    }
    float sf = af, sr = ar;
#pragma unroll
    for (int o = 1; o < 64; o <<= 1) { const float tf = __shfl_up(sf, o), tr = __shfl_up(sr, o); if (lane >= o) { sf += tf; sr += tr; } }
    if (tid == 63) { vec[1026] = sf; vec[1027] = sr; }
    __syncthreads();
    if (tid >= 64 && tid < 128) { sf += vec[1026]; sr += vec[1027]; }
    if (tid == 127) { vec[1024] = sf; vec[1025] = sr; }
    __syncthreads();
    if (tid < 128) {
        const float totf = vec[1024], totr = vec[1025], cer = sr - ar;
        vec[tid] = dtf; vec[128 + tid] = dtr; vec[256 + tid] = sf; vec[384 + tid] = cer;
        vec[512 + tid] = dtf * __expf(totf - sf); vec[640 + tid] = dtr * __expf(cer);
        vec[768 + tid] = __expf(sf); vec[896 + tid] = __expf(totr - cer);
    }
    __syncthreads();
}
__device__ __forceinline__ void ssd_s1(const Ctx& c, int layer, int tile, unsigned char* lds) {
    const int h = tile & 3, j = (tile >> 2) % NCH, b = tile / (4 * NCH);
    float* vec = (float*)lds;
    ssd_vectors(c, layer, b, j, h, vec);
    const int tid = c.tid, lane = tid & 63, wid = tid >> 6, fr = lane & 15, fq = lane >> 4, grp = h >> 1;
    const bf16* XT = c.w<bf16>(WS_XT) + ((size_t)b * 256 + h * 64 + wid * 16 + fr) * LT + j * 128;
    const bf16* BT = c.w<bf16>(WS_BT) + ((size_t)b * 256 + grp * 128 + fr) * LT + j * 128;
    f32x4 acc[2][8];
#pragma unroll
    for (int d = 0; d < 2; ++d)
#pragma unroll
        for (int ns = 0; ns < 8; ++ns) acc[d][ns] = (f32x4){0.f, 0.f, 0.f, 0.f};
    u32x4 xraw[4];
#pragma unroll
    for (int kk = 0; kk < 4; ++kk) xraw[kk] = *(const u32x4*)(XT + 32 * kk + 8 * fq);
#pragma unroll
    for (int kk = 0; kk < 4; ++kk) {
        bf16x8 bfr[8];
#pragma unroll
        for (int ns = 0; ns < 8; ++ns) bfr[ns] = *(const bf16x8*)(BT + (size_t)ns * 16 * LT + 32 * kk + 8 * fq);
        float xv[8], xa[8], xb[8];
        unpack8v(xraw[kk], xv);
        const f32x4 w0 = *(const f32x4*)(vec + 512 + 32 * kk + 8 * fq), w1 = *(const f32x4*)(vec + 512 + 32 * kk + 8 * fq + 4);
        const f32x4 r0 = *(const f32x4*)(vec + 640 + 32 * kk + 8 * fq), r1 = *(const f32x4*)(vec + 640 + 32 * kk + 8 * fq + 4);
#pragma unroll
        for (int i = 0; i < 4; ++i) { xa[i] = xv[i] * w0[i]; xa[4 + i] = xv[4 + i] * w1[i]; xb[i] = xv[i] * r0[i]; xb[4 + i] = xv[4 + i] * r1[i]; }
        const bf16x8 xf = pack8(xa), xr = pack8(xb);
#pragma unroll
        for (int ns = 0; ns < 8; ++ns) {
            acc[0][ns] = __builtin_amdgcn_mfma_f32_16x16x32_bf16(bfr[ns], xf, acc[0][ns], 0, 0, 0);
            acc[1][ns] = __builtin_amdgcn_mfma_f32_16x16x32_bf16(bfr[ns], xr, acc[1][ns], 0, 0, 0);
        }
    }
    const size_t sidx = (size_t)((b * NCH + j) * 4 + h) * 2;
    float* ST = c.w<float>(WS_ST);
#pragma unroll
    for (int d = 0; d < 2; ++d)
#pragma unroll
        for (int ns = 0; ns < 8; ++ns) *(f32x4*)(ST + ((sidx + d) * 64 + wid * 16 + fr) * 128 + ns * 16 + 4 * fq) = acc[d][ns];
    if (tid == 0) { float* TOT = c.w<float>(WS_TOT); TOT[sidx] = __expf(vec[1024]); TOT[sidx + 1] = __expf(vec[1025]); }
}
__device__ __forceinline__ void ssd_recur(const Ctx& c, int gtid, int gthreads) {
    const float* ST = c.w<float>(WS_ST); bf16* HIN = c.w<bf16>(WS_HIN); const float* TOT = c.w<float>(WS_TOT);
    for (int it = gtid; it < 4 * 4 * 2 * 64 * 32; it += gthreads) {
        const int n4 = it & 31, p = (it >> 5) & 63, d = (it >> 11) & 1, h = (it >> 12) & 3, b = it >> 14;
        f32x4 H = (f32x4){0.f, 0.f, 0.f, 0.f};
#pragma unroll 1
        for (int s0 = 0; s0 < NCH; s0 += 17) {
            f32x4 sv[17]; float tv[17];
#pragma unroll
            for (int i = 0; i < 17; ++i) { const int s = s0 + i, jj = d == 0 ? s : (s < 2 ? 1 - s : 35 - s);
                const size_t idx = (size_t)((b * NCH + jj) * 4 + h) * 2 + d;
                sv[i] = *(const f32x4*)(ST + (idx * 64 + p) * 128 + n4 * 4); tv[i] = TOT[idx]; }
#pragma unroll
            for (int i = 0; i < 17; ++i) { const int s = s0 + i, jj = d == 0 ? s : (s < 2 ? 1 - s : 35 - s);
                const size_t idx = (size_t)((b * NCH + jj) * 4 + h) * 2 + d;
                uint2 o; o.x = pk2bf(H[0], H[1]); o.y = pk2bf(H[2], H[3]);
                *(uint2*)(HIN + (idx * 64 + p) * 128 + n4 * 4) = o;
                H = H * tv[i] + sv[i]; }
        }
    }
}
__device__ __forceinline__ void ssd_s3(const Ctx& c, int layer, int tile, unsigned char* lds) {
    const int half = tile & 1, h = (tile >> 1) & 3, j = (tile >> 3) % NCH, b = tile / (8 * NCH);
    float* vec = (float*)lds;
    const int tid = c.tid, lane = tid & 63, wid = tid >> 6, fr = lane & 15, fq = lane >> 4, grp = h >> 1;
    const size_t tok0 = (size_t)b * LT + j * 128;
    const bf16* XS = c.w<bf16>(WS_XBCS) + tok0 * 768;
    const int l = 64 * half + 16 * wid + fr;
    bf16x8 cf[4];
#pragma unroll
    for (int k = 0; k < 4; ++k) cf[k] = *(const bf16x8*)(XS + (size_t)l * 768 + 512 + grp * 128 + 32 * k + 8 * fq);
    const bf16* XT = c.w<bf16>(WS_XT) + ((size_t)b * 256 + h * 64 + fr) * LT + j * 128;
    s16x4 xlo[4][4], xhi[4][4];
#pragma unroll
    for (int kk = 0; kk < 4; ++kk)
#pragma unroll
        for (int pt = 0; pt < 4; ++pt) { const bf16* xp = XT + (size_t)pt * 16 * LT + 32 * kk + 4 * fq; xlo[kk][pt] = *(const s16x4*)xp; xhi[kk][pt] = *(const s16x4*)(xp + 16); }
    bf16x8 bfr[2][2][4];
    auto loadB = [&](int sp, bf16x8 (&dst)[2][4]) __attribute__((always_inline)) {
#pragma unroll
        for (int s2 = 0; s2 < 2; ++s2)
#pragma unroll
            for (int k = 0; k < 4; ++k) dst[s2][k] = *(const bf16x8*)(XS + (size_t)(16 * (sp + s2) + fr) * 768 + 256 + grp * 128 + 32 * k + 8 * fq);
    };
    loadB(0, bfr[0]);
    asm volatile("" ::: "memory");
    ssd_vectors(c, layer, b, j, h, vec);
    f32x4 G[8];
#pragma unroll
    for (int sp = 0; sp < 8; sp += 2) {
        if (sp + 2 < 8) { loadB(sp + 2, bfr[((sp >> 1) + 1) & 1]); asm volatile("" ::: "memory"); }
#pragma unroll
        for (int s2 = 0; s2 < 2; ++s2) {
            G[sp + s2] = (f32x4){0.f, 0.f, 0.f, 0.f};
#pragma unroll
            for (int k = 0; k < 4; ++k) G[sp + s2] = __builtin_amdgcn_mfma_f32_16x16x32_bf16(bfr[(sp >> 1) & 1][s2][k], cf[k], G[sp + s2], 0, 0, 0);
        }
    }
    const bf16* HIN = c.w<bf16>(WS_HIN) + (size_t)((b * NCH + j) * 4 + h) * 2 * 8192;
    bf16x8 hfr[4][4];
    auto loadH = [&](int d) __attribute__((always_inline)) {
#pragma unroll
        for (int k = 0; k < 4; ++k)
#pragma unroll
            for (int pt = 0; pt < 4; ++pt) hfr[k][pt] = *(const bf16x8*)(HIN + ((size_t)d * 64 + 16 * pt + fr) * 128 + 32 * k + 8 * fq);
    };
    loadH(0);
    asm volatile("" ::: "memory");
    {
        const float csf_l = vec[256 + l], cer_l = vec[384 + l];
#pragma unroll
        for (int st = 0; st < 8; ++st) {
            const int sb = 16 * st + 4 * fq;
            const f32x4 dtf_s = *(const f32x4*)(vec + sb), dtr_s = *(const f32x4*)(vec + 128 + sb), csf_s = *(const f32x4*)(vec + 256 + sb), cer_s = *(const f32x4*)(vec + 384 + sb);
#pragma unroll
            for (int jj = 0; jj < 4; ++jj) {
                const int s = sb + jj;
                float w = 0.f;
                if (s <= l) w += dtf_s[jj] * __expf(csf_l - csf_s[jj]);
                if (s >= l) w += dtr_s[jj] * __expf(cer_s[jj] - cer_l);
                G[st][jj] *= w;
            }
        }
    }
    f32x4 y[4];
#pragma unroll
    for (int pt = 0; pt < 4; ++pt) y[pt] = (f32x4){0.f, 0.f, 0.f, 0.f};
#pragma unroll
    for (int kk = 0; kk < 4; ++kk) {
        float t8[8];
#pragma unroll
        for (int i = 0; i < 4; ++i) { t8[i] = G[2 * kk][i]; t8[4 + i] = G[2 * kk + 1][i]; }
        const bf16x8 pf = pack8(t8);
#pragma unroll
        for (int pt = 0; pt < 4; ++pt) {
            const bf16x8 xf = (bf16x8){xlo[kk][pt][0], xlo[kk][pt][1], xlo[kk][pt][2], xlo[kk][pt][3], xhi[kk][pt][0], xhi[kk][pt][1], xhi[kk][pt][2], xhi[kk][pt][3]};
            y[pt] = __builtin_amdgcn_mfma_f32_16x16x32_bf16(xf, pf, y[pt], 0, 0, 0);
        }
    }
#pragma unroll
    for (int d = 0; d < 2; ++d) {
        const float e = vec[(d == 0 ? 768 : 896) + l];
        bf16x8 cs[4];
#pragma unroll
        for (int k = 0; k < 4; ++k) {
            float t8[8]; unpack8v(__builtin_bit_cast(u32x4, cf[k]), t8);
#pragma unroll
            for (int i = 0; i < 8; ++i) t8[i] *= e;
            cs[k] = pack8(t8);
        }
#pragma unroll
        for (int k = 0; k < 4; ++k)
#pragma unroll
            for (int pt = 0; pt < 4; ++pt) y[pt] = __builtin_amdgcn_mfma_f32_16x16x32_bf16(hfr[k][pt], cs[k], y[pt], 0, 0, 0);
        if (d == 0) loadH(1);
    }
    float* Y = c.w<float>(WS_YSSD) + tok0 * 256;
#pragma unroll
    for (int pt = 0; pt < 4; ++pt) *(f32x4*)(Y + (size_t)l * 256 + h * 64 + 16 * pt + 4 * fq) = y[pt];
}

__device__ __forceinline__ void ph_mix1(Ctx& c, int layer, int bid, int G, unsigned char* lds, const volatile unsigned* rolew) {
    const unsigned* ctl = c.w<unsigned>(WS_CTL);
    int role = __builtin_amdgcn_readfirstlane((int)rolew[0]), idx = __builtin_amdgcn_readfirstlane((int)rolew[1]);
    int nheavy = __builtin_amdgcn_readfirstlane((int)__hip_atomic_load(ctl + CW_NROLE, __ATOMIC_RELAXED, __HIP_MEMORY_SCOPE_AGENT)), nlight = __builtin_amdgcn_readfirstlane((int)__hip_atomic_load(ctl + CW_NROLE + 64, __ATOMIC_RELAXED, __HIP_MEMORY_SCOPE_AGENT));
    if (nheavy < 1 || nlight < 1 || nheavy + nlight != G) {
        nheavy = G / 2; nlight = G - nheavy; role = bid < nheavy ? 0 : 1; idx = role ? bid - nheavy : bid;
    }
    constexpr int CVT_H = CVT_MOE_TILES / 3;
    if (role == 0) {
        for (int t = idx; t < 512; t += nheavy) { asm volatile("" : "+v"(c.tid)); asm volatile("" : "+s"(c.p)); PR_BEGIN(130); attn_tile(c, layer, t, lds); PR_END(130); }
        for (int t = idx; t < CVT_H; t += nheavy) { asm volatile("" : "+v"(c.tid)); asm volatile("" : "+s"(c.p)); PR_BEGIN(131); cvt_moe(c, layer, t); PR_END(131); }
        return;
    }
    for (int t = idx; t < 1280 + (CVT_MOE_TILES - CVT_H); t += nlight) {
        asm volatile("" : "+v"(c.tid)); asm volatile("" : "+s"(c.p));
        if (t < 544) { PR_BEGIN(132); ssd_s1(c, layer, t, lds); PR_END(132); }
        else if (t < 1120) { PR_BEGIN(134); attn_tile(c, layer, t - 544 + 512, lds); PR_END(134); }
        else if (t < 1280) s5_gemm_s(c, layer, t - 1120, lds);
        else { PR_BEGIN(131); cvt_moe(c, layer, CVT_H + t - 1280); PR_END(131); }
    }
}

constexpr int PH_PER_LAYER = 12, N_PHASES = 2 + 2 * PH_PER_LAYER;

__global__ void __launch_bounds__(NTHR, 2) mk_fwd(Params prm) {
    __shared__ __attribute__((aligned(16))) unsigned char smem_raw[GEMM_LDS + 512 + 1536];
    float* smem = (float*)(smem_raw + GEMM_LDS);
    Ctx c; c.p = (const CAS Params*)__builtin_amdgcn_kernarg_segment_ptr(); c.smf = smem; c.tid = threadIdx.x;
    const int G = gridDim.x, bid = blockIdx.x;
    const int gthreads = G * NTHR, nwaves = gthreads >> 6;
#define gtid (bid * NTHR + c.tid)
#define gw ((bid * NTHR + c.tid) >> 6)
    int* smi = (int*)(smem + 16);
#if MK_SINGLE
    volatile unsigned* bst = (volatile unsigned*)(smem + 120);
    if (c.tid == 0) { bst[0] = 0u; bst[1] = 0u; }
    __syncthreads();
    XcdBarrier bar = xcd_barrier_post(c.w<unsigned>(WS_CTL) + CW_BAR, bst);
    if (c.tid == 0) {
        unsigned* ctl = c.w<unsigned>(WS_CTL);
        const unsigned key = (xb_xcc_id() << 8) | ((unsigned)__builtin_amdgcn_s_getreg((7 << 11) | (8 << 6) | 4) & 0xFFu);
        const unsigned prev = xb_add(&ctl[CW_CUKEY + key], 1u);
        const unsigned role = prev & 1u;
        const unsigned idx = xb_add(&ctl[CW_NROLE + 64 * role], 1u);
        ((volatile unsigned*)smem)[100] = role; ((volatile unsigned*)smem)[101] = idx;
    }
#endif
    unsigned long long pr_t0 = 0ull; c.pracc = 0ull; c.prt = 0ull;
#define pr_acc c.pracc
#if MK_SINGLE
    if (PROBE_SP == 102) { pr_t0 = __builtin_amdgcn_s_memrealtime(); xcd_barrier(bar); pr_acc += __builtin_amdgcn_s_memrealtime() - pr_t0; }
#endif
    for (int ph = prm.ph_lo; ph < prm.ph_hi; ++ph) {
        if (PROBE_SP >= 0) pr_t0 = __builtin_amdgcn_s_memrealtime();
        asm volatile("" : "+s"(c.p));
        { int t_ = threadIdx.x; asm volatile("" : "+v"(t_)); c.tid = t_; }
        if (ph == 0) { ph_prep(c, gtid, gthreads, bid, G, (float*)smem_raw); PR_BEGIN(124); cvt_small(c, gtid, gthreads); PR_END(124); }
        else if (ph == 1) ph_norm1(c, 0, gw, nwaves, smem_raw);
        else {
            const int layer = (ph - 2) / PH_PER_LAYER, sp = (ph - 2) % PH_PER_LAYER;
            switch (sp) {
            case 0: for (int t = bid; t < 136 * 18 + (layer == 0 ? 5120 : 0); t += G) { asm volatile("" : "+v"(c.tid)); if (t < 136 * 18) ph_inproj_mfma(c, layer, t, smem_raw); else ph_prepB(c, t - 136 * 18); } break;
            case 1: for (int t = bid; t < (NT / 32) * 3; t += G) ph_minipost(c, layer, t, smem_raw); break;
            case 2: ph_mix1(c, layer, bid, G, smem_raw, (const volatile unsigned*)smem + 100); break;
            case 3: s5_recur(c, layer, gtid, gthreads); ssd_recur(c, gtid, gthreads); break;
            case 4: for (int t = bid; t < 1088 + 320; t += G) { asm volatile("" : "+v"(c.tid)); asm volatile("" : "+s"(c.p)); if (t < 1088) ssd_s3(c, layer, t, smem_raw); else s5_gemm_y(c, layer, t - 1088, smem_raw); } break;
            case 5: for (int t = bid; t < 136 * 2 + NT / 8; t += G) { asm volatile("" : "+v"(c.tid)); if (t < 136 * 2) ph_glu_mfma(c, layer, t, smem_raw); else ph_gates(c, layer, t - 136 * 2); } break;
            case 6: for (int t = bid; t < 136 * 8; t += G) ph_outproj_mfma(c, layer, t, smem_raw); break;
            case 7: ph_norm2(c, layer, bid, G, smem_raw, (int*)(smem_raw + GEMM_LDS + 512)); break;
            case 8: ph_assign(c, layer, bid, G, (int*)smem_raw, (const int*)(smem_raw + GEMM_LDS + 512)); break;
            case 9: moe_offsets(c, layer, smi); for (int t = bid; t < (NSLOT / 128) * 8; t += G) ph_moe1_mfma(c, layer, t, smi, smem_raw); break;
            case 10: moe_offsets(c, layer, smi); for (int t = bid; t < (NSLOT / 128) * 8; t += G) ph_moe2_mfma(c, layer, t, smi, smem_raw); break;
            case 11: moe_offsets(c, layer, smi); ph_combine(c, layer, gw, nwaves, smi, smem_raw); break;
            }
        }
#if MK_SINGLE
        if (ph + 1 < prm.ph_hi) xcd_barrier(bar);
#endif
        if (PROBE_SP >= 0 && ((PROBE_SP < 100 && ph >= 2 && (ph - 2) % PH_PER_LAYER == PROBE_SP) || (PROBE_SP == 100 && ph == 0) || (PROBE_SP == 101 && ph == 1))) pr_acc += __builtin_amdgcn_s_memrealtime() - pr_t0;
    }
#if MK_SINGLE
    if (PROBE_SP == 200) { for (int i = 0; i < 16; ++i) xcd_barrier(bar); }
#endif
    if (PROBE_SP >= 0 && PROBE_SP < 200 && bid == 0 && c.tid == 0) { const unsigned long long t1 = __builtin_amdgcn_s_memrealtime(); while (__builtin_amdgcn_s_memrealtime() - t1 < 8ull * pr_acc) __builtin_amdgcn_s_sleep(8); }
}
}

extern "C" void kernel_launch(void* const* d_in, const int* in_sizes, int n_in, void* d_out, int out_size, void* d_ws, size_t ws_size, hipStream_t stream) {
    static int grid = 0;
    if (grid == 0) {
        if (n_in != 37 || ws_size < WS_END) { fprintf(stderr, "kernel_launch: need 37 inputs and %zu bytes of workspace; got %d, %zu\n", (size_t)WS_END, n_in, ws_size); grid = -1; return; }
        int dev = 0, cus = 0, per_cu = 0;
        hipGetDevice(&dev); hipDeviceGetAttribute(&cus, hipDeviceAttributeMultiprocessorCount, dev);
        if (hipOccupancyMaxActiveBlocksPerMultiprocessor(&per_cu, (const void*)mk_fwd, NTHR, 0) != hipSuccess || per_cu < 1) per_cu = 1;
        if (per_cu > 4) per_cu = 4;
        grid = cus * per_cu;
    }
    if (grid < 0) return;
    hipMemsetAsync((char*)d_ws + WS_CTL, 0, CTL_BYTES, stream);
    Params p{};
    for (int i = 0; i < 37; ++i) p.in[i] = (const float*)d_in[i];
    p.out = (float*)d_out; p.ws = (unsigned char*)d_ws;
#if MK_SINGLE
    p.ph_lo = 0; p.ph_hi = N_PHASES;
    void* args[] = {&p};
    hipError_t e = hipLaunchCooperativeKernel((const void*)mk_fwd, dim3(grid), dim3(NTHR), args, 0, stream);
    if (e != hipSuccess) fprintf(stderr, "cooperative launch failed: %s (grid %d)\n", hipGetErrorString(e), grid);
#else
    for (int ph = 0; ph < N_PHASES; ++ph) {
        p.ph_lo = ph; p.ph_hi = ph + 1;
        hipLaunchKernelGGL(mk_fwd, dim3(grid), dim3(NTHR), 0, stream, p);
    }
#endif
}
```

```cpp
#include <hip/hip_runtime.h>
#include <cstdio>
#include <cstdint>

#ifndef PROBE_SP
#define PROBE_SP -1
#endif
#ifndef MK_SINGLE
#define MK_SINGLE 1
#endif

namespace {
typedef unsigned short bf16;
#define LAS __attribute__((address_space(3)))

constexpr int D = 1024, NB = 4, SEQ = 4096, CTX = 256, LT = SEQ + CTX, NT = NB * LT;
constexpr int DIN = 2312;
constexpr int C_U = 0, C_GQ = 256, C_GK = 512, C_GV = 640, C_Z = 768, C_XBC = 1024, C_DT = 1792, C_WQ = 1800, C_WK = 2056, C_WV = 2184;
constexpr int NEXP = 32, DE = 512;
constexpr int NSLOT = 2 * NT + NEXP * 128;
constexpr float EPS = 1e-6f;
constexpr int NTHR = 256;

constexpr size_t al(size_t x) { return (x + 255) & ~(size_t)255; }
constexpr size_t WS_CTL = 0, CTL_BYTES = 1u << 20;
constexpr size_t WS_MOD = WS_CTL + CTL_BYTES;
constexpr size_t WS_S5A = al(WS_MOD + 2 * 5 * 6144 * 4);
constexpr size_t WS_S5BB = al(WS_S5A + 2 * 2 * 16 * 64 * 2 * 4);
constexpr size_t WS_ROPE = al(WS_S5BB + 2 * 2 * 16 * 64 * 16 * 2 * 4);
constexpr size_t WS_X = al(WS_ROPE + 64 * 16 * 2 * 4);
constexpr size_t WS_HA = al(WS_X + (size_t)NT * D * 4);
constexpr size_t WS_Z = al(WS_HA + (size_t)NT * D * 2);
constexpr size_t WS_XBR = al(WS_Z + (size_t)NT * 256 * 2);
constexpr size_t WS_GQ = al(WS_XBR + (size_t)NT * 768 * 2);
constexpr size_t WS_GK = al(WS_GQ + (size_t)NT * 256 * 2);
constexpr size_t WS_GV = al(WS_GK + (size_t)NT * 128 * 2);
constexpr size_t WS_WQ = al(WS_GV + (size_t)NT * 128 * 2);
constexpr size_t WS_WK = al(WS_WQ + (size_t)NT * 256 * 2);
constexpr size_t WS_WV = al(WS_WK + (size_t)NT * 128 * 2);
constexpr size_t WS_XBCS = al(WS_WV + (size_t)NT * 128 * 2);
constexpr size_t WS_YSSD = al(WS_XBCS + (size_t)NT * 768 * 2);
constexpr size_t WS_G5 = al(WS_YSSD + (size_t)NT * 256 * 4);
constexpr size_t WS_MIX = al(WS_G5 + (size_t)NT * 256 * 2);
constexpr size_t WS_OUT = WS_Z;
constexpr size_t WS_ACT = al(WS_OUT + (size_t)NSLOT * D * 2);
static_assert(WS_ACT + (size_t)NSLOT * DE * 2 <= WS_MIX, "MoE-stage alias must end before MIX");
constexpr size_t WS_TOKE = al(WS_MIX + (size_t)NT * D * 2);
constexpr size_t WS_TOKP = al(WS_TOKE + (size_t)NT * 2 * 4);
constexpr size_t WS_TOKW = al(WS_TOKP + (size_t)NT * 2 * 4);
constexpr size_t WS_LIST = al(WS_TOKW + (size_t)NT * 2 * 4);
constexpr size_t WS_DTR = al(WS_LIST + (size_t)NEXP * NT * 4);
constexpr int NCH5 = NT / 32;
constexpr size_t WS_S5P = al(WS_DTR + (size_t)NT * 8 * 4);
constexpr size_t WS_KLAG = al(WS_S5P + (size_t)2 * 2 * 16 * 64 * 33 * 2 * 4);
constexpr size_t WS_WY = al(WS_KLAG + (size_t)2 * 16 * 2 * 32 * 256 * 4);
constexpr size_t WS_WS = al(WS_WY + (size_t)2 * 16 * 768 * 512 * 2);
constexpr size_t WS_UH = al(WS_WS + (size_t)2 * 16 * 512 * 256 * 2);
constexpr size_t WS_SALL = al(WS_UH + (size_t)16 * NCH5 * 768 * 2);
constexpr int NCH = LT / 128;
constexpr size_t WS_XT = al(WS_SALL + (size_t)16 * NCH5 * 256 * 4);
constexpr size_t WS_BT = al(WS_XT + (size_t)NB * 256 * LT * 2);
constexpr size_t WS_ST = al(WS_BT + (size_t)NB * 256 * LT * 2);
constexpr size_t WS_HIN = al(WS_ST + (size_t)NB * NCH * 8 * 8192 * 4);
constexpr size_t WS_TOT = al(WS_HIN + (size_t)NB * NCH * 8 * 8192 * 2);
constexpr size_t WS_BCNT = al(WS_TOT + (size_t)NB * NCH * 8 * 4);
constexpr size_t WS_WDT = al(WS_BCNT + 1024 * 32 * 4);
constexpr size_t WS_RWT = al(WS_WDT + 2 * 8 * 1024 * 4);
constexpr int DINV = 2304;
constexpr size_t WS_BIN = al(WS_RWT + 2 * 36 * 1024 * 4);
constexpr size_t WS_BOUT = al(WS_BIN + (size_t)2 * D * DINV * 2);
constexpr size_t WS_BGLU = al(WS_BOUT + (size_t)2 * D * D * 2);
constexpr size_t WS_BGU = al(WS_BGLU + (size_t)2 * 256 * 256 * 2);
constexpr size_t WS_BDN = al(WS_BGU + (size_t)NEXP * D * 1024 * 2);
constexpr size_t WS_END = al(WS_BDN + (size_t)NEXP * DE * D * 2);
constexpr size_t WS_VEC = WS_HA;
constexpr int CW_CNT = 8192;
constexpr int CW_BAR = 4096;
constexpr int CW_NROLE = 64;
constexpr int CW_MOEF = 16384;
constexpr int CW_L1 = 40960;
constexpr int CW_CUKEY = 32768;

struct Params {
    const float* in[37];
    float* out;
    unsigned char* ws;
    int ph_lo, ph_hi;
};

typedef short bf16x8 __attribute__((ext_vector_type(8)));
typedef short s16x4 __attribute__((ext_vector_type(4)));
typedef float f32x4 __attribute__((ext_vector_type(4)));
typedef unsigned u32x4 __attribute__((ext_vector_type(4)));
__device__ __forceinline__ float bf2f(bf16 v) { return __uint_as_float(((unsigned)v) << 16); }
typedef float f32x2 __attribute__((ext_vector_type(2)));
typedef __bf16 bf16x2_t __attribute__((ext_vector_type(2)));
__device__ __forceinline__ bf16 f2bf(float f) { return __builtin_bit_cast(bf16, (__bf16)f); }
__device__ __forceinline__ float silu_f(float x) { return x * __builtin_amdgcn_rcpf(1.f + __expf(-x)); }
__device__ __forceinline__ float sigmoid_f(float x) { return __builtin_amdgcn_rcpf(1.f + __expf(-x)); }
__device__ __forceinline__ float gelu_tanh(float x) { const float u = 0.7978845608028654f * (x + 0.044715f * x * x * x); return x * __builtin_amdgcn_rcpf(1.f + __expf(-2.f * u)); }
__device__ __forceinline__ float softplus_f(float x) { return fmaxf(x, 0.f) + log1pf(__expf(-fabsf(x))); }
__device__ __forceinline__ float wave_sum(float v) {
#pragma unroll
    for (int o = 1; o < 64; o <<= 1) v += __shfl_xor(v, o);
    return v;
}
__device__ __forceinline__ float block_sum(float v, float* red) {
    v = wave_sum(v);
    __syncthreads();
    if ((threadIdx.x & 63) == 0) red[threadIdx.x >> 6] = v;
    __syncthreads();
    return red[0] + red[1] + red[2] + red[3];
}
__device__ __forceinline__ unsigned pk2bf(float lo, float hi) { const f32x2 v = {lo, hi}; return __builtin_bit_cast(unsigned, __builtin_convertvector(v, bf16x2_t)); }
__device__ __forceinline__ void unpack8v(const u32x4 v, float (&f)[8]) {
    f[0] = __uint_as_float(v[0] << 16); f[1] = __uint_as_float(v[0] & 0xffff0000u);
    f[2] = __uint_as_float(v[1] << 16); f[3] = __uint_as_float(v[1] & 0xffff0000u);
    f[4] = __uint_as_float(v[2] << 16); f[5] = __uint_as_float(v[2] & 0xffff0000u);
    f[6] = __uint_as_float(v[3] << 16); f[7] = __uint_as_float(v[3] & 0xffff0000u);
}
__device__ __forceinline__ bf16x8 pack8(const float (&f)[8]) {
    u32x4 v; v[0] = pk2bf(f[0], f[1]); v[1] = pk2bf(f[2], f[3]); v[2] = pk2bf(f[4], f[5]); v[3] = pk2bf(f[6], f[7]);
    return __builtin_bit_cast(bf16x8, v);
}
__device__ __forceinline__ f32x4 bf4(const uint2 u) { return (f32x4){__uint_as_float(u.x << 16), __uint_as_float(u.x & 0xffff0000u), __uint_as_float(u.y << 16), __uint_as_float(u.y & 0xffff0000u)}; }
__device__ __forceinline__ uint2 pack4(const f32x4 v) { uint2 o; o.x = pk2bf(v[0], v[1]); o.y = pk2bf(v[2], v[3]); return o; }
__device__ __forceinline__ void unpack8(const uint4 v, float (&f)[8]) {
    f[0] = __uint_as_float(v.x << 16); f[1] = __uint_as_float(v.x & 0xffff0000u);
    f[2] = __uint_as_float(v.y << 16); f[3] = __uint_as_float(v.y & 0xffff0000u);
    f[4] = __uint_as_float(v.z << 16); f[5] = __uint_as_float(v.z & 0xffff0000u);
    f[6] = __uint_as_float(v.w << 16); f[7] = __uint_as_float(v.w & 0xffff0000u);
}

#define XB_TMO      128
#define XB_XCNT(j)  (256  + 64 * (j))
#define XB_XSUB(j)  (1280 + 64 * (j))
#define XB_XGEN(j)  (2304 + 64 * (j))
#define XB_TOP      3328
#define XB_TOPGEN   3392
#define XCD_BAR_WORDS 3456
#define XB_SPIN_CAP (1u << 22)
__device__ __forceinline__ unsigned xb_ld(unsigned* p)              { return __hip_atomic_load(p, __ATOMIC_RELAXED, __HIP_MEMORY_SCOPE_AGENT); }
__device__ __forceinline__ unsigned xb_add(unsigned* p, unsigned v) { return __hip_atomic_fetch_add(p, v, __ATOMIC_RELAXED, __HIP_MEMORY_SCOPE_AGENT); }
__device__ __forceinline__ unsigned xb_xcc_id() { return (unsigned)__builtin_amdgcn_s_getreg((3 << 11) | 20) & 0xFu; }
#define XB_SPIN(cond, bar) do { unsigned _sp = 0; while (cond) { __builtin_amdgcn_s_sleep(1); \
    if ((++_sp & 255u) == 0u) { if (xb_ld(&(bar)[XB_TMO])) break; if (_sp > XB_SPIN_CAP) { atomicAdd(&(bar)[XB_TMO], 1u); break; } } } } while (0)
struct XcdBarrier { unsigned* bar; unsigned x; volatile unsigned* st; };
__device__ __forceinline__ XcdBarrier xcd_barrier_post(unsigned* bar, volatile unsigned* st) {
    XcdBarrier b; b.bar = bar; b.x = xb_xcc_id(); b.st = st;
    if (threadIdx.x == 0) (void)xb_add(&bar[XB_XCNT(b.x)], 1u);
    return b;
}
__device__ __forceinline__ void xcd_barrier_complete(unsigned* bar, unsigned x, unsigned& nloc, unsigned& nx) {
    const unsigned G = gridDim.x * gridDim.y * gridDim.z;
    unsigned sum, cnt, mine, sp = 0u;
    for (;;) {
        sum = 0u; cnt = 0u; mine = 0u;
#pragma unroll
        for (unsigned j = 0; j < 16; ++j) { const unsigned c = xb_ld(&bar[XB_XCNT(j)]); sum += c; cnt += (c > 0u) ? 1u : 0u; mine = (j == x) ? c : mine; }
        if (sum == G) break;
        __builtin_amdgcn_s_sleep(1);
        if ((++sp & 255u) == 0u) { if (xb_ld(&bar[XB_TMO])) break; if (sp > XB_SPIN_CAP) { atomicAdd(&bar[XB_TMO], 1u); break; } }
    }
    nloc = mine > 0u ? mine : 1u; nx = cnt > 0u ? cnt : 1u;
}
__device__ __forceinline__ void xcd_barrier(const XcdBarrier& b) {
    asm volatile("s_waitcnt vmcnt(0)" ::: "memory");
    __syncthreads();
    if (threadIdx.x == 0) {
        unsigned* bar = b.bar;
        __builtin_amdgcn_s_waitcnt(0);
        unsigned nloc = b.st[0], nx = b.st[1];
        if (nloc == 0u) { xcd_barrier_complete(bar, b.x, nloc, nx); b.st[0] = nloc; b.st[1] = nx; }
        const unsigned old = xb_add(&bar[XB_XSUB(b.x)], 1u);
        const unsigned gen = old / nloc;
        if (old + 1u == (gen + 1u) * nloc) {
            __builtin_amdgcn_fence(__ATOMIC_RELEASE, "agent");
            asm volatile("s_waitcnt vmcnt(0)" ::: "memory");
            const unsigned og = xb_add(&bar[XB_TOP], 1u);
            const unsigned tg = og / nx;
            if (og + 1u == (tg + 1u) * nx) xb_add(&bar[XB_TOPGEN], 1u);
            else XB_SPIN(xb_ld(&bar[XB_TOPGEN]) == tg, bar);
            __builtin_amdgcn_fence(__ATOMIC_ACQUIRE, "agent");
            xb_add(&bar[XB_XGEN(b.x)], 1u);
            asm volatile("s_waitcnt vmcnt(0)" ::: "memory");
        } else {
            XB_SPIN(xb_ld(&bar[XB_XGEN(b.x)]) == gen, bar);
            __builtin_amdgcn_fence(__ATOMIC_ACQUIRE, "agent");
            asm volatile("s_waitcnt vmcnt(0)" ::: "memory");
        }
    }
    __syncthreads();
}

#define CAS __attribute__((address_space(4)))
#define PR_BEGIN(id) do { if (PROBE_SP == (id)) c.prt = __builtin_amdgcn_s_memrealtime(); } while (0)
#define PR_END(id) do { if (PROBE_SP == (id)) c.pracc += __builtin_amdgcn_s_memrealtime() - c.prt; } while (0)
struct Ctx {
    const CAS Params* p;
    float* smf;
    int tid;
    mutable unsigned long long pracc, prt;
    __device__ __forceinline__ const float* in(int i) const { return p->in[i]; }
    __device__ __forceinline__ float* out() const { return p->out; }
    template <class T> __device__ __forceinline__ T* w(size_t off) const { return (T*)(p->ws + off); }
};

__device__ __forceinline__ const float* xsrc(const Ctx& c, int layer, int n) {
    if (layer == 0) { const int b = n / LT, pos = n % LT; return pos < CTX ? c.in(2) + ((size_t)b * CTX + pos) * D : c.in(0) + ((size_t)b * SEQ + (pos - CTX)) * D; }
    return c.w<float>(WS_X) + (size_t)n * D;
}
__device__ __forceinline__ void ngemm8(const bf16* const (&ar)[8], const float* bcol, int ldb, int K, float (&acc)[8]) {
    for (int k0 = 0; k0 < K; k0 += 8) {
        float w[8];
#pragma unroll
        for (int kk = 0; kk < 8; ++kk) w[kk] = bcol[(size_t)(k0 + kk) * ldb];
#pragma unroll
        for (int r = 0; r < 8; ++r) {
            float a[8]; unpack8(*(const uint4*)(ar[r] + k0), a);
#pragma unroll
            for (int kk = 0; kk < 8; ++kk) acc[r] = fmaf(a[kk], w[kk], acc[r]);
        }
    }
}

__device__ __forceinline__ void ph_prep(Ctx& c, int gtid, int gthreads, int bid, int G, float* lds) {
    float* MOD = c.w<float>(WS_MOD);
    const int tid = c.tid;
    PR_BEGIN(120);
    for (int tile = bid; tile < 192; tile += G) {
        const int l = tile / 96, j0 = (tile % 96) * 64;
        __syncthreads();
        for (int idx = tid; idx < 5 * D; idx += NTHR) { const int r = idx >> 10, k = idx & 1023; lds[idx] = silu_f(r < 4 ? c.in(1)[r * D + k] : c.in(3)[k]); }
        __syncthreads();
        const int jj = tid & 63, kq = tid >> 6;
        const float* aw = c.in(4) + (size_t)l * D * 6144 + j0 + jj;
        float acc[5] = {0.f, 0.f, 0.f, 0.f, 0.f};
        for (int k0 = kq * 256; k0 < kq * 256 + 256; k0 += 32) {
            float w[32];
#pragma unroll
            for (int i = 0; i < 32; ++i) w[i] = aw[(size_t)(k0 + i) * 6144];
#pragma unroll
            for (int i = 0; i < 32; ++i)
#pragma unroll
                for (int r = 0; r < 5; ++r) acc[r] = fmaf(lds[r * D + k0 + i], w[i], acc[r]);
        }
#pragma unroll
        for (int r = 0; r < 5; ++r) lds[5 * D + (kq * 64 + jj) * 5 + r] = acc[r];
        __syncthreads();
        for (int idx = tid; idx < 320; idx += NTHR) { const int j2 = idx / 5, r = idx % 5;
            const float s = lds[5 * D + j2 * 5 + r] + lds[5 * D + (64 + j2) * 5 + r] + lds[5 * D + (128 + j2) * 5 + r] + lds[5 * D + (192 + j2) * 5 + r];
            MOD[(l * 5 + r) * 6144 + j0 + j2] = s + c.in(5)[l * 6144 + j0 + j2]; }
    }
    PR_END(120); PR_BEGIN(121);
    asm volatile("" : "+s"(c.p));
    float* S5A = c.w<float>(WS_S5A); float* S5BB = c.w<float>(WS_S5BB);
    for (int it = gtid; it < 2 * 2 * 16 * 64; it += gthreads) {
        const int ldg = it / 64;
        const float lr = c.in(10)[it], li = c.in(11)[it], dt = expf(c.in(12)[ldg]);
        const float mag = expf(lr * dt), are = mag * cosf(li * dt), aim = mag * sinf(li * dt);
        const float den = lr * lr + li * li;
        const float fre = ((are - 1.f) * lr + aim * li) / den, fim = (aim * lr - (are - 1.f) * li) / den;
        S5A[it * 2] = are; S5A[it * 2 + 1] = aim;
        f32x4 brv[4], biv[4];
#pragma unroll
        for (int q = 0; q < 4; ++q) { brv[q] = *(const f32x4*)(c.in(13) + (size_t)it * 16 + 4 * q); biv[q] = *(const f32x4*)(c.in(14) + (size_t)it * 16 + 4 * q); }
#pragma unroll
        for (int q = 0; q < 4; ++q) {
            f32x4 o0, o1;
            o0[0] = fre * brv[q][0] - fim * biv[q][0]; o0[1] = fre * biv[q][0] + fim * brv[q][0]; o0[2] = fre * brv[q][1] - fim * biv[q][1]; o0[3] = fre * biv[q][1] + fim * brv[q][1];
            o1[0] = fre * brv[q][2] - fim * biv[q][2]; o1[1] = fre * biv[q][2] + fim * brv[q][2]; o1[2] = fre * brv[q][3] - fim * biv[q][3]; o1[3] = fre * biv[q][3] + fim * brv[q][3];
            *(f32x4*)(S5BB + ((size_t)it * 16 + 4 * q) * 2) = o0; *(f32x4*)(S5BB + ((size_t)it * 16 + 4 * q + 2) * 2) = o1;
        }
    }
    asm volatile("" : "+s"(c.p));
    float* S5P = c.w<float>(WS_S5P);
    for (int it = gtid; it < 2 * 2 * 16 * 64 * 33; it += gthreads) {
        const int ldgp = it / 33, k = it % 33;
        const float lr = c.in(10)[ldgp], li = c.in(11)[ldgp], dt = expf(c.in(12)[ldgp / 64]);
        const float e = expf((float)k * lr * dt), ang = (float)k * li * dt;
        S5P[it * 2] = e * cosf(ang); S5P[it * 2 + 1] = e * sinf(ang);
    }
    PR_END(121); PR_BEGIN(122);
    asm volatile("" : "+s"(c.p));
    float* KLAG = c.w<float>(WS_KLAG);
    for (int tile = (G >= 256 ? bid - 192 + (bid < 192 ? G : 0) : bid); tile < 64; tile += G) {
        const int d = tile & 1, g = (tile >> 1) & 15, l = tile >> 5, ldg = (l * 2 + d) * 16 + g;
        float* LA = lds;
        float* LB = lds + 256;
        float* LC = lds + 2304;
        __syncthreads();
        if (tid < 64) {
            const int ldgp = ldg * 64 + tid;
            const float lr = c.in(10)[ldgp], li = c.in(11)[ldgp], dt = expf(c.in(12)[ldg]);
            const float mag = expf(lr * dt), are = mag * cosf(li * dt), aim = mag * sinf(li * dt), den = lr * lr + li * li;
            LA[tid * 4] = are; LA[tid * 4 + 1] = aim; LA[tid * 4 + 2] = ((are - 1.f) * lr + aim * li) / den; LA[tid * 4 + 3] = (aim * lr - (are - 1.f) * li) / den;
        }
        __syncthreads();
        for (int idx = tid; idx < 1024; idx += NTHR) {
            const int p = idx >> 4, cp = idx & 15;
            const float fre = LA[p * 4 + 2], fim = LA[p * 4 + 3];
            const float br = c.in(13)[((size_t)ldg * 64 + p) * 16 + cp], bi = c.in(14)[((size_t)ldg * 64 + p) * 16 + cp];
            LB[idx * 2] = fre * br - fim * bi; LB[idx * 2 + 1] = fre * bi + fim * br;
            const int cc = idx >> 6, p2 = idx & 63;
            LC[idx * 2] = c.in(15)[(size_t)ldg * 1024 + cc * 64 + p2]; LC[idx * 2 + 1] = c.in(16)[(size_t)ldg * 1024 + cc * 64 + p2];
        }
        __syncthreads();
        const int cp = tid >> 4, cc = tid & 15;
        float acc[32];
#pragma unroll
        for (int k = 0; k < 32; ++k) acc[k] = 0.f;
        for (int p = 0; p < 64; ++p) {
            const float are = LA[p * 4], aim = LA[p * 4 + 1];
            const float bbr = LB[(p * 16 + cp) * 2], bbi = LB[(p * 16 + cp) * 2 + 1], cr = LC[(cc * 64 + p) * 2], ci = LC[(cc * 64 + p) * 2 + 1];
            float zr = cr * bbr - ci * bbi, zi = cr * bbi + ci * bbr;
#pragma unroll
            for (int k = 0; k < 32; ++k) { acc[k] += zr; const float tr = zr * are - zi * aim, ti = zr * aim + zi * are; zr = tr; zi = ti; }
        }
#pragma unroll
        for (int k = 0; k < 32; ++k) KLAG[((size_t)((l * 16 + g) * 2 + d) * 32 + k) * 256 + cp * 16 + cc] = acc[k];
    }
    PR_END(122); PR_BEGIN(123);
    asm volatile("" : "+s"(c.p));
    float* RWT = c.w<float>(WS_RWT);
    for (int it = gtid; it < 2 * 36 * 1024; it += gthreads) { const int k = it & 1023, o = (it >> 10) % 36, l = it / (36 * 1024);
        RWT[it] = o < 4 ? c.in(29)[((size_t)l * D + k) * 4 + o] : c.in(31)[((size_t)l * D + k) * 32 + (o - 4)]; }
    asm volatile("" : "+s"(c.p));
    float* WDT = c.w<float>(WS_WDT);
    for (int it = gtid; it < 2 * 8 * 1024; it += gthreads) { const int k = it & 1023, j = (it >> 10) & 7, l = it >> 13; WDT[it] = c.in(8)[((size_t)l * D + k) * DIN + C_DT + j]; }
    asm volatile("" : "+s"(c.p));
    float* ROPE = c.w<float>(WS_ROPE);
    for (int it = gtid; it < 64 * 16; it += gthreads) {
        const int pos = it / 16, f = it % 16;
        const float inv = powf(10000.0f, -(float)f / 16.0f);
        const float ang = (float)pos * inv;
        ROPE[it * 2] = cosf(ang); ROPE[it * 2 + 1] = sinf(ang);
    }
    PR_END(123);
}

__device__ __forceinline__ void dt_project(const LAS float* wdt, const f32x4 (&h)[4], int lane, float* dst) {
    float mine = 0.f;
#pragma unroll 2
    for (int q = 0; q < 8; ++q) {
        float s = 0.f;
#pragma unroll
        for (int i = 0; i < 4; ++i) { const f32x4 w = *(const LAS f32x4*)(wdt + q * 1024 + (lane + 64 * i) * 4); s += h[i][0] * w[0] + h[i][1] * w[1] + h[i][2] * w[2] + h[i][3] * w[3]; }
        s = wave_sum(s);
        if (lane == q) mine = s;
    }
    if (lane < 8) dst[lane] = mine;
}
__device__ __forceinline__ void ph_norm1(const Ctx& c, int layer, int gw, int nwaves, unsigned char* lds) {
    const int lane = c.tid & 63;
    bf16* HA = c.w<bf16>(WS_HA); float* DTR = c.w<float>(WS_DTR);
    const float* MOD = c.w<float>(WS_MOD) + (size_t)layer * 5 * 6144;
    const float* g = c.in(6) + layer * D;
    __syncthreads();
    {
        f32x4 w8[8];
#pragma unroll
        for (int j = 0; j < 8; ++j) w8[j] = ((const f32x4*)(c.w<float>(WS_WDT) + (size_t)layer * 8 * 1024))[c.tid + NTHR * j];
#pragma unroll
        for (int j = 0; j < 8; ++j) ((LAS f32x4*)lds)[c.tid + NTHR * j] = w8[j];
    }
    __syncthreads();
    const LAS float* wdt = (const LAS float*)lds;
    f32x4 gv[4];
#pragma unroll
    for (int i = 0; i < 4; ++i) gv[i] = *(const f32x4*)(g + (lane + 64 * i) * 4);
    for (int n = gw; n < NT; n += nwaves) {
        const int b = n / LT, pos = n % LT, mr = pos < CTX ? 4 : b;
        const float* x = xsrc(c, layer, n);
        f32x4 v[4], sc[4], sh[4]; float ss = 0.f;
#pragma unroll
        for (int i = 0; i < 4; ++i) { const int k = (lane + 64 * i) * 4; v[i] = *(const f32x4*)(x + k); sc[i] = *(const f32x4*)(MOD + mr * 6144 + 1024 + k); sh[i] = *(const f32x4*)(MOD + mr * 6144 + k); }
#pragma unroll
        for (int i = 0; i < 4; ++i) ss += v[i][0] * v[i][0] + v[i][1] * v[i][1] + v[i][2] * v[i][2] + v[i][3] * v[i][3];
        const float rstd = rsqrtf(wave_sum(ss) * (1.f / D) + EPS);
#pragma unroll
        for (int i = 0; i < 4; ++i) {
            const int k = (lane + 64 * i) * 4;
            v[i] = v[i] * rstd * gv[i] * (sc[i] + 1.f) + sh[i];
            *(uint2*)(HA + (size_t)n * D + k) = pack4(v[i]);
        }
        dt_project(wdt, v, lane, DTR + (size_t)n * 8);
    }
}

constexpr int MP_TOK = 32, MP_RST = 528;
struct MpRegs { u32x4 v[5]; };
__device__ __forceinline__ void mp_load(const Ctx& c, int tile, MpRegs& R) {
    const int r = tile % 3, tb = tile / 3, tid = c.tid;
    const int n0 = tb * MP_TOK, b = n0 / LT, pos0 = n0 % LT;
    const bf16* XB = c.w<bf16>(WS_XBR) + r * 256;
#pragma unroll
    for (int i = 0; i < 5; ++i) {
        int idx = tid + NTHR * i; idx = idx < 34 * 32 ? idx : 34 * 32 - 1;
        const int row = idx >> 5, ch = idx & 31;
        const bool ok = !((row == 0 && (pos0 == 0 || pos0 == CTX)) || (row == 33 && (pos0 + MP_TOK == CTX || pos0 + MP_TOK == LT)));
        const int pos = ok ? pos0 + row - 1 : pos0;
        const u32x4 v = *(const u32x4*)(XB + ((size_t)b * LT + pos) * 768 + ch * 8);
        R.v[i] = ok ? v : (u32x4){0u, 0u, 0u, 0u};
    }
}
__device__ __forceinline__ void ph_minipost(const Ctx& c, int layer, int tile, int tile_next, MpRegs& R, unsigned char* lds) {
    const int r = tile % 3, tb = tile / 3, tid = c.tid;
    const int n0 = tb * MP_TOK, b = n0 / LT, pos0 = n0 % LT;
    unsigned char* raw = lds;
    bf16* trs = (bf16*)(lds + 34 * MP_RST);
    __syncthreads();
#pragma unroll
    for (int i = 0; i < 5; ++i) { const int idx = tid + NTHR * i; if (idx < 34 * 32) *(u32x4*)(raw + (idx >> 5) * MP_RST + (idx & 31) * 16) = R.v[i]; }
    if (tile_next >= 0) mp_load(c, tile_next, R);
    __syncthreads();
    const float* cw = c.in(22) + (size_t)layer * 3 * 768 + r * 256; const float* cb = c.in(23) + layer * 768 + r * 256;
    const int ch = tid & 31;
    f32x4 w0[2], w1[2], w2[2], bb[2];
#pragma unroll
    for (int q = 0; q < 2; ++q) { w0[q] = *(const f32x4*)(cw + ch * 8 + 4 * q); w1[q] = *(const f32x4*)(cw + 768 + ch * 8 + 4 * q); w2[q] = *(const f32x4*)(cw + 1536 + ch * 8 + 4 * q); bb[q] = *(const f32x4*)(cb + ch * 8 + 4 * q); }
    bf16* XS = c.w<bf16>(WS_XBCS) + r * 256;
#pragma unroll
    for (int i = 0; i < 4; ++i) {
        const int t = (tid >> 5) + 8 * i;
        float xl[8], xc[8], xr[8], y[8];
        unpack8v(*(const u32x4*)(raw + t * MP_RST + ch * 16), xl); unpack8v(*(const u32x4*)(raw + (t + 1) * MP_RST + ch * 16), xc); unpack8v(*(const u32x4*)(raw + (t + 2) * MP_RST + ch * 16), xr);
#pragma unroll
        for (int q = 0; q < 2; ++q)
#pragma unroll
            for (int j = 0; j < 4; ++j) y[4 * q + j] = silu_f(w1[q][j] * xc[4 * q + j] + w0[q][j] * xl[4 * q + j] + w2[q][j] * xr[4 * q + j] + bb[q][j]);
        const bf16x8 yb = pack8(y);
        *(bf16x8*)(XS + ((size_t)n0 + t) * 768 + ch * 8) = yb;
        if (r < 2) {
#pragma unroll
            for (int j = 0; j < 8; ++j) trs[(ch * 8 + j) * 32 + t] = (bf16)yb[j];
        }
    }
    if (r < 2) {
        __syncthreads();
        bf16* TR = (r == 0 ? c.w<bf16>(WS_XT) : c.w<bf16>(WS_BT)) + (size_t)b * 256 * LT + pos0;
        for (int idx = tid; idx < 1024; idx += NTHR) { const int chn = idx >> 2, pc = idx & 3;
            *(u32x4*)(TR + (size_t)chn * LT + pc * 8) = *(const u32x4*)(trs + chn * 32 + pc * 8); }
    }
}

__device__ __forceinline__ void ph_gates(const Ctx& c, int layer, int tile) {
    const int lane = c.tid & 63, n0 = tile * 32 + (c.tid >> 6) * 8, t4 = lane * 4;
    const float dsk = c.in(26)[layer * 4 + (lane >> 4)];
    const f32x4 gn = *(const f32x4*)(c.in(27) + layer * 256 + t4);
    f32x4 ys[8]; uint2 xr[8], zr[8];
#pragma unroll
    for (int u = 0; u < 8; ++u) { const size_t n = (size_t)n0 + u;
        ys[u] = *(const f32x4*)(c.w<float>(WS_YSSD) + n * 256 + t4); xr[u] = *(const uint2*)(c.w<bf16>(WS_XBCS) + n * 768 + t4); zr[u] = *(const uint2*)(c.w<bf16>(WS_Z) + n * 256 + t4); }
    asm volatile("" ::: "memory");
#pragma unroll
    for (int u = 0; u < 8; ++u) {
        const f32x4 x = bf4(xr[u]), z = bf4(zr[u]);
        f32x4 y;
#pragma unroll
        for (int j = 0; j < 4; ++j) y[j] = (ys[u][j] + x[j] * dsk) * silu_f(z[j]);
        const float ss = wave_sum(y[0] * y[0] + y[1] * y[1] + y[2] * y[2] + y[3] * y[3]);
        const float rstd = rsqrtf(ss * (1.f / 256.f) + EPS);
        *(uint2*)(c.w<bf16>(WS_MIX) + ((size_t)n0 + u) * D + 512 + t4) = pack4(y * rstd * gn);
    }
}

__device__ __forceinline__ float half_sum(float v) {
#pragma unroll
    for (int o = 1; o < 32; o <<= 1) v += __shfl_xor(v, o);
    return v;
}
__device__ __forceinline__ void ph_norm2(const Ctx& c, int layer, int bid, int G, unsigned char* hbuf, int* lsm) {
    const int lane = c.tid & 63, wid = c.tid >> 6, hl = lane & 31, half = lane >> 5;
    const int per = (NT + G - 1) / G, n0 = bid * per, n1 = (n0 + per < NT) ? n0 + per : NT;
    __syncthreads();
    const float* X = c.w<float>(WS_X); bf16* HA = c.w<bf16>(WS_HA);
    const float* MOD = c.w<float>(WS_MOD) + (size_t)layer * 5 * 6144;
    const float* g = c.in(7) + layer * D;
    int* TE = c.w<int>(WS_TOKE); float* TW = c.w<float>(WS_TOKW);
    LAS float* Lr = (LAS float*)hbuf; LAS float* Lcw = Lr + 4 * D;
    const float* rwt = c.w<float>(WS_RWT) + (size_t)layer * 36 * 1024;
    const int nl = n1 > n0 ? n1 - 1 : n0;
    const int mrA = (n0 % LT) < CTX ? 4 : n0 / LT, mrB = (nl % LT) < CTX ? 4 : nl / LT;
    {
        const int i = c.tid;
        const f32x4 gg = ((const f32x4*)g)[i];
        const f32x4 scA = ((const f32x4*)(MOD + mrA * 6144 + 4096))[i], shA = ((const f32x4*)(MOD + mrA * 6144 + 3072))[i];
        const f32x4 scB = ((const f32x4*)(MOD + mrB * 6144 + 4096))[i], shB = ((const f32x4*)(MOD + mrB * 6144 + 3072))[i];
        f32x4 cw[4];
#pragma unroll
        for (int e = 0; e < 4; ++e) cw[e] = ((const f32x4*)(rwt + e * 1024))[i];
        ((LAS f32x4*)Lr)[i] = gg * (scA + 1.f); ((LAS f32x4*)(Lr + D))[i] = shA;
        ((LAS f32x4*)(Lr + 2 * D))[i] = gg * (scB + 1.f); ((LAS f32x4*)(Lr + 3 * D))[i] = shB;
#pragma unroll
        for (int e = 0; e < 4; ++e) ((LAS f32x4*)(Lcw + e * D))[i] = cw[e];
    }
    f32x4 cbias = *(const f32x4*)(c.in(30) + layer * 4);
    __syncthreads();
    for (int nb = n0 + wid * 2; nb < n1; nb += 8) {
        const bool inr = nb + half < n1;
        const int n = inr ? nb + half : n1 - 1;
        const int b = n / LT, pos = n % LT, mr = pos < CTX ? 4 : b;
        const bool act = inr && !(layer == 1 && pos < CTX);
        if (hl == 0 && inr && !act) { lsm[(n - n0) * 2] = -1; lsm[(n - n0) * 2 + 1] = -1; }
        const float* x = X + (size_t)n * D;
        const LAS float* gp = Lr + (mr == mrA ? 0 : 2 * D);
        float ss = 0.f;
        PR_BEGIN(110);
        f32x4 v[8];
#pragma unroll
        for (int i = 0; i < 8; ++i) { v[i] = *(const f32x4*)(x + (hl + 32 * i) * 4); ss += v[i][0] * v[i][0] + v[i][1] * v[i][1] + v[i][2] * v[i][2] + v[i][3] * v[i][3]; }
        const float rstd = rsqrtf(half_sum(ss) * (1.f / D) + EPS);
        PR_END(110); PR_BEGIN(111);
        float cg[4] = {0.f, 0.f, 0.f, 0.f};
#pragma unroll
        for (int i = 0; i < 8; ++i) {
            const int k = (hl + 32 * i) * 4;
            const f32x4 h = v[i] * rstd * *(const LAS f32x4*)(gp + k) + *(const LAS f32x4*)(gp + D + k);
            v[i] = h;
            *(uint2*)(HA + (size_t)n * D + k) = pack4(h);
#pragma unroll
            for (int e = 0; e < 4; ++e) { const f32x4 w = *(const LAS f32x4*)(Lcw + e * D + k); cg[e] += h[0] * w[0] + h[1] * w[1] + h[2] * w[2] + h[3] * w[3]; }
        }
        float mx = -1e30f; int gi = 0; float cl[4];
#pragma unroll
        for (int e = 0; e < 4; ++e) { cl[e] = half_sum(cg[e]) + cbias[e]; if (cl[e] > mx) { mx = cl[e]; gi = e; } }
        PR_END(111); PR_BEGIN(112);
        float fg[8] = {0.f, 0.f, 0.f, 0.f, 0.f, 0.f, 0.f, 0.f};
        const float* fwt = rwt + (4 + gi * 8) * 1024;
        const f32x4 fb0 = *(const f32x4*)(c.in(32) + layer * 32 + gi * 8), fb1 = *(const f32x4*)(c.in(32) + layer * 32 + gi * 8 + 4);
#pragma unroll
        for (int ib = 0; ib < 8; ib += 2) {
            f32x4 w[2][8];
#pragma unroll
            for (int i = 0; i < 2; ++i)
#pragma unroll
                for (int e = 0; e < 8; ++e) w[i][e] = *(const f32x4*)(fwt + e * 1024 + (hl + 32 * (ib + i)) * 4);
#pragma unroll
            for (int i = 0; i < 2; ++i)
#pragma unroll
                for (int e = 0; e < 8; ++e) { const f32x4 h = v[ib + i]; fg[e] += h[0] * w[i][e][0] + h[1] * w[i][e][1] + h[2] * w[i][e][2] + h[3] * w[i][e][3]; }
            asm volatile("" ::: "memory");
        }
#pragma unroll
        for (int e = 0; e < 8; ++e) fg[e] = half_sum(fg[e]);
        PR_END(112); PR_BEGIN(113);
        if (hl == 0 && act) {
            float den = 0.f;
#pragma unroll
            for (int e = 0; e < 4; ++e) den += expf(cl[e] - mx);
            const float pg = 1.f / den;
            float f1 = -1e30f, f2 = -1e30f; int i1 = 0, i2 = 0;
#pragma unroll
            for (int e = 0; e < 8; ++e) {
                const float fv = fg[e] + (e < 4 ? fb0[e & 3] : fb1[e & 3]);
                if (fv > f1) { f2 = f1; i2 = i1; f1 = fv; i1 = e; } else if (fv > f2) { f2 = fv; i2 = e; }
            }
            const float e2 = expf(f2 - f1), w1 = pg / (1.f + e2), w2 = pg * e2 / (1.f + e2);
            const int ex1 = gi * 8 + i1, ex2 = gi * 8 + i2;
            lsm[(n - n0) * 2] = ex1; lsm[(n - n0) * 2 + 1] = ex2;
            TE[n * 2] = ex1; TE[n * 2 + 1] = ex2; TW[n * 2] = w1; TW[n * 2 + 1] = w2;
        }
        PR_END(113);
    }
    PR_BEGIN(114);
    __syncthreads();
    if (c.tid < 32) {
        const int e = c.tid, ne = (n1 > n0 ? n1 - n0 : 0) * 2;
        int cl_ = 0;
        for (int i0 = 0; i0 < ne; i0 += 8) {
            int lv[8];
#pragma unroll
            for (int k = 0; k < 8; ++k) lv[k] = ((const LAS int*)lsm)[i0 + k < ne ? i0 + k : ne - 1];
#pragma unroll
            for (int k = 0; k < 8; ++k) cl_ += (i0 + k < ne && lv[k] == e) ? 1 : 0;
        }
        const int base = (int)__hip_atomic_fetch_add(c.w<unsigned>(WS_CTL) + CW_CNT + (layer * 32 + e) * 64, (unsigned)cl_, __ATOMIC_RELAXED, __HIP_MEMORY_SCOPE_AGENT);
        int* TP = c.w<int>(WS_TOKP); int* LI = c.w<int>(WS_LIST);
        int r = 0;
        for (int i0 = 0; i0 < ne; i0 += 8) {
            int lv[8];
#pragma unroll
            for (int k = 0; k < 8; ++k) lv[k] = ((const LAS int*)lsm)[i0 + k < ne ? i0 + k : ne - 1];
#pragma unroll
            for (int k = 0; k < 8; ++k) { const int i = i0 + k; if (i < ne && lv[k] == e) { const int n = n0 + (i >> 1); const int ps = base + r; ++r; TP[n * 2 + (i & 1)] = ps; LI[(size_t)e * NT + ps] = n; } }
        }
    }
    PR_END(114);
}

__device__ __forceinline__ void moe_offsets(const Ctx& c, int layer, int* sm) {
    __syncthreads();
    if (c.tid < 64) {
        const int e = c.tid & 31;
        const unsigned* cnt = c.w<unsigned>(WS_CTL) + CW_CNT + layer * 32 * 64;
        const int ce = (int)__hip_atomic_load(cnt + e * 64, __ATOMIC_RELAXED, __HIP_MEMORY_SCOPE_AGENT);
        const int pad = (ce + 127) & ~127;
        int inc = pad;
#pragma unroll
        for (int o = 1; o < 32; o <<= 1) { const int t = __shfl_up(inc, o); if (e >= o) inc += t; }
        if (c.tid < 32) { sm[e] = inc - pad; sm[33 + e] = ce; if (e == 31) sm[32] = inc; }
    }
    __syncthreads();
}
__device__ __forceinline__ int slot_expert(const int* sm, int slot) {
    const int l = threadIdx.x & 63;
    const bool p = (l >= 1 && l < 32) && slot >= ((const LAS int*)sm)[l & 31];
    return __popcll(__ballot(p)); }

__device__ __forceinline__ void ph_combine(const Ctx& c, int layer, int bid, int G, const int* sm, unsigned char* lds) {
    const int lane = c.tid & 63, wid = c.tid >> 6;
    const int ntok = layer == 1 ? NB * SEQ : NT;
    const int per = (ntok + G - 1) / G, q0 = bid * per, q1 = (q0 + per < ntok) ? q0 + per : ntok;
    __syncthreads();
    if (layer == 0) {
        f32x4 w8[8];
#pragma unroll
        for (int j = 0; j < 8; ++j) w8[j] = ((const f32x4*)(c.w<float>(WS_WDT) + (size_t)8 * 1024))[c.tid + NTHR * j];
#pragma unroll
        for (int j = 0; j < 8; ++j) ((LAS f32x4*)lds)[c.tid + NTHR * j] = w8[j];
    }
    __syncthreads();
    if (q0 >= q1) return;
    const LAS float* wdt = (const LAS float*)lds;
    const LAS int* sml = (const LAS int*)sm;
    const int* TE = c.w<int>(WS_TOKE); const int* TP = c.w<int>(WS_TOKP); const float* TW = c.w<float>(WS_TOKW);
    const bf16* OUT = c.w<bf16>(WS_OUT);
    bf16* HA = c.w<bf16>(WS_HA); float* DTR = c.w<float>(WS_DTR);
    const float* MODc = c.w<float>(WS_MOD) + (size_t)layer * 5 * 6144;
    const float* MODn = c.w<float>(WS_MOD) + (size_t)1 * 5 * 6144;
    const float* gnext = c.in(6) + D;
    auto tokn = [&](int q) __attribute__((always_inline)) { return layer == 1 ? (q / SEQ) * LT + CTX + (q % SEQ) : q; };
    f32x4 G2c[4], GGc[4], SSc[4]; int mrc = -1;
    auto loadrow = [&](int mr) __attribute__((always_inline)) {
        f32x4 sc[4], gn[4];
#pragma unroll
        for (int i = 0; i < 4; ++i) { const int k = (lane + 64 * i) * 4;
            G2c[i] = *(const f32x4*)(MODc + mr * 6144 + 5120 + k);
            if (layer == 1) { gn[i] = *(const f32x4*)(c.in(36) + k); sc[i] = (f32x4){0.f, 0.f, 0.f, 0.f}; SSc[i] = (f32x4){0.f, 0.f, 0.f, 0.f}; }
            else { gn[i] = *(const f32x4*)(gnext + k); sc[i] = *(const f32x4*)(MODn + mr * 6144 + 1024 + k); SSc[i] = *(const f32x4*)(MODn + mr * 6144 + k); } }
#pragma unroll
        for (int i = 0; i < 4; ++i) GGc[i] = gn[i] * (sc[i] + 1.f);
        mrc = mr;
    };
    int2 te[2], tp[2]; f32x2 tw[2];
    auto ldidx = [&](int qb) __attribute__((always_inline)) {
#pragma unroll
        for (int u = 0; u < 2; ++u) { int qq = qb + u; qq = qq < q1 ? qq : q1 - 1; const int n = tokn(qq);
            te[u] = *(const int2*)(TE + n * 2); tp[u] = *(const int2*)(TP + n * 2); tw[u] = *(const f32x2*)(TW + n * 2); }
    };
    ldidx(q0 + wid * 2);
    { const int n = tokn(q0); loadrow((n % LT) < CTX ? 4 : n / LT); }
    for (int qb = q0 + wid * 2; qb < q1; qb += 8) {
        int nn[2]; bool ok[2]; int mr[2], s0[2], s1[2]; float w0[2], w1[2];
#pragma unroll
        for (int u = 0; u < 2; ++u) { int qq = qb + u; ok[u] = qq < q1; qq = ok[u] ? qq : q1 - 1; nn[u] = tokn(qq); mr[u] = (nn[u] % LT) < CTX ? 4 : nn[u] / LT;
            s0[u] = sml[te[u].x] + tp[u].x; s1[u] = sml[te[u].y] + tp[u].y; w0[u] = tw[u][0]; w1[u] = tw[u][1]; }
        f32x4 xv[2][4]; uint2 oa[2][4], ob[2][4];
#pragma unroll
        for (int u = 0; u < 2; ++u) { const float* X = c.w<float>(WS_X) + (size_t)nn[u] * D;
#pragma unroll
            for (int i = 0; i < 4; ++i) { const int k = (lane + 64 * i) * 4;
                xv[u][i] = *(const f32x4*)(X + k);
                oa[u][i] = *(const uint2*)(OUT + (size_t)s0[u] * D + k); ob[u][i] = *(const uint2*)(OUT + (size_t)s1[u] * D + k); } }
        ldidx(qb + 8);
        asm volatile("" ::: "memory");
#pragma unroll
        for (int u = 0; u < 2; ++u) {
            if (mr[u] != mrc) loadrow(mr[u]);
            float ss = 0.f;
#pragma unroll
            for (int i = 0; i < 4; ++i) { xv[u][i] = xv[u][i] + G2c[i] * (bf4(oa[u][i]) * w0[u] + bf4(ob[u][i]) * w1[u]);
                ss += xv[u][i][0] * xv[u][i][0] + xv[u][i][1] * xv[u][i][1] + xv[u][i][2] * xv[u][i][2] + xv[u][i][3] * xv[u][i][3]; }
            const float rstd = rsqrtf(wave_sum(ss) * (1.f / D) + EPS);
            if (!ok[u]) continue;
            const int n = nn[u];
            if (layer == 1) {
                float* o = c.out() + ((size_t)(n / LT) * SEQ + (n % LT - CTX)) * D;
#pragma unroll
                for (int i = 0; i < 4; ++i) { const int k = (lane + 64 * i) * 4; *(f32x4*)(o + k) = xv[u][i] * rstd * GGc[i]; }
            } else {
                float* X = c.w<float>(WS_X) + (size_t)n * D;
                f32x4 hv[4];
#pragma unroll
                for (int i = 0; i < 4; ++i) {
                    const int k = (lane + 64 * i) * 4;
                    *(f32x4*)(X + k) = xv[u][i];
                    hv[i] = xv[u][i] * rstd * GGc[i] + SSc[i];
                    *(uint2*)(HA + (size_t)n * D + k) = pack4(hv[i]);
                }
                dt_project(wdt, hv, lane, DTR + (size_t)n * 8);
            }
        }
    }
}

typedef LAS const char* lds_cptr;
constexpr int GEMM_LDS = 35840;
constexpr int GA_KH = 8256, GB_OFF = 16512, GB_ST = 288;
__device__ __forceinline__ s16x4 lds_tr(lds_cptr p) { return __builtin_bit_cast(s16x4, __builtin_amdgcn_ds_read_tr16_b64_v4i16((LAS s16x4*)p)); }

template <bool B_F32, int DEEP = 2  , class ARow>
__device__ __forceinline__ void gemm_tile(const int tid, unsigned char* lds, const bf16* Abase, ARow arow  , const void* Bbase, unsigned boff  , int ldb, bool bval, int K, f32x4 (&acc)[4][4]) {
    const int lane = tid & 63, wid = tid >> 6, wr = wid >> 1, wc = wid & 1, fr = lane & 15, fq = lane >> 4;
#pragma unroll
    for (int m = 0; m < 4; ++m)
#pragma unroll
        for (int n = 0; n < 4; ++n) acc[m][n] = (f32x4){0.f, 0.f, 0.f, 0.f};
    unsigned ao[4];
#pragma unroll
    for (int i = 0; i < 4; ++i) ao[i] = arow((tid >> 3) + 32 * i) + (tid & 7) * 8;
    const int bk = tid >> 4, bnc = tid & 15;
    constexpr int NRB = B_F32 ? 8 : 4;
    u32x4 ra0[4], ra1[4]; u32x4 rb0[NRB], rb1[NRB];
    auto gloadA = [&](int kt, u32x4 (&ra)[4]) __attribute__((always_inline)) {
#pragma unroll
        for (int i = 0; i < 4; ++i) ra[i] = *(const u32x4*)(Abase + (ao[i] + kt * 64));
    };
    auto gloadB = [&](int kt, u32x4 (&rb)[NRB]) __attribute__((always_inline)) {
        if (B_F32) {
            const float* bp = (const float*)Bbase + (boff + (unsigned)((kt * 64 + bk) * ldb));
#pragma unroll
            for (int i = 0; i < 4; ++i) {
                if (bval) { rb[2 * i] = *(const u32x4*)(bp + (unsigned)(16 * i * ldb)); rb[2 * i + 1] = *(const u32x4*)(bp + (unsigned)(16 * i * ldb) + 4); }
                else { rb[2 * i] = (u32x4){0u, 0u, 0u, 0u}; rb[2 * i + 1] = rb[2 * i]; }
            }
        } else {
            const bf16* bp = (const bf16*)Bbase + (boff + (unsigned)((kt * 64 + bk) * ldb));
#pragma unroll
            for (int i = 0; i < 4; ++i) rb[i] = bval ? *(const u32x4*)(bp + (unsigned)(16 * i * ldb)) : (u32x4){0u, 0u, 0u, 0u};
        }
    };
    auto lstore = [&](const u32x4 (&ra)[4], const u32x4 (&rb)[NRB]) __attribute__((always_inline)) {
#pragma unroll
        for (int i = 0; i < 4; ++i) { const int row = (tid >> 3) + 32 * i, kc = tid & 7;
            const u32x4 v = (kc & 1) ? (u32x4){ra[i][2], ra[i][3], ra[i][0], ra[i][1]} : ra[i];
            *(u32x4*)(lds + (kc >> 2) * GA_KH + row * 64 + (kc & 3) * 16) = v; }
#pragma unroll
        for (int i = 0; i < 4; ++i) { const int k = bk + 16 * i;
            u32x4 v;
            if (B_F32) { const f32x4 x = __builtin_bit_cast(f32x4, rb[2 * i]), y = __builtin_bit_cast(f32x4, rb[2 * i + 1]);
                v[0] = pk2bf(x[0], x[1]); v[1] = pk2bf(x[2], x[3]); v[2] = pk2bf(y[0], y[1]); v[3] = pk2bf(y[2], y[3]); }
            else v = rb[i];
            *(u32x4*)(lds + GB_OFF + k * GB_ST + bnc * 16) = v; }
    };
    const lds_cptr la = (lds_cptr)lds + (wr * 64 + fr) * 64 + fq * 16;
    const lds_cptr lb = (lds_cptr)lds + GB_OFF + (8 * fq + (fr >> 2) + (fq & 1) * 4) * GB_ST + wc * 128 + (fr & 3) * 8;
    const int bsw = (fq & 1) ? -4 * GB_ST : 4 * GB_ST;
    auto compute = [&]() __attribute__((always_inline)) {
#pragma unroll
        for (int kh = 0; kh < 2; ++kh) {
            bf16x8 af[4], bfr[4];
#pragma unroll
            for (int m = 0; m < 4; ++m) af[m] = *(const LAS bf16x8*)(la + kh * GA_KH + m * 1024);
#pragma unroll
            for (int n = 0; n < 4; ++n) {
                const s16x4 r0 = lds_tr(lb + kh * 32 * GB_ST + n * 32), r1 = lds_tr(lb + kh * 32 * GB_ST + n * 32 + bsw);
                bfr[n] = (bf16x8){r0[0], r0[1], r0[2], r0[3], r1[0], r1[1], r1[2], r1[3]};
            }
#pragma unroll
            for (int m = 0; m < 4; ++m)
#pragma unroll
                for (int n = 0; n < 4; ++n) acc[m][n] = __builtin_amdgcn_mfma_f32_16x16x32_bf16(bfr[n], af[m], acc[m][n], 0, 0, 0);
        }
    };
    const int nk = K / 64;
    if (DEEP == 0) {
        gloadA(0, ra0); gloadB(0, rb0);
        for (int kt = 0; kt < nk; ++kt) {
            __syncthreads();
            lstore(ra0, rb0);
            __syncthreads();
            if (kt + 1 < nk) { gloadA(kt + 1, ra0); gloadB(kt + 1, rb0); }
            compute();
        }
        return;
    }
    if (DEEP == 1) {
        gloadA(0, ra0); gloadB(0, rb0); gloadA(1, ra1);
        for (int kt = 0; kt < nk; kt += 2) {
            __syncthreads();
            lstore(ra0, rb0);
            __syncthreads();
            gloadB(kt + 1, rb0);
            if (kt + 2 < nk) gloadA(kt + 2, ra0);
            compute();
            __syncthreads();
            lstore(ra1, rb0);
            __syncthreads();
            if (kt + 2 < nk) gloadB(kt + 2, rb0);
            if (kt + 3 < nk) gloadA(kt + 3, ra1);
            compute();
        }
        return;
    }
    gloadB(0, rb0); gloadA(0, ra0); gloadB(1, rb1);
    for (int kt = 0; kt < nk; kt += 2) {
        __syncthreads();
        lstore(ra0, rb0);
        __syncthreads();
        gloadA(kt + 1, ra0);
        if (kt + 2 < nk) gloadB(kt + 2, rb0);
        compute();
        __syncthreads();
        lstore(ra0, rb1);
        __syncthreads();
        if (kt + 2 < nk) gloadA(kt + 2, ra0);
        if (kt + 3 < nk) gloadB(kt + 3, rb1);
        compute();
    }
}


__device__ __forceinline__ void cvt8(const float* s, bf16* d) {
    const f32x4 a = *(const f32x4*)s, b = *(const f32x4*)(s + 4);
    u32x4 o; o[0] = pk2bf(a[0], a[1]); o[1] = pk2bf(a[2], a[3]); o[2] = pk2bf(b[0], b[1]); o[3] = pk2bf(b[2], b[3]);
    *(u32x4*)d = o;
}
__device__ __forceinline__ void cvt_small(Ctx& c, int gtid, int gthreads) {
    asm volatile("" : "+s"(c.p));

    constexpr int N_IN = 2 * D * (DINV / 8), N_OUT = 2 * D * (D / 8), N_GLU = 2 * 256 * 32, N_ALL = N_IN + N_OUT + N_GLU;
    if (gtid >= N_ALL) return;
    for (int it0 = gtid; it0 < N_ALL; it0 += 4 * gthreads) {
        const float* sp[4]; bf16* dp[4]; bool ok[4];
#pragma unroll
        for (int u = 0; u < 4; ++u) {
            int it = it0 + u * gthreads; ok[u] = it < N_ALL; it = ok[u] ? it : it0;
            if (it < N_IN) { const int ch = it % (DINV / 8), lk = it / (DINV / 8), vc = ch * 8, ac = vc < C_DT ? vc : vc + 8;
                sp[u] = c.in(8) + (size_t)lk * DIN + ac; dp[u] = c.w<bf16>(WS_BIN) + (size_t)lk * DINV + vc; }
            else if (it < N_IN + N_OUT) { const int j = it - N_IN; sp[u] = c.in(9) + (size_t)j * 8; dp[u] = c.w<bf16>(WS_BOUT) + (size_t)j * 8; }
            else { const int j = it - N_IN - N_OUT; sp[u] = c.in(18) + (size_t)j * 8; dp[u] = c.w<bf16>(WS_BGLU) + (size_t)j * 8; }
        }
        f32x4 va[4], vb[4];
#pragma unroll
        for (int u = 0; u < 4; ++u) { va[u] = *(const f32x4*)sp[u]; vb[u] = *(const f32x4*)(sp[u] + 4); }
#pragma unroll
        for (int u = 0; u < 4; ++u) if (ok[u]) { u32x4 o; o[0] = pk2bf(va[u][0], va[u][1]); o[1] = pk2bf(va[u][2], va[u][3]); o[2] = pk2bf(vb[u][0], vb[u][1]); o[3] = pk2bf(vb[u][2], vb[u][3]); *(u32x4*)dp[u] = o; }
    }
}
constexpr int CVT_MOE_TILES = 1536;
__device__ __forceinline__ void cvt_moe(const Ctx& c, int layer, int tile) {
    typedef const __attribute__((address_space(1))) float* gfp; typedef __attribute__((address_space(1))) bf16* gbp;
    gfp pg = (gfp)c.in(33), pu = (gfp)c.in(34), pd = (gfp)c.in(35);
    asm volatile("" : "+s"(pg), "+s"(pu), "+s"(pd));
#pragma unroll 1
    for (int h = 0; h < 2; ++h) {
        gfp sp[8]; gbp dp[8];
        if (tile < 1024) {
#pragma unroll
            for (int i = 0; i < 8; ++i) {
                const int it = tile * 4096 + (h * 8 + i) * 256 + c.tid;
                const int ch = it & 127, ek = it >> 7;
                const int blk = ch >> 3, w = (ch & 7) * 8;
                sp[i] = (w < 32 ? pg : pu) + ((size_t)layer * NEXP * D + ek) * DE + blk * 32 + (w & 31);
                dp[i] = (gbp)c.w<bf16>(WS_BGU) + (size_t)ek * 1024 + ch * 8;
            }
        } else {
#pragma unroll
            for (int i = 0; i < 8; ++i) {
                const int j = tile * 4096 + (h * 8 + i) * 256 + c.tid - 32 * 1024 * 128;
                sp[i] = pd + (size_t)layer * NEXP * DE * D + (size_t)j * 8; dp[i] = (gbp)c.w<bf16>(WS_BDN) + (size_t)j * 8;
            }
        }
        f32x4 va[8], vb[8];
#pragma unroll
        for (int i = 0; i < 8; ++i) { va[i] = *(const __attribute__((address_space(1))) f32x4*)sp[i]; vb[i] = *(const __attribute__((address_space(1))) f32x4*)(sp[i] + 4); }
#pragma unroll
        for (int i = 0; i < 8; ++i) { u32x4 o; o[0] = pk2bf(va[i][0], va[i][1]); o[1] = pk2bf(va[i][2], va[i][3]); o[2] = pk2bf(vb[i][0], vb[i][1]); o[3] = pk2bf(vb[i][2], vb[i][3]); *(__attribute__((address_space(1))) u32x4*)dp[i] = o; }
    }
}

__device__ __forceinline__ void ph_inproj_mfma(const Ctx& c, int layer, int tile, unsigned char* lds) {
    const int mt = tile / 18, nt = tile % 18;
    const bf16* HA = c.w<bf16>(WS_HA) + (size_t)mt * 128 * D;
    f32x4 acc[4][4];
    const int vc = nt * 128 + (c.tid & 15) * 8;
    gemm_tile<false, 1>(c.tid, lds, HA, [&](int r) __attribute__((always_inline)) { return (unsigned)(r * D); }, c.w<bf16>(WS_BIN) + (size_t)layer * D * DINV, (unsigned)vc, DINV, true, D, acc);
    const int lane = c.tid & 63, wid = c.tid >> 6, wr = wid >> 1, wc = wid & 1, fr = lane & 15, fq = lane >> 4;
    const int n0 = mt * 128, b = n0 / LT, pos0 = n0 % LT;
    if (nt < 2) {
        bf16* UH = c.w<bf16>(WS_UH);
#pragma unroll
        for (int m = 0; m < 4; ++m) {
            const int pos = pos0 + wr * 64 + m * 16 + fr, J = b * 136 + (pos >> 5), tt = pos & 31;
#pragma unroll
            for (int n = 0; n < 4; ++n) { const int col = nt * 128 + wc * 64 + n * 16 + fq * 4;
                *(uint2*)(UH + ((size_t)(col >> 4) * NCH5 + J) * 768 + tt * 16 + (col & 15)) = pack4(acc[m][n]); }
        }
    } else if (nt < 6 || nt >= 14) {
        const int kind = nt >= 14 ? 1 : 0, sub = nt - (kind ? 14 : 2);
        if (sub == 3) {
            bf16* Vt = c.w<bf16>(kind ? WS_WV : WS_GV) + ((size_t)b * 2 + wc) * 64 * LT;
#pragma unroll
            for (int m = 0; m < 4; ++m) { const int pos = pos0 + wr * 64 + m * 16 + fr;
#pragma unroll
                for (int n = 0; n < 4; ++n)
#pragma unroll
                    for (int jj = 0; jj < 4; ++jj) Vt[(size_t)(n * 16 + fq * 4 + jj) * LT + pos] = f2bf(acc[m][n][jj]); }
        } else {
            const bool isq = sub < 2; const int head = isq ? sub * 2 + wc : wc;
            bf16* dst = isq ? c.w<bf16>(kind ? WS_WQ : WS_GQ) + ((size_t)b * 4 + head) * LT * 64 : c.w<bf16>(kind ? WS_WK : WS_GK) + ((size_t)b * 2 + head) * LT * 64;
            const float* gain = (isq ? c.in(20) : c.in(21)) + layer * 64;
            const float qs = isq ? 0.18033688011112042f : 1.f;
            const float* ROPE = c.w<float>(WS_ROPE);
            f32x4 gq[4]; f32x4 rc[4][2][2];
#pragma unroll
            for (int n = 0; n < 4; ++n) gq[n] = *(const f32x4*)(gain + n * 16 + fq * 4);
            if (pos0 >= CTX) {
#pragma unroll
                for (int m = 0; m < 4; ++m) { const int l = pos0 + wr * 64 + m * 16 + fr - CTX;
#pragma unroll
                    for (int a = 0; a < 2; ++a) { const int rp = a == 0 ? (l >> 6) : (l & 63);
                        rc[m][a][0] = *(const f32x4*)(ROPE + (rp * 16 + fq * 4) * 2); rc[m][a][1] = *(const f32x4*)(ROPE + (rp * 16 + fq * 4 + 2) * 2); } }
            }
            asm volatile("" ::: "memory");
#pragma unroll
            for (int m = 0; m < 4; ++m) {
                const int pos = pos0 + wr * 64 + m * 16 + fr;
                f32x4 v[4];
#pragma unroll
                for (int n = 0; n < 4; ++n) v[n] = acc[m][n];
                if (kind == 0) {
                    float ss = 0.f;
#pragma unroll
                    for (int n = 0; n < 4; ++n) ss += v[n][0] * v[n][0] + v[n][1] * v[n][1] + v[n][2] * v[n][2] + v[n][3] * v[n][3];
                    ss += __shfl_xor(ss, 16); ss += __shfl_xor(ss, 32);
                    const float rstd = rsqrtf(ss * (1.f / 64.f) + EPS);
#pragma unroll
                    for (int n = 0; n < 4; ++n) v[n] = v[n] * rstd * gq[n];
                }
                if (pos0 >= CTX) {
#pragma unroll
                    for (int a = 0; a < 2; ++a) {
#pragma unroll
                        for (int jj = 0; jj < 4; ++jj) { const float cs0 = rc[m][a][jj >> 1][(jj & 1) * 2], cs1 = rc[m][a][jj >> 1][(jj & 1) * 2 + 1];
                            const float x0 = v[2 * a][jj], x1 = v[2 * a + 1][jj];
                            v[2 * a][jj] = x0 * cs0 - x1 * cs1; v[2 * a + 1][jj] = x1 * cs0 + x0 * cs1; } }
                }
#pragma unroll
                for (int n = 0; n < 4; ++n) *(uint2*)(dst + (size_t)pos * 64 + n * 16 + fq * 4) = pack4(v[n] * qs);
            }
        }
    } else {
        bf16* dst; int ld, col0;
        if (nt < 8) { dst = c.w<bf16>(WS_Z); ld = 256; col0 = (nt - 6) * 128; } else { dst = c.w<bf16>(WS_XBR); ld = 768; col0 = (nt - 8) * 128; }
#pragma unroll
        for (int m = 0; m < 4; ++m) { const size_t row = (size_t)n0 + wr * 64 + m * 16 + fr;
#pragma unroll
            for (int n = 0; n < 4; ++n) *(uint2*)(dst + row * ld + col0 + wc * 64 + n * 16 + fq * 4) = pack4(acc[m][n]); }
    }
}

#define EPI_COORDS const int lane = c.tid & 63, wid = c.tid >> 6, wr = wid >> 1, wc = wid & 1, fr = lane & 15, fq = lane >> 4
__device__ __forceinline__ void ph_glu_mfma(const Ctx& c, int layer, int tile, unsigned char* lds) {
    const int mt = tile >> 1, nt = tile & 1;
    const bf16* G5 = c.w<bf16>(WS_G5) + (size_t)mt * 128 * 256;
    f32x4 acc[4][4];
    const int bc = nt * 128 + (c.tid & 15) * 8;
    gemm_tile<false>(c.tid, lds, G5, [&](int r) __attribute__((always_inline)) { return (unsigned)(r * 256); }, c.w<bf16>(WS_BGLU) + (size_t)layer * 256 * 256, (unsigned)bc, 256, true, 256, acc);
    EPI_COORDS;
    bf16* MIX = c.w<bf16>(WS_MIX);
    f32x4 bb[4]; uint2 gvv[4][4];
#pragma unroll
    for (int n = 0; n < 4; ++n) bb[n] = *(const f32x4*)(c.in(19) + layer * 256 + nt * 128 + wc * 64 + n * 16 + fq * 4);
#pragma unroll
    for (int m = 0; m < 4; ++m)
#pragma unroll
        for (int n = 0; n < 4; ++n) gvv[m][n] = *(const uint2*)(G5 + (size_t)(wr * 64 + m * 16 + fr) * 256 + nt * 128 + wc * 64 + n * 16 + fq * 4);
    asm volatile("" ::: "memory");
#pragma unroll
    for (int m = 0; m < 4; ++m)
#pragma unroll
        for (int n = 0; n < 4; ++n) {
            const int rl = wr * 64 + m * 16 + fr, col = nt * 128 + wc * 64 + n * 16 + fq * 4;
            const uint2 gv = gvv[m][n];
            const float g0 = __uint_as_float(gv.x << 16), g1 = __uint_as_float(gv.x & 0xffff0000u), g2 = __uint_as_float(gv.y << 16), g3 = __uint_as_float(gv.y & 0xffff0000u);
            uint2 o;
            o.x = pk2bf(g0 * sigmoid_f(acc[m][n][0] + bb[n][0]), g1 * sigmoid_f(acc[m][n][1] + bb[n][1]));
            o.y = pk2bf(g2 * sigmoid_f(acc[m][n][2] + bb[n][2]), g3 * sigmoid_f(acc[m][n][3] + bb[n][3]));
            *(uint2*)(MIX + (size_t)(mt * 128 + rl) * D + col) = o;
        }
}
__device__ __forceinline__ void ph_outproj_mfma(const Ctx& c, int layer, int tile, unsigned char* lds) {
    int mt = tile >> 3; const int nt = tile & 7;
    if (layer == 1) { if (mt >= 128) return; mt = (mt >> 5) * 34 + 2 + (mt & 31); }
    const bf16* MIX = c.w<bf16>(WS_MIX) + (size_t)mt * 128 * D;
    f32x4 acc[4][4];
    const int bc = nt * 128 + (c.tid & 15) * 8;
    gemm_tile<false, 1>(c.tid, lds, MIX, [&](int r) __attribute__((always_inline)) { return (unsigned)(r * D); }, c.w<bf16>(WS_BOUT) + (size_t)layer * D * D, (unsigned)bc, D, true, D, acc);
    EPI_COORDS;
    const float* MOD = c.w<float>(WS_MOD) + (size_t)layer * 5 * 6144;
    float* X = c.w<float>(WS_X);
    const int mr = ((mt * 128) % LT) < CTX ? 4 : (mt * 128) / LT;
    f32x4 g1[4], xs[4][4];
#pragma unroll
    for (int n = 0; n < 4; ++n) g1[n] = *(const f32x4*)(MOD + mr * 6144 + 2048 + nt * 128 + wc * 64 + n * 16 + fq * 4);
#pragma unroll
    for (int m = 0; m < 4; ++m) {
        const float* xr = xsrc(c, layer, mt * 128 + wr * 64 + m * 16 + fr);
#pragma unroll
        for (int n = 0; n < 4; ++n) xs[m][n] = *(const f32x4*)(xr + nt * 128 + wc * 64 + n * 16 + fq * 4);
    }
    asm volatile("" ::: "memory");
#pragma unroll
    for (int m = 0; m < 4; ++m) {
        const int row = mt * 128 + wr * 64 + m * 16 + fr;
#pragma unroll
        for (int n = 0; n < 4; ++n) {
            const int col = nt * 128 + wc * 64 + n * 16 + fq * 4;
            *(f32x4*)(X + (size_t)row * D + col) = xs[m][n] + g1[n] * acc[m][n];
        }
    }
}
__device__ __forceinline__ void ph_moe1_mfma(const Ctx& c, int layer, int tile, const int* sm, unsigned char* lds) {
    const int st = tile >> 3, nt = tile & 7;
    const int s0 = st * 128;
    if (s0 >= sm[32]) return;
    unsigned* flag = c.w<unsigned>(WS_CTL) + CW_MOEF + (layer * 512 + st) * 16;
    const int e = slot_expert(sm, s0), base = s0 - sm[e], ce = sm[33 + e];
    if (base >= ce) { if (c.tid == 0) (void)__hip_atomic_fetch_add(flag, 1u, __ATOMIC_RELAXED, __HIP_MEMORY_SCOPE_AGENT); return; }
    const bf16* HA = c.w<bf16>(WS_HA); const int* LI = c.w<int>(WS_LIST) + (size_t)e * NT;
    f32x4 acc[4][4];
    gemm_tile<false>(c.tid, lds, HA, [&](int r) __attribute__((always_inline)) { const int tok = LI[(base + r < ce) ? (base + r) : base]; return (unsigned)(tok * D); }, c.w<bf16>(WS_BGU) + (size_t)e * D * 1024, (unsigned)(nt * 128 + (c.tid & 15) * 8), 1024, true, D, acc);
    EPI_COORDS;
    bf16* ACT = c.w<bf16>(WS_ACT);
#pragma unroll
    for (int m = 0; m < 4; ++m) {
        const int rl = wr * 64 + m * 16 + fr;
#pragma unroll
        for (int n = 0; n < 2; ++n) {
            const int col = nt * 64 + wc * 32 + n * 16 + fq * 4;
            const f32x4 g = acc[m][n], u = acc[m][n + 2];
            uint2 o; o.x = pk2bf(silu_f(g[0]) * u[0], silu_f(g[1]) * u[1]); o.y = pk2bf(silu_f(g[2]) * u[2], silu_f(g[3]) * u[3]);
            __hip_atomic_store((unsigned long long*)(ACT + (size_t)(s0 + rl) * DE + col), ((unsigned long long)o.y << 32) | o.x, __ATOMIC_RELAXED, __HIP_MEMORY_SCOPE_AGENT);
        }
    }
    asm volatile("s_waitcnt vmcnt(0)" ::: "memory");
    __syncthreads();
    if (c.tid == 0) (void)__hip_atomic_fetch_add(flag, 1u, __ATOMIC_RELAXED, __HIP_MEMORY_SCOPE_AGENT);
}
__device__ __forceinline__ void ph_moe2_mfma(const Ctx& c, int layer, int tile, const int* sm, unsigned char* lds) {
    const int st = tile >> 3, nt = tile & 7;
    const int s0 = st * 128;
    if (s0 >= sm[32]) return;
    const int e = slot_expert(sm, s0), base = s0 - sm[e], ce = sm[33 + e];
    if (base >= ce) return;
    {
        unsigned* flag = c.w<unsigned>(WS_CTL) + CW_MOEF + (layer * 512 + st) * 16;
        if (c.tid == 0) {
            unsigned sp = 0u;
            while (__hip_atomic_load(flag, __ATOMIC_RELAXED, __HIP_MEMORY_SCOPE_AGENT) < 8u) { __builtin_amdgcn_s_sleep(1); if (++sp > (1u << 22)) break; }
            __builtin_amdgcn_fence(__ATOMIC_ACQUIRE, "agent");
        }
        __syncthreads();
    }
    const bf16* ACT = c.w<bf16>(WS_ACT) + (size_t)s0 * DE;
    f32x4 acc[4][4];
    const int bc = nt * 128 + (c.tid & 15) * 8;
    gemm_tile<false>(c.tid, lds, ACT, [&](int r) __attribute__((always_inline)) { return (unsigned)(r * DE); }, c.w<bf16>(WS_BDN) + (size_t)e * DE * D, (unsigned)bc, D, true, DE, acc);
    EPI_COORDS;
    bf16* OUT = c.w<bf16>(WS_OUT);
#pragma unroll
    for (int m = 0; m < 4; ++m)
#pragma unroll
        for (int n = 0; n < 4; ++n) {
            const int rl = wr * 64 + m * 16 + fr, col = nt * 128 + wc * 64 + n * 16 + fq * 4;
            uint2 o; o.x = pk2bf(acc[m][n][0], acc[m][n][1]); o.y = pk2bf(acc[m][n][2], acc[m][n][3]);
            *(uint2*)(OUT + (size_t)(s0 + rl) * D + col) = o;
        }
}


typedef float f32x16 __attribute__((ext_vector_type(16)));
constexpr int AT_KST = 144, AT_VST = 136;
constexpr int AT_KOFF = 0, AT_VOFF = 64 * AT_KST, AT_BUF = AT_VOFF + 64 * AT_VST;
constexpr int AT_SOFF = GEMM_LDS + 512;
static_assert(2 * AT_BUF <= GEMM_LDS, "attention double buffer must fit the GEMM LDS region");
constexpr float AT_THR = 5.0f;
__device__ __forceinline__ float vmax(float a, float b) { return __builtin_fmaxf(a, b); }
__device__ __forceinline__ float vmax3(float a, float b, float c) { return __builtin_fmaxf(__builtin_fmaxf(a, b), c); }
__device__ __forceinline__ float xhalf(float v) { const auto r = __builtin_amdgcn_permlane32_swap(__float_as_uint(v), __float_as_uint(v), false, false); return __uint_as_float((threadIdx.x & 32) ? r[0] : r[1]); }
__device__ __forceinline__ int crow(int r, int hi) { return (r & 3) + 8 * (r >> 2) + 4 * hi; }

template <int KIND_CT  >
__device__ __forceinline__ void attn_tile(const Ctx& c, int layer, int idx, unsigned char* lds) {
    const int tid = c.tid, lane = tid & 63, wid = tid >> 6, r32 = lane & 31, hi = lane >> 5;
    int kind_rt, b, h, qt;
    if (KIND_CT == 0 || idx < 1024) { kind_rt = idx >> 9; const int r = idx & 511; b = r >> 7; h = (r >> 5) & 3; qt = 2 + (r & 31); }
    else { const int r = idx - 1024; kind_rt = r >> 5; b = (r >> 3) & 3; h = (r >> 1) & 3; qt = r & 1; }
    const int kind = KIND_CT >= 0 ? KIND_CT : kind_rt;
    const int kvh = h >> 1;
    const bf16* Q = c.w<bf16>(kind ? WS_WQ : WS_GQ) + ((size_t)b * 4 + h) * LT * 64;
    const bf16* K = c.w<bf16>(kind ? WS_WK : WS_GK) + ((size_t)b * 2 + kvh) * LT * 64;
    const bf16* Vt = c.w<bf16>(kind ? WS_WV : WS_GV) + ((size_t)b * 2 + kvh) * 64 * LT;
    const int q0 = qt * 128;
    const int qpos = q0 + wid * 32 + r32;
    int b0 = CTX, b1 = CTX;
    if (qt >= 2) { if (kind == 0) { b0 = CTX; b1 = LT; } else { b0 = q0 - 128 < CTX ? CTX : q0 - 128; b1 = q0 + 256 > LT ? LT : q0 + 256; } }
    const int nA = CTX / 64, ntile = nA + (b1 - b0) / 64;
    bf16x8 qf[4];
#pragma unroll
    for (int d0 = 0; d0 < 4; ++d0) qf[d0] = *(const bf16x8*)(Q + (size_t)qpos * 64 + d0 * 16 + hi * 8);
    f32x16 o0, o1;
#pragma unroll
    for (int r = 0; r < 16; ++r) { o0[r] = 0.f; o1[r] = 0.f; }
    float m = -1e30f, l = 0.f;
    if (kind == 1) { m = c.in(28)[layer * 4 + h] * 1.4426950408889634f; l = (hi == 0) ? 1.f : 0.f; }
    bool fixedref = false;
    if (kind == 0) {
        float gm = fmaxf(fabsf(c.in(20)[layer * 64 + lane]), 0.f), km = fabsf(c.in(21)[layer * 64 + lane]);
#pragma unroll
        for (int o = 1; o < 64; o <<= 1) { gm = fmaxf(gm, __shfl_xor(gm, o)); km = fmaxf(km, __shfl_xor(km, o)); }
        fixedref = __builtin_amdgcn_readfirstlane((int)(gm * km * 8.f * 1.4426950408889634f < 40.f)) != 0;
        if (fixedref) m = 0.f;
    }
    float* wsf = (float*)(lds + AT_SOFF) + wid * 32;
    u32x4 rkA[2], rvA[2], rkB[2], rvB[2];
    auto gload = [&](int ti, u32x4 (&rk)[2], u32x4 (&rv)[2]) __attribute__((always_inline)) {
        const int kb = ti < nA ? ti * 64 : b0 + (ti - nA) * 64;
#pragma unroll
        for (int i = 0; i < 2; ++i) { const int cc = tid + 256 * i;
            rk[i] = *(const u32x4*)(K + (size_t)(kb + (cc >> 3)) * 64 + (cc & 7) * 8);
            rv[i] = *(const u32x4*)(Vt + (size_t)(cc >> 3) * LT + kb + (cc & 7) * 8); }
    };
    auto lstore = [&](int buf, const u32x4 (&rk)[2], const u32x4 (&rv)[2]) __attribute__((always_inline)) {
#pragma unroll
        for (int i = 0; i < 2; ++i) { const int cc = tid + 256 * i;
            *(u32x4*)(lds + buf * AT_BUF + AT_KOFF + (cc >> 3) * AT_KST + (cc & 7) * 16) = rk[i];
            unsigned char* vp = lds + buf * AT_BUF + AT_VOFF + (cc >> 3) * AT_VST + (cc & 7) * 16;
            *(uint2*)vp = make_uint2(rv[i][0], rv[i][1]); *(uint2*)(vp + 8) = make_uint2(rv[i][2], rv[i][3]); }
    };
    const lds_cptr lk0 = (lds_cptr)lds + AT_KOFF + r32 * AT_KST + hi * 16;
    const lds_cptr lv0 = (lds_cptr)lds + AT_VOFF + r32 * AT_VST + hi * 8;
    auto kfrag = [&](int buf, bf16x8 (&k0)[4], bf16x8 (&k1)[4]) __attribute__((always_inline)) {
        const lds_cptr lk = lk0 + buf * AT_BUF;
#pragma unroll
        for (int d0 = 0; d0 < 4; ++d0) { k0[d0] = *(const LAS bf16x8*)(lk + d0 * 32); k1[d0] = *(const LAS bf16x8*)(lk + 32 * AT_KST + d0 * 32); }
    };
    auto vfrag = [&](int buf, int t, int s, int d0) __attribute__((always_inline)) {
        const lds_cptr vp = lv0 + buf * AT_BUF + d0 * 32 * AT_VST + (32 * t + 16 * s) * 2;
        const s16x4 lo = *(const LAS s16x4*)vp, hv = *(const LAS s16x4*)(vp + 16);
        return (bf16x8){lo[0], lo[1], lo[2], lo[3], hv[0], hv[1], hv[2], hv[3]};
    };
    auto lsum = [&](const f32x16& p0, const f32x16& p1) __attribute__((always_inline)) {
        const f32x16 sv = p0 + p1;
        const f32x4 s4 = (f32x4){sv[0], sv[1], sv[2], sv[3]} + (f32x4){sv[4], sv[5], sv[6], sv[7]} + (f32x4){sv[8], sv[9], sv[10], sv[11]} + (f32x4){sv[12], sv[13], sv[14], sv[15]};
        l += (s4[0] + s4[1]) + (s4[2] + s4[3]);
    };
    auto compute = [&](int ti, int buf) __attribute__((always_inline)) {
        const int kb = ti < nA ? ti * 64 : b0 + (ti - nA) * 64;
        f32x16 p0, p1;
#pragma unroll
        for (int r = 0; r < 16; ++r) { p0[r] = 0.f; p1[r] = 0.f; }
        bf16x8 k0[4], k1[4];
        kfrag(buf, k0, k1);
#pragma unroll
        for (int d0 = 0; d0 < 4; ++d0) {
            p0 = __builtin_amdgcn_mfma_f32_32x32x16_bf16(k0[d0], qf[d0], p0, 0, 0, 0);
            p1 = __builtin_amdgcn_mfma_f32_32x32x16_bf16(k1[d0], qf[d0], p1, 0, 0, 0);
        }
        if (kind == 1 && ti >= nA) {
#pragma unroll
            for (int r = 0; r < 16; ++r) {
                const int d0_ = kb + crow(r, hi) - qpos, d1_ = d0_ + 32;
                if (d0_ > 128 || d0_ < -128) p0[r] = -INFINITY;
                if (d1_ > 128 || d1_ < -128) p1[r] = -INFINITY;
            }
        }
        if (!fixedref) {
        float ma[8];
#pragma unroll
        for (int r = 0; r < 8; ++r) ma[r] = vmax3(p0[2 * r], p0[2 * r + 1], vmax(p1[2 * r], p1[2 * r + 1]));
        float rm = vmax(vmax3(ma[0], ma[1], ma[2]), vmax3(ma[3], ma[4], vmax3(ma[5], ma[6], ma[7])));
        rm = vmax(rm, xhalf(rm));
        if (__any(rm > m + AT_THR)) {
            const float mn = fmaxf(m, rm), f = __builtin_amdgcn_exp2f(m - mn);
            m = mn; l *= f;
            if (hi == 0) wsf[r32] = f;
#pragma unroll
            for (int g = 0; g < 4; ++g) { const f32x4 fv = *(const f32x4*)(wsf + 8 * g + 4 * hi);
#pragma unroll
                for (int j = 0; j < 4; ++j) { o0[4 * g + j] *= fv[j]; o1[4 * g + j] *= fv[j]; } }
        }
        p0 = p0 - m; p1 = p1 - m;
        }
#pragma unroll
        for (int r = 0; r < 16; ++r) { p0[r] = __builtin_amdgcn_exp2f(p0[r]); p1[r] = __builtin_amdgcn_exp2f(p1[r]); }
        lsum(p0, p1);
#pragma unroll
        for (int t = 0; t < 2; ++t)
#pragma unroll
            for (int s = 0; s < 2; ++s) {
                float t8[8];
#pragma unroll
                for (int j = 0; j < 8; ++j) t8[j] = t == 0 ? p0[8 * s + j] : p1[8 * s + j];
                const bf16x8 pa = pack8(t8);
                o0 = __builtin_amdgcn_mfma_f32_32x32x16_bf16(pa, vfrag(buf, t, s, 0), o0, 0, 0, 0);
                o1 = __builtin_amdgcn_mfma_f32_32x32x16_bf16(pa, vfrag(buf, t, s, 1), o1, 0, 0, 0);
            }
    };
    auto pair_fast = [&](int tnB) __attribute__((always_inline)) {
        f32x16 pa0, pa1, pb0, pb1;
#pragma unroll
        for (int r = 0; r < 16; ++r) { pa0[r] = 0.f; pa1[r] = 0.f; pb0[r] = 0.f; pb1[r] = 0.f; }
        {
            bf16x8 k0[4], k1[4];
            kfrag(0, k0, k1);
#pragma unroll
            for (int d0 = 0; d0 < 4; ++d0) {
                pa0 = __builtin_amdgcn_mfma_f32_32x32x16_bf16(k0[d0], qf[d0], pa0, 0, 0, 0);
                pa1 = __builtin_amdgcn_mfma_f32_32x32x16_bf16(k1[d0], qf[d0], pa1, 0, 0, 0);
            }
        }
        __builtin_amdgcn_sched_barrier(0);
        bf16x8 vf0[2][2], vf0b[2][2];
        {
            bf16x8 j0[4], j1[4];
            kfrag(1, j0, j1);
#pragma unroll
            for (int d0 = 0; d0 < 4; ++d0) {
                pb0 = __builtin_amdgcn_mfma_f32_32x32x16_bf16(j0[d0], qf[d0], pb0, 0, 0, 0);
#pragma unroll
                for (int r = 4 * d0; r < 4 * d0 + 4; ++r) pa0[r] = __builtin_amdgcn_exp2f(pa0[r]);
                pb1 = __builtin_amdgcn_mfma_f32_32x32x16_bf16(j1[d0], qf[d0], pb1, 0, 0, 0);
#pragma unroll
                for (int r = 4 * d0; r < 4 * d0 + 4; ++r) pa1[r] = __builtin_amdgcn_exp2f(pa1[r]);
            }
        }
        lsum(pa0, pa1);
        __builtin_amdgcn_sched_barrier(0);
        gload(tnB, rkB, rvB);
        bf16x8 vf1[2][2], vf1b[2][2];
#pragma unroll
        for (int s = 0; s < 2; ++s) { vf0[s][0] = vfrag(0, 0, s, 0); vf0[s][1] = vfrag(0, 0, s, 1); vf0b[s][0] = vfrag(0, 1, s, 0); vf0b[s][1] = vfrag(0, 1, s, 1); }
        asm volatile("" ::: "memory");
#pragma unroll
        for (int t = 0; t < 2; ++t) {
#pragma unroll
            for (int s = 0; s < 2; ++s) {
                float t8[8];
#pragma unroll
                for (int j = 0; j < 8; ++j) t8[j] = t == 0 ? pa0[8 * s + j] : pa1[8 * s + j];
                const bf16x8 pk = pack8(t8);
                o0 = __builtin_amdgcn_mfma_f32_32x32x16_bf16(pk, t == 0 ? vf0[s][0] : vf0b[s][0], o0, 0, 0, 0);
#pragma unroll
                for (int j = 0; j < 4; ++j) { if (t == 0) pb0[8 * s + j] = __builtin_amdgcn_exp2f(pb0[8 * s + j]); else pb1[8 * s + j] = __builtin_amdgcn_exp2f(pb1[8 * s + j]); }
                o1 = __builtin_amdgcn_mfma_f32_32x32x16_bf16(pk, t == 0 ? vf0[s][1] : vf0b[s][1], o1, 0, 0, 0);
#pragma unroll
                for (int j = 4; j < 8; ++j) { if (t == 0) pb0[8 * s + j] = __builtin_amdgcn_exp2f(pb0[8 * s + j]); else pb1[8 * s + j] = __builtin_amdgcn_exp2f(pb1[8 * s + j]); }
            }
        }
        lsum(pb0, pb1);
        __builtin_amdgcn_sched_barrier(0);
#pragma unroll
        for (int s = 0; s < 2; ++s) { vf1[s][0] = vfrag(1, 0, s, 0); vf1[s][1] = vfrag(1, 0, s, 1); vf1b[s][0] = vfrag(1, 1, s, 0); vf1b[s][1] = vfrag(1, 1, s, 1); }
        asm volatile("" ::: "memory");
#pragma unroll
        for (int t = 0; t < 2; ++t)
#pragma unroll
            for (int s = 0; s < 2; ++s) {
                float t8[8];
#pragma unroll
                for (int j = 0; j < 8; ++j) t8[j] = t == 0 ? pb0[8 * s + j] : pb1[8 * s + j];
                const bf16x8 pk = pack8(t8);
                o0 = __builtin_amdgcn_mfma_f32_32x32x16_bf16(pk, t == 0 ? vf1[s][0] : vf1b[s][0], o0, 0, 0, 0);
                o1 = __builtin_amdgcn_mfma_f32_32x32x16_bf16(pk, t == 0 ? vf1[s][1] : vf1b[s][1], o1, 0, 0, 0);
            }
    };
    gload(0, rkA, rvA); gload(1, rkB, rvB);
    __syncthreads();
    lstore(0, rkA, rvA); lstore(1, rkB, rvB);
    __syncthreads();
    if (KIND_CT == 0 && fixedref) {
        for (int ti = 0; ti < ntile; ti += 2) {
            const int tn = ti + 2 < ntile ? ti + 2 : ti;
            gload(tn, rkA, rvA);
            pair_fast(tn + 1);
            __syncthreads();
            lstore(0, rkA, rvA); lstore(1, rkB, rvB);
            __syncthreads();
        }
    } else {
        for (int ti = 0; ti < ntile; ti += 2) {
            { const int tn = ti + 2 < ntile ? ti + 2 : ti; gload(tn, rkA, rvA); gload(tn + 1, rkB, rvB); }
            compute(ti, 0); compute(ti + 1, 1);
            __syncthreads();
            lstore(0, rkA, rvA); lstore(1, rkB, rvB);
            __syncthreads();
        }
    }
    l += __shfl_xor(l, 32);
    if (hi == 0) wsf[r32] = 1.f / l;
    bf16* MIX = c.w<bf16>(WS_MIX) + ((size_t)b * LT + q0 + wid * 32) * D + (kind ? 768 : 256) + h * 64 + r32;
#pragma unroll
    for (int g = 0; g < 4; ++g) { const f32x4 fv = *(const f32x4*)(wsf + 8 * g + 4 * hi);
#pragma unroll
        for (int j = 0; j < 4; ++j) { const int r = 4 * g + j; bf16* mp = MIX + (size_t)crow(r, hi) * D;
            mp[0] = f2bf(o0[r] * fv[j]); mp[32] = f2bf(o1[r] * fv[j]); } }
}


__device__ __forceinline__ void ph_prepB(const Ctx& c, int tile) {
    const float* KLAG = c.w<float>(WS_KLAG); const float* S5P = c.w<float>(WS_S5P); const float* S5BB = c.w<float>(WS_S5BB);
    bf16* WY = c.w<bf16>(WS_WY); bf16* WSm = c.w<bf16>(WS_WS);
    if (tile < 3072) {
        const int it = tile * NTHR + c.tid;
        const int t = it & 31, kr = (it >> 5) % 768, lg = it / (768 * 32), l = lg >> 4, g = lg & 15;
        float v[16];
        if (kr < 512) {
            const int s = kr >> 4, cp = kr & 15;
            const int dl = t - s, ia = dl > 0 ? dl : 0, ib = dl < 0 ? -dl : 0;
            const f32x4* kpa = (const f32x4*)(KLAG + ((size_t)(lg * 2 + 0) * 32 + ia) * 256 + cp * 16);
            const f32x4* kpb = (const f32x4*)(KLAG + ((size_t)(lg * 2 + 1) * 32 + ib) * 256 + cp * 16);
            f32x4 xa[4], xb[4];
#pragma unroll
            for (int q = 0; q < 4; ++q) { xa[q] = kpa[q]; xb[q] = kpb[q]; }
            const float dsk = c.in(17)[l * 256 + g * 16 + cp];
            const float ma = dl >= 0 ? 1.f : 0.f, mb = dl <= 0 ? 1.f : 0.f;
#pragma unroll
            for (int q = 0; q < 4; ++q)
#pragma unroll
                for (int jq = 0; jq < 4; ++jq) v[4 * q + jq] = ma * xa[q][jq] + mb * xb[q][jq];
#pragma unroll
            for (int i = 0; i < 16; ++i) if (dl == 0 && i == cp) v[i] += dsk;
        } else {
            const int q = kr - 512, d = q >> 7, p = (q >> 1) & 63, ri = q & 1, e = d == 0 ? t + 1 : 32 - t;
            const int ldg = (l * 2 + d) * 16 + g;
            const float pr = S5P[((size_t)(ldg * 64 + p) * 33 + e) * 2], pi = S5P[((size_t)(ldg * 64 + p) * 33 + e) * 2 + 1];
#pragma unroll
            for (int i = 0; i < 16; ++i) {
                const float cr = c.in(15)[(size_t)ldg * 1024 + i * 64 + p], ci = c.in(16)[(size_t)ldg * 1024 + i * 64 + p];
                v[i] = ri == 0 ? (cr * pr - ci * pi) : -(cr * pi + ci * pr);
            }
        }
        u32x4 o0, o1;
        o0[0] = pk2bf(v[0], v[1]); o0[1] = pk2bf(v[2], v[3]); o0[2] = pk2bf(v[4], v[5]); o0[3] = pk2bf(v[6], v[7]);
        o1[0] = pk2bf(v[8], v[9]); o1[1] = pk2bf(v[10], v[11]); o1[2] = pk2bf(v[12], v[13]); o1[3] = pk2bf(v[14], v[15]);
        u32x4* op = (u32x4*)(WY + ((size_t)lg * 768 + kr) * 512 + t * 16);
        op[0] = o0; op[1] = o1;
    }
    else {
        const int it = (tile - 3072) * NTHR + c.tid;
        const int ncq = it & 31, kr = (it >> 5) & 511, lg = it >> 14, l = lg >> 4, g = lg & 15;
        const int s = kr >> 4, cp = kr & 15, d = ncq >> 4, p0 = (ncq & 15) * 4, e = d == 0 ? 31 - s : s;
        const int ldg = (l * 2 + d) * 16 + g;
        float v[8];
#pragma unroll
        for (int i = 0; i < 4; ++i) {
            const int p = p0 + i;
            const float pr = S5P[((size_t)(ldg * 64 + p) * 33 + e) * 2], pi = S5P[((size_t)(ldg * 64 + p) * 33 + e) * 2 + 1];
            const float br = S5BB[((size_t)(ldg * 64 + p) * 16 + cp) * 2], bi = S5BB[((size_t)(ldg * 64 + p) * 16 + cp) * 2 + 1];
            v[2 * i] = pr * br - pi * bi; v[2 * i + 1] = pr * bi + pi * br;
        }
        u32x4 o; o[0] = pk2bf(v[0], v[1]); o[1] = pk2bf(v[2], v[3]); o[2] = pk2bf(v[4], v[5]); o[3] = pk2bf(v[6], v[7]);
        *(u32x4*)(WSm + ((size_t)lg * 512 + kr) * 256 + ncq * 8) = o;
    }
}
__device__ __forceinline__ void s5_gemm_s(const Ctx& c, int layer, int tile, unsigned char* lds) {
    const int nt = tile & 1, mt = (tile >> 1) % 5, g = tile / 10;
    const bf16* UH = c.w<bf16>(WS_UH) + (size_t)g * NCH5 * 768;
    f32x4 acc[4][4];
    const int bc = nt * 128 + (c.tid & 15) * 8;
    gemm_tile<false, 1>(c.tid, lds, UH, [&](int r) __attribute__((always_inline)) { int row = mt * 128 + r; row = row < NCH5 ? row : NCH5 - 1; return (unsigned)(row * 768); },
                     c.w<bf16>(WS_WS) + (size_t)(layer * 16 + g) * 512 * 256, (unsigned)bc, 256, true, 512, acc);
    EPI_COORDS;
    float* SALL = c.w<float>(WS_SALL) + (size_t)g * NCH5 * 256;
#pragma unroll
    for (int m = 0; m < 4; ++m)
#pragma unroll
        for (int n = 0; n < 4; ++n) {
            const int row = mt * 128 + wr * 64 + m * 16 + fr, col = nt * 128 + wc * 64 + n * 16 + fq * 4;
            if (row < NCH5) *(f32x4*)(SALL + (size_t)row * 256 + col) = acc[m][n];
        }
}
__device__ __forceinline__ void s5_recur(const Ctx& c, int layer, int gtid, int gthreads) {
    const float* S5P = c.w<float>(WS_S5P);
    for (int it = gtid; it < 4 * 16 * 2 * 64; it += gthreads) {
        const int p = it & 63, d = (it >> 6) & 1, g = (it >> 7) & 15, b = it >> 11;
        const int ldg = (layer * 2 + d) * 16 + g;
        const float ar = S5P[((size_t)(ldg * 64 + p) * 33 + 32) * 2], ai = S5P[((size_t)(ldg * 64 + p) * 33 + 32) * 2 + 1];
        const float* S = c.w<float>(WS_SALL) + ((size_t)g * NCH5 + b * 136) * 256 + d * 128 + p * 2;
        bf16* H = c.w<bf16>(WS_UH) + ((size_t)g * NCH5 + b * 136) * 768 + 512 + d * 128 + p * 2;
        float hr = 0.f, hi = 0.f;
#pragma unroll 1
        for (int s0 = 0; s0 < 136; s0 += 34) {
            f32x2 sv[34]; int jj[34];
#pragma unroll
            for (int i = 0; i < 34; ++i) { const int s = s0 + i; jj[i] = d == 0 ? s : (s < 8 ? 7 - s : 143 - s); sv[i] = *(const f32x2*)(S + (size_t)jj[i] * 256); }
#pragma unroll
            for (int i = 0; i < 34; ++i) {
                *(unsigned*)(H + (size_t)jj[i] * 768) = pk2bf(hr, hi);
                const float nr = ar * hr - ai * hi + sv[i][0], ni = ar * hi + ai * hr + sv[i][1]; hr = nr; hi = ni;
            }
        }
    }
}
__device__ __forceinline__ void s5_gemm_y(const Ctx& c, int layer, int tile, unsigned char* lds) {
    const int nt = tile & 3, mt = (tile >> 2) % 5, g = tile / 20;
    const bf16* UH = c.w<bf16>(WS_UH) + (size_t)g * NCH5 * 768;
    f32x4 acc[4][4];
    const int bc = nt * 128 + (c.tid & 15) * 8;
    gemm_tile<false, 1>(c.tid, lds, UH, [&](int r) __attribute__((always_inline)) { int row = mt * 128 + r; row = row < NCH5 ? row : NCH5 - 1; return (unsigned)(row * 768); },
                     c.w<bf16>(WS_WY) + (size_t)(layer * 16 + g) * 768 * 512, (unsigned)bc, 512, true, 768, acc);
    EPI_COORDS;
    bf16* G5 = c.w<bf16>(WS_G5);
#pragma unroll
    for (int m = 0; m < 4; ++m) {
        const int row = mt * 128 + wr * 64 + m * 16 + fr;
        if (row < NCH5) {
            const int b = row / 136, jj = row % 136;
#pragma unroll
            for (int n = 0; n < 4; ++n) {
                const int col = nt * 128 + wc * 64 + n * 16 + fq * 4, t = col >> 4, cc = col & 15;
                const size_t tok = (size_t)b * LT + jj * 32 + t;
                uint2 o; o.x = pk2bf(gelu_tanh(acc[m][n][0]), gelu_tanh(acc[m][n][1])); o.y = pk2bf(gelu_tanh(acc[m][n][2]), gelu_tanh(acc[m][n][3]));
                *(uint2*)(G5 + tok * 256 + g * 16 + cc) = o;
            }
        }
    }
}


__device__ __forceinline__ void ssd_dt_load(const Ctx& c, int b, int j, int h, float& r0, float& r1) {
    const float* DTR = c.w<float>(WS_DTR) + ((size_t)b * LT + j * 128 + (c.tid & 127)) * 8;
    r0 = DTR[h]; r1 = DTR[4 + h];
}
__device__ __forceinline__ void ssd_vectors(const Ctx& c, int layer, int h, float r0, float r1, float* vec) {
    const int tid = c.tid, lane = tid & 63;
    __syncthreads();
    float dtf = 0.f, dtr = 0.f, af = 0.f, ar = 0.f;
    if (tid < 128) {
        dtf = softplus_f(r0 + c.in(24)[(layer * 2 + 0) * 4 + h]);
        dtr = softplus_f(r1 + c.in(24)[(layer * 2 + 1) * 4 + h]);
        af = -dtf * expf(c.in(25)[(layer * 2 + 0) * 4 + h]); ar = -dtr * expf(c.in(25)[(layer * 2 + 1) * 4 + h]);
    }
    float sf = af, sr = ar;
#pragma unroll
    for (int o = 1; o < 64; o <<= 1) { const float tf = __shfl_up(sf, o), tr = __shfl_up(sr, o); if (lane >= o) { sf += tf; sr += tr; } }
    if (tid == 63) { vec[1026] = sf; vec[1027] = sr; }
    __syncthreads();
    if (tid >= 64 && tid < 128) { sf += vec[1026]; sr += vec[1027]; }
    if (tid == 127) { vec[1024] = sf; vec[1025] = sr; }
    __syncthreads();
    if (tid < 128) {
        const float totf = vec[1024], totr = vec[1025], cer = sr - ar;
        vec[tid] = dtf; vec[128 + tid] = dtr; vec[256 + tid] = sf; vec[384 + tid] = cer;
        vec[512 + tid] = dtf * __expf(totf - sf); vec[640 + tid] = dtr * __expf(cer);
        vec[768 + tid] = __expf(sf); vec[896 + tid] = __expf(totr - cer);
    }
    __syncthreads();
}
__device__ __forceinline__ void ssd_s1(const Ctx& c, int layer, int tile, unsigned char* lds) {
    const int h = tile & 3, j = (tile >> 2) % NCH, b = tile / (4 * NCH);
    float* vec = (float*)lds;
    const int tid = c.tid, lane = tid & 63, wid = tid >> 6, fr = lane & 15, fq = lane >> 4, grp = h >> 1;
    const bf16* XT = c.w<bf16>(WS_XT) + ((size_t)b * 256 + h * 64 + wid * 16 + fr) * LT + j * 128;
    const bf16* BT = c.w<bf16>(WS_BT) + ((size_t)b * 256 + grp * 128 + fr) * LT + j * 128;
    f32x4 acc[2][8];
#pragma unroll
    for (int d = 0; d < 2; ++d)
#pragma unroll
        for (int ns = 0; ns < 8; ++ns) acc[d][ns] = (f32x4){0.f, 0.f, 0.f, 0.f};
    float dr0, dr1; ssd_dt_load(c, b, j, h, dr0, dr1);
    u32x4 xraw[4];
#pragma unroll
    for (int kk = 0; kk < 4; ++kk) xraw[kk] = *(const u32x4*)(XT + 32 * kk + 8 * fq);
    bf16x8 bfr2[2][8];
    auto loadB = [&](int kk, bf16x8 (&dst)[8]) __attribute__((always_inline)) {
#pragma unroll
        for (int ns = 0; ns < 8; ++ns) dst[ns] = *(const bf16x8*)(BT + (size_t)ns * 16 * LT + 32 * kk + 8 * fq);
    };
    loadB(0, bfr2[0]);
    asm volatile("" ::: "memory");
    ssd_vectors(c, layer, h, dr0, dr1, vec);
    if (tid < 257) *(f32x4*)(c.w<float>(WS_VEC) + (size_t)((b * NCH + j) * 4 + h) * 1028 + tid * 4) = *(const f32x4*)(vec + tid * 4);
#pragma unroll
    for (int kk = 0; kk < 4; ++kk) {
        if (kk + 1 < 4) { loadB(kk + 1, bfr2[(kk + 1) & 1]); asm volatile("" ::: "memory"); }
        const bf16x8 (&bfr)[8] = bfr2[kk & 1];
        float xv[8], xa[8], xb[8];
        unpack8v(xraw[kk], xv);
        const f32x4 w0 = *(const f32x4*)(vec + 512 + 32 * kk + 8 * fq), w1 = *(const f32x4*)(vec + 512 + 32 * kk + 8 * fq + 4);
        const f32x4 r0 = *(const f32x4*)(vec + 640 + 32 * kk + 8 * fq), r1 = *(const f32x4*)(vec + 640 + 32 * kk + 8 * fq + 4);
#pragma unroll
        for (int i = 0; i < 4; ++i) { xa[i] = xv[i] * w0[i]; xa[4 + i] = xv[4 + i] * w1[i]; xb[i] = xv[i] * r0[i]; xb[4 + i] = xv[4 + i] * r1[i]; }
        const bf16x8 xf = pack8(xa), xr = pack8(xb);
#pragma unroll
        for (int ns = 0; ns < 8; ++ns) {
            acc[0][ns] = __builtin_amdgcn_mfma_f32_16x16x32_bf16(bfr[ns], xf, acc[0][ns], 0, 0, 0);
            acc[1][ns] = __builtin_amdgcn_mfma_f32_16x16x32_bf16(bfr[ns], xr, acc[1][ns], 0, 0, 0);
        }
    }
    const size_t sidx = (size_t)((b * NCH + j) * 4 + h) * 2;
    float* ST = c.w<float>(WS_ST);
#pragma unroll
    for (int d = 0; d < 2; ++d)
#pragma unroll
        for (int ns = 0; ns < 8; ++ns) *(f32x4*)(ST + ((sidx + d) * 64 + wid * 16 + fr) * 128 + ns * 16 + 4 * fq) = acc[d][ns];
    if (tid == 0) { float* TOT = c.w<float>(WS_TOT); TOT[sidx] = __expf(vec[1024]); TOT[sidx + 1] = __expf(vec[1025]); }
}
__device__ __forceinline__ void ssd_recur(const Ctx& c, int gtid, int gthreads) {
    const float* ST = c.w<float>(WS_ST); bf16* HIN = c.w<bf16>(WS_HIN); const float* TOT = c.w<float>(WS_TOT);
    for (int it = gtid; it < 4 * 4 * 2 * 64 * 32; it += gthreads) {
        const int n4 = it & 31, p = (it >> 5) & 63, d = (it >> 11) & 1, h = (it >> 12) & 3, b = it >> 14;
        f32x4 H = (f32x4){0.f, 0.f, 0.f, 0.f};
#pragma unroll 1
        for (int s0 = 0; s0 < NCH; s0 += 17) {
            f32x4 sv[17]; float tv[17];
#pragma unroll
            for (int i = 0; i < 17; ++i) { const int s = s0 + i, jj = d == 0 ? s : (s < 2 ? 1 - s : 35 - s);
                const size_t idx = (size_t)((b * NCH + jj) * 4 + h) * 2 + d;
                sv[i] = *(const f32x4*)(ST + (idx * 64 + p) * 128 + n4 * 4); tv[i] = TOT[idx]; }
#pragma unroll
            for (int i = 0; i < 17; ++i) { const int s = s0 + i, jj = d == 0 ? s : (s < 2 ? 1 - s : 35 - s);
                const size_t idx = (size_t)((b * NCH + jj) * 4 + h) * 2 + d;
                uint2 o; o.x = pk2bf(H[0], H[1]); o.y = pk2bf(H[2], H[3]);
                *(uint2*)(HIN + (idx * 64 + p) * 128 + n4 * 4) = o;
                H = H * tv[i] + sv[i]; }
        }
    }
}
constexpr int S3_XOFF = 4608, S3_ST = 272, S3_BOFF = GEMM_LDS + 2048, S3_LDS_END = S3_BOFF + 128 * S3_ST;
static_assert(S3_XOFF + 64 * S3_ST <= GEMM_LDS, "x image must stay below the control words");
__device__ __forceinline__ void ssd_s3(const Ctx& c, int layer, int tile, unsigned char* lds) {
    const int half = tile & 1, h = (tile >> 1) & 3, j = (tile >> 3) % NCH, b = tile / (8 * NCH);
    float* vec = (float*)lds;
    const int tid = c.tid, lane = tid & 63, wid = tid >> 6, fr = lane & 15, fq = lane >> 4, grp = h >> 1;
    const size_t tok0 = (size_t)b * LT + j * 128;
    const bf16* XS = c.w<bf16>(WS_XBCS) + tok0 * 768;
    const int l = 64 * half + 16 * wid + fr;
    const f32x4 vecr = *(const f32x4*)(c.w<float>(WS_VEC) + (size_t)((b * NCH + j) * 4 + h) * 1028 + (tid < 257 ? tid : 0) * 4);
    bf16x8 cf[4];
#pragma unroll
    for (int k = 0; k < 4; ++k) cf[k] = *(const bf16x8*)(XS + (size_t)l * 768 + 512 + grp * 128 + 32 * k + 8 * fq);
    const bf16* HIN = c.w<bf16>(WS_HIN) + (size_t)((b * NCH + j) * 4 + h) * 2 * 8192;
    bf16x8 hfr[4][4];
    auto loadH = [&](int d) __attribute__((always_inline)) {
#pragma unroll
        for (int k = 0; k < 4; ++k)
#pragma unroll
            for (int pt = 0; pt < 4; ++pt) hfr[k][pt] = *(const bf16x8*)(HIN + ((size_t)d * 64 + 16 * pt + fr) * 128 + 32 * k + 8 * fq);
    };
    loadH(0);
    u32x4 sb[8], sx[4];
    const bf16* XT = c.w<bf16>(WS_XT) + ((size_t)b * 256 + h * 64) * LT + j * 128;
#pragma unroll
    for (int i = 0; i < 8; ++i) { const int cc = tid + 256 * i; sb[i] = *(const u32x4*)(XS + (size_t)(cc >> 4) * 768 + 256 + grp * 128 + (cc & 15) * 8); }
#pragma unroll
    for (int i = 0; i < 4; ++i) { const int cc = tid + 256 * i; sx[i] = *(const u32x4*)(XT + (size_t)(cc >> 4) * LT + (cc & 15) * 8); }
    asm volatile("" ::: "memory");
    __syncthreads();
    if (tid < 257) *(f32x4*)(vec + tid * 4) = vecr;
#pragma unroll
    for (int i = 0; i < 8; ++i) { const int cc = tid + 256 * i; *(u32x4*)(lds + S3_BOFF + (cc >> 4) * S3_ST + (cc & 15) * 16) = sb[i]; }
#pragma unroll
    for (int i = 0; i < 4; ++i) { const int cc = tid + 256 * i; *(u32x4*)(lds + S3_XOFF + (cc >> 4) * S3_ST + (cc & 15) * 16) = sx[i]; }
    __syncthreads();
    const lds_cptr lb = (lds_cptr)lds + S3_BOFF + fr * S3_ST + fq * 16;
    const lds_cptr lx = (lds_cptr)lds + S3_XOFF + fr * S3_ST + fq * 8;
    f32x4 G[8];
#pragma unroll
    for (int sp = 0; sp < 8; ++sp) {
        G[sp] = (f32x4){0.f, 0.f, 0.f, 0.f};
#pragma unroll
        for (int k = 0; k < 4; ++k) { const bf16x8 bf = *(const LAS bf16x8*)(lb + sp * 16 * S3_ST + k * 64); G[sp] = __builtin_amdgcn_mfma_f32_16x16x32_bf16(bf, cf[k], G[sp], 0, 0, 0); }
    }
    {
        const float csf_l = vec[256 + l], cer_l = vec[384 + l];
#pragma unroll
        for (int st = 0; st < 8; ++st) {
            const int sb_ = 16 * st + 4 * fq;
            const f32x4 dtf_s = *(const f32x4*)(vec + sb_), dtr_s = *(const f32x4*)(vec + 128 + sb_), csf_s = *(const f32x4*)(vec + 256 + sb_), cer_s = *(const f32x4*)(vec + 384 + sb_);
#pragma unroll
            for (int jj = 0; jj < 4; ++jj) {
                const int s_ = sb_ + jj;
                float w = 0.f;
                if (s_ <= l) w += dtf_s[jj] * __expf(csf_l - csf_s[jj]);
                if (s_ >= l) w += dtr_s[jj] * __expf(cer_s[jj] - cer_l);
                G[st][jj] *= w;
            }
        }
    }
    f32x4 y[4];
#pragma unroll
    for (int pt = 0; pt < 4; ++pt) y[pt] = (f32x4){0.f, 0.f, 0.f, 0.f};
    auto inter = [&](int d) __attribute__((always_inline)) {
        const float e = vec[(d == 0 ? 768 : 896) + l];
        bf16x8 cs[4];
#pragma unroll
        for (int k = 0; k < 4; ++k) {
            float t8[8]; unpack8v(__builtin_bit_cast(u32x4, cf[k]), t8);
#pragma unroll
            for (int i = 0; i < 8; ++i) t8[i] *= e;
            cs[k] = pack8(t8);
        }
#pragma unroll
        for (int k = 0; k < 4; ++k)
#pragma unroll
            for (int pt = 0; pt < 4; ++pt) y[pt] = __builtin_amdgcn_mfma_f32_16x16x32_bf16(hfr[k][pt], cs[k], y[pt], 0, 0, 0);
    };
    inter(0);
    loadH(1);
    asm volatile("" ::: "memory");
#pragma unroll
    for (int kk = 0; kk < 4; ++kk) {
        float t8[8];
#pragma unroll
        for (int i = 0; i < 4; ++i) { t8[i] = G[2 * kk][i]; t8[4 + i] = G[2 * kk + 1][i]; }
        const bf16x8 pf = pack8(t8);
#pragma unroll
        for (int pt = 0; pt < 4; ++pt) {
            const lds_cptr xp = lx + pt * 16 * S3_ST + kk * 64;
            const s16x4 xlo = *(const LAS s16x4*)xp, xhi = *(const LAS s16x4*)(xp + 32);
            const bf16x8 xf = (bf16x8){xlo[0], xlo[1], xlo[2], xlo[3], xhi[0], xhi[1], xhi[2], xhi[3]};
            y[pt] = __builtin_amdgcn_mfma_f32_16x16x32_bf16(xf, pf, y[pt], 0, 0, 0);
        }
    }
    inter(1);
    float* Y = c.w<float>(WS_YSSD) + tok0 * 256;
#pragma unroll
    for (int pt = 0; pt < 4; ++pt) *(f32x4*)(Y + (size_t)l * 256 + h * 64 + 16 * pt + 4 * fq) = y[pt];
}

__device__ __forceinline__ void ph_mix1(Ctx& c, int layer, int bid, int G, unsigned char* lds, const volatile unsigned* rolew) {
    const unsigned* ctl = c.w<unsigned>(WS_CTL);
    int role = __builtin_amdgcn_readfirstlane((int)rolew[0]), idx = __builtin_amdgcn_readfirstlane((int)rolew[1]);
    int nheavy = __builtin_amdgcn_readfirstlane((int)__hip_atomic_load(ctl + CW_NROLE, __ATOMIC_RELAXED, __HIP_MEMORY_SCOPE_AGENT)), nlight = __builtin_amdgcn_readfirstlane((int)__hip_atomic_load(ctl + CW_NROLE + 64, __ATOMIC_RELAXED, __HIP_MEMORY_SCOPE_AGENT));
    if (nheavy < 1 || nlight < 1 || nheavy + nlight != G) {
        nheavy = G / 2; nlight = G - nheavy; role = bid < nheavy ? 0 : 1; idx = role ? bid - nheavy : bid;
    }
    constexpr int CVT_H = CVT_MOE_TILES / 4;
    unsigned* l1done = c.w<unsigned>(WS_CTL) + CW_L1 + layer * 16;
    if (role == 0) {
        for (int t = idx; t < 512; t += nheavy) { asm volatile("" : "+v"(c.tid)); asm volatile("" : "+s"(c.p)); PR_BEGIN(130); attn_tile<0>(c, layer, t, lds); PR_END(130); }
        for (int t = idx; t < CVT_H; t += nheavy) { asm volatile("" : "+v"(c.tid)); asm volatile("" : "+s"(c.p)); PR_BEGIN(131); cvt_moe(c, layer, t); PR_END(131); }
        asm volatile("" : "+v"(c.tid)); asm volatile("" : "+s"(c.p));
        if (c.tid == 0) {
            unsigned sp = 0u;
            while ((int)__hip_atomic_load(l1done, __ATOMIC_RELAXED, __HIP_MEMORY_SCOPE_AGENT) < nlight) { __builtin_amdgcn_s_sleep(2); if (++sp > (1u << 22)) break; }
            __builtin_amdgcn_fence(__ATOMIC_ACQUIRE, "agent");
        }
        __syncthreads();
        const int gt = idx * NTHR + c.tid, gth = nheavy * NTHR;
        ssd_recur(c, gt, gth);
        s5_recur(c, layer, gth >= 65536 ? (gt >= 32768 ? gt - 32768 : gt + gth - 32768) : gt, gth);
        return;
    }
    for (int t = idx; t < 704; t += nlight) {
        asm volatile("" : "+v"(c.tid)); asm volatile("" : "+s"(c.p));
        if (t < 544) { PR_BEGIN(132); ssd_s1(c, layer, t, lds); PR_END(132); }
        else s5_gemm_s(c, layer, t - 544, lds);
    }
    asm volatile("s_waitcnt vmcnt(0)" ::: "memory");
    __syncthreads();
    if (c.tid == 0) { __builtin_amdgcn_fence(__ATOMIC_RELEASE, "agent"); asm volatile("s_waitcnt vmcnt(0)" ::: "memory"); (void)__hip_atomic_fetch_add(l1done, 1u, __ATOMIC_RELAXED, __HIP_MEMORY_SCOPE_AGENT); }
    for (int t = idx; t < 576 + (CVT_MOE_TILES - CVT_H); t += nlight) {
        asm volatile("" : "+v"(c.tid)); asm volatile("" : "+s"(c.p));
        if (t < 576) { PR_BEGIN(134); attn_tile<-1>(c, layer, t + 512, lds); PR_END(134); }
        else { PR_BEGIN(131); cvt_moe(c, layer, CVT_H + t - 576); PR_END(131); }
    }
}

constexpr int PH_PER_LAYER = 9, N_PHASES = 2 + 2 * PH_PER_LAYER;

__global__ void __launch_bounds__(NTHR, 2) mk_fwd(Params prm) {
    __shared__ __attribute__((aligned(16))) unsigned char smem_raw[S3_LDS_END];
    float* smem = (float*)(smem_raw + GEMM_LDS);
    Ctx c; c.p = (const CAS Params*)__builtin_amdgcn_kernarg_segment_ptr(); c.smf = smem; c.tid = threadIdx.x;
    const int G = gridDim.x, bid = blockIdx.x;
    const int gthreads = G * NTHR, nwaves = gthreads >> 6;
#define gtid (bid * NTHR + c.tid)
#define gw ((bid * NTHR + c.tid) >> 6)
    int* smi = (int*)(smem + 16);
#if MK_SINGLE
    volatile unsigned* bst = (volatile unsigned*)(smem + 120);
    if (c.tid == 0) { bst[0] = 0u; bst[1] = 0u; }
    __syncthreads();
    XcdBarrier bar = xcd_barrier_post(c.w<unsigned>(WS_CTL) + CW_BAR, bst);
    if (c.tid == 0) {
        unsigned* ctl = c.w<unsigned>(WS_CTL);
        const unsigned key = (xb_xcc_id() << 8) | ((unsigned)__builtin_amdgcn_s_getreg((7 << 11) | (8 << 6) | 4) & 0xFFu);
        const unsigned prev = xb_add(&ctl[CW_CUKEY + key], 1u);
        const unsigned role = prev & 1u;
        const unsigned idx = xb_add(&ctl[CW_NROLE + 64 * role], 1u);
        ((volatile unsigned*)smem)[100] = role; ((volatile unsigned*)smem)[101] = idx;
    }
#endif
    unsigned long long pr_t0 = 0ull; c.pracc = 0ull; c.prt = 0ull;
#define pr_acc c.pracc
#if MK_SINGLE
    if (PROBE_SP == 102) { pr_t0 = __builtin_amdgcn_s_memrealtime(); xcd_barrier(bar); pr_acc += __builtin_amdgcn_s_memrealtime() - pr_t0; }
#endif
    for (int ph = prm.ph_lo; ph < prm.ph_hi; ++ph) {
        if (PROBE_SP >= 0) pr_t0 = __builtin_amdgcn_s_memrealtime();
        asm volatile("" : "+s"(c.p));
        { int t_ = threadIdx.x; asm volatile("" : "+v"(t_)); c.tid = t_; }
        if (ph == 0) {
            const bool split = G >= 384;
            const int g2 = split ? (bid >= 256 ? gtid - 65536 : 0x3fffffff) : gtid, gth2 = split ? gthreads - 65536 : gthreads;
            ph_prep(c, g2, gth2, bid, G, (float*)smem_raw); PR_BEGIN(124); cvt_small(c, g2, gth2); PR_END(124); }
        else if (ph == 1) ph_norm1(c, 0, gw, nwaves, smem_raw);
        else {
            const int layer = (ph - 2) / PH_PER_LAYER, sp = (ph - 2) % PH_PER_LAYER;
            switch (sp) {
            case 0: for (int t = bid; t < 136 * 18 + (layer == 0 ? 5120 : 0); t += G) { asm volatile("" : "+v"(c.tid)); if (t < 136 * 18) ph_inproj_mfma(c, layer, t, smem_raw); else ph_prepB(c, t - 136 * 18); } break;
            case 1: for (int t = bid; t < (NT / 32) * 3; t += G) { asm volatile("" : "+v"(c.tid)); asm volatile("" : "+s"(c.p)); MpRegs mpr; mp_load(c, t, mpr); ph_minipost(c, layer, t, -1, mpr, smem_raw); } break;
            case 2: ph_mix1(c, layer, bid, G, smem_raw, (const volatile unsigned*)smem + 100); break;
            case 3: for (int t = bid; t < 1088 + 320; t += G) { asm volatile("" : "+v"(c.tid)); asm volatile("" : "+s"(c.p)); if (t < 1088) ssd_s3(c, layer, t, smem_raw); else s5_gemm_y(c, layer, t - 1088, smem_raw); } break;
            case 4: if (G > 272 + 64) {
                        if (bid < 272) ph_glu_mfma(c, layer, bid, smem_raw);
                        else for (int t = bid - 272; t < NT / 32; t += G - 272) { asm volatile("" : "+v"(c.tid)); ph_gates(c, layer, t); }
                    } else for (int t = bid; t < 136 * 2 + NT / 32; t += G) { asm volatile("" : "+v"(c.tid)); if (t < 136 * 2) ph_glu_mfma(c, layer, t, smem_raw); else ph_gates(c, layer, t - 136 * 2); }
                    break;
            case 5: for (int t = bid; t < 136 * 8; t += G) ph_outproj_mfma(c, layer, t, smem_raw); break;
            case 6: ph_norm2(c, layer, bid, G, smem_raw, (int*)(smem_raw + GEMM_LDS + 512)); break;
            case 7: { moe_offsets(c, layer, smi);
                      const int n1v = (__builtin_amdgcn_readfirstlane(((const LAS int*)smi)[32]) >> 7) * 8;
                      for (int t = bid; t < 2 * n1v; t += G) { asm volatile("" : "+v"(c.tid)); asm volatile("" : "+s"(c.p)); if (t < n1v) ph_moe1_mfma(c, layer, t, smi, smem_raw); else ph_moe2_mfma(c, layer, t - n1v, smi, smem_raw); } } break;
            case 8: moe_offsets(c, layer, smi); ph_combine(c, layer, bid, G, smi, smem_raw); break;
            }
        }
#if MK_SINGLE
        if (ph + 1 < prm.ph_hi) xcd_barrier(bar);
#endif
        if (PROBE_SP >= 0 && ((PROBE_SP < 100 && ph >= 2 && (ph - 2) % PH_PER_LAYER == PROBE_SP) || (PROBE_SP == 100 && ph == 0) || (PROBE_SP == 101 && ph == 1))) pr_acc += __builtin_amdgcn_s_memrealtime() - pr_t0;
    }
#if MK_SINGLE
    if (PROBE_SP == 200) { for (int i = 0; i < 16; ++i) xcd_barrier(bar); }
#endif
    if (PROBE_SP >= 0 && PROBE_SP < 200 && bid == 0 && c.tid == 0) { const unsigned long long t1 = __builtin_amdgcn_s_memrealtime(); while (__builtin_amdgcn_s_memrealtime() - t1 < 8ull * pr_acc) __builtin_amdgcn_s_sleep(8); }
}
}

extern "C" void kernel_launch(void* const* d_in, const int* in_sizes, int n_in, void* d_out, int out_size, void* d_ws, size_t ws_size, hipStream_t stream) {
    static int grid = 0;
    if (grid == 0) {
        if (n_in != 37 || ws_size < WS_END) { fprintf(stderr, "kernel_launch: need 37 inputs and %zu bytes of workspace; got %d, %zu\n", (size_t)WS_END, n_in, ws_size); grid = -1; return; }
        int dev = 0, cus = 0, per_cu = 0;
        hipGetDevice(&dev); hipDeviceGetAttribute(&cus, hipDeviceAttributeMultiprocessorCount, dev);
        if (hipOccupancyMaxActiveBlocksPerMultiprocessor(&per_cu, (const void*)mk_fwd, NTHR, 0) != hipSuccess || per_cu < 1) per_cu = 1;
        if (per_cu > 4) per_cu = 4;
        grid = cus * per_cu;
    }
    if (grid < 0) return;
    hipMemsetAsync((char*)d_ws + WS_CTL, 0, CTL_BYTES, stream);
    Params p{};
    for (int i = 0; i < 37; ++i) p.in[i] = (const float*)d_in[i];
    p.out = (float*)d_out; p.ws = (unsigned char*)d_ws;
#if MK_SINGLE
    p.ph_lo = 0; p.ph_hi = N_PHASES;
    void* args[] = {&p};
    hipError_t e = hipLaunchCooperativeKernel((const void*)mk_fwd, dim3(grid), dim3(NTHR), args, 0, stream);
    if (e != hipSuccess) fprintf(stderr, "cooperative launch failed: %s (grid %d)\n", hipGetErrorString(e), grid);
#else
    for (int ph = 0; ph < N_PHASES; ++ph) {
        p.ph_lo = ph; p.ph_hi = ph + 1;
        hipLaunchKernelGGL(mk_fwd, dim3(grid), dim3(NTHR), 0, stream, p);
    }
#endif
}
```
